# Optimizing an MI355X kernel written in HIP

```python
import math
import jax
import jax.numpy as jnp
from jax import lax
import numpy as np

D_MODEL = 1024
BATCH = 8
SEQ = 4096
DEPTH = 1

MIX_WIDTH = D_MODEL
HYENA_WIDTH = MIX_WIDTH // 2
HYENA_ORDER = 2
HYENA_GROUPS = 8
SHORT_CONV_WIDTH = 3
FILTER_EMB_DIM = 33
FILTER_BANDS = (FILTER_EMB_DIM - 1) // 2
FILTER_HIDDEN = 64
DECAY_TARGET = 1e-2
FAST_DECAY_PCT = 0.3
SLOW_DECAY_PCT = 1.5
ATTN_WIDTH = MIX_WIDTH - HYENA_WIDTH
ATTN_HEADS = 4
ATTN_HEAD_DIM = ATTN_WIDTH // (2 * ATTN_HEADS)
Q_BLOCK = 128
HYENA_COLS = (HYENA_ORDER + 1) * HYENA_WIDTH
IN_COLS = HYENA_COLS + 3 * ATTN_WIDTH
N_EXPERTS = 16
EC_CAPACITY_FACTOR = 2
EXPERT_FF = 2816
NORM_EPS = 1e-6

kernel_name = 'hymba_hyena_diffattn_ec_block'


def _rmsnorm(x, g):
    xf = x.astype(jnp.float32)
    y = xf * lax.rsqrt(jnp.mean(xf * xf, axis=-1, keepdims=True) + NORM_EPS)
    return (y * g.astype(jnp.float32)).astype(x.dtype)


def _alibi_slopes(n):
    return jnp.asarray([2.0 ** (-8.0 * (i + 1) / n) for i in range(n)], dtype=jnp.float32)


def _hyena_filters(L, w1, b1, w2, b2, w3, freq):
    f32 = jnp.float32
    t = jnp.linspace(0.0, 1.0, L, dtype=f32)[:, None]
    w = 2.0 * math.pi * jnp.arange(L, dtype=f32)[:, None] / L
    bands = jnp.linspace(1e-4, FILTER_BANDS - 1, FILTER_BANDS, dtype=f32)[None, :]
    z = jnp.concatenate([t, jnp.cos(bands * w), -jnp.sin(bands * w)], axis=-1)
    fr = freq.astype(f32)
    hid = jnp.sin(fr * (z @ w1.astype(f32) + b1.astype(f32)))
    hid = jnp.sin(fr * (hid @ w2.astype(f32) + b2.astype(f32)))
    h = (hid @ w3.astype(f32)).reshape(L, 2, HYENA_ORDER, HYENA_WIDTH)
    min_decay = math.log(DECAY_TARGET) / SLOW_DECAY_PCT
    max_decay = math.log(DECAY_TARGET) / FAST_DECAY_PCT
    deltas = jnp.abs(jnp.linspace(min_decay, max_decay, HYENA_WIDTH, dtype=f32))
    h = h * jnp.exp(-t[:, :, None, None] * deltas)
    fwd, bwd = h[:, 0], h[:, 1]
    k = jnp.concatenate([fwd, jnp.zeros((1, HYENA_ORDER, HYENA_WIDTH), f32), bwd[:0:-1]], axis=0)
    return k / jnp.sum(jnp.abs(k), axis=0, keepdims=True)


def _fft_conv(u, k_freq, L):
    uf = jnp.fft.rfft(u, n=2 * L, axis=1)
    return jnp.fft.irfft(uf * k_freq[None], n=2 * L, axis=1)[:, :L]


def _hyena_mixer(proj, conv_w, conv_b, w1, b1, w2, b2, w3, freq, skip, norm_g):
    B, L, _ = proj.shape
    pad = SHORT_CONV_WIDTH // 2
    up = jnp.pad(proj, ((0, 0), (pad, pad), (0, 0)))
    u = conv_b
    for j in range(SHORT_CONV_WIDTH):
        u = u + up[:, j:j + L] * conv_w[j]
    x1, x2, v = jnp.split(u, HYENA_ORDER + 1, axis=-1)
    k_freq = jnp.fft.rfft(_hyena_filters(L, w1, b1, w2, b2, w3, freq), axis=0)
    skip = skip.astype(jnp.float32)
    z = v.astype(jnp.float32)
    for n, gate in enumerate((x1, x2)):
        z = gate.astype(jnp.float32) * (_fft_conv(z, k_freq[:, n], L) + skip[n] * z)
    z = z.reshape(B, L, HYENA_GROUPS, HYENA_WIDTH // HYENA_GROUPS)
    z = _rmsnorm(z, norm_g.reshape(HYENA_GROUPS, HYENA_WIDTH // HYENA_GROUPS))
    return z.reshape(B, L, HYENA_WIDTH).astype(proj.dtype)


def _diff_attention(q, k, v, lam, lam_init, subln_g):
    B, L, _ = q.shape
    H, Dh = ATTN_HEADS, ATTN_HEAD_DIM
    q = q.reshape(B, L, H, 2, Dh)
    k = k.reshape(B, L, H, 2, Dh)
    v = v.reshape(B, L, H, 2 * Dh)
    scale = Dh ** -0.5
    slopes = _alibi_slopes(H)
    nb = L // Q_BLOCK
    qb = q.reshape(B, nb, Q_BLOCK, H, 2, Dh).transpose(1, 0, 2, 3, 4, 5)
    starts = jnp.arange(nb, dtype=jnp.int32) * Q_BLOCK
    kpos = jnp.arange(L, dtype=jnp.float32)

    def block(args):
        qblk, s0 = args
        qpos = (s0 + jnp.arange(Q_BLOCK, dtype=jnp.int32)).astype(jnp.float32)
        dist = jnp.abs(qpos[:, None] - kpos[None, :])
        s = jnp.einsum('bqhcd,bkhcd->bhcqk', qblk, k).astype(jnp.float32) * scale
        s = s - slopes[None, :, None, None, None] * dist
        p = jax.nn.softmax(s, axis=-1)
        a = p[:, :, 0] - lam * p[:, :, 1]
        return jnp.einsum('bhqk,bkhe->bqhe', a.astype(v.dtype), v)

    o = lax.map(block, (qb, starts))
    o = o.transpose(1, 0, 2, 3, 4).reshape(B, L, H, 2 * Dh)
    o = _rmsnorm(o, subln_g) * (1.0 - lam_init)
    return o.reshape(B, L, H * 2 * Dh).astype(q.dtype)


def _expert_choice_ffn(h, w_router, w_gate, w_up, w_down):
    B, L, _ = h.shape
    cap = EC_CAPACITY_FACTOR * L // N_EXPERTS
    logits = jnp.einsum('bsd,de->bse', h, w_router).astype(jnp.float32)
    aff = jax.nn.softmax(logits, axis=-1)
    g, idx = lax.top_k(aff.transpose(2, 0, 1), cap)
    bi = jnp.arange(B, dtype=jnp.int32)[None, :, None]
    xin = h[bi, idx]

    def expert(args):
        xe, wg, wu, wd = args
        a = jnp.einsum('bcd,df->bcf', xe, wg)
        u = jnp.einsum('bcd,df->bcf', xe, wu)
        return jnp.einsum('bcf,fd->bcd', jax.nn.silu(a) * u, wd)

    out = lax.map(expert, (xin, w_gate, w_up, w_down))
    out = out * g[..., None].astype(out.dtype)
    return jnp.zeros_like(h).at[bi, idx].add(out)


def setup_inputs(seed: int = 0) -> dict:
    key = jax.random.key(seed)
    ks = jax.random.split(key, 25)
    f32 = jnp.float32

    def nrm(k, shape, scale):
        return jax.random.normal(k, shape, f32) * scale

    D, E, F = D_MODEL, N_EXPERTS, EXPERT_FF
    return {
        'x': nrm(ks[0], (BATCH, SEQ, D), 1.0),
        'attn_norm_g': 1.0 + nrm(ks[1], (DEPTH, D), 0.02),
        'w_in': nrm(ks[2], (DEPTH, D, IN_COLS), D ** -0.5),
        'conv_w': nrm(ks[3], (DEPTH, SHORT_CONV_WIDTH, HYENA_COLS), SHORT_CONV_WIDTH ** -0.5),
        'conv_b': nrm(ks[4], (DEPTH, HYENA_COLS), 0.02),
        'filt_w1': nrm(ks[5], (DEPTH, FILTER_EMB_DIM, FILTER_HIDDEN), FILTER_EMB_DIM ** -0.5),
        'filt_b1': nrm(ks[6], (DEPTH, FILTER_HIDDEN), 0.1),
        'filt_w2': nrm(ks[7], (DEPTH, FILTER_HIDDEN, FILTER_HIDDEN), FILTER_HIDDEN ** -0.5),
        'filt_b2': nrm(ks[8], (DEPTH, FILTER_HIDDEN), 0.1),
        'filt_w3': nrm(ks[9], (DEPTH, FILTER_HIDDEN, 2 * HYENA_ORDER * HYENA_WIDTH), FILTER_HIDDEN ** -0.5),
        'filt_freq': 1.0 + nrm(ks[10], (DEPTH, FILTER_HIDDEN), 0.1),
        'hyena_skip': nrm(ks[11], (DEPTH, HYENA_ORDER, HYENA_WIDTH), 1.0),
        'hyena_norm_g': 1.0 + nrm(ks[12], (DEPTH, HYENA_WIDTH), 0.02),
        'lambda_q1': nrm(ks[13], (DEPTH, ATTN_HEAD_DIM), 0.1),
        'lambda_k1': nrm(ks[14], (DEPTH, ATTN_HEAD_DIM), 0.1),
        'lambda_q2': nrm(ks[15], (DEPTH, ATTN_HEAD_DIM), 0.1),
        'lambda_k2': nrm(ks[16], (DEPTH, ATTN_HEAD_DIM), 0.1),
        'subln_g': 1.0 + nrm(ks[17], (DEPTH, 2 * ATTN_HEAD_DIM), 0.02),
        'w_out': nrm(ks[18], (DEPTH, MIX_WIDTH, D), MIX_WIDTH ** -0.5),
        'ffn_norm_g': 1.0 + nrm(ks[19], (DEPTH, D), 0.02),
        'w_router': nrm(ks[20], (DEPTH, D, E), D ** -0.5),
        'w_gate': nrm(ks[21], (DEPTH, E, D, F), D ** -0.5),
        'w_up': nrm(ks[22], (DEPTH, E, D, F), D ** -0.5),
        'w_down': nrm(ks[23], (DEPTH, E, F, D), F ** -0.5),
        'final_norm_g': 1.0 + nrm(ks[24], (D,), 0.02),
    }


def reference(x, attn_norm_g, w_in, conv_w, conv_b, filt_w1, filt_b1, filt_w2, filt_b2,
              filt_w3, filt_freq, hyena_skip, hyena_norm_g, lambda_q1, lambda_k1,
              lambda_q2, lambda_k2, subln_g, w_out, ffn_norm_g, w_router, w_gate, w_up,
              w_down, final_norm_g):
    f32 = jnp.float32
    for l in range(DEPTH):
        hn = _rmsnorm(x, attn_norm_g[l])
        proj = jnp.einsum('bsd,dn->bsn', hn, w_in[l])
        hy = _hyena_mixer(proj[..., :HYENA_COLS], conv_w[l], conv_b[l], filt_w1[l], filt_b1[l],
                          filt_w2[l], filt_b2[l], filt_w3[l], filt_freq[l], hyena_skip[l],
                          hyena_norm_g[l])
        q, k, v = jnp.split(proj[..., HYENA_COLS:], 3, axis=-1)
        lam_init = 0.8 - 0.6 * math.exp(-0.3 * l)
        lam = (jnp.exp(jnp.sum(lambda_q1[l].astype(f32) * lambda_k1[l].astype(f32)))
               - jnp.exp(jnp.sum(lambda_q2[l].astype(f32) * lambda_k2[l].astype(f32)))
               + lam_init)
        at = _diff_attention(q, k, v, lam, lam_init, subln_g[l])
        mix = jnp.concatenate([hy, at], axis=-1)
        x = x + jnp.einsum('bsm,md->bsd', mix, w_out[l])
        x = x + _expert_choice_ffn(_rmsnorm(x, ffn_norm_g[l]), w_router[l], w_gate[l],
                                   w_up[l], w_down[l])
    return _rmsnorm(x, final_norm_g)
```

```cpp
#include <hip/hip_runtime.h>
#include <hip/hip_bf16.h>
#include <stdint.h>
#include <string.h>

typedef short bf16x8 __attribute__((ext_vector_type(8)));
typedef float f32x4 __attribute__((ext_vector_type(4)));

constexpr int DM = 1024, NB = 8, SEQ = 4096, NTOK = NB * SEQ;
constexpr int HW = 512, HCOLS = 1536, INC = 3072;
constexpr int NE = 16, CAP = 512, FF = 2816;
constexpr float EPS = 1e-6f;

__device__ __forceinline__ unsigned short f2bf(float f) { unsigned u = __float_as_uint(f); return (unsigned short)((u + 0x7fffu + ((u >> 16) & 1u)) >> 16); }
__device__ __forceinline__ float wave_sum(float v) {
#pragma unroll
    for (int o = 1; o < 64; o <<= 1) v += __shfl_xor(v, o);
    return v;
}

__global__ __launch_bounds__(512) void k_rmsnorm(const float* x, const float* g, float* out, int rows) {
    int w = (blockIdx.x * 512 + threadIdx.x) >> 6, lane = threadIdx.x & 63;
    if (w >= rows) return;
    const float4* xr = (const float4*)(x + (size_t)w * DM) + lane;
    float4 v[4]; float s = 0.f;
#pragma unroll
    for (int j = 0; j < 4; ++j) { v[j] = xr[64 * j]; s += v[j].x * v[j].x + v[j].y * v[j].y + v[j].z * v[j].z + v[j].w * v[j].w; }
    float r = rsqrtf(wave_sum(s) * (1.f / DM) + EPS);
    float4* o = (float4*)(out + (size_t)w * DM) + lane;
#pragma unroll
    for (int j = 0; j < 4; ++j) { float4 gg = ((const float4*)g)[lane + 64 * j]; o[64 * j] = make_float4(v[j].x * r * gg.x, v[j].y * r * gg.y, v[j].z * r * gg.z, v[j].w * r * gg.w); }
}

struct GemmP { const float* A; int lda; const int* arow; const float* Bm; int ldb; float* C; int ldc; int M, N, K; int mode; const float* R; const int* crow; const float* cscale; };
__global__ __launch_bounds__(512) void k_gemm(GemmP p) {
    __shared__ __attribute__((aligned(16))) unsigned short As[128][40];
    __shared__ __attribute__((aligned(16))) unsigned short Bs[64][40];
    const int tid = threadIdx.x, lane = tid & 63, w = tid >> 6, wm = w >> 1, wn = w & 1;
    const int nN = p.N / 64, bm = blockIdx.x / nN, bn = blockIdx.x % nN, m0 = bm * 128, n0 = bn * 64;
    f32x4 acc[2][2];
#pragma unroll
    for (int i = 0; i < 2; ++i)
#pragma unroll
        for (int j = 0; j < 2; ++j) acc[i][j] = (f32x4){0.f, 0.f, 0.f, 0.f};
    const int ar = tid >> 2, ak = (tid & 3) * 8;
    const int arg = p.arow ? p.arow[m0 + ar] : (m0 + ar);
    const float* ap = p.A + (size_t)arg * p.lda + ak;
    const int bk = tid >> 4, bn4 = (tid & 15) * 4;
    const float* bp = p.Bm + (size_t)bk * p.ldb + n0 + bn4;
    for (int k0 = 0; k0 < p.K; k0 += 32) {
        float4 a0 = *(const float4*)(ap + k0), a1 = *(const float4*)(ap + k0 + 4);
        float4 b0 = *(const float4*)(bp + (size_t)k0 * p.ldb);
        __syncthreads();
        uint4 pa; pa.x = f2bf(a0.x) | ((unsigned)f2bf(a0.y) << 16); pa.y = f2bf(a0.z) | ((unsigned)f2bf(a0.w) << 16);
        pa.z = f2bf(a1.x) | ((unsigned)f2bf(a1.y) << 16); pa.w = f2bf(a1.z) | ((unsigned)f2bf(a1.w) << 16);
        *(uint4*)&As[ar][ak] = pa;
        Bs[bn4 + 0][bk] = f2bf(b0.x); Bs[bn4 + 1][bk] = f2bf(b0.y); Bs[bn4 + 2][bk] = f2bf(b0.z); Bs[bn4 + 3][bk] = f2bf(b0.w);
        __syncthreads();
        bf16x8 af[2], bfr[2];
#pragma unroll
        for (int i = 0; i < 2; ++i) af[i] = *(const bf16x8*)&As[wm * 32 + i * 16 + (lane & 15)][(lane >> 4) * 8];
#pragma unroll
        for (int j = 0; j < 2; ++j) bfr[j] = *(const bf16x8*)&Bs[wn * 32 + j * 16 + (lane & 15)][(lane >> 4) * 8];
#pragma unroll
        for (int i = 0; i < 2; ++i)
#pragma unroll
            for (int j = 0; j < 2; ++j) acc[i][j] = __builtin_amdgcn_mfma_f32_16x16x32_bf16(af[i], bfr[j], acc[i][j], 0, 0, 0);
    }
#pragma unroll
    for (int i = 0; i < 2; ++i)
#pragma unroll
        for (int j = 0; j < 2; ++j)
#pragma unroll
            for (int r = 0; r < 4; ++r) {
                const int row = m0 + wm * 32 + i * 16 + (lane >> 4) * 4 + r, col = n0 + wn * 32 + j * 16 + (lane & 15);
                const float v = acc[i][j][r];
                if (p.mode == 0) p.C[(size_t)row * p.ldc + col] = v;
                else if (p.mode == 1) p.C[(size_t)row * p.ldc + col] = p.R[(size_t)row * p.ldc + col] + v;
                else { const size_t o = (size_t)p.crow[row] * p.ldc + col; p.C[o] = p.C[o] + p.cscale[row] * v; }
            }
}

__global__ __launch_bounds__(64) void k_filt_hid(const float* w1, const float* b1, const float* w2, const float* b2, const float* fr, float* hid2) {
    __shared__ float z[33]; __shared__ float h1[64];
    const int i = blockIdx.x, j = threadIdx.x;
    if (j < 33) {
        const float t = (float)i / (float)(SEQ - 1);
        const float w = 6.283185307179586f * (float)i / (float)SEQ;
        float v;
        if (j == 0) v = t;
        else { const int q = (j - 1) & 15; const float band = 1e-4f + (float)q * ((15.f - 1e-4f) / 15.f); v = (j <= 16) ? cosf(band * w) : -sinf(band * w); }
        z[j] = v;
    }
    __syncthreads();
    float a = b1[j];
    for (int k = 0; k < 33; ++k) a += z[k] * w1[k * 64 + j];
    h1[j] = sinf(fr[j] * a);
    __syncthreads();
    float c = b2[j];
    for (int k = 0; k < 64; ++k) c += h1[k] * w2[k * 64 + j];
    hid2[i * 64 + j] = sinf(fr[j] * c);
}
__global__ __launch_bounds__(256) void k_filt_h(const float* hid2, const float* w3, float* Kf, float* normsum) {
    const int col = blockIdx.x * 256 + threadIdx.x;
    const int i0 = blockIdx.y * 64;
    const int dir = col >> 10, n = (col >> 9) & 1, c = col & 511;
    float wc[64];
#pragma unroll
    for (int k = 0; k < 64; ++k) wc[k] = w3[k * 2048 + col];
    const float mind = logf(1e-2f) / 1.5f, maxd = logf(1e-2f) / 0.3f;
    const float delta = fabsf(mind + (float)c * ((maxd - mind) / 511.f));
    float asum = 0.f;
    for (int i = i0; i < i0 + 64; ++i) {
        float h = 0.f;
#pragma unroll
        for (int k = 0; k < 64; ++k) h += hid2[i * 64 + k] * wc[k];
        const float t = (float)i / (float)(SEQ - 1);
        h *= expf(-t * delta);
        if (dir == 0) { Kf[((size_t)(n * 512 + c)) * 8192 + 4096 + i] = h; asum += fabsf(h); }
        else if (i > 0) { Kf[((size_t)(n * 512 + c)) * 8192 + 4096 - i] = h; asum += fabsf(h); }
    }
    atomicAdd(&normsum[n * 512 + c], asum);
}

__global__ __launch_bounds__(512) void k_hyena(const float* proj, const float* conv_w, const float* conv_b, const float* Kf, const float* normsum,
                                               const float* skip, float* z2) {
    extern __shared__ __attribute__((aligned(16))) float sm[];
    float* zb = sm; float* z1b = sm + 4096; float* fb = sm + 8192;
    const int b = blockIdx.x >> 9, c = blockIdx.x & 511, tid = threadIdx.x;
    const float* pb = proj + (size_t)b * SEQ * INC;
    auto convcol = [&](int col, int t) -> float {
        float v = conv_b[col] + conv_w[1 * HCOLS + col] * pb[(size_t)t * INC + col];
        if (t > 0) v += conv_w[0 * HCOLS + col] * pb[(size_t)(t - 1) * INC + col];
        if (t < SEQ - 1) v += conv_w[2 * HCOLS + col] * pb[(size_t)(t + 1) * INC + col];
        return v;
    };
    for (int t = tid; t < SEQ; t += 512) zb[t] = convcol(1024 + c, t);
    for (int n = 0; n < 2; ++n) {
        const float inv = 1.f / normsum[n * 512 + c];
        __syncthreads();
        for (int e = tid; e < 8192; e += 512) fb[e] = (e == 0) ? 0.f : Kf[((size_t)(n * 512 + c)) * 8192 + e] * inv;
        __syncthreads();
        const float* zin = n == 0 ? zb : z1b;
        const int t0 = tid * 8;
        float y[8];
#pragma unroll
        for (int j = 0; j < 8; ++j) y[j] = 0.f;
        for (int s = 0; s < SEQ; ++s) {
            const float zs = zin[s]; const int e = t0 - s + 4096;
#pragma unroll
            for (int j = 0; j < 8; ++j) y[j] += fb[e + j] * zs;
        }
        const float sk = skip[n * 512 + c];
#pragma unroll
        for (int j = 0; j < 8; ++j) {
            const int t = t0 + j;
            const float gate = convcol(n * 512 + c, t);
            const float zo = gate * (y[j] + sk * zin[t]);
            if (n == 0) z1b[t] = zo; else z2[((size_t)b * SEQ + t) * HW + c] = zo;
        }
    }
}
__global__ __launch_bounds__(512) void k_hy_norm(const float* z2, const float* g, float* mix) {
    const int w = (blockIdx.x * 512 + threadIdx.x) >> 6, lane = threadIdx.x & 63;
    const float4* zr = (const float4*)(z2 + (size_t)w * HW) + lane * 2;
    float4 a = zr[0], b = zr[1];
    float s = a.x * a.x + a.y * a.y + a.z * a.z + a.w * a.w + b.x * b.x + b.y * b.y + b.z * b.z + b.w * b.w;
    s += __shfl_xor(s, 1); s += __shfl_xor(s, 2); s += __shfl_xor(s, 4);
    const float r = rsqrtf(s * (1.f / 64.f) + EPS);
    const float4 g0 = ((const float4*)g)[lane * 2], g1 = ((const float4*)g)[lane * 2 + 1];
    float4* o = (float4*)(mix + (size_t)w * DM) + lane * 2;
    o[0] = make_float4(a.x * r * g0.x, a.y * r * g0.y, a.z * r * g0.z, a.w * r * g0.w);
    o[1] = make_float4(b.x * r * g1.x, b.y * r * g1.y, b.z * r * g1.z, b.w * r * g1.w);
}

constexpr int AT_LDS = (2 * 64 * 65 + 2 * 64 * 65 + 2 * 64 * 65 + 64 * 128 + 2 * 64 * 2) * 4;
__global__ __launch_bounds__(512) void k_attn(const float* proj, const float* lq1, const float* lk1, const float* lq2, const float* lk2, const float* subg, float* mix) {
    extern __shared__ __attribute__((aligned(16))) float sm[];
    float* Qs = sm;
    float* Ks = Qs + 2 * 64 * 65;
    float* Ss = Ks + 2 * 64 * 65;
    float* Vs = Ss + 2 * 64 * 65;
    float* al = Vs + 64 * 128;
    const int tid = threadIdx.x;
    const int qb = blockIdx.x & 63, h = (blockIdx.x >> 6) & 3, b = blockIdx.x >> 8;
    const int q0 = qb * 64;
    const float* pb = proj + (size_t)b * SEQ * INC;
    const float slope = exp2f(-2.f * (float)(h + 1));
    float lam;
    { float s1 = 0.f, s2 = 0.f; for (int i = 0; i < 64; ++i) { s1 += lq1[i] * lk1[i]; s2 += lq2[i] * lk2[i]; } lam = expf(s1) - expf(s2) + 0.2f; }
    for (int i = tid; i < 2 * 64 * 64; i += 512) { const int m = i >> 12, q = (i >> 6) & 63, d = i & 63; Qs[(m * 64 + q) * 65 + d] = pb[(size_t)(q0 + q) * INC + 1536 + h * 128 + m * 64 + d] * 0.125f; }
    const int mp = tid >> 8, qg = (tid >> 4) & 15, xg = tid & 15;
    float o[4][8];
#pragma unroll
    for (int i = 0; i < 4; ++i)
#pragma unroll
        for (int j = 0; j < 8; ++j) o[i][j] = 0.f;
    const int srow = tid >> 2, spart = tid & 3;
    float m_run = -1e30f, l_run = 0.f;
    for (int kt = 0; kt < SEQ / 64; ++kt) {
        const int k0 = kt * 64;
        __syncthreads();
        for (int i = tid; i < 2 * 64 * 64; i += 512) { const int m = i >> 12, k = (i >> 6) & 63, d = i & 63; Ks[(m * 64 + k) * 65 + d] = pb[(size_t)(k0 + k) * INC + 2048 + h * 128 + m * 64 + d]; }
        for (int i = tid; i < 64 * 128; i += 512) { const int k = i >> 7, d = i & 127; Vs[k * 128 + d] = pb[(size_t)(k0 + k) * INC + 2560 + h * 128 + d]; }
        __syncthreads();
        float s[4][4];
#pragma unroll
        for (int i = 0; i < 4; ++i)
#pragma unroll
            for (int j = 0; j < 4; ++j) s[i][j] = 0.f;
        for (int d = 0; d < 64; ++d) {
            float qv[4], kv[4];
#pragma unroll
            for (int i = 0; i < 4; ++i) qv[i] = Qs[(mp * 64 + qg * 4 + i) * 65 + d];
#pragma unroll
            for (int j = 0; j < 4; ++j) kv[j] = Ks[(mp * 64 + xg * 4 + j) * 65 + d];
#pragma unroll
            for (int i = 0; i < 4; ++i)
#pragma unroll
                for (int j = 0; j < 4; ++j) s[i][j] += qv[i] * kv[j];
        }
#pragma unroll
        for (int i = 0; i < 4; ++i)
#pragma unroll
            for (int j = 0; j < 4; ++j) {
                const int q = qg * 4 + i, k = xg * 4 + j;
                Ss[(mp * 64 + q) * 65 + k] = s[i][j] - slope * fabsf((float)(q0 + q) - (float)(k0 + k));
            }
        __syncthreads();
        {
            float* sr = Ss + srow * 65 + spart * 16;
            float mx = -1e30f;
#pragma unroll
            for (int j = 0; j < 16; ++j) mx = fmaxf(mx, sr[j]);
            mx = fmaxf(mx, __shfl_xor(mx, 1)); mx = fmaxf(mx, __shfl_xor(mx, 2));
            const float mn = fmaxf(m_run, mx), a = expf(m_run - mn);
            float ps = 0.f;
#pragma unroll
            for (int j = 0; j < 16; ++j) { const float pv = expf(sr[j] - mn); sr[j] = pv; ps += pv; }
            ps += __shfl_xor(ps, 1); ps += __shfl_xor(ps, 2);
            l_run = l_run * a + ps; m_run = mn;
            if (spart == 0) al[srow] = a;
        }
        __syncthreads();
#pragma unroll
        for (int i = 0; i < 4; ++i) { const float a = al[mp * 64 + qg * 4 + i];
#pragma unroll
            for (int j = 0; j < 8; ++j) o[i][j] *= a; }
        for (int k = 0; k < 64; ++k) {
            float pv[4];
#pragma unroll
            for (int i = 0; i < 4; ++i) pv[i] = Ss[(mp * 64 + qg * 4 + i) * 65 + k];
            const float4 v0 = *(const float4*)&Vs[k * 128 + xg * 8], v1 = *(const float4*)&Vs[k * 128 + xg * 8 + 4];
#pragma unroll
            for (int i = 0; i < 4; ++i) { o[i][0] += pv[i] * v0.x; o[i][1] += pv[i] * v0.y; o[i][2] += pv[i] * v0.z; o[i][3] += pv[i] * v0.w;
                o[i][4] += pv[i] * v1.x; o[i][5] += pv[i] * v1.y; o[i][6] += pv[i] * v1.z; o[i][7] += pv[i] * v1.w; }
        }
    }
    __syncthreads();
    if (spart == 0) al[128 + srow] = l_run;
    __syncthreads();
#pragma unroll
    for (int i = 0; i < 4; ++i) { const float li = 1.f / al[128 + mp * 64 + qg * 4 + i];
#pragma unroll
        for (int j = 0; j < 8; ++j) o[i][j] *= li; }
    if (mp == 1) {
#pragma unroll
        for (int i = 0; i < 4; ++i)
#pragma unroll
            for (int j = 0; j < 8; ++j) Vs[(qg * 4 + i) * 128 + xg * 8 + j] = o[i][j];
    }
    __syncthreads();
    if (mp == 0) {
#pragma unroll
        for (int i = 0; i < 4; ++i) {
            float ss = 0.f;
#pragma unroll
            for (int j = 0; j < 8; ++j) { o[i][j] -= lam * Vs[(qg * 4 + i) * 128 + xg * 8 + j]; ss += o[i][j] * o[i][j]; }
            ss += __shfl_xor(ss, 1); ss += __shfl_xor(ss, 2); ss += __shfl_xor(ss, 4); ss += __shfl_xor(ss, 8);
            const float r = rsqrtf(ss * (1.f / 128.f) + EPS) * 0.8f;
            float* op = mix + ((size_t)b * SEQ + q0 + qg * 4 + i) * DM + 512 + h * 128 + xg * 8;
#pragma unroll
            for (int j = 0; j < 8; ++j) op[j] = o[i][j] * r * subg[xg * 8 + j];
        }
    }
}

__global__ __launch_bounds__(512) void k_router(const float* x1, const float* g, const float* wr, float* h2, float* aff) {
    const int w = (blockIdx.x * 512 + threadIdx.x) >> 6, lane = threadIdx.x & 63;
    const float4* xr = (const float4*)(x1 + (size_t)w * DM) + lane;
    float4 v[4]; float s = 0.f;
#pragma unroll
    for (int j = 0; j < 4; ++j) { v[j] = xr[64 * j]; s += v[j].x * v[j].x + v[j].y * v[j].y + v[j].z * v[j].z + v[j].w * v[j].w; }
    const float r = rsqrtf(wave_sum(s) * (1.f / DM) + EPS);
    float lg[16];
#pragma unroll
    for (int e = 0; e < 16; ++e) lg[e] = 0.f;
    float4* o = (float4*)(h2 + (size_t)w * DM) + lane;
#pragma unroll
    for (int j = 0; j < 4; ++j) {
        const float4 gg = ((const float4*)g)[lane + 64 * j];
        const float4 hv = make_float4(v[j].x * r * gg.x, v[j].y * r * gg.y, v[j].z * r * gg.z, v[j].w * r * gg.w);
        o[64 * j] = hv;
        const int d0 = (lane + 64 * j) * 4;
        const float hx[4] = {hv.x, hv.y, hv.z, hv.w};
#pragma unroll
        for (int q = 0; q < 4; ++q) {
            const float4* wp = (const float4*)(wr + (size_t)(d0 + q) * 16);
#pragma unroll
            for (int e4 = 0; e4 < 4; ++e4) { const float4 ww = wp[e4]; lg[e4 * 4 + 0] += hx[q] * ww.x; lg[e4 * 4 + 1] += hx[q] * ww.y; lg[e4 * 4 + 2] += hx[q] * ww.z; lg[e4 * 4 + 3] += hx[q] * ww.w; }
        }
    }
    float mx = -1e30f;
#pragma unroll
    for (int e = 0; e < 16; ++e) { lg[e] = wave_sum(lg[e]); mx = fmaxf(mx, lg[e]); }
    float den = 0.f;
#pragma unroll
    for (int e = 0; e < 16; ++e) { lg[e] = expf(lg[e] - mx); den += lg[e]; }
    const int b = w >> 12, t = w & 4095;
#pragma unroll
    for (int e = 0; e < 16; ++e) if (lane == e) aff[((size_t)e * NB + b) * SEQ + t] = lg[e] / den;
}

__global__ __launch_bounds__(512) void k_topk(const float* aff, int* tok, float* gsel) {
    __shared__ unsigned hist[256]; __shared__ unsigned sel_s, need_s; __shared__ unsigned scan[512];
    const int eb = blockIdx.x, b = eb & 7, tid = threadIdx.x;
    const float* a = aff + (size_t)eb * SEQ;
    unsigned v[8];
#pragma unroll
    for (int j = 0; j < 8; ++j) v[j] = __float_as_uint(a[tid * 8 + j]);
    unsigned prefix = 0, mask = 0, need = CAP;
    for (int pass = 0; pass < 4; ++pass) {
        const int shift = 24 - 8 * pass;
        if (tid < 256) hist[tid] = 0;
        __syncthreads();
#pragma unroll
        for (int j = 0; j < 8; ++j) if ((v[j] & mask) == prefix) atomicAdd(&hist[(v[j] >> shift) & 255u], 1u);
        __syncthreads();
        if (tid == 0) { unsigned cum = 0; int bin = 255; for (; bin > 0; --bin) { if (cum + hist[bin] >= need) break; cum += hist[bin]; } sel_s = (unsigned)bin; need_s = need - cum; }
        __syncthreads();
        prefix |= sel_s << shift; mask |= 255u << shift; need = need_s;
        __syncthreads();
    }
    unsigned cg = 0, ce = 0;
#pragma unroll
    for (int j = 0; j < 8; ++j) { cg += v[j] > prefix; ce += v[j] == prefix; }
    scan[tid] = (cg << 16) | ce;
    __syncthreads();
    for (int off = 1; off < 512; off <<= 1) { unsigned x = tid >= off ? scan[tid - off] : 0u; __syncthreads(); scan[tid] += x; __syncthreads(); }
    const unsigned incl = scan[tid]; unsigned pg = (incl >> 16) - cg, pe = (incl & 0xffffu) - ce;
#pragma unroll
    for (int j = 0; j < 8; ++j) {
        const bool isg = v[j] > prefix, ise = v[j] == prefix;
        if (isg || (ise && pe < need)) {
            const unsigned pos = pg + (pe < need ? pe : need);
            tok[(size_t)eb * CAP + pos] = b * SEQ + tid * 8 + j; gsel[(size_t)eb * CAP + pos] = __uint_as_float(v[j]);
        }
        pg += isg; pe += ise;
    }
}

__global__ void k_swiglu(float* a, const float* u, size_t n) {
    size_t i = (size_t)blockIdx.x * blockDim.x + threadIdx.x;
    if (i < n) { const float x = a[i]; a[i] = x / (1.f + expf(-x)) * u[i]; }
}

static GemmP mkp(const float* A, int lda, const int* arow, const float* Bm, int ldb, float* C, int ldc, int M, int N, int K, int mode, const float* R, const int* crow, const float* cscale) {
    GemmP p; memset(&p, 0, sizeof p);
    p.A = A; p.lda = lda; p.arow = arow; p.Bm = Bm; p.ldb = ldb; p.C = C; p.ldc = ldc; p.M = M; p.N = N; p.K = K; p.mode = mode; p.R = R; p.crow = crow; p.cscale = cscale;
    return p;
}
extern "C" void kernel_launch(void* const* d_in, const int* in_sizes, int n_in, void* d_out, int out_size, void* d_ws, size_t ws_size, hipStream_t stream) {
    const float* x = (const float*)d_in[0]; const float* attn_g = (const float*)d_in[1]; const float* w_in = (const float*)d_in[2];
    const float* conv_w = (const float*)d_in[3]; const float* conv_b = (const float*)d_in[4];
    const float* fw1 = (const float*)d_in[5]; const float* fb1 = (const float*)d_in[6]; const float* fw2 = (const float*)d_in[7]; const float* fb2 = (const float*)d_in[8];
    const float* fw3 = (const float*)d_in[9]; const float* ffr = (const float*)d_in[10]; const float* hskip = (const float*)d_in[11]; const float* hng = (const float*)d_in[12];
    const float* lq1 = (const float*)d_in[13]; const float* lk1 = (const float*)d_in[14]; const float* lq2 = (const float*)d_in[15]; const float* lk2 = (const float*)d_in[16];
    const float* subg = (const float*)d_in[17]; const float* w_out = (const float*)d_in[18]; const float* ffn_g = (const float*)d_in[19]; const float* w_router = (const float*)d_in[20];
    const float* w_gate = (const float*)d_in[21]; const float* w_up = (const float*)d_in[22]; const float* w_down = (const float*)d_in[23]; const float* fin_g = (const float*)d_in[24];
    float* out = (float*)d_out;
    char* ws = (char*)d_ws;
    const size_t MB = 1u << 20;
    float* XN = (float*)(ws);
    float* MIX = XN;
    float* PROJ = (float*)(ws + 128 * MB);
    float* Z2 = (float*)(ws + 512 * MB);
    float* KF = (float*)(ws + 576 * MB);
    float* HID2 = (float*)(ws + 608 * MB);
    float* NSUM = (float*)(ws + 609 * MB);
    float* H2 = (float*)(ws + 128 * MB);
    float* AFF = (float*)(ws + 256 * MB);
    int* TOK = (int*)(ws + 258 * MB);
    float* GSEL = (float*)(ws + 259 * MB);
    float* ABUF = (float*)(ws + 260 * MB);
    float* UBUF = (float*)(ws + 308 * MB);

    static bool attr_done = false;
    if (!attr_done) {
        (void)hipFuncSetAttribute((const void*)k_hyena, hipFuncAttributeMaxDynamicSharedMemorySize, 65536);
        (void)hipFuncSetAttribute((const void*)k_attn, hipFuncAttributeMaxDynamicSharedMemorySize, AT_LDS);
        attr_done = true;
    }
    (void)hipMemsetAsync(NSUM, 0, 4096, stream);
    k_rmsnorm<<<NTOK / 8, 512, 0, stream>>>(x, attn_g, XN, NTOK);
    { GemmP p = mkp(XN, DM, nullptr, w_in, INC, PROJ, INC, NTOK, INC, DM, 0, nullptr, nullptr, nullptr); k_gemm<<<(NTOK / 128) * (INC / 64), 512, 0, stream>>>(p); }
    k_filt_hid<<<SEQ, 64, 0, stream>>>(fw1, fb1, fw2, fb2, ffr, HID2);
    k_filt_h<<<dim3(8, 64), 256, 0, stream>>>(HID2, fw3, KF, NSUM);
    k_hyena<<<NB * HW, 512, 65536, stream>>>(PROJ, conv_w, conv_b, KF, NSUM, hskip, Z2);
    k_hy_norm<<<NTOK / 8, 512, 0, stream>>>(Z2, hng, MIX);
    k_attn<<<NB * 4 * 64, 512, AT_LDS, stream>>>(PROJ, lq1, lk1, lq2, lk2, subg, MIX);
    { GemmP p = mkp(MIX, DM, nullptr, w_out, DM, out, DM, NTOK, DM, DM, 1, x, nullptr, nullptr); k_gemm<<<(NTOK / 128) * (DM / 64), 512, 0, stream>>>(p); }
    k_router<<<NTOK / 8, 512, 0, stream>>>(out, ffn_g, w_router, H2, AFF);
    k_topk<<<NE * NB, 512, 0, stream>>>(AFF, TOK, GSEL);
    for (int e = 0; e < NE; ++e) {
        const int M = NB * CAP;
        { GemmP p = mkp(H2, DM, TOK + (size_t)e * M, w_gate + (size_t)e * DM * FF, FF, ABUF, FF, M, FF, DM, 0, nullptr, nullptr, nullptr); k_gemm<<<(M / 128) * (FF / 64), 512, 0, stream>>>(p); }
        { GemmP p = mkp(H2, DM, TOK + (size_t)e * M, w_up + (size_t)e * DM * FF, FF, UBUF, FF, M, FF, DM, 0, nullptr, nullptr, nullptr); k_gemm<<<(M / 128) * (FF / 64), 512, 0, stream>>>(p); }
        k_swiglu<<<(unsigned)(((size_t)M * FF + 255) / 256), 256, 0, stream>>>(ABUF, UBUF, (size_t)M * FF);
        { GemmP p = mkp(ABUF, FF, nullptr, w_down + (size_t)e * FF * DM, DM, out, DM, M, DM, FF, 2, nullptr, TOK + (size_t)e * M, GSEL + (size_t)e * M); k_gemm<<<(M / 128) * (DM / 64), 512, 0, stream>>>(p); }
    }
    k_rmsnorm<<<NTOK / 8, 512, 0, stream>>>(out, fin_g, out, NTOK);
}
```

```cpp
#include <hip/hip_runtime.h>
#include <cstdio>
#include <cstdint>
#include <cstring>

#define GAS __attribute__((address_space(1)))
#define LAS __attribute__((address_space(3)))
typedef unsigned short bf16_t;
typedef short bf16x8 __attribute__((ext_vector_type(8)));
typedef float f32x4 __attribute__((ext_vector_type(4)));
typedef float f32x2 __attribute__((ext_vector_type(2)));
typedef unsigned u32x4 __attribute__((ext_vector_type(4)));
typedef unsigned u32x2 __attribute__((ext_vector_type(2)));

constexpr int DM = 1024, NB = 8, SEQ = 4096, NTOK = NB * SEQ;
constexpr int HW = 512, HCOLS = 1536, INC = 3072, ACOLS = 1536;
constexpr int NE = 16, CAP = 512, FF = 2816, NSLOT = NE * NB * CAP;
constexpr float EPS = 1e-6f;
constexpr float LOG2E = 1.4426950408889634f;
constexpr float QSCALE = 0.125f * LOG2E;
constexpr int GOFF = 4352, GLEN = 8704;

constexpr size_t MiB = 1u << 20;
constexpr size_t WS_CTL = 0, CTL_BYTES = 1 * MiB;
constexpr size_t WS_WGU = 2 * MiB;
constexpr size_t WS_Y = WS_WGU;
constexpr size_t WS_WD = 178 * MiB;
constexpr size_t WS_AFF = 266 * MiB;
constexpr size_t WS_TOK = 268 * MiB;
constexpr size_t WS_GSEL = WS_TOK + 256 * 1024;
constexpr size_t WS_INV = 269 * MiB;
constexpr size_t WS_XN = 270 * MiB;
constexpr size_t WS_H2 = WS_XN;
constexpr size_t WS_ACT = 334 * MiB;
constexpr size_t WS_WIN = 334 * MiB;
constexpr size_t WS_WOUT = 340 * MiB;
constexpr size_t WS_GF = 342 * MiB;
constexpr size_t WS_HP = 360 * MiB;
constexpr size_t WS_QKV = 456 * MiB;
constexpr size_t WS_HZ = 552 * MiB;
constexpr size_t WS_MIX = 584 * MiB;
constexpr size_t WS_END = 686 * MiB;
constexpr int CW_BAR = 4096;
constexpr int CW_NSUM = 16384;

constexpr int LDS_BYTES = 160 * 1024;
constexpr int MISC_OFF = LDS_BYTES - 256;
constexpr int TBL_OFF = 131072;

__device__ __forceinline__ unsigned f2bf(float f) { unsigned u = __builtin_bit_cast(unsigned, f); return (u + 0x7fffu + ((u >> 16) & 1u)) >> 16; }
__device__ __forceinline__ unsigned pk2(float lo, float hi) { return f2bf(lo) | (f2bf(hi) << 16); }
__device__ __forceinline__ float bf2f(unsigned short h) { return __builtin_bit_cast(float, (unsigned)h << 16); }
__device__ __forceinline__ float bflo(unsigned w) { return __builtin_bit_cast(float, w << 16); }
__device__ __forceinline__ float bfhi(unsigned w) { return __builtin_bit_cast(float, w & 0xffff0000u); }
__device__ __forceinline__ float wave_sum(float v) {
#pragma unroll
    for (int o = 1; o < 64; o <<= 1) v += __shfl_xor(v, o);
    return v;
}
#define LDS_WAIT() asm volatile("s_waitcnt lgkmcnt(0)" ::: "memory")
#define PHASE_IDS() int tid_o = threadIdx.x; asm volatile("" : "+v"(tid_o)); const int tid = tid_o, lane = tid & 63; (void)lane

namespace pg8 {
constexpr int BM = 256, BK = 64, HALF = 128, HTB = HALF * BK * 2, STAGE_BYTES = 8 * HTB, NXCD = 8, WGM = 8;
__host__ __device__ __forceinline__ int lds_byte(int r, int c) { const int st = (r >> 4) * 2 + (c >> 5), rr = r & 15, cc = c & 31, ob = rr * 64 + cc * 2; return st * 1024 + (ob ^ (((ob >> 9) & 1) << 5)); }
__host__ __device__ __forceinline__ void stage_rc(int b, int& R, int& C) { const int st = b / 1024, sb = b % 1024, swz = sb ^ (((sb >> 9) & 1) << 5); R = (st >> 1) * 16 + swz / 64; C = (st & 1) * 32 + (swz % 64) / 2; }
__host__ __device__ __forceinline__ int perm32(int rho) { const int n = rho >> 4, i = rho & 15; return 8 * (i >> 2) + 4 * n + (i & 3); }
struct Unit { int pm, pn; };

struct TileOrder {
    int nM, nN, nwg, G, c;
    __device__ void init(int nM_, int nN_, int G_, int c_) { nM = nM_; nN = nN_; nwg = nM * nN; G = G_; c = c_; }
    __device__ bool next(int i, Unit& u) const {
        const long L = (long)i * G + c; if (L >= nwg) return false;
        int wgid = (int)L; { const int q = nwg / NXCD, r = nwg % NXCD, xcd = wgid % NXCD, off = wgid / NXCD; wgid = (xcd < r ? xcd * (q + 1) : r * (q + 1) + (xcd - r) * q) + off; }
        const int nig = WGM * nN, gid = wgid / nig, fm = gid * WGM, gsz = (nM - fm) < WGM ? (nM - fm) : WGM;
        u.pm = fm + ((wgid % nig) % gsz); u.pn = (wgid % nig) / gsz; return true;
    }
};
__device__ __forceinline__ unsigned cvt_pk_bf16(float lo, float hi) { unsigned r; asm volatile("v_cvt_pk_bf16_f32 %0, %1, %2" : "=v"(r) : "v"(lo), "v"(hi)); return r; }

struct EpiBf16 {
    static constexpr bool PERM = true;
    bf16_t* O; int ldc; int scols; float sc;
    __device__ __forceinline__ void operator()(const f32x4 (&acc)[2][2][4][2], const Unit& u, int wr, int wc, int fr, int fq) const {
        const int row0 = u.pm * BM + wr * 64 + fr, col0 = u.pn * BM + wc * 32 + 8 * fq;
        const float s = (u.pn * BM < scols) ? sc : 1.f;
#pragma unroll
        for (int ai = 0; ai < 2; ++ai)
#pragma unroll
            for (int m = 0; m < 4; ++m) { bf16_t* rowp = O + (size_t)(row0 + ai * HALF + m * 16) * ldc + col0;
#pragma unroll
                for (int bj = 0; bj < 2; ++bj) { const f32x4 v0 = acc[ai][bj][m][0] * s, v1 = acc[ai][bj][m][1] * s;
                    u32x4 w; w.x = cvt_pk_bf16(v0[0], v0[1]); w.y = cvt_pk_bf16(v0[2], v0[3]); w.z = cvt_pk_bf16(v1[0], v1[1]); w.w = cvt_pk_bf16(v1[2], v1[3]);
                    *(u32x4*)(rowp + bj * HALF) = w; } }
    }
};
struct EpiResF32 {
    static constexpr bool PERM = false;
    const float* R; float* C; int ldc;
    __device__ __forceinline__ void operator()(const f32x4 (&acc)[2][2][4][2], const Unit& u, int wr, int wc, int fr, int fq) const {
        const int row0 = u.pm * BM + wr * 64 + fr, col0 = u.pn * BM + wc * 32 + 4 * fq;
#pragma unroll
        for (int ai = 0; ai < 2; ++ai)
#pragma unroll
            for (int m = 0; m < 4; ++m) { const size_t off = (size_t)(row0 + ai * HALF + m * 16) * ldc + col0;
#pragma unroll
                for (int bj = 0; bj < 2; ++bj)
#pragma unroll
                    for (int n = 0; n < 2; ++n) { const f32x4 r = *(const f32x4*)(R + off + bj * HALF + n * 16); *(f32x4*)(C + off + bj * HALF + n * 16) = r + acc[ai][bj][m][n]; } }
    }
};
struct EpiSwiGLU {
    static constexpr bool PERM = true;
    bf16_t* O; int ldc;
    __device__ __forceinline__ void operator()(const f32x4 (&acc)[2][2][4][2], const Unit& u, int wr, int wc, int fr, int fq) const {
        const int row0 = u.pm * BM + wr * 64 + fr, col0 = u.pn * HALF + wc * 32 + 8 * fq;
#pragma unroll
        for (int ai = 0; ai < 2; ++ai)
#pragma unroll
            for (int m = 0; m < 4; ++m) { bf16_t* rowp = O + (size_t)(row0 + ai * HALF + m * 16) * ldc + col0;
                float o[8];
#pragma unroll
                for (int n = 0; n < 2; ++n)
#pragma unroll
                    for (int j = 0; j < 4; ++j) { const float g = acc[ai][0][m][n][j], up = acc[ai][1][m][n][j];
                        o[n * 4 + j] = g * __builtin_amdgcn_rcpf(1.f + __builtin_amdgcn_exp2f(-g * LOG2E)) * up; }
                u32x4 w; w.x = cvt_pk_bf16(o[0], o[1]); w.y = cvt_pk_bf16(o[2], o[3]); w.z = cvt_pk_bf16(o[4], o[5]); w.w = cvt_pk_bf16(o[6], o[7]);
                *(u32x4*)rowp = w; }
    }
};

struct GeoPlain {
    static constexpr bool GATHER = false;
    const bf16_t* A; const bf16_t* Bt; int K; TileOrder ord;
    __device__ __forceinline__ bool next(int i, Unit& u) const { return ord.next(i, u); }
    __device__ __forceinline__ const char* a_ptr(const Unit& u) const { return (const char*)A + (size_t)u.pm * BM * K * 2; }
    __device__ __forceinline__ const char* b_ptr(const Unit& u) const { return (const char*)Bt + (size_t)u.pn * BM * K * 2; }
    __device__ __forceinline__ size_t hstepA() const { return (size_t)HALF * K * 2; }
    __device__ __forceinline__ size_t hstepB() const { return (size_t)HALF * K * 2; }
    __device__ __forceinline__ unsigned a_voff(int R, int C) const { return (unsigned)(R * K + C) * 2u; }
    __device__ __forceinline__ unsigned b_voff(int R, int C) const { return (unsigned)(R * K + C) * 2u; }
    __device__ __forceinline__ void fill_table(LAS unsigned*, const Unit&, int) const {}
};
struct GeoTokPerm {
    static constexpr bool GATHER = false;
    const bf16_t* A; const bf16_t* X; int K; TileOrder ord;
    __device__ __forceinline__ bool next(int i, Unit& u) const { return ord.next(i, u); }
    __device__ __forceinline__ const char* a_ptr(const Unit& u) const { return (const char*)A + (size_t)u.pm * BM * K * 2; }
    __device__ __forceinline__ const char* b_ptr(const Unit& u) const { return (const char*)X + (size_t)u.pn * 32 * K * 2; }
    __device__ __forceinline__ size_t hstepA() const { return (size_t)HALF * K * 2; }
    __device__ __forceinline__ size_t hstepB() const { return (size_t)16 * K * 2; }
    __device__ __forceinline__ unsigned a_voff(int R, int C) const { return (unsigned)(R * K + C) * 2u; }
    __device__ __forceinline__ unsigned b_voff(int R, int C) const { return (unsigned)(((R & 7) * SEQ + (R >> 3)) * K + C) * 2u; }
    __device__ __forceinline__ void fill_table(LAS unsigned*, const Unit&, int) const {}
};
template <bool G> struct GeoExpert {
    static constexpr bool GATHER = G;
    const bf16_t* A; const bf16_t* Bt; int K; size_t bexp;    const int* tok; TileOrder ord;
    __device__ __forceinline__ bool next(int i, Unit& u) const { return ord.next(i, u); }
    __device__ __forceinline__ const char* a_ptr(const Unit& u) const { return G ? (const char*)A : (const char*)A + (size_t)u.pm * BM * K * 2; }
    __device__ __forceinline__ const char* b_ptr(const Unit& u) const { return (const char*)Bt + (size_t)(u.pm >> 4) * bexp + (size_t)u.pn * BM * K * 2; }
    __device__ __forceinline__ size_t hstepA() const { return (size_t)HALF * K * 2; }
    __device__ __forceinline__ size_t hstepB() const { return (size_t)HALF * K * 2; }
    __device__ __forceinline__ unsigned a_voff(int R, int C) const { return (unsigned)(R * K + C) * 2u; }
    __device__ __forceinline__ unsigned b_voff(int R, int C) const { return (unsigned)(R * K + C) * 2u; }
    __device__ __forceinline__ void fill_table(LAS unsigned* tb, const Unit& u, int tid) const { if (G) { int t_ = tid; asm volatile("" : "+v"(t_));
#pragma unroll
        for (int i = 0; i < 2; ++i) { int R, C; stage_rc(t_ * 16 + i * 8192, R, C);
#pragma unroll
            for (int h = 0; h < 2; ++h) tb[h * 1024 + i * 512 + tid] = (unsigned)tok[u.pm * 256 + h * 128 + R] * (unsigned)(K * 2) + (unsigned)C * 2u; } } }
};

template <class Epi, class Geo>
__device__ __forceinline__ void gemm_phase(LAS unsigned char* lds, LAS unsigned* tbl, const Geo& S, const Epi& E) {
    int tid_ = threadIdx.x; asm volatile("" : "+v"(tid_));
    const int tid = tid_, wid = __builtin_amdgcn_readfirstlane(tid >> 6), lane = tid & 63, wr = wid >> 2, wc = wid & 3, fr = lane & 15, fq = lane >> 4;
    const int K = S.K, nt = K / BK;
    unsigned voffA[2], voffB[2];
#pragma unroll
    for (int i = 0; i < 2; ++i) { int R, C; stage_rc(tid * 16 + i * 8192, R, C); const int Rb = Epi::PERM ? ((R & ~31) + perm32(R & 31)) : R;
        voffA[i] = S.a_voff(R, C); voffB[i] = S.b_voff(Rb, C); }
    const size_t kstep = (size_t)(BK * 2);
    const size_t hstepA = S.hstepA(), hstepB = S.hstepB();
    const unsigned ldsw = (unsigned)wid * 1024u;
    const int aoff = lds_byte(wr * 64 + fr, fq * 8), boff = lds_byte(wc * 32 + fr, fq * 8);
#define PG8_SA(b, h) (((b) * 2 + (h)) * HTB)
#define PG8_SB(b, h) ((4 + (b) * 2 + (h)) * HTB)
#define PG8_STAGE(bufoff, gbase, voff) do { _Pragma("unroll") for (int _i = 0; _i < 2; ++_i) \
        __builtin_amdgcn_global_load_lds((const unsigned*)((const char*)(gbase) + (voff)[_i]), (LAS unsigned*)(lds + (bufoff) + ldsw + _i * 8192), 16, 0, 0); } while (0)
#define PG8_STAGE_A(bufoff, gbase, h, nx) do { if constexpr (Geo::GATHER) { const LAS unsigned* _tb = tbl + (((ui + ((nx) ? 1 : 0)) & 1) * 2048) + (h) * 1024 + tid; unsigned _vo[2]; \
        _vo[0] = _tb[0]; _vo[1] = _tb[512]; PG8_STAGE(bufoff, gbase, _vo); } else { PG8_STAGE(bufoff, (gbase) + (h) * hstepA, voffA); } } while (0)
#define PG8_LDA(dst, b, h) do { _Pragma("unroll") for (int m = 0; m < 4; ++m) _Pragma("unroll") for (int k = 0; k < 2; ++k) dst[m][k] = *(const LAS bf16x8*)(lds + PG8_SA(b, h) + aoff + m * 2048 + k * 1024); } while (0)
#define PG8_LDB(dst, b, h) do { _Pragma("unroll") for (int n = 0; n < 2; ++n) _Pragma("unroll") for (int k = 0; k < 2; ++k) dst[n][k] = *(const LAS bf16x8*)(lds + PG8_SB(b, h) + boff + n * 2048 + k * 1024); } while (0)
#define PG8_MMA(ai, bj, At, Bt) do { __builtin_amdgcn_s_setprio(1); _Pragma("unroll") for (int m = 0; m < 4; ++m) _Pragma("unroll") for (int n = 0; n < 2; ++n) _Pragma("unroll") for (int k = 0; k < 2; ++k) \
        acc[ai][bj][m][n] = __builtin_amdgcn_mfma_f32_16x16x32_bf16(Bt[n][k], At[m][k], acc[ai][bj][m][n], 0, 0, 0); __builtin_amdgcn_s_setprio(0); } while (0)
#define PG8_WAIT_V(n) asm volatile("s_waitcnt vmcnt(" #n ")" ::: "memory")
#define PG8_WAIT_L(n) asm volatile("s_waitcnt lgkmcnt(" #n ")" ::: "memory")
#define PG8_BAR __builtin_amdgcn_s_barrier()
#define PG8_SCHED __builtin_amdgcn_sched_barrier(0)
    Unit cur, nxt; int ui = 0;
    if (!S.next(0, cur)) return;
    f32x4 acc[2][2][4][2];
#pragma unroll
    for (int a = 0; a < 2; ++a)
#pragma unroll
        for (int b = 0; b < 2; ++b)
#pragma unroll
            for (int m = 0; m < 4; ++m)
#pragma unroll
                for (int n = 0; n < 2; ++n) acc[a][b][m][n] = (f32x4){0.f, 0.f, 0.f, 0.f};
    bf16x8 At[4][2], B0[2][2], B1[2][2];
    const char* cA = S.a_ptr(cur); const char* cB = S.b_ptr(cur);
    if constexpr (Geo::GATHER) {
        S.fill_table(tbl, cur, tid);
        Unit u1; if (S.next(1, u1)) S.fill_table(tbl + 2048, u1, tid);
        asm volatile("s_waitcnt vmcnt(0) lgkmcnt(0)" ::: "memory"); PG8_BAR; asm volatile("" ::: "memory");
    }
    PG8_STAGE(PG8_SB(0, 0), cB, voffB); PG8_STAGE(PG8_SB(0, 1), cB + hstepB, voffB); PG8_STAGE_A(PG8_SA(0, 0), cA, 0, false); PG8_STAGE_A(PG8_SA(0, 1), cA, 1, false);
    if (wr == 1) PG8_BAR;
    PG8_WAIT_V(2); PG8_BAR;
    PG8_STAGE(PG8_SB(1, 0), cB + kstep, voffB); PG8_STAGE_A(PG8_SA(1, 0), cA + kstep, 0, false); PG8_STAGE(PG8_SB(1, 1), cB + hstepB + kstep, voffB);
    PG8_WAIT_V(6); PG8_BAR;
    for (;;) {
        const bool has_next = S.next(ui + 1, nxt);
        const char* nA = has_next ? S.a_ptr(nxt) : cA; const char* nB = has_next ? S.b_ptr(nxt) : cB;
        for (int t = 0; t < nt; t += 2) {
            const bool last = (t == nt - 2);
            const bool lastn = last && has_next;
            const char* a1 = cA + (size_t)(t + 1) * kstep;
            const char* a2 = last ? nA : cA + (size_t)(t + 2) * kstep; const char* b2 = last ? nB : cB + (size_t)(t + 2) * kstep;
            const char* a3 = a2 + kstep; const char* b3 = b2 + kstep;
            if constexpr (Geo::GATHER) { if (t == 2 && ui > 0) { Unit u2; if (S.next(ui + 1, u2)) S.fill_table(tbl + (((ui + 1) & 1) * 2048), u2, tid); } }
            PG8_LDB(B0, 0, 0); PG8_LDB(B1, 0, 1); PG8_SCHED; PG8_LDA(At, 0, 0); PG8_STAGE_A(PG8_SA(1, 1), a1, 1, false);
            PG8_WAIT_V(8); PG8_WAIT_L(0); PG8_BAR; PG8_MMA(0, 0, At, B0); PG8_MMA(0, 1, At, B1); PG8_BAR; PG8_SCHED;
            PG8_LDA(At, 0, 1); PG8_STAGE(PG8_SB(0, 0), b2, voffB); PG8_STAGE(PG8_SB(0, 1), b2 + hstepB, voffB); PG8_STAGE_A(PG8_SA(0, 0), a2, 0, lastn);
            PG8_WAIT_V(8); PG8_WAIT_L(0); PG8_BAR; PG8_MMA(1, 0, At, B0); PG8_MMA(1, 1, At, B1); PG8_BAR; PG8_SCHED;
            PG8_LDB(B0, 1, 0); PG8_LDB(B1, 1, 1); PG8_SCHED; PG8_LDA(At, 1, 0); PG8_STAGE_A(PG8_SA(0, 1), a2, 1, lastn);
            PG8_WAIT_V(8); PG8_WAIT_L(0); PG8_BAR; PG8_MMA(0, 0, At, B0); PG8_MMA(0, 1, At, B1); PG8_BAR; PG8_SCHED;
            PG8_LDA(At, 1, 1); PG8_STAGE(PG8_SB(1, 0), b3, voffB); PG8_STAGE(PG8_SB(1, 1), b3 + hstepB, voffB); PG8_STAGE_A(PG8_SA(1, 0), a3, 0, lastn);
            PG8_WAIT_V(8); PG8_WAIT_L(0); PG8_BAR; PG8_MMA(1, 0, At, B0); PG8_MMA(1, 1, At, B1); PG8_BAR; PG8_SCHED;
        }
        if (wr == 0) PG8_BAR;
        E(acc, cur, wr, wc, fr, fq);
        if (!has_next) break;
#pragma unroll
        for (int a = 0; a < 2; ++a)
#pragma unroll
            for (int b = 0; b < 2; ++b)
#pragma unroll
                for (int m = 0; m < 4; ++m)
#pragma unroll
                    for (int n = 0; n < 2; ++n) acc[a][b][m][n] = (f32x4){0.f, 0.f, 0.f, 0.f};
        cur = nxt; cA = nA; cB = nB; ++ui;
        if (wr == 1) PG8_BAR;
    }
    PG8_WAIT_V(0);
    PG8_BAR;
#undef PG8_SA
#undef PG8_SB
#undef PG8_STAGE
#undef PG8_STAGE_A
#undef PG8_LDA
#undef PG8_LDB
#undef PG8_MMA
#undef PG8_WAIT_V
#undef PG8_WAIT_L
#undef PG8_BAR
#undef PG8_SCHED
}
}

typedef GAS unsigned gu32;
#define XB_TMO      128
#define XB_XCNT(j)  (256  + 64 * (j))
#define XB_XSUB(j)  (1280 + 64 * (j))
#define XB_XGEN(j)  (2304 + 64 * (j))
#define XB_TOP      3328
#define XB_TOPGEN   3392
#define XCD_BAR_WORDS 3456
#define XB_SPIN_CAP (1u << 23)
__device__ __forceinline__ unsigned xb_ld(unsigned* p)              { return __hip_atomic_load(p, __ATOMIC_RELAXED, __HIP_MEMORY_SCOPE_AGENT); }
__device__ __forceinline__ unsigned xb_add(unsigned* p, unsigned v) { return __hip_atomic_fetch_add(p, v, __ATOMIC_RELAXED, __HIP_MEMORY_SCOPE_AGENT); }
__device__ __forceinline__ unsigned xb_xcc_id() { return (unsigned)__builtin_amdgcn_s_getreg((3 << 11) | 20) & 0xFu; }
#define XB_SPIN(cond, bar) do { unsigned _sp = 0; while (cond) { __builtin_amdgcn_s_sleep(1); \
    if ((++_sp & 255u) == 0u) { if (xb_ld(&(bar)[XB_TMO])) break; if (_sp > XB_SPIN_CAP) { atomicAdd(&(bar)[XB_TMO], 1u); break; } } } } while (0)
struct XcdBarrier { unsigned* bar; unsigned x; volatile LAS unsigned* st; };
__device__ __forceinline__ XcdBarrier xcd_barrier_post(unsigned* bar, volatile LAS unsigned* st) {
    XcdBarrier b; b.bar = bar; b.x = xb_xcc_id(); b.st = st;
    if (threadIdx.x == 0) (void)xb_add(&bar[XB_XCNT(b.x)], 1u);
    return b;
}
__device__ __forceinline__ void xcd_barrier_complete(unsigned* bar, unsigned x, unsigned& nloc, unsigned& nx) {
    const unsigned G = gridDim.x * gridDim.y * gridDim.z;
    unsigned sum, cnt, mine, sp = 0u;
    for (;;) {
        sum = 0u; cnt = 0u; mine = 0u;
#pragma unroll
        for (unsigned j = 0; j < 16; ++j) { const unsigned c = xb_ld(&bar[XB_XCNT(j)]); sum += c; cnt += (c > 0u) ? 1u : 0u; mine = (j == x) ? c : mine; }
        if (sum == G) break;
        __builtin_amdgcn_s_sleep(1);
        if ((++sp & 255u) == 0u) { if (xb_ld(&bar[XB_TMO])) break; if (sp > XB_SPIN_CAP) { atomicAdd(&bar[XB_TMO], 1u); break; } }
    }
    nloc = mine > 0u ? mine : 1u; nx = cnt > 0u ? cnt : 1u;
}
__device__ __forceinline__ void xcd_barrier(const XcdBarrier& b) {
    asm volatile("s_waitcnt vmcnt(0)" ::: "memory");
    __syncthreads();
    if (threadIdx.x == 0) {
        unsigned* bar = b.bar;
        __builtin_amdgcn_s_waitcnt(0);
        unsigned nloc = b.st[0], nx = b.st[1];
        if (nloc == 0u) { xcd_barrier_complete(bar, b.x, nloc, nx); b.st[0] = nloc; b.st[1] = nx; }
        const unsigned old = xb_add(&bar[XB_XSUB(b.x)], 1u);
        const unsigned gen = old / nloc;
        if (old + 1u == (gen + 1u) * nloc) {
            __builtin_amdgcn_fence(__ATOMIC_RELEASE, "agent");
            asm volatile("s_waitcnt vmcnt(0)" ::: "memory");
            const unsigned og = xb_add(&bar[XB_TOP], 1u);
            const unsigned tg = og / nx;
            if (og + 1u == (tg + 1u) * nx) xb_add(&bar[XB_TOPGEN], 1u);
            else XB_SPIN(xb_ld(&bar[XB_TOPGEN]) == tg, bar);
            __builtin_amdgcn_fence(__ATOMIC_ACQUIRE, "agent");
            xb_add(&bar[XB_XGEN(b.x)], 1u);
            asm volatile("s_waitcnt vmcnt(0)" ::: "memory");
        } else {
            XB_SPIN(xb_ld(&bar[XB_XGEN(b.x)]) == gen, bar);
            __builtin_amdgcn_fence(__ATOMIC_ACQUIRE, "agent");
            asm volatile("s_waitcnt vmcnt(0)" ::: "memory");
        }
    }
    __syncthreads();
}

__device__ __forceinline__ void p0_transpose_item(const float* W, int K, int N, bf16_t* WT, int k0, int n0, int orow0, LAS float* scr, int lane) {
#pragma unroll 8
    for (int i = 0; i < 32; ++i) { const int kk = 2 * i + (lane >> 5); scr[kk * 33 + (lane & 31)] = W[(size_t)(k0 + kk) * N + n0 + (lane & 31)]; }
    LDS_WAIT(); asm volatile("" ::: "memory");
    const int c = lane & 7;
#pragma unroll
    for (int j = 0; j < 4; ++j) { const int n = (lane >> 3) + 8 * j; const LAS float* s = scr + (8 * c) * 33 + n;
        u32x4 o; o.x = pk2(s[0 * 33], s[1 * 33]); o.y = pk2(s[2 * 33], s[3 * 33]); o.z = pk2(s[4 * 33], s[5 * 33]); o.w = pk2(s[6 * 33], s[7 * 33]);
        *(GAS u32x4*)(WT + (size_t)(orow0 + n) * K + k0 + 8 * c) = o; }
    LDS_WAIT(); asm volatile("" ::: "memory");
}

struct Args { const float* in[25]; float* out; unsigned char* ws; };

__global__ void __launch_bounds__(512, 2) mega_fwd(Args args) {
    extern __shared__ __attribute__((aligned(16))) unsigned char lds_raw[];
    LAS unsigned char* lds = (LAS unsigned char*)lds_raw;
    volatile LAS unsigned* MISC = (volatile LAS unsigned*)(lds + MISC_OFF);
    const int tid = threadIdx.x, lane = tid & 63, wave = __builtin_amdgcn_readfirstlane(tid >> 6);
    const int G = gridDim.x, bx = blockIdx.x;
    const int gw = bx * 8 + wave, NGW = G * 8;
    unsigned char* ws = args.ws;
    gu32* ctl = (gu32*)(ws + WS_CTL);
    const float* x = args.in[0];
    float* out = args.out;
    bf16_t* WGU = (bf16_t*)(ws + WS_WGU); bf16_t* WD = (bf16_t*)(ws + WS_WD); bf16_t* WIN = (bf16_t*)(ws + WS_WIN); bf16_t* WOUT = (bf16_t*)(ws + WS_WOUT);
    bf16_t* XN = (bf16_t*)(ws + WS_XN); bf16_t* H2 = (bf16_t*)(ws + WS_H2); bf16_t* GF = (bf16_t*)(ws + WS_GF);
    bf16_t* HP = (bf16_t*)(ws + WS_HP); bf16_t* QKV = (bf16_t*)(ws + WS_QKV); bf16_t* HZ = (bf16_t*)(ws + WS_HZ); bf16_t* MIX = (bf16_t*)(ws + WS_MIX);
    bf16_t* ACT = (bf16_t*)(ws + WS_ACT); bf16_t* Y = (bf16_t*)(ws + WS_Y);
    float* AFF = (float*)(ws + WS_AFF); int* TOK = (int*)(ws + WS_TOK); float* GSEL = (float*)(ws + WS_GSEL); unsigned short* INV = (unsigned short*)(ws + WS_INV);
    float* NSUM = (float*)(ws + WS_CTL) + CW_NSUM;

    if (tid < 64) ((LAS unsigned*)(lds + MISC_OFF))[tid] = 0u;
    __syncthreads();
    XcdBarrier bar = xcd_barrier_post((unsigned*)(ctl + CW_BAR), MISC + 8);

    {
        PHASE_IDS();
        LAS float* scr = (LAS float*)(lds + wave * 16384);
        constexpr int I_IN = (DM / 64) * (INC / 32), I_OUT = (DM / 64) * (DM / 32), I_GU = (DM / 64) * (FF / 32), I_DN = (FF / 64) * (DM / 32);
        constexpr int NITEMS = I_IN + I_OUT + NE * (2 * I_GU + I_DN);
        for (int it = gw; it < NITEMS; it += NGW) {
            int r = it;
            if (r < I_IN) { const int nblk = INC / 32, kb = r / nblk, nb = r % nblk; p0_transpose_item(args.in[2], DM, INC, WIN, 64 * kb, 32 * nb, 32 * nb, scr, lane); continue; } r -= I_IN;
            if (r < I_OUT) { const int nblk = DM / 32, kb = r / nblk, nb = r % nblk; p0_transpose_item(args.in[18], DM, DM, WOUT, 64 * kb, 32 * nb, 32 * nb, scr, lane); continue; } r -= I_OUT;
            const int e = r / (2 * I_GU + I_DN); r -= e * (2 * I_GU + I_DN);
            if (r < 2 * I_GU) { const int up = r >= I_GU; if (up) r -= I_GU; const int nblk = FF / 32, kb = r / nblk, nb = r % nblk, f0 = 32 * nb;
                const int orow = (f0 >> 7) * 256 + up * 128 + (f0 & 127);
                p0_transpose_item(args.in[up ? 22 : 21] + (size_t)e * DM * FF, DM, FF, WGU + (size_t)e * 2 * FF * DM, 64 * kb, f0, orow, scr, lane); continue; }
            r -= 2 * I_GU;
            { const int nblk = DM / 32, kb = r / nblk, nb = r % nblk; p0_transpose_item(args.in[23] + (size_t)e * FF * DM, FF, DM, WD + (size_t)e * DM * FF, 64 * kb, 32 * nb, 32 * nb, scr, lane); }
        }
        const float* g = args.in[1];
        for (int m = gw; m < NTOK; m += NGW) {
            const GAS f32x4* xr = (const GAS f32x4*)(x + (size_t)m * DM) + lane;
            f32x4 v[4]; float s = 0.f;
#pragma unroll
            for (int j = 0; j < 4; ++j) { v[j] = xr[64 * j]; s += (v[j].x * v[j].x + v[j].y * v[j].y) + (v[j].z * v[j].z + v[j].w * v[j].w); }
            const float rstd = rsqrtf(wave_sum(s) * (1.f / DM) + EPS);
            GAS u32x2* o8 = (GAS u32x2*)(XN + (size_t)m * DM) + lane;
#pragma unroll
            for (int j = 0; j < 4; ++j) { const f32x4 gg = ((const GAS f32x4*)g)[lane + 64 * j]; u32x2 w; w.x = pk2(v[j].x * rstd * gg.x, v[j].y * rstd * gg.y); w.y = pk2(v[j].z * rstd * gg.z, v[j].w * rstd * gg.w); o8[64 * j] = w; }
        }
        __syncthreads();
        for (int it = bx; it < 256; it += G) {
            const int ib = it >> 2, dn = it & 3, dir = dn >> 1, n = dn & 1, i0 = ib * 64;
            LAS float* zz = (LAS float*)lds;
            LAS float* h1 = zz + 64 * 33;
            LAS float* h2 = h1 + 64 * 64;
            const float* w1 = args.in[5]; const float* b1 = args.in[6]; const float* w2 = args.in[7]; const float* b2 = args.in[8]; const float* w3 = args.in[9]; const float* fr = args.in[10];
            for (int q = tid; q < 64 * 33; q += 512) { const int p = q / 33, j = q % 33, i = i0 + p;
                const float t = (float)i / (float)(SEQ - 1), w = 6.283185307179586f * (float)i / (float)SEQ; float v;
                if (j == 0) v = t; else { const float band = 1e-4f + (float)((j - 1) & 15) * ((15.f - 1e-4f) / 15.f); v = (j <= 16) ? cosf(band * w) : -sinf(band * w); }
                zz[q] = v; }
            __syncthreads();
            for (int q = tid; q < 64 * 64; q += 512) { const int p = q >> 6, j = q & 63; float a = b1[j]; for (int k = 0; k < 33; ++k) a += zz[p * 33 + k] * w1[k * 64 + j]; h1[q] = sinf(fr[j] * a); }
            __syncthreads();
            for (int q = tid; q < 64 * 64; q += 512) { const int p = q >> 6, j = q & 63; float a = b2[j]; for (int k = 0; k < 64; ++k) a += h1[p * 64 + k] * w2[k * 64 + j]; h2[q] = sinf(fr[j] * a); }
            __syncthreads();
            const int c = tid, col = dn * 512 + c;
            const float mind = logf(1e-2f) / 1.5f, maxd = logf(1e-2f) / 0.3f;
            const float delta = fabsf(mind + (float)c * ((maxd - mind) / 511.f));
            bf16_t* gf = GF + (size_t)(n * 512 + c) * GLEN;
            float asum = 0.f;
            for (int p0 = 0; p0 < 64; p0 += 16) {
                float hv[16];
#pragma unroll
                for (int p = 0; p < 16; ++p) hv[p] = 0.f;
                for (int k = 0; k < 64; ++k) { const float wk = w3[k * 2048 + col];
#pragma unroll
                    for (int p = 0; p < 16; ++p) hv[p] += h2[(p0 + p) * 64 + k] * wk; }
#pragma unroll
                for (int p = 0; p < 16; ++p) { const int i = i0 + p0 + p; const float t = (float)i / (float)(SEQ - 1); const float h = hv[p] * expf(-t * delta);
                    const unsigned hb = f2bf(h); const float hr = __builtin_bit_cast(float, hb << 16);
                    if (dir == 0) { gf[GOFF - i] = (bf16_t)hb; asum += fabsf(hr); } else if (i > 0) { gf[GOFF + i] = (bf16_t)hb; asum += fabsf(hr); } }
            }
            if (ib == 63) { if (dir == 0) { for (int q = 0; q < GOFF - 4095; ++q) gf[q] = 0; } else { for (int q = GOFF + 4096; q < GLEN; ++q) gf[q] = 0; } }
            atomicAdd(&NSUM[n * 512 + c], asum);
            __syncthreads();
        }
    }
    xcd_barrier(bar);

    {
        pg8::GeoTokPerm S; S.A = WIN; S.X = XN; S.K = DM; S.ord.init(HCOLS / 256, NTOK / 256, G, bx);
        pg8::EpiBf16 E{HP, NTOK, 0, 1.f};
        pg8::gemm_phase(lds, (LAS unsigned*)(lds + TBL_OFF), S, E);
    }
    {
        pg8::GeoPlain S; S.A = XN; S.Bt = WIN + (size_t)HCOLS * DM; S.K = DM; S.ord.init(NTOK / 256, ACOLS / 256, G, bx);
        pg8::EpiBf16 E{QKV, ACOLS, 512, QSCALE};
        pg8::gemm_phase(lds, (LAS unsigned*)(lds + TBL_OFF), S, E);
    }
    xcd_barrier(bar);

    {
        PHASE_IDS();
        LAS float* zb = (LAS float*)lds; LAS float* z1b = zb + 4096; LAS float* fb = zb + 8192;
        const float* conv_w = args.in[3]; const float* conv_b = args.in[4]; const float* skip = args.in[11];
        for (int unit = bx; unit < NB * HW; unit += G) {
            const int b = unit >> 9, c = unit & 511;
#define HPV(col, t) bf2f(HP[((size_t)(col) * SEQ + (t)) * 8 + b])
#define CONVCOL(col, t) (conv_b[col] + conv_w[HCOLS + (col)] * HPV(col, t) + ((t) > 0 ? conv_w[col] * HPV(col, (t) - 1) : 0.f) + ((t) < SEQ - 1 ? conv_w[2 * HCOLS + (col)] * HPV(col, (t) + 1) : 0.f))
            __syncthreads();
            for (int t = tid; t < SEQ; t += 512) zb[t] = bf2f((bf16_t)f2bf(CONVCOL(1024 + c, t)));
            for (int n = 0; n < 2; ++n) {
                const float inv = 1.f / NSUM[n * 512 + c];
                __syncthreads();
                const bf16_t* gf = GF + (size_t)(n * 512 + c) * GLEN;
                for (int e = tid; e < 8192; e += 512) fb[e] = (e == 0) ? 0.f : bf2f(gf[GOFF - (e - 4096)]);
                __syncthreads();
                LAS float* zin = n == 0 ? zb : z1b;
                const int t0 = tid * 8;
                float y[8];
#pragma unroll
                for (int j = 0; j < 8; ++j) y[j] = 0.f;
                for (int s = 0; s < SEQ; ++s) { const float zs = zin[s]; const int e = t0 - s + 4096;
#pragma unroll
                    for (int j = 0; j < 8; ++j) y[j] += fb[e + j] * zs; }
                const float sk = skip[n * 512 + c];
#pragma unroll
                for (int j = 0; j < 8; ++j) { const int t = t0 + j; const float gate = CONVCOL(n * 512 + c, t); const float zo = gate * (y[j] * inv + sk * zin[t]);
                    if (n == 0) z1b[t] = bf2f((bf16_t)f2bf(zo)); else HZ[((size_t)c * SEQ + t) * 8 + b] = (bf16_t)f2bf(zo); }
            }
#undef HPV
#undef CONVCOL
        }
        __syncthreads();
        LAS float* Qs = (LAS float*)lds; LAS float* Ks = Qs + 2 * 64 * 65; LAS float* Ss = Ks + 2 * 64 * 65; LAS float* Vs = Ss + 2 * 64 * 65; LAS float* al = Vs + 64 * 128;
        const float* subg = args.in[17];
        float lam;
        { float s1 = 0.f, s2 = 0.f; for (int i = 0; i < 64; ++i) { s1 += args.in[13][i] * args.in[14][i]; s2 += args.in[15][i] * args.in[16][i]; } lam = expf(s1) - expf(s2) + 0.2f; }
        const int mp = tid >> 8, qg = (tid >> 4) & 15, xg = tid & 15, srow = tid >> 2, spart = tid & 3;
        for (int unit = bx; unit < NB * 4 * 64; unit += G) {
            const int qb = unit & 63, h = (unit >> 6) & 3, b = unit >> 8, q0 = qb * 64;
            const bf16_t* pb = QKV + (size_t)b * SEQ * ACOLS;
            const float slope = exp2f(-2.f * (float)(h + 1)) * LOG2E;
            __syncthreads();
            for (int i = tid; i < 2 * 64 * 64; i += 512) { const int m = i >> 12, q = (i >> 6) & 63, d = i & 63; Qs[(m * 64 + q) * 65 + d] = bf2f(pb[(size_t)(q0 + q) * ACOLS + h * 128 + m * 64 + d]); }
            float o[4][8];
#pragma unroll
            for (int i = 0; i < 4; ++i)
#pragma unroll
                for (int j = 0; j < 8; ++j) o[i][j] = 0.f;
            float m_run = -1e30f, l_run = 0.f;
            for (int kt = 0; kt < SEQ / 64; ++kt) {
                const int k0 = kt * 64;
                __syncthreads();
                for (int i = tid; i < 2 * 64 * 64; i += 512) { const int m = i >> 12, k = (i >> 6) & 63, d = i & 63; Ks[(m * 64 + k) * 65 + d] = bf2f(pb[(size_t)(k0 + k) * ACOLS + 512 + h * 128 + m * 64 + d]); }
                for (int i = tid; i < 64 * 128; i += 512) { const int k = i >> 7, d = i & 127; Vs[k * 128 + d] = bf2f(pb[(size_t)(k0 + k) * ACOLS + 1024 + h * 128 + d]); }
                __syncthreads();
                float s[4][4];
#pragma unroll
                for (int i = 0; i < 4; ++i)
#pragma unroll
                    for (int j = 0; j < 4; ++j) s[i][j] = 0.f;
                for (int d = 0; d < 64; ++d) {
                    float qv[4], kv[4];
#pragma unroll
                    for (int i = 0; i < 4; ++i) qv[i] = Qs[(mp * 64 + qg * 4 + i) * 65 + d];
#pragma unroll
                    for (int j = 0; j < 4; ++j) kv[j] = Ks[(mp * 64 + xg * 4 + j) * 65 + d];
#pragma unroll
                    for (int i = 0; i < 4; ++i)
#pragma unroll
                        for (int j = 0; j < 4; ++j) s[i][j] += qv[i] * kv[j];
                }
#pragma unroll
                for (int i = 0; i < 4; ++i)
#pragma unroll
                    for (int j = 0; j < 4; ++j) { const int q = qg * 4 + i, k = xg * 4 + j; Ss[(mp * 64 + q) * 65 + k] = s[i][j] - slope * fabsf((float)(q0 + q) - (float)(k0 + k)); }
                __syncthreads();
                {
                    LAS float* sr = Ss + srow * 65 + spart * 16;
                    float mx = -1e30f;
#pragma unroll
                    for (int j = 0; j < 16; ++j) mx = fmaxf(mx, sr[j]);
                    mx = fmaxf(mx, __shfl_xor(mx, 1)); mx = fmaxf(mx, __shfl_xor(mx, 2));
                    const float mn = fmaxf(m_run, mx), a = exp2f(m_run - mn);
                    float ps = 0.f;
#pragma unroll
                    for (int j = 0; j < 16; ++j) { const float pv = exp2f(sr[j] - mn); sr[j] = pv; ps += pv; }
                    ps += __shfl_xor(ps, 1); ps += __shfl_xor(ps, 2);
                    l_run = l_run * a + ps; m_run = mn;
                    if (spart == 0) al[srow] = a;
                }
                __syncthreads();
#pragma unroll
                for (int i = 0; i < 4; ++i) { const float a = al[mp * 64 + qg * 4 + i];
#pragma unroll
                    for (int j = 0; j < 8; ++j) o[i][j] *= a; }
                for (int k = 0; k < 64; ++k) {
                    float pv[4];
#pragma unroll
                    for (int i = 0; i < 4; ++i) pv[i] = Ss[(mp * 64 + qg * 4 + i) * 65 + k];
                    const f32x4 v0 = *(const LAS f32x4*)&Vs[k * 128 + xg * 8], v1 = *(const LAS f32x4*)&Vs[k * 128 + xg * 8 + 4];
#pragma unroll
                    for (int i = 0; i < 4; ++i) { o[i][0] += pv[i] * v0.x; o[i][1] += pv[i] * v0.y; o[i][2] += pv[i] * v0.z; o[i][3] += pv[i] * v0.w;
                        o[i][4] += pv[i] * v1.x; o[i][5] += pv[i] * v1.y; o[i][6] += pv[i] * v1.z; o[i][7] += pv[i] * v1.w; }
                }
            }
            __syncthreads();
            if (spart == 0) al[128 + srow] = l_run;
            __syncthreads();
#pragma unroll
            for (int i = 0; i < 4; ++i) { const float li = 1.f / al[128 + mp * 64 + qg * 4 + i];
#pragma unroll
                for (int j = 0; j < 8; ++j) o[i][j] *= li; }
            if (mp == 1) {
#pragma unroll
                for (int i = 0; i < 4; ++i)
#pragma unroll
                    for (int j = 0; j < 8; ++j) Vs[(qg * 4 + i) * 128 + xg * 8 + j] = o[i][j];
            }
            __syncthreads();
            if (mp == 0) {
#pragma unroll
                for (int i = 0; i < 4; ++i) {
                    float ss = 0.f;
#pragma unroll
                    for (int j = 0; j < 8; ++j) { o[i][j] -= lam * Vs[(qg * 4 + i) * 128 + xg * 8 + j]; ss += o[i][j] * o[i][j]; }
                    ss += __shfl_xor(ss, 1); ss += __shfl_xor(ss, 2); ss += __shfl_xor(ss, 4); ss += __shfl_xor(ss, 8);
                    const float r = rsqrtf(ss * (1.f / 128.f) + EPS) * 0.8f;
                    u32x4 w; w.x = pk2(o[i][0] * r * subg[xg * 8 + 0], o[i][1] * r * subg[xg * 8 + 1]); w.y = pk2(o[i][2] * r * subg[xg * 8 + 2], o[i][3] * r * subg[xg * 8 + 3]);
                    w.z = pk2(o[i][4] * r * subg[xg * 8 + 4], o[i][5] * r * subg[xg * 8 + 5]); w.w = pk2(o[i][6] * r * subg[xg * 8 + 6], o[i][7] * r * subg[xg * 8 + 7]);
                    *(GAS u32x4*)(MIX + ((size_t)b * SEQ + q0 + qg * 4 + i) * DM + 512 + h * 128 + xg * 8) = w;
                }
            }
        }
    }
    xcd_barrier(bar);

    {
        PHASE_IDS();
        const float* hg = args.in[12];
        LAS unsigned short* tile = (LAS unsigned short*)lds;
        LAS float* rs = (LAS float*)(lds + 32768);
        for (int it = bx; it < 8 * 128; it += G) {
            const int g = it & 7, tb = it >> 3, t0 = tb * 32;
            __syncthreads();
            for (int q = tid; q < 64 * 32; q += 512) { const int ch = q >> 5, seg = q & 31;
                const u32x4 v = *(const GAS u32x4*)(HZ + ((size_t)(g * 64 + ch) * SEQ + t0 + seg) * 8);
                *(LAS u32x4*)(tile + ch * 256 + seg * 8) = v; }
            __syncthreads();
            if (tid < 256) { float s = 0.f; for (int ch = 0; ch < 64; ++ch) { const float v = bf2f(tile[ch * 256 + tid]); s += v * v; } rs[tid] = rsqrtf(s * (1.f / 64.f) + EPS); }
            __syncthreads();
            for (int q = tid; q < 256 * 8; q += 512) { const int tk = q >> 3, c8 = (q & 7) * 8;
                const float r = rs[tk]; const int t = t0 + (tk >> 3), b = tk & 7;
                float v[8];
#pragma unroll
                for (int j = 0; j < 8; ++j) v[j] = bf2f(tile[(c8 + j) * 256 + tk]) * r * hg[g * 64 + c8 + j];
                u32x4 w; w.x = pk2(v[0], v[1]); w.y = pk2(v[2], v[3]); w.z = pk2(v[4], v[5]); w.w = pk2(v[6], v[7]);
                *(GAS u32x4*)(MIX + ((size_t)b * SEQ + t) * DM + g * 64 + c8) = w; }
        }
        __syncthreads();
    }
    xcd_barrier(bar);

    {
        pg8::GeoPlain S; S.A = MIX; S.Bt = WOUT; S.K = DM; S.ord.init(NTOK / 256, DM / 256, G, bx);
        pg8::EpiResF32 E{x, out, DM};
        pg8::gemm_phase(lds, (LAS unsigned*)(lds + TBL_OFF), S, E);
    }
    xcd_barrier(bar);

    {
        PHASE_IDS();
        const float* g = args.in[19]; const float* wr = args.in[20];
        for (int m = gw; m < NTOK; m += NGW) {
            const GAS f32x4* xr = (const GAS f32x4*)(out + (size_t)m * DM) + lane;
            f32x4 v[4]; float s = 0.f;
#pragma unroll
            for (int j = 0; j < 4; ++j) { v[j] = xr[64 * j]; s += (v[j].x * v[j].x + v[j].y * v[j].y) + (v[j].z * v[j].z + v[j].w * v[j].w); }
            const float r = rsqrtf(wave_sum(s) * (1.f / DM) + EPS);
            float lg[16];
#pragma unroll
            for (int e = 0; e < 16; ++e) lg[e] = 0.f;
            GAS u32x2* o8 = (GAS u32x2*)(H2 + (size_t)m * DM) + lane;
#pragma unroll
            for (int j = 0; j < 4; ++j) {
                const f32x4 gg = ((const GAS f32x4*)g)[lane + 64 * j];
                const float hx[4] = {v[j].x * r * gg.x, v[j].y * r * gg.y, v[j].z * r * gg.z, v[j].w * r * gg.w};
                u32x2 w; w.x = pk2(hx[0], hx[1]); w.y = pk2(hx[2], hx[3]); o8[64 * j] = w;
                const int d0 = (lane + 64 * j) * 4;
#pragma unroll
                for (int q = 0; q < 4; ++q) { const GAS f32x4* wp = (const GAS f32x4*)(wr + (size_t)(d0 + q) * 16);
#pragma unroll
                    for (int e4 = 0; e4 < 4; ++e4) { const f32x4 ww = wp[e4]; lg[e4 * 4 + 0] += hx[q] * ww.x; lg[e4 * 4 + 1] += hx[q] * ww.y; lg[e4 * 4 + 2] += hx[q] * ww.z; lg[e4 * 4 + 3] += hx[q] * ww.w; } }
            }
            float mx = -1e30f;
#pragma unroll
            for (int e = 0; e < 16; ++e) { lg[e] = wave_sum(lg[e]); mx = fmaxf(mx, lg[e]); }
            float den = 0.f;
#pragma unroll
            for (int e = 0; e < 16; ++e) { lg[e] = expf(lg[e] - mx); den += lg[e]; }
            const int b = m >> 12, t = m & 4095;
            float mine = 0.f;
#pragma unroll
            for (int e = 0; e < 16; ++e) mine = (lane == e) ? lg[e] : mine;
            if (lane < 16) { AFF[((size_t)lane * NB + b) * SEQ + t] = mine / den; INV[(size_t)m * 16 + lane] = 0xffffu; }
        }
    }
    xcd_barrier(bar);

    {
        PHASE_IDS();
        LAS unsigned* hist = (LAS unsigned*)lds; LAS unsigned* scan = hist + 256; LAS unsigned* selw = scan + 512;
        for (int eb = bx; eb < NE * NB; eb += G) {
            const int b = eb & 7, e = eb >> 3;
            const float* a = AFF + (size_t)eb * SEQ;
            unsigned v[8];
#pragma unroll
            for (int j = 0; j < 8; ++j) v[j] = __float_as_uint(a[tid * 8 + j]);
            unsigned prefix = 0, mask = 0, need = CAP;
            __syncthreads();
            for (int pass = 0; pass < 4; ++pass) {
                const int shift = 24 - 8 * pass;
                if (tid < 256) hist[tid] = 0;
                __syncthreads();
#pragma unroll
                for (int j = 0; j < 8; ++j) if ((v[j] & mask) == prefix) atomicAdd((unsigned*)&hist[(v[j] >> shift) & 255u], 1u);
                __syncthreads();
                if (tid == 0) { unsigned cum = 0; int bin = 255; for (; bin > 0; --bin) { if (cum + hist[bin] >= need) break; cum += hist[bin]; } selw[0] = (unsigned)bin; selw[1] = need - cum; }
                __syncthreads();
                prefix |= selw[0] << shift; mask |= 255u << shift; need = selw[1];
                __syncthreads();
            }
            unsigned cg = 0, ce = 0;
#pragma unroll
            for (int j = 0; j < 8; ++j) { cg += v[j] > prefix; ce += v[j] == prefix; }
            scan[tid] = (cg << 16) | ce;
            __syncthreads();
            for (int off = 1; off < 512; off <<= 1) { const unsigned xx = tid >= off ? scan[tid - off] : 0u; __syncthreads(); scan[tid] += xx; __syncthreads(); }
            const unsigned incl = scan[tid]; unsigned pg = (incl >> 16) - cg, pe = (incl & 0xffffu) - ce;
#pragma unroll
            for (int j = 0; j < 8; ++j) {
                const bool isg = v[j] > prefix, ise = v[j] == prefix;
                if (isg || (ise && pe < need)) {
                    const unsigned pos = pg + (pe < need ? pe : need); const int token = b * SEQ + tid * 8 + j;
                    TOK[(size_t)eb * CAP + pos] = token; GSEL[(size_t)eb * CAP + pos] = __uint_as_float(v[j]); INV[(size_t)token * 16 + e] = (unsigned short)pos;
                }
                pg += isg; pe += ise;
            }
            __syncthreads();
        }
    }
    xcd_barrier(bar);

    {
        pg8::GeoExpert<true> S; S.A = H2; S.Bt = WGU; S.K = DM; S.bexp = (size_t)2 * FF * DM * 2; S.tok = TOK; S.ord.init(NSLOT / 256, 2 * FF / 256, G, bx);
        pg8::EpiSwiGLU E{ACT, FF};
        pg8::gemm_phase(lds, (LAS unsigned*)(lds + TBL_OFF), S, E);
    }
    xcd_barrier(bar);

    {
        pg8::GeoExpert<false> S; S.A = ACT; S.Bt = WD; S.K = FF; S.bexp = (size_t)DM * FF * 2; S.tok = nullptr; S.ord.init(NSLOT / 256, DM / 256, G, bx);
        pg8::EpiBf16 E{Y, DM, 0, 1.f};
        pg8::gemm_phase(lds, (LAS unsigned*)(lds + TBL_OFF), S, E);
    }
    xcd_barrier(bar);

    {
        PHASE_IDS();
        const float* g = args.in[24];
        for (int m = gw; m < NTOK; m += NGW) {
            const GAS f32x4* xr = (const GAS f32x4*)(out + (size_t)m * DM) + lane;
            f32x4 v[4];
#pragma unroll
            for (int j = 0; j < 4; ++j) v[j] = xr[64 * j];
            const int b = m >> 12;
            const unsigned short myinv = INV[(size_t)m * 16 + (lane & 15)];
            for (int e = 0; e < 16; ++e) {
                const unsigned s = (unsigned)__shfl((int)myinv, e);
                if (s != 0xffffu) {
                    const size_t slot = ((size_t)e * NB + b) * CAP + s;
                    const float gv = GSEL[slot];
                    const GAS u32x2* yr = (const GAS u32x2*)(Y + slot * DM) + lane;
#pragma unroll
                    for (int j = 0; j < 4; ++j) { const u32x2 w = yr[64 * j]; v[j].x += gv * bflo(w.x); v[j].y += gv * bfhi(w.x); v[j].z += gv * bflo(w.y); v[j].w += gv * bfhi(w.y); }
                }
            }
            float s = 0.f;
#pragma unroll
            for (int j = 0; j < 4; ++j) s += (v[j].x * v[j].x + v[j].y * v[j].y) + (v[j].z * v[j].z + v[j].w * v[j].w);
            const float r = rsqrtf(wave_sum(s) * (1.f / DM) + EPS);
            GAS f32x4* o = (GAS f32x4*)(out + (size_t)m * DM) + lane;
#pragma unroll
            for (int j = 0; j < 4; ++j) { const f32x4 gg = ((const GAS f32x4*)g)[lane + 64 * j]; o[64 * j] = (f32x4){v[j].x * r * gg.x, v[j].y * r * gg.y, v[j].z * r * gg.z, v[j].w * r * gg.w}; }
        }
    }
}

extern "C" void kernel_launch(void* const* d_in, const int* in_sizes, int n_in, void* d_out, int out_size, void* d_ws, size_t ws_size, hipStream_t stream) {
    static int grid = 0;
    if (grid == 0) {
        if (n_in != 25 || ws_size < WS_END) { fprintf(stderr, "kernel_launch: unexpected n_in %d / ws %zu\n", n_in, ws_size); grid = -1; return; }
        int dev = 0, cus = 0;
        if (hipGetDevice(&dev) != hipSuccess || hipDeviceGetAttribute(&cus, hipDeviceAttributeMultiprocessorCount, dev) != hipSuccess) { grid = -1; return; }
        if (hipFuncSetAttribute((const void*)mega_fwd, hipFuncAttributeMaxDynamicSharedMemorySize, LDS_BYTES) != hipSuccess) { fprintf(stderr, "kernel_launch: hipFuncSetAttribute failed\n"); grid = -1; return; }
        int per_cu = 0;
        if (hipOccupancyMaxActiveBlocksPerMultiprocessor(&per_cu, (const void*)mega_fwd, 512, LDS_BYTES) != hipSuccess || per_cu < 1) fprintf(stderr, "kernel_launch: occupancy query says %d\n", per_cu);
        (void)hipGetLastError();
        grid = cus;
    }
    if (grid < 0) return;
    (void)hipMemsetAsync((char*)d_ws + WS_CTL, 0, CTL_BYTES, stream);
    Args a; memset(&a, 0, sizeof a);
    for (int i = 0; i < 25; ++i) a.in[i] = (const float*)d_in[i];
    a.out = (float*)d_out; a.ws = (unsigned char*)d_ws;
    hipLaunchKernelGGL(mega_fwd, dim3(grid), dim3(512), LDS_BYTES, stream, a);
}
```

```cpp
#include <hip/hip_runtime.h>
#include <cstdio>
#include <cstdint>
#include <cstring>

#define GAS __attribute__((address_space(1)))
#define LAS __attribute__((address_space(3)))
typedef unsigned short bf16_t;
typedef short bf16x8 __attribute__((ext_vector_type(8)));
typedef float f32x4 __attribute__((ext_vector_type(4)));
typedef float f32x2 __attribute__((ext_vector_type(2)));
typedef unsigned u32x4 __attribute__((ext_vector_type(4)));
typedef unsigned u32x2 __attribute__((ext_vector_type(2)));
typedef short v4i16_t __attribute__((ext_vector_type(4)));
typedef float f32x16 __attribute__((ext_vector_type(16)));

constexpr int DM = 1024, NB = 8, SEQ = 4096, NTOK = NB * SEQ;
constexpr int HW = 512, HCOLS = 1536, INC = 3072, ACOLS = 1536;
constexpr int NE = 16, CAP = 512, FF = 2816, NSLOT = NE * NB * CAP;
constexpr float EPS = 1e-6f;
constexpr float LOG2E = 1.4426950408889634f;
constexpr float QSCALE = 0.125f * LOG2E;
constexpr int GOFF = 4352, GLEN = 8704;

constexpr size_t MiB = 1u << 20;
constexpr size_t WS_CTL = 0, CTL_BYTES = 1 * MiB;
constexpr size_t WS_WGU = 2 * MiB;
constexpr size_t WS_Y = WS_WGU;
constexpr size_t WS_WD = 178 * MiB;
constexpr size_t WS_AFF = 266 * MiB;
constexpr size_t WS_TOK = 268 * MiB;
constexpr size_t WS_GSEL = WS_TOK + 256 * 1024;
constexpr size_t WS_INV = 269 * MiB;
constexpr size_t WS_XN = 270 * MiB;
constexpr size_t WS_H2 = WS_XN;
constexpr size_t WS_ACT = 334 * MiB;
constexpr size_t WS_WIN = 334 * MiB;
constexpr size_t WS_WOUT = 340 * MiB;
constexpr size_t WS_GF = 342 * MiB;
constexpr size_t WS_HP = 360 * MiB;
constexpr size_t WS_QKV = 456 * MiB;
constexpr size_t WS_HZ = 552 * MiB;
constexpr size_t WS_MIX = 584 * MiB;
constexpr size_t WS_END = 686 * MiB;
constexpr int CW_BAR = 4096;
constexpr int CW_NSUM = 16384;

constexpr int LDS_BYTES = 160 * 1024;
constexpr int MISC_OFF = LDS_BYTES - 256;
constexpr int HY_ZBYTES = (SEQ + 32) * 16, HY_ZA = 0, HY_ZB = HY_ZBYTES, HY_FB = 2 * HY_ZBYTES;
constexpr int TBL_OFF = 131072;

__device__ __forceinline__ unsigned f2bf(float f) { unsigned u = __builtin_bit_cast(unsigned, f); return (u + 0x7fffu + ((u >> 16) & 1u)) >> 16; }
__device__ __forceinline__ unsigned pk2(float lo, float hi) { return f2bf(lo) | (f2bf(hi) << 16); }
__device__ __forceinline__ float bf2f(unsigned short h) { return __builtin_bit_cast(float, (unsigned)h << 16); }
__device__ __forceinline__ float bflo(unsigned w) { return __builtin_bit_cast(float, w << 16); }
__device__ __forceinline__ float bfhi(unsigned w) { return __builtin_bit_cast(float, w & 0xffff0000u); }
__device__ __forceinline__ float wave_sum(float v) {
#pragma unroll
    for (int o = 1; o < 64; o <<= 1) v += __shfl_xor(v, o);
    return v;
}
#define LDS_WAIT() asm volatile("s_waitcnt lgkmcnt(0)" ::: "memory")
#define PHASE_IDS() int tid_o = threadIdx.x; asm volatile("" : "+v"(tid_o)); const int tid = tid_o, lane = tid & 63; (void)lane

namespace pg8 {
constexpr int BM = 256, BK = 64, HALF = 128, HTB = HALF * BK * 2, STAGE_BYTES = 8 * HTB, NXCD = 8, WGM = 8;
__host__ __device__ __forceinline__ int lds_byte(int r, int c) { const int st = (r >> 4) * 2 + (c >> 5), rr = r & 15, cc = c & 31, ob = rr * 64 + cc * 2; return st * 1024 + (ob ^ (((ob >> 9) & 1) << 5)); }
__host__ __device__ __forceinline__ void stage_rc(int b, int& R, int& C) { const int st = b / 1024, sb = b % 1024, swz = sb ^ (((sb >> 9) & 1) << 5); R = (st >> 1) * 16 + swz / 64; C = (st & 1) * 32 + (swz % 64) / 2; }
__host__ __device__ __forceinline__ int perm32(int rho) { const int n = rho >> 4, i = rho & 15; return 8 * (i >> 2) + 4 * n + (i & 3); }
struct Unit { int pm, pn; };

struct TileOrder {
    int nM, nN, nwg, G, c;
    __device__ void init(int nM_, int nN_, int G_, int c_) { nM = nM_; nN = nN_; nwg = nM * nN; G = G_; c = c_; }
    __device__ bool next(int i, Unit& u) const {
        const long L = (long)i * G + c; if (L >= nwg) return false;
        int wgid = (int)L; { const int q = nwg / NXCD, r = nwg % NXCD, xcd = wgid % NXCD, off = wgid / NXCD; wgid = (xcd < r ? xcd * (q + 1) : r * (q + 1) + (xcd - r) * q) + off; }
        const int nig = WGM * nN, gid = wgid / nig, fm = gid * WGM, gsz = (nM - fm) < WGM ? (nM - fm) : WGM;
        u.pm = fm + ((wgid % nig) % gsz); u.pn = (wgid % nig) / gsz; return true;
    }
};
__device__ __forceinline__ unsigned cvt_pk_bf16(float lo, float hi) { unsigned r; asm volatile("v_cvt_pk_bf16_f32 %0, %1, %2" : "=v"(r) : "v"(lo), "v"(hi)); return r; }

struct EpiBf16 {
    static constexpr bool PERM = true;
    bf16_t* O; int ldc; int scols; float sc;
    __device__ __forceinline__ void operator()(const f32x4 (&acc)[2][2][4][2], const Unit& u, int wr, int wc, int fr, int fq) const {
        const int row0 = u.pm * BM + wr * 64 + fr, col0 = u.pn * BM + wc * 32 + 8 * fq;
        const float s = (u.pn * BM < scols) ? sc : 1.f;
#pragma unroll
        for (int ai = 0; ai < 2; ++ai)
#pragma unroll
            for (int m = 0; m < 4; ++m) { bf16_t* rowp = O + (size_t)(row0 + ai * HALF + m * 16) * ldc + col0;
#pragma unroll
                for (int bj = 0; bj < 2; ++bj) { const f32x4 v0 = acc[ai][bj][m][0] * s, v1 = acc[ai][bj][m][1] * s;
                    u32x4 w; w.x = cvt_pk_bf16(v0[0], v0[1]); w.y = cvt_pk_bf16(v0[2], v0[3]); w.z = cvt_pk_bf16(v1[0], v1[1]); w.w = cvt_pk_bf16(v1[2], v1[3]);
                    *(u32x4*)(rowp + bj * HALF) = w; } }
    }
};
struct EpiResF32 {
    static constexpr bool PERM = false;
    const float* R; float* C; int ldc;
    __device__ __forceinline__ void operator()(const f32x4 (&acc)[2][2][4][2], const Unit& u, int wr, int wc, int fr, int fq) const {
        const int row0 = u.pm * BM + wr * 64 + fr, col0 = u.pn * BM + wc * 32 + 4 * fq;
#pragma unroll
        for (int ai = 0; ai < 2; ++ai)
#pragma unroll
            for (int m = 0; m < 4; ++m) { const size_t off = (size_t)(row0 + ai * HALF + m * 16) * ldc + col0;
#pragma unroll
                for (int bj = 0; bj < 2; ++bj)
#pragma unroll
                    for (int n = 0; n < 2; ++n) { const f32x4 r = *(const f32x4*)(R + off + bj * HALF + n * 16); *(f32x4*)(C + off + bj * HALF + n * 16) = r + acc[ai][bj][m][n]; } }
    }
};
struct EpiSwiGLU {
    static constexpr bool PERM = true;
    bf16_t* O; int ldc;
    __device__ __forceinline__ void operator()(const f32x4 (&acc)[2][2][4][2], const Unit& u, int wr, int wc, int fr, int fq) const {
        const int row0 = u.pm * BM + wr * 64 + fr, col0 = u.pn * HALF + wc * 32 + 8 * fq;
#pragma unroll
        for (int ai = 0; ai < 2; ++ai)
#pragma unroll
            for (int m = 0; m < 4; ++m) { bf16_t* rowp = O + (size_t)(row0 + ai * HALF + m * 16) * ldc + col0;
                float o[8];
#pragma unroll
                for (int n = 0; n < 2; ++n)
#pragma unroll
                    for (int j = 0; j < 4; ++j) { const float g = acc[ai][0][m][n][j], up = acc[ai][1][m][n][j];
                        o[n * 4 + j] = g * __builtin_amdgcn_rcpf(1.f + __builtin_amdgcn_exp2f(-g * LOG2E)) * up; }
                u32x4 w; w.x = cvt_pk_bf16(o[0], o[1]); w.y = cvt_pk_bf16(o[2], o[3]); w.z = cvt_pk_bf16(o[4], o[5]); w.w = cvt_pk_bf16(o[6], o[7]);
                *(u32x4*)rowp = w; }
    }
};

struct GeoPlain {
    static constexpr bool GATHER = false;
    const bf16_t* A; const bf16_t* Bt; int K; TileOrder ord;
    __device__ __forceinline__ bool next(int i, Unit& u) const { return ord.next(i, u); }
    __device__ __forceinline__ const char* a_ptr(const Unit& u) const { return (const char*)A + (size_t)u.pm * BM * K * 2; }
    __device__ __forceinline__ const char* b_ptr(const Unit& u) const { return (const char*)Bt + (size_t)u.pn * BM * K * 2; }
    __device__ __forceinline__ size_t hstepA() const { return (size_t)HALF * K * 2; }
    __device__ __forceinline__ size_t hstepB() const { return (size_t)HALF * K * 2; }
    __device__ __forceinline__ unsigned a_voff(int R, int C) const { return (unsigned)(R * K + C) * 2u; }
    __device__ __forceinline__ unsigned b_voff(int R, int C) const { return (unsigned)(R * K + C) * 2u; }
    __device__ __forceinline__ void fill_table(LAS unsigned*, const Unit&, int) const {}
};
struct GeoTokPerm {
    static constexpr bool GATHER = false;
    const bf16_t* A; const bf16_t* X; int K; TileOrder ord;
    __device__ __forceinline__ bool next(int i, Unit& u) const { return ord.next(i, u); }
    __device__ __forceinline__ const char* a_ptr(const Unit& u) const { return (const char*)A + (size_t)u.pm * BM * K * 2; }
    __device__ __forceinline__ const char* b_ptr(const Unit& u) const { return (const char*)X + (size_t)u.pn * 32 * K * 2; }
    __device__ __forceinline__ size_t hstepA() const { return (size_t)HALF * K * 2; }
    __device__ __forceinline__ size_t hstepB() const { return (size_t)16 * K * 2; }
    __device__ __forceinline__ unsigned a_voff(int R, int C) const { return (unsigned)(R * K + C) * 2u; }
    __device__ __forceinline__ unsigned b_voff(int R, int C) const { return (unsigned)(((R & 7) * SEQ + (R >> 3)) * K + C) * 2u; }
    __device__ __forceinline__ void fill_table(LAS unsigned*, const Unit&, int) const {}
};
template <bool G> struct GeoExpert {
    static constexpr bool GATHER = G;
    const bf16_t* A; const bf16_t* Bt; int K; size_t bexp;    const int* tok; TileOrder ord;
    __device__ __forceinline__ bool next(int i, Unit& u) const { return ord.next(i, u); }
    __device__ __forceinline__ const char* a_ptr(const Unit& u) const { return G ? (const char*)A : (const char*)A + (size_t)u.pm * BM * K * 2; }
    __device__ __forceinline__ const char* b_ptr(const Unit& u) const { return (const char*)Bt + (size_t)(u.pm >> 4) * bexp + (size_t)u.pn * BM * K * 2; }
    __device__ __forceinline__ size_t hstepA() const { return (size_t)HALF * K * 2; }
    __device__ __forceinline__ size_t hstepB() const { return (size_t)HALF * K * 2; }
    __device__ __forceinline__ unsigned a_voff(int R, int C) const { return (unsigned)(R * K + C) * 2u; }
    __device__ __forceinline__ unsigned b_voff(int R, int C) const { return (unsigned)(R * K + C) * 2u; }
    __device__ __forceinline__ void fill_table(LAS unsigned* tb, const Unit& u, int tid) const { if (G) { int t_ = tid; asm volatile("" : "+v"(t_));
#pragma unroll
        for (int i = 0; i < 2; ++i) { int R, C; stage_rc(t_ * 16 + i * 8192, R, C);
#pragma unroll
            for (int h = 0; h < 2; ++h) tb[h * 1024 + i * 512 + tid] = (unsigned)tok[u.pm * 256 + h * 128 + R] * (unsigned)(K * 2) + (unsigned)C * 2u; } } }
};

template <class Epi, class Geo>
__device__ __forceinline__ void gemm_phase(LAS unsigned char* lds, LAS unsigned* tbl, const Geo& S, const Epi& E) {
    int tid_ = threadIdx.x; asm volatile("" : "+v"(tid_));
    const int tid = tid_, wid = __builtin_amdgcn_readfirstlane(tid >> 6), lane = tid & 63, wr = wid >> 2, wc = wid & 3, fr = lane & 15, fq = lane >> 4;
    const int K = S.K, nt = K / BK;
    unsigned voffA[2], voffB[2];
#pragma unroll
    for (int i = 0; i < 2; ++i) { int R, C; stage_rc(tid * 16 + i * 8192, R, C); const int Rb = Epi::PERM ? ((R & ~31) + perm32(R & 31)) : R;
        voffA[i] = S.a_voff(R, C); voffB[i] = S.b_voff(Rb, C); }
    const size_t kstep = (size_t)(BK * 2);
    const size_t hstepA = S.hstepA(), hstepB = S.hstepB();
    const unsigned ldsw = (unsigned)wid * 1024u;
    const int aoff = lds_byte(wr * 64 + fr, fq * 8), boff = lds_byte(wc * 32 + fr, fq * 8);
#define PG8_SA(b, h) (((b) * 2 + (h)) * HTB)
#define PG8_SB(b, h) ((4 + (b) * 2 + (h)) * HTB)
#define PG8_STAGE(bufoff, gbase, voff) do { _Pragma("unroll") for (int _i = 0; _i < 2; ++_i) \
        __builtin_amdgcn_global_load_lds((const unsigned*)((const char*)(gbase) + (voff)[_i]), (LAS unsigned*)(lds + (bufoff) + ldsw + _i * 8192), 16, 0, 0); } while (0)
#define PG8_STAGE_A(bufoff, gbase, h, nx) do { if constexpr (Geo::GATHER) { const LAS unsigned* _tb = tbl + (((ui + ((nx) ? 1 : 0)) & 1) * 2048) + (h) * 1024 + tid; unsigned _vo[2]; \
        _vo[0] = _tb[0]; _vo[1] = _tb[512]; PG8_STAGE(bufoff, gbase, _vo); } else { PG8_STAGE(bufoff, (gbase) + (h) * hstepA, voffA); } } while (0)
#define PG8_LDA(dst, b, h) do { _Pragma("unroll") for (int m = 0; m < 4; ++m) _Pragma("unroll") for (int k = 0; k < 2; ++k) dst[m][k] = *(const LAS bf16x8*)(lds + PG8_SA(b, h) + aoff + m * 2048 + k * 1024); } while (0)
#define PG8_LDB(dst, b, h) do { _Pragma("unroll") for (int n = 0; n < 2; ++n) _Pragma("unroll") for (int k = 0; k < 2; ++k) dst[n][k] = *(const LAS bf16x8*)(lds + PG8_SB(b, h) + boff + n * 2048 + k * 1024); } while (0)
#define PG8_MMA(ai, bj, At, Bt) do { __builtin_amdgcn_s_setprio(1); _Pragma("unroll") for (int m = 0; m < 4; ++m) _Pragma("unroll") for (int n = 0; n < 2; ++n) _Pragma("unroll") for (int k = 0; k < 2; ++k) \
        acc[ai][bj][m][n] = __builtin_amdgcn_mfma_f32_16x16x32_bf16(Bt[n][k], At[m][k], acc[ai][bj][m][n], 0, 0, 0); __builtin_amdgcn_s_setprio(0); } while (0)
#define PG8_WAIT_V(n) asm volatile("s_waitcnt vmcnt(" #n ")" ::: "memory")
#define PG8_WAIT_L(n) asm volatile("s_waitcnt lgkmcnt(" #n ")" ::: "memory")
#define PG8_BAR __builtin_amdgcn_s_barrier()
#define PG8_SCHED __builtin_amdgcn_sched_barrier(0)
    Unit cur, nxt; int ui = 0;
    if (!S.next(0, cur)) return;
    f32x4 acc[2][2][4][2];
#pragma unroll
    for (int a = 0; a < 2; ++a)
#pragma unroll
        for (int b = 0; b < 2; ++b)
#pragma unroll
            for (int m = 0; m < 4; ++m)
#pragma unroll
                for (int n = 0; n < 2; ++n) acc[a][b][m][n] = (f32x4){0.f, 0.f, 0.f, 0.f};
    bf16x8 At[4][2], B0[2][2], B1[2][2];
    const char* cA = S.a_ptr(cur); const char* cB = S.b_ptr(cur);
    if constexpr (Geo::GATHER) {
        S.fill_table(tbl, cur, tid);
        Unit u1; if (S.next(1, u1)) S.fill_table(tbl + 2048, u1, tid);
        asm volatile("s_waitcnt vmcnt(0) lgkmcnt(0)" ::: "memory"); PG8_BAR; asm volatile("" ::: "memory");
    }
    PG8_STAGE(PG8_SB(0, 0), cB, voffB); PG8_STAGE(PG8_SB(0, 1), cB + hstepB, voffB); PG8_STAGE_A(PG8_SA(0, 0), cA, 0, false); PG8_STAGE_A(PG8_SA(0, 1), cA, 1, false);
    if (wr == 1) PG8_BAR;
    PG8_WAIT_V(2); PG8_BAR;
    PG8_STAGE(PG8_SB(1, 0), cB + kstep, voffB); PG8_STAGE_A(PG8_SA(1, 0), cA + kstep, 0, false); PG8_STAGE(PG8_SB(1, 1), cB + hstepB + kstep, voffB);
    PG8_WAIT_V(6); PG8_BAR;
    for (;;) {
        const bool has_next = S.next(ui + 1, nxt);
        const char* nA = has_next ? S.a_ptr(nxt) : cA; const char* nB = has_next ? S.b_ptr(nxt) : cB;
        for (int t = 0; t < nt; t += 2) {
            const bool last = (t == nt - 2);
            const bool lastn = last && has_next;
            const char* a1 = cA + (size_t)(t + 1) * kstep;
            const char* a2 = last ? nA : cA + (size_t)(t + 2) * kstep; const char* b2 = last ? nB : cB + (size_t)(t + 2) * kstep;
            const char* a3 = a2 + kstep; const char* b3 = b2 + kstep;
            if constexpr (Geo::GATHER) { if (t == 2 && ui > 0) { Unit u2; if (S.next(ui + 1, u2)) S.fill_table(tbl + (((ui + 1) & 1) * 2048), u2, tid); } }
            PG8_LDB(B0, 0, 0); PG8_LDB(B1, 0, 1); PG8_SCHED; PG8_LDA(At, 0, 0); PG8_STAGE_A(PG8_SA(1, 1), a1, 1, false);
            PG8_WAIT_V(8); PG8_WAIT_L(0); PG8_BAR; PG8_MMA(0, 0, At, B0); PG8_MMA(0, 1, At, B1); PG8_BAR; PG8_SCHED;
            PG8_LDA(At, 0, 1); PG8_STAGE(PG8_SB(0, 0), b2, voffB); PG8_STAGE(PG8_SB(0, 1), b2 + hstepB, voffB); PG8_STAGE_A(PG8_SA(0, 0), a2, 0, lastn);
            PG8_WAIT_V(8); PG8_WAIT_L(0); PG8_BAR; PG8_MMA(1, 0, At, B0); PG8_MMA(1, 1, At, B1); PG8_BAR; PG8_SCHED;
            PG8_LDB(B0, 1, 0); PG8_LDB(B1, 1, 1); PG8_SCHED; PG8_LDA(At, 1, 0); PG8_STAGE_A(PG8_SA(0, 1), a2, 1, lastn);
            PG8_WAIT_V(8); PG8_WAIT_L(0); PG8_BAR; PG8_MMA(0, 0, At, B0); PG8_MMA(0, 1, At, B1); PG8_BAR; PG8_SCHED;
            PG8_LDA(At, 1, 1); PG8_STAGE(PG8_SB(1, 0), b3, voffB); PG8_STAGE(PG8_SB(1, 1), b3 + hstepB, voffB); PG8_STAGE_A(PG8_SA(1, 0), a3, 0, lastn);
            PG8_WAIT_V(8); PG8_WAIT_L(0); PG8_BAR; PG8_MMA(1, 0, At, B0); PG8_MMA(1, 1, At, B1); PG8_BAR; PG8_SCHED;
        }
        if (wr == 0) PG8_BAR;
        E(acc, cur, wr, wc, fr, fq);
        if (!has_next) break;
#pragma unroll
        for (int a = 0; a < 2; ++a)
#pragma unroll
            for (int b = 0; b < 2; ++b)
#pragma unroll
                for (int m = 0; m < 4; ++m)
#pragma unroll
                    for (int n = 0; n < 2; ++n) acc[a][b][m][n] = (f32x4){0.f, 0.f, 0.f, 0.f};
        cur = nxt; cA = nA; cB = nB; ++ui;
        if (wr == 1) PG8_BAR;
    }
    PG8_WAIT_V(0);
    PG8_BAR;
#undef PG8_SA
#undef PG8_SB
#undef PG8_STAGE
#undef PG8_STAGE_A
#undef PG8_LDA
#undef PG8_LDB
#undef PG8_MMA
#undef PG8_WAIT_V
#undef PG8_WAIT_L
#undef PG8_BAR
#undef PG8_SCHED
}
}

typedef GAS unsigned gu32;
#define XB_TMO      128
#define XB_XCNT(j)  (256  + 64 * (j))
#define XB_XSUB(j)  (1280 + 64 * (j))
#define XB_XGEN(j)  (2304 + 64 * (j))
#define XB_TOP      3328
#define XB_TOPGEN   3392
#define XCD_BAR_WORDS 3456
#define XB_SPIN_CAP (1u << 23)
__device__ __forceinline__ unsigned xb_ld(unsigned* p)              { return __hip_atomic_load(p, __ATOMIC_RELAXED, __HIP_MEMORY_SCOPE_AGENT); }
__device__ __forceinline__ unsigned xb_add(unsigned* p, unsigned v) { return __hip_atomic_fetch_add(p, v, __ATOMIC_RELAXED, __HIP_MEMORY_SCOPE_AGENT); }
__device__ __forceinline__ unsigned xb_xcc_id() { return (unsigned)__builtin_amdgcn_s_getreg((3 << 11) | 20) & 0xFu; }
#define XB_SPIN(cond, bar) do { unsigned _sp = 0; while (cond) { __builtin_amdgcn_s_sleep(1); \
    if ((++_sp & 255u) == 0u) { if (xb_ld(&(bar)[XB_TMO])) break; if (_sp > XB_SPIN_CAP) { atomicAdd(&(bar)[XB_TMO], 1u); break; } } } } while (0)
struct XcdBarrier { unsigned* bar; unsigned x; volatile LAS unsigned* st; };
__device__ __forceinline__ XcdBarrier xcd_barrier_post(unsigned* bar, volatile LAS unsigned* st) {
    XcdBarrier b; b.bar = bar; b.x = xb_xcc_id(); b.st = st;
    if (threadIdx.x == 0) (void)xb_add(&bar[XB_XCNT(b.x)], 1u);
    return b;
}
__device__ __forceinline__ void xcd_barrier_complete(unsigned* bar, unsigned x, unsigned& nloc, unsigned& nx) {
    const unsigned G = gridDim.x * gridDim.y * gridDim.z;
    unsigned sum, cnt, mine, sp = 0u;
    for (;;) {
        sum = 0u; cnt = 0u; mine = 0u;
#pragma unroll
        for (unsigned j = 0; j < 16; ++j) { const unsigned c = xb_ld(&bar[XB_XCNT(j)]); sum += c; cnt += (c > 0u) ? 1u : 0u; mine = (j == x) ? c : mine; }
        if (sum == G) break;
        __builtin_amdgcn_s_sleep(1);
        if ((++sp & 255u) == 0u) { if (xb_ld(&bar[XB_TMO])) break; if (sp > XB_SPIN_CAP) { atomicAdd(&bar[XB_TMO], 1u); break; } }
    }
    nloc = mine > 0u ? mine : 1u; nx = cnt > 0u ? cnt : 1u;
}
__device__ __forceinline__ void xcd_barrier(const XcdBarrier& b) {
    asm volatile("s_waitcnt vmcnt(0)" ::: "memory");
    __syncthreads();
    if (threadIdx.x == 0) {
        unsigned* bar = b.bar;
        __builtin_amdgcn_s_waitcnt(0);
        unsigned nloc = b.st[0], nx = b.st[1];
        if (nloc == 0u) { xcd_barrier_complete(bar, b.x, nloc, nx); b.st[0] = nloc; b.st[1] = nx; }
        const unsigned old = xb_add(&bar[XB_XSUB(b.x)], 1u);
        const unsigned gen = old / nloc;
        if (old + 1u == (gen + 1u) * nloc) {
            __builtin_amdgcn_fence(__ATOMIC_RELEASE, "agent");
            asm volatile("s_waitcnt vmcnt(0)" ::: "memory");
            const unsigned og = xb_add(&bar[XB_TOP], 1u);
            const unsigned tg = og / nx;
            if (og + 1u == (tg + 1u) * nx) xb_add(&bar[XB_TOPGEN], 1u);
            else XB_SPIN(xb_ld(&bar[XB_TOPGEN]) == tg, bar);
            __builtin_amdgcn_fence(__ATOMIC_ACQUIRE, "agent");
            xb_add(&bar[XB_XGEN(b.x)], 1u);
            asm volatile("s_waitcnt vmcnt(0)" ::: "memory");
        } else {
            XB_SPIN(xb_ld(&bar[XB_XGEN(b.x)]) == gen, bar);
            __builtin_amdgcn_fence(__ATOMIC_ACQUIRE, "agent");
            asm volatile("s_waitcnt vmcnt(0)" ::: "memory");
        }
    }
    __syncthreads();
}

__device__ __forceinline__ void p0_transpose_item(const float* W, int K, int N, bf16_t* WT, int k0, int n0, int orow0, LAS float* scr, int lane) {
#pragma unroll 8
    for (int i = 0; i < 32; ++i) { const int kk = 2 * i + (lane >> 5); scr[kk * 33 + (lane & 31)] = W[(size_t)(k0 + kk) * N + n0 + (lane & 31)]; }
    LDS_WAIT(); asm volatile("" ::: "memory");
    const int c = lane & 7;
#pragma unroll
    for (int j = 0; j < 4; ++j) { const int n = (lane >> 3) + 8 * j; const LAS float* s = scr + (8 * c) * 33 + n;
        u32x4 o; o.x = pk2(s[0 * 33], s[1 * 33]); o.y = pk2(s[2 * 33], s[3 * 33]); o.z = pk2(s[4 * 33], s[5 * 33]); o.w = pk2(s[6 * 33], s[7 * 33]);
        *(GAS u32x4*)(WT + (size_t)(orow0 + n) * K + k0 + 8 * c) = o; }
    LDS_WAIT(); asm volatile("" ::: "memory");
}

struct Args { const float* in[25]; float* out; unsigned char* ws; };

__global__ void __launch_bounds__(512, 2) mega_fwd(Args args) {
    extern __shared__ __attribute__((aligned(16))) unsigned char lds_raw[];
    LAS unsigned char* lds = (LAS unsigned char*)lds_raw;
    volatile LAS unsigned* MISC = (volatile LAS unsigned*)(lds + MISC_OFF);
    const int tid = threadIdx.x, lane = tid & 63, wave = __builtin_amdgcn_readfirstlane(tid >> 6);
    const int G = gridDim.x, bx = blockIdx.x;
    const int gw = bx * 8 + wave, NGW = G * 8;
    unsigned char* ws = args.ws;
    gu32* ctl = (gu32*)(ws + WS_CTL);
    const float* x = args.in[0];
    float* out = args.out;
    bf16_t* WGU = (bf16_t*)(ws + WS_WGU); bf16_t* WD = (bf16_t*)(ws + WS_WD); bf16_t* WIN = (bf16_t*)(ws + WS_WIN); bf16_t* WOUT = (bf16_t*)(ws + WS_WOUT);
    bf16_t* XN = (bf16_t*)(ws + WS_XN); bf16_t* H2 = (bf16_t*)(ws + WS_H2); bf16_t* GF = (bf16_t*)(ws + WS_GF);
    bf16_t* HP = (bf16_t*)(ws + WS_HP); bf16_t* QKV = (bf16_t*)(ws + WS_QKV); bf16_t* HZ = (bf16_t*)(ws + WS_HZ); bf16_t* MIX = (bf16_t*)(ws + WS_MIX);
    bf16_t* ACT = (bf16_t*)(ws + WS_ACT); bf16_t* Y = (bf16_t*)(ws + WS_Y);
    float* AFF = (float*)(ws + WS_AFF); int* TOK = (int*)(ws + WS_TOK); float* GSEL = (float*)(ws + WS_GSEL); unsigned short* INV = (unsigned short*)(ws + WS_INV);
    float* NSUM = (float*)(ws + WS_CTL) + CW_NSUM;

    if (tid < 64) ((LAS unsigned*)(lds + MISC_OFF))[tid] = 0u;
    __syncthreads();
    XcdBarrier bar = xcd_barrier_post((unsigned*)(ctl + CW_BAR), MISC + 8);

    {
        PHASE_IDS();
        LAS float* scr = (LAS float*)(lds + wave * 16384);
        constexpr int I_IN = (DM / 64) * (INC / 32), I_OUT = (DM / 64) * (DM / 32), I_GU = (DM / 64) * (FF / 32), I_DN = (FF / 64) * (DM / 32);
        constexpr int NITEMS = I_IN + I_OUT + NE * (2 * I_GU + I_DN);
        for (int it = gw; it < NITEMS; it += NGW) {
            int r = it;
            if (r < I_IN) { const int nblk = INC / 32, kb = r / nblk, nb = r % nblk; p0_transpose_item(args.in[2], DM, INC, WIN, 64 * kb, 32 * nb, 32 * nb, scr, lane); continue; } r -= I_IN;
            if (r < I_OUT) { const int nblk = DM / 32, kb = r / nblk, nb = r % nblk; p0_transpose_item(args.in[18], DM, DM, WOUT, 64 * kb, 32 * nb, 32 * nb, scr, lane); continue; } r -= I_OUT;
            const int e = r / (2 * I_GU + I_DN); r -= e * (2 * I_GU + I_DN);
            if (r < 2 * I_GU) { const int up = r >= I_GU; if (up) r -= I_GU; const int nblk = FF / 32, kb = r / nblk, nb = r % nblk, f0 = 32 * nb;
                const int orow = (f0 >> 7) * 256 + up * 128 + (f0 & 127);
                p0_transpose_item(args.in[up ? 22 : 21] + (size_t)e * DM * FF, DM, FF, WGU + (size_t)e * 2 * FF * DM, 64 * kb, f0, orow, scr, lane); continue; }
            r -= 2 * I_GU;
            { const int nblk = DM / 32, kb = r / nblk, nb = r % nblk; p0_transpose_item(args.in[23] + (size_t)e * FF * DM, FF, DM, WD + (size_t)e * DM * FF, 64 * kb, 32 * nb, 32 * nb, scr, lane); }
        }
        const float* g = args.in[1];
        for (int m = gw; m < NTOK; m += NGW) {
            const GAS f32x4* xr = (const GAS f32x4*)(x + (size_t)m * DM) + lane;
            f32x4 v[4]; float s = 0.f;
#pragma unroll
            for (int j = 0; j < 4; ++j) { v[j] = xr[64 * j]; s += (v[j].x * v[j].x + v[j].y * v[j].y) + (v[j].z * v[j].z + v[j].w * v[j].w); }
            const float rstd = rsqrtf(wave_sum(s) * (1.f / DM) + EPS);
            GAS u32x2* o8 = (GAS u32x2*)(XN + (size_t)m * DM) + lane;
#pragma unroll
            for (int j = 0; j < 4; ++j) { const f32x4 gg = ((const GAS f32x4*)g)[lane + 64 * j]; u32x2 w; w.x = pk2(v[j].x * rstd * gg.x, v[j].y * rstd * gg.y); w.y = pk2(v[j].z * rstd * gg.z, v[j].w * rstd * gg.w); o8[64 * j] = w; }
        }
        __syncthreads();
        for (int it = bx; it < 256; it += G) {
            const int ib = it >> 2, dn = it & 3, dir = dn >> 1, n = dn & 1, i0 = ib * 64;
            LAS float* zz = (LAS float*)lds;
            LAS float* h1 = zz + 64 * 33;
            LAS float* h2 = h1 + 64 * 64;
            const float* w1 = args.in[5]; const float* b1 = args.in[6]; const float* w2 = args.in[7]; const float* b2 = args.in[8]; const float* w3 = args.in[9]; const float* fr = args.in[10];
            for (int q = tid; q < 64 * 33; q += 512) { const int p = q / 33, j = q % 33, i = i0 + p;
                const float t = (float)i / (float)(SEQ - 1), w = 6.283185307179586f * (float)i / (float)SEQ; float v;
                if (j == 0) v = t; else { const float band = 1e-4f + (float)((j - 1) & 15) * ((15.f - 1e-4f) / 15.f); v = (j <= 16) ? cosf(band * w) : -sinf(band * w); }
                zz[q] = v; }
            __syncthreads();
            for (int q = tid; q < 64 * 64; q += 512) { const int p = q >> 6, j = q & 63; float a = b1[j]; for (int k = 0; k < 33; ++k) a += zz[p * 33 + k] * w1[k * 64 + j]; h1[q] = sinf(fr[j] * a); }
            __syncthreads();
            for (int q = tid; q < 64 * 64; q += 512) { const int p = q >> 6, j = q & 63; float a = b2[j]; for (int k = 0; k < 64; ++k) a += h1[p * 64 + k] * w2[k * 64 + j]; h2[q] = sinf(fr[j] * a); }
            __syncthreads();
            const int c = tid, col = dn * 512 + c;
            const float mind = logf(1e-2f) / 1.5f, maxd = logf(1e-2f) / 0.3f;
            const float delta = fabsf(mind + (float)c * ((maxd - mind) / 511.f));
            bf16_t* gf = GF + (size_t)(n * 512 + c) * GLEN;
            float asum = 0.f;
            for (int p0 = 0; p0 < 64; p0 += 16) {
                float hv[16];
#pragma unroll
                for (int p = 0; p < 16; ++p) hv[p] = 0.f;
                for (int k = 0; k < 64; ++k) { const float wk = w3[k * 2048 + col];
#pragma unroll
                    for (int p = 0; p < 16; ++p) hv[p] += h2[(p0 + p) * 64 + k] * wk; }
#pragma unroll
                for (int p = 0; p < 16; ++p) { const int i = i0 + p0 + p; const float t = (float)i / (float)(SEQ - 1); const float h = hv[p] * expf(-t * delta);
                    const unsigned hb = f2bf(h); const float hr = __builtin_bit_cast(float, hb << 16);
                    if (dir == 0) { gf[GOFF - i] = (bf16_t)hb; asum += fabsf(hr); } else if (i > 0) { gf[GOFF + i] = (bf16_t)hb; asum += fabsf(hr); } }
            }
            if (ib == 63) { if (dir == 0) { for (int q = 0; q < GOFF - 4095; ++q) gf[q] = 0; } else { for (int q = GOFF + 4096; q < GLEN; ++q) gf[q] = 0; } }
            atomicAdd(&NSUM[n * 512 + c], asum);
            __syncthreads();
        }
    }
    xcd_barrier(bar);

    {
        pg8::GeoTokPerm S; S.A = WIN; S.X = XN; S.K = DM; S.ord.init(HCOLS / 256, NTOK / 256, G, bx);
        pg8::EpiBf16 E{HP, NTOK, 0, 1.f};
        pg8::gemm_phase(lds, (LAS unsigned*)(lds + TBL_OFF), S, E);
    }
    {
        pg8::GeoPlain S; S.A = XN; S.Bt = WIN + (size_t)HCOLS * DM; S.K = DM; S.ord.init(NTOK / 256, ACOLS / 256, G, bx);
        pg8::EpiBf16 E{QKV, ACOLS, 512, QSCALE};
        pg8::gemm_phase(lds, (LAS unsigned*)(lds + TBL_OFF), S, E);
    }
    xcd_barrier(bar);

    {
        PHASE_IDS();
        {
            const int wave = __builtin_amdgcn_readfirstlane(tid >> 6);
            const float* conv_w = args.in[3]; const float* conv_b = args.in[4]; const float* skip = args.in[11];
            if (tid < 64) { const int bufi = tid >> 5, row = tid & 31, rr = row < 16 ? row : SEQ + row; *(LAS u32x4*)(lds + bufi * HY_ZBYTES + rr * 16) = (u32x4){0u, 0u, 0u, 0u}; }
            const int r32 = lane & 31, hi = lane >> 5;
            const int tr_lane = (2 * ((lane >> 4) & 1) + ((lane & 3) >> 1) + 8 * hi + ((lane & 15) >> 2)) * 16 + 8 * (lane & 1);
            for (int unit = bx; unit < HW; unit += G) {
                const int c = unit;
                __syncthreads();
                {
                    const int col = 1024 + c; const float w0 = conv_w[col], w1 = conv_w[HCOLS + col], w2 = conv_w[2 * HCOLS + col], cb = conv_b[col];
                    const bf16_t* hp = HP + (size_t)col * SEQ * 8;
#pragma unroll 2
                    for (int i = 0; i < 8; ++i) { const int t = tid + 512 * i;
                        const u32x4 z4 = (u32x4){0u, 0u, 0u, 0u};
                        const u32x4 pm = t > 0 ? *(const GAS u32x4*)(hp + (size_t)(t - 1) * 8) : z4, p0 = *(const GAS u32x4*)(hp + (size_t)t * 8), pp = t < SEQ - 1 ? *(const GAS u32x4*)(hp + (size_t)(t + 1) * 8) : z4;
                        u32x4 o;
#pragma unroll
                        for (int k = 0; k < 4; ++k) { const float lo = cb + w0 * bflo(pm[k]) + w1 * bflo(p0[k]) + w2 * bflo(pp[k]), hh = cb + w0 * bfhi(pm[k]) + w1 * bfhi(p0[k]) + w2 * bfhi(pp[k]); o[k] = pk2(lo, hh); }
                        *(LAS u32x4*)(lds + HY_ZA + (t + 16) * 16) = o; }
                }
                for (int n = 0; n < 2; ++n) {
                    {
                        const GAS u32x4* gsrc = (const GAS u32x4*)(GF + (size_t)(n * 512 + c) * GLEN);
                        for (int q = tid; q < GLEN * 2 / 16; q += 512) *(LAS u32x4*)(lds + HY_FB + q * 16) = gsrc[q];
                    }
                    __syncthreads();
                    f32x16 acc[2][2];
#pragma unroll
                    for (int a = 0; a < 2; ++a)
#pragma unroll
                        for (int b = 0; b < 2; ++b)
#pragma unroll
                            for (int k = 0; k < 16; ++k) acc[a][b][k] = 0.f;
                    const LAS unsigned char* za = lds + (n == 0 ? HY_ZA : HY_ZB) + tr_lane;
                    const LAS unsigned char* fbp = lds + HY_FB + 2 * GOFF - 32 + 16 * (hi - r32) - 512 * (2 * wave);
#define HY_STEP(OFFA, OFFB) do { \
                        const v4i16_t x0 = __builtin_amdgcn_ds_read_tr16_b64_v4i16((LAS v4i16_t*)(za + (OFFA))); \
                        const v4i16_t x1 = __builtin_amdgcn_ds_read_tr16_b64_v4i16((LAS v4i16_t*)(za + (OFFA) + 64)); \
                        const v4i16_t x2 = __builtin_amdgcn_ds_read_tr16_b64_v4i16((LAS v4i16_t*)(za + (OFFA) + 128)); \
                        const bf16x8 b0 = *(const LAS bf16x8*)(fbp + (OFFB)), b1 = *(const LAS bf16x8*)(fbp + (OFFB) - 512); \
                        const bf16x8 a0 = (bf16x8){x0[0], x0[1], x0[2], x0[3], x1[0], x1[1], x1[2], x1[3]}, a1 = (bf16x8){x1[0], x1[1], x1[2], x1[3], x2[0], x2[1], x2[2], x2[3]}; \
                        acc[0][0] = __builtin_amdgcn_mfma_f32_32x32x16_bf16(a0, b0, acc[0][0], 0, 0, 0); \
                        acc[0][1] = __builtin_amdgcn_mfma_f32_32x32x16_bf16(a1, b0, acc[0][1], 0, 0, 0); \
                        acc[1][0] = __builtin_amdgcn_mfma_f32_32x32x16_bf16(a0, b1, acc[1][0], 0, 0, 0); \
                        acc[1][1] = __builtin_amdgcn_mfma_f32_32x32x16_bf16(a1, b1, acc[1][1], 0, 0, 0); } while (0)
#pragma clang loop unroll(disable)
                    for (int c4 = 0; c4 < 64; ++c4) {
                        HY_STEP(0, 0); HY_STEP(256, 32); HY_STEP(512, 64); HY_STEP(768, 96);
                        za += 1024; fbp += 128;
                    }
                    HY_STEP(0, 0);
#undef HY_STEP
                    const int gcol = n * 512 + c; const float w0 = conv_w[gcol], w1 = conv_w[HCOLS + gcol], w2 = conv_w[2 * HCOLS + gcol], cb = conv_b[gcol];
                    const float inv = 1.f / NSUM[n * 512 + c], sk = skip[n * 512 + c];
                    const bf16_t* hp = HP + (size_t)gcol * SEQ * 8 + 4 * hi;
                    const LAS unsigned char* zin = lds + (n == 0 ? HY_ZA : HY_ZB) + 8 * hi;
#pragma unroll
                    for (int sp = 0; sp < 2; ++sp) {
                        const int tb = 256 * (2 * wave + sp) + 8 * r32;
                        u32x2 P[10];
#pragma unroll
                        for (int k = 0; k < 10; ++k) { const int tq = tb - 1 + k; P[k] = (tq >= 0 && tq < SEQ) ? *(const GAS u32x2*)(hp + (size_t)tq * 8) : (u32x2){0u, 0u}; }
#pragma unroll
                        for (int tt = 0; tt < 8; ++tt) {
                            const int t = tb + tt; const u32x2 zi = *(const LAS u32x2*)(zin + (t + 16) * 16);
                            const float zv[4] = {bflo(zi.x), bfhi(zi.x), bflo(zi.y), bfhi(zi.y)};
                            const float pm[4] = {bflo(P[tt].x), bfhi(P[tt].x), bflo(P[tt].y), bfhi(P[tt].y)};
                            const float pc[4] = {bflo(P[tt + 1].x), bfhi(P[tt + 1].x), bflo(P[tt + 1].y), bfhi(P[tt + 1].y)};
                            const float pp[4] = {bflo(P[tt + 2].x), bfhi(P[tt + 2].x), bflo(P[tt + 2].y), bfhi(P[tt + 2].y)};
                            float zo[4];
#pragma unroll
                            for (int bb = 0; bb < 4; ++bb) { const float gate = cb + w0 * pm[bb] + w1 * pc[bb] + w2 * pp[bb]; zo[bb] = gate * (acc[sp][tt >> 2][(tt & 3) * 4 + bb] * inv + sk * zv[bb]); }
                            u32x2 w; w.x = pk2(zo[0], zo[1]); w.y = pk2(zo[2], zo[3]);
                            if (n == 0) *(LAS u32x2*)(lds + HY_ZB + (t + 16) * 16 + 8 * hi) = w;
                            else *(GAS u32x2*)(HZ + ((size_t)c * SEQ + t) * 8 + 4 * hi) = w;
                        }
                    }
                    __syncthreads();
                }
            }
        }
        __syncthreads();
        LAS float* Qs = (LAS float*)lds; LAS float* Ks = Qs + 2 * 64 * 65; LAS float* Ss = Ks + 2 * 64 * 65; LAS float* Vs = Ss + 2 * 64 * 65; LAS float* al = Vs + 64 * 128;
        const float* subg = args.in[17];
        float lam;
        { float s1 = 0.f, s2 = 0.f; for (int i = 0; i < 64; ++i) { s1 += args.in[13][i] * args.in[14][i]; s2 += args.in[15][i] * args.in[16][i]; } lam = expf(s1) - expf(s2) + 0.2f; }
        const int mp = tid >> 8, qg = (tid >> 4) & 15, xg = tid & 15, srow = tid >> 2, spart = tid & 3;
        for (int unit = bx; unit < NB * 4 * 64; unit += G) {
            const int qb = unit & 63, h = (unit >> 6) & 3, b = unit >> 8, q0 = qb * 64;
            const bf16_t* pb = QKV + (size_t)b * SEQ * ACOLS;
            const float slope = exp2f(-2.f * (float)(h + 1)) * LOG2E;
            __syncthreads();
            for (int i = tid; i < 2 * 64 * 64; i += 512) { const int m = i >> 12, q = (i >> 6) & 63, d = i & 63; Qs[(m * 64 + q) * 65 + d] = bf2f(pb[(size_t)(q0 + q) * ACOLS + h * 128 + m * 64 + d]); }
            float o[4][8];
#pragma unroll
            for (int i = 0; i < 4; ++i)
#pragma unroll
                for (int j = 0; j < 8; ++j) o[i][j] = 0.f;
            float m_run = -1e30f, l_run = 0.f;
            for (int kt = 0; kt < SEQ / 64; ++kt) {
                const int k0 = kt * 64;
                __syncthreads();
                for (int i = tid; i < 2 * 64 * 64; i += 512) { const int m = i >> 12, k = (i >> 6) & 63, d = i & 63; Ks[(m * 64 + k) * 65 + d] = bf2f(pb[(size_t)(k0 + k) * ACOLS + 512 + h * 128 + m * 64 + d]); }
                for (int i = tid; i < 64 * 128; i += 512) { const int k = i >> 7, d = i & 127; Vs[k * 128 + d] = bf2f(pb[(size_t)(k0 + k) * ACOLS + 1024 + h * 128 + d]); }
                __syncthreads();
                float s[4][4];
#pragma unroll
                for (int i = 0; i < 4; ++i)
#pragma unroll
                    for (int j = 0; j < 4; ++j) s[i][j] = 0.f;
                for (int d = 0; d < 64; ++d) {
                    float qv[4], kv[4];
#pragma unroll
                    for (int i = 0; i < 4; ++i) qv[i] = Qs[(mp * 64 + qg * 4 + i) * 65 + d];
#pragma unroll
                    for (int j = 0; j < 4; ++j) kv[j] = Ks[(mp * 64 + xg * 4 + j) * 65 + d];
#pragma unroll
                    for (int i = 0; i < 4; ++i)
#pragma unroll
                        for (int j = 0; j < 4; ++j) s[i][j] += qv[i] * kv[j];
                }
#pragma unroll
                for (int i = 0; i < 4; ++i)
#pragma unroll
                    for (int j = 0; j < 4; ++j) { const int q = qg * 4 + i, k = xg * 4 + j; Ss[(mp * 64 + q) * 65 + k] = s[i][j] - slope * fabsf((float)(q0 + q) - (float)(k0 + k)); }
                __syncthreads();
                {
                    LAS float* sr = Ss + srow * 65 + spart * 16;
                    float mx = -1e30f;
#pragma unroll
                    for (int j = 0; j < 16; ++j) mx = fmaxf(mx, sr[j]);
                    mx = fmaxf(mx, __shfl_xor(mx, 1)); mx = fmaxf(mx, __shfl_xor(mx, 2));
                    const float mn = fmaxf(m_run, mx), a = exp2f(m_run - mn);
                    float ps = 0.f;
#pragma unroll
                    for (int j = 0; j < 16; ++j) { const float pv = exp2f(sr[j] - mn); sr[j] = pv; ps += pv; }
                    ps += __shfl_xor(ps, 1); ps += __shfl_xor(ps, 2);
                    l_run = l_run * a + ps; m_run = mn;
                    if (spart == 0) al[srow] = a;
                }
                __syncthreads();
#pragma unroll
                for (int i = 0; i < 4; ++i) { const float a = al[mp * 64 + qg * 4 + i];
#pragma unroll
                    for (int j = 0; j < 8; ++j) o[i][j] *= a; }
                for (int k = 0; k < 64; ++k) {
                    float pv[4];
#pragma unroll
                    for (int i = 0; i < 4; ++i) pv[i] = Ss[(mp * 64 + qg * 4 + i) * 65 + k];
                    const f32x4 v0 = *(const LAS f32x4*)&Vs[k * 128 + xg * 8], v1 = *(const LAS f32x4*)&Vs[k * 128 + xg * 8 + 4];
#pragma unroll
                    for (int i = 0; i < 4; ++i) { o[i][0] += pv[i] * v0.x; o[i][1] += pv[i] * v0.y; o[i][2] += pv[i] * v0.z; o[i][3] += pv[i] * v0.w;
                        o[i][4] += pv[i] * v1.x; o[i][5] += pv[i] * v1.y; o[i][6] += pv[i] * v1.z; o[i][7] += pv[i] * v1.w; }
                }
            }
            __syncthreads();
            if (spart == 0) al[128 + srow] = l_run;
            __syncthreads();
#pragma unroll
            for (int i = 0; i < 4; ++i) { const float li = 1.f / al[128 + mp * 64 + qg * 4 + i];
#pragma unroll
                for (int j = 0; j < 8; ++j) o[i][j] *= li; }
            if (mp == 1) {
#pragma unroll
                for (int i = 0; i < 4; ++i)
#pragma unroll
                    for (int j = 0; j < 8; ++j) Vs[(qg * 4 + i) * 128 + xg * 8 + j] = o[i][j];
            }
            __syncthreads();
            if (mp == 0) {
#pragma unroll
                for (int i = 0; i < 4; ++i) {
                    float ss = 0.f;
#pragma unroll
                    for (int j = 0; j < 8; ++j) { o[i][j] -= lam * Vs[(qg * 4 + i) * 128 + xg * 8 + j]; ss += o[i][j] * o[i][j]; }
                    ss += __shfl_xor(ss, 1); ss += __shfl_xor(ss, 2); ss += __shfl_xor(ss, 4); ss += __shfl_xor(ss, 8);
                    const float r = rsqrtf(ss * (1.f / 128.f) + EPS) * 0.8f;
                    u32x4 w; w.x = pk2(o[i][0] * r * subg[xg * 8 + 0], o[i][1] * r * subg[xg * 8 + 1]); w.y = pk2(o[i][2] * r * subg[xg * 8 + 2], o[i][3] * r * subg[xg * 8 + 3]);
                    w.z = pk2(o[i][4] * r * subg[xg * 8 + 4], o[i][5] * r * subg[xg * 8 + 5]); w.w = pk2(o[i][6] * r * subg[xg * 8 + 6], o[i][7] * r * subg[xg * 8 + 7]);
                    *(GAS u32x4*)(MIX + ((size_t)b * SEQ + q0 + qg * 4 + i) * DM + 512 + h * 128 + xg * 8) = w;
                }
            }
        }
    }
    xcd_barrier(bar);

    {
        PHASE_IDS();
        const float* hg = args.in[12];
        LAS unsigned short* tile = (LAS unsigned short*)lds;
        LAS float* rs = (LAS float*)(lds + 32768);
        for (int it = bx; it < 8 * 128; it += G) {
            const int g = it & 7, tb = it >> 3, t0 = tb * 32;
            __syncthreads();
            for (int q = tid; q < 64 * 32; q += 512) { const int ch = q >> 5, seg = q & 31;
                const u32x4 v = *(const GAS u32x4*)(HZ + ((size_t)(g * 64 + ch) * SEQ + t0 + seg) * 8);
                *(LAS u32x4*)(tile + ch * 256 + seg * 8) = v; }
            __syncthreads();
            if (tid < 256) { float s = 0.f; for (int ch = 0; ch < 64; ++ch) { const float v = bf2f(tile[ch * 256 + tid]); s += v * v; } rs[tid] = rsqrtf(s * (1.f / 64.f) + EPS); }
            __syncthreads();
            for (int q = tid; q < 256 * 8; q += 512) { const int tk = q >> 3, c8 = (q & 7) * 8;
                const float r = rs[tk]; const int t = t0 + (tk >> 3), b = tk & 7;
                float v[8];
#pragma unroll
                for (int j = 0; j < 8; ++j) v[j] = bf2f(tile[(c8 + j) * 256 + tk]) * r * hg[g * 64 + c8 + j];
                u32x4 w; w.x = pk2(v[0], v[1]); w.y = pk2(v[2], v[3]); w.z = pk2(v[4], v[5]); w.w = pk2(v[6], v[7]);
                *(GAS u32x4*)(MIX + ((size_t)b * SEQ + t) * DM + g * 64 + c8) = w; }
        }
        __syncthreads();
    }
    xcd_barrier(bar);

    {
        pg8::GeoPlain S; S.A = MIX; S.Bt = WOUT; S.K = DM; S.ord.init(NTOK / 256, DM / 256, G, bx);
        pg8::EpiResF32 E{x, out, DM};
        pg8::gemm_phase(lds, (LAS unsigned*)(lds + TBL_OFF), S, E);
    }
    xcd_barrier(bar);

    {
        PHASE_IDS();
        const float* g = args.in[19]; const float* wr = args.in[20];
        for (int m = gw; m < NTOK; m += NGW) {
            const GAS f32x4* xr = (const GAS f32x4*)(out + (size_t)m * DM) + lane;
            f32x4 v[4]; float s = 0.f;
#pragma unroll
            for (int j = 0; j < 4; ++j) { v[j] = xr[64 * j]; s += (v[j].x * v[j].x + v[j].y * v[j].y) + (v[j].z * v[j].z + v[j].w * v[j].w); }
            const float r = rsqrtf(wave_sum(s) * (1.f / DM) + EPS);
            float lg[16];
#pragma unroll
            for (int e = 0; e < 16; ++e) lg[e] = 0.f;
            GAS u32x2* o8 = (GAS u32x2*)(H2 + (size_t)m * DM) + lane;
#pragma unroll
            for (int j = 0; j < 4; ++j) {
                const f32x4 gg = ((const GAS f32x4*)g)[lane + 64 * j];
                const float hx[4] = {v[j].x * r * gg.x, v[j].y * r * gg.y, v[j].z * r * gg.z, v[j].w * r * gg.w};
                u32x2 w; w.x = pk2(hx[0], hx[1]); w.y = pk2(hx[2], hx[3]); o8[64 * j] = w;
                const int d0 = (lane + 64 * j) * 4;
#pragma unroll
                for (int q = 0; q < 4; ++q) { const GAS f32x4* wp = (const GAS f32x4*)(wr + (size_t)(d0 + q) * 16);
#pragma unroll
                    for (int e4 = 0; e4 < 4; ++e4) { const f32x4 ww = wp[e4]; lg[e4 * 4 + 0] += hx[q] * ww.x; lg[e4 * 4 + 1] += hx[q] * ww.y; lg[e4 * 4 + 2] += hx[q] * ww.z; lg[e4 * 4 + 3] += hx[q] * ww.w; } }
            }
            float mx = -1e30f;
#pragma unroll
            for (int e = 0; e < 16; ++e) { lg[e] = wave_sum(lg[e]); mx = fmaxf(mx, lg[e]); }
            float den = 0.f;
#pragma unroll
            for (int e = 0; e < 16; ++e) { lg[e] = expf(lg[e] - mx); den += lg[e]; }
            const int b = m >> 12, t = m & 4095;
            float mine = 0.f;
#pragma unroll
            for (int e = 0; e < 16; ++e) mine = (lane == e) ? lg[e] : mine;
            if (lane < 16) { AFF[((size_t)lane * NB + b) * SEQ + t] = mine / den; INV[(size_t)m * 16 + lane] = 0xffffu; }
        }
    }
    xcd_barrier(bar);

    {
        PHASE_IDS();
        LAS unsigned* hist = (LAS unsigned*)lds; LAS unsigned* scan = hist + 256; LAS unsigned* selw = scan + 512;
        for (int eb = bx; eb < NE * NB; eb += G) {
            const int b = eb & 7, e = eb >> 3;
            const float* a = AFF + (size_t)eb * SEQ;
            unsigned v[8];
#pragma unroll
            for (int j = 0; j < 8; ++j) v[j] = __float_as_uint(a[tid * 8 + j]);
            unsigned prefix = 0, mask = 0, need = CAP;
            __syncthreads();
            for (int pass = 0; pass < 4; ++pass) {
                const int shift = 24 - 8 * pass;
                if (tid < 256) hist[tid] = 0;
                __syncthreads();
#pragma unroll
                for (int j = 0; j < 8; ++j) if ((v[j] & mask) == prefix) atomicAdd((unsigned*)&hist[(v[j] >> shift) & 255u], 1u);
                __syncthreads();
                if (tid == 0) { unsigned cum = 0; int bin = 255; for (; bin > 0; --bin) { if (cum + hist[bin] >= need) break; cum += hist[bin]; } selw[0] = (unsigned)bin; selw[1] = need - cum; }
                __syncthreads();
                prefix |= selw[0] << shift; mask |= 255u << shift; need = selw[1];
                __syncthreads();
            }
            unsigned cg = 0, ce = 0;
#pragma unroll
            for (int j = 0; j < 8; ++j) { cg += v[j] > prefix; ce += v[j] == prefix; }
            scan[tid] = (cg << 16) | ce;
            __syncthreads();
            for (int off = 1; off < 512; off <<= 1) { const unsigned xx = tid >= off ? scan[tid - off] : 0u; __syncthreads(); scan[tid] += xx; __syncthreads(); }
            const unsigned incl = scan[tid]; unsigned pg = (incl >> 16) - cg, pe = (incl & 0xffffu) - ce;
#pragma unroll
            for (int j = 0; j < 8; ++j) {
                const bool isg = v[j] > prefix, ise = v[j] == prefix;
                if (isg || (ise && pe < need)) {
                    const unsigned pos = pg + (pe < need ? pe : need); const int token = b * SEQ + tid * 8 + j;
                    TOK[(size_t)eb * CAP + pos] = token; GSEL[(size_t)eb * CAP + pos] = __uint_as_float(v[j]); INV[(size_t)token * 16 + e] = (unsigned short)pos;
                }
                pg += isg; pe += ise;
            }
            __syncthreads();
        }
    }
    xcd_barrier(bar);

    {
        pg8::GeoExpert<true> S; S.A = H2; S.Bt = WGU; S.K = DM; S.bexp = (size_t)2 * FF * DM * 2; S.tok = TOK; S.ord.init(NSLOT / 256, 2 * FF / 256, G, bx);
        pg8::EpiSwiGLU E{ACT, FF};
        pg8::gemm_phase(lds, (LAS unsigned*)(lds + TBL_OFF), S, E);
    }
    xcd_barrier(bar);

    {
        pg8::GeoExpert<false> S; S.A = ACT; S.Bt = WD; S.K = FF; S.bexp = (size_t)DM * FF * 2; S.tok = nullptr; S.ord.init(NSLOT / 256, DM / 256, G, bx);
        pg8::EpiBf16 E{Y, DM, 0, 1.f};
        pg8::gemm_phase(lds, (LAS unsigned*)(lds + TBL_OFF), S, E);
    }
    xcd_barrier(bar);

    {
        PHASE_IDS();
        const float* g = args.in[24];
        for (int m = gw; m < NTOK; m += NGW) {
            const GAS f32x4* xr = (const GAS f32x4*)(out + (size_t)m * DM) + lane;
            f32x4 v[4];
#pragma unroll
            for (int j = 0; j < 4; ++j) v[j] = xr[64 * j];
            const int b = m >> 12;
            const unsigned short myinv = INV[(size_t)m * 16 + (lane & 15)];
            for (int e = 0; e < 16; ++e) {
                const unsigned s = (unsigned)__shfl((int)myinv, e);
                if (s != 0xffffu) {
                    const size_t slot = ((size_t)e * NB + b) * CAP + s;
                    const float gv = GSEL[slot];
                    const GAS u32x2* yr = (const GAS u32x2*)(Y + slot * DM) + lane;
#pragma unroll
                    for (int j = 0; j < 4; ++j) { const u32x2 w = yr[64 * j]; v[j].x += gv * bflo(w.x); v[j].y += gv * bfhi(w.x); v[j].z += gv * bflo(w.y); v[j].w += gv * bfhi(w.y); }
                }
            }
            float s = 0.f;
#pragma unroll
            for (int j = 0; j < 4; ++j) s += (v[j].x * v[j].x + v[j].y * v[j].y) + (v[j].z * v[j].z + v[j].w * v[j].w);
            const float r = rsqrtf(wave_sum(s) * (1.f / DM) + EPS);
            GAS f32x4* o = (GAS f32x4*)(out + (size_t)m * DM) + lane;
#pragma unroll
            for (int j = 0; j < 4; ++j) { const f32x4 gg = ((const GAS f32x4*)g)[lane + 64 * j]; o[64 * j] = (f32x4){v[j].x * r * gg.x, v[j].y * r * gg.y, v[j].z * r * gg.z, v[j].w * r * gg.w}; }
        }
    }
}

extern "C" void kernel_launch(void* const* d_in, const int* in_sizes, int n_in, void* d_out, int out_size, void* d_ws, size_t ws_size, hipStream_t stream) {
    static int grid = 0;
    if (grid == 0) {
        if (n_in != 25 || ws_size < WS_END) { fprintf(stderr, "kernel_launch: unexpected n_in %d / ws %zu\n", n_in, ws_size); grid = -1; return; }
        int dev = 0, cus = 0;
        if (hipGetDevice(&dev) != hipSuccess || hipDeviceGetAttribute(&cus, hipDeviceAttributeMultiprocessorCount, dev) != hipSuccess) { grid = -1; return; }
        if (hipFuncSetAttribute((const void*)mega_fwd, hipFuncAttributeMaxDynamicSharedMemorySize, LDS_BYTES) != hipSuccess) { fprintf(stderr, "kernel_launch: hipFuncSetAttribute failed\n"); grid = -1; return; }
        int per_cu = 0;
        if (hipOccupancyMaxActiveBlocksPerMultiprocessor(&per_cu, (const void*)mega_fwd, 512, LDS_BYTES) != hipSuccess || per_cu < 1) fprintf(stderr, "kernel_launch: occupancy query says %d\n", per_cu);
        (void)hipGetLastError();
        grid = cus;
    }
    if (grid < 0) return;
    (void)hipMemsetAsync((char*)d_ws + WS_CTL, 0, CTL_BYTES, stream);
    Args a; memset(&a, 0, sizeof a);
    for (int i = 0; i < 25; ++i) a.in[i] = (const float*)d_in[i];
    a.out = (float*)d_out; a.ws = (unsigned char*)d_ws;
    hipLaunchKernelGGL(mega_fwd, dim3(grid), dim3(512), LDS_BYTES, stream, a);
}
```

```cpp
#include <hip/hip_runtime.h>
#include <cstdio>
#include <cstdint>
#include <cstring>

#define GAS __attribute__((address_space(1)))
#define LAS __attribute__((address_space(3)))
typedef unsigned short bf16_t;
typedef short bf16x8 __attribute__((ext_vector_type(8)));
typedef float f32x4 __attribute__((ext_vector_type(4)));
typedef float f32x2 __attribute__((ext_vector_type(2)));
typedef unsigned u32x4 __attribute__((ext_vector_type(4)));
typedef unsigned u32x2 __attribute__((ext_vector_type(2)));
typedef short v4i16_t __attribute__((ext_vector_type(4)));
typedef float f32x16 __attribute__((ext_vector_type(16)));

constexpr int DM = 1024, NB = 8, SEQ = 4096, NTOK = NB * SEQ;
constexpr int HW = 512, HCOLS = 1536, INC = 3072, ACOLS = 1536;
constexpr int NE = 16, CAP = 512, FF = 2816, NSLOT = NE * NB * CAP;
constexpr float EPS = 1e-6f;
constexpr float LOG2E = 1.4426950408889634f;
constexpr float QSCALE = 0.125f * LOG2E;
constexpr int GOFF = 4352, GLEN = 8704;

constexpr size_t MiB = 1u << 20;
constexpr size_t WS_CTL = 0, CTL_BYTES = 1 * MiB;
constexpr size_t WS_WGU = 2 * MiB;
constexpr size_t WS_Y = WS_WGU;
constexpr size_t WS_WD = 178 * MiB;
constexpr size_t WS_AFF = 266 * MiB;
constexpr size_t WS_TOK = 268 * MiB;
constexpr size_t WS_GSEL = WS_TOK + 256 * 1024;
constexpr size_t WS_INV = 269 * MiB;
constexpr size_t WS_XN = 270 * MiB;
constexpr size_t WS_H2 = WS_XN;
constexpr size_t WS_ACT = 334 * MiB;
constexpr size_t WS_WIN = 334 * MiB;
constexpr size_t WS_WOUT = 340 * MiB;
constexpr size_t WS_GF = 342 * MiB;
constexpr size_t WS_HP = 360 * MiB;
constexpr size_t WS_QKV = 456 * MiB;
constexpr size_t WS_HZ = 552 * MiB;
constexpr size_t WS_MIX = 584 * MiB;
constexpr size_t WS_PARK = 648 * MiB;
constexpr size_t WS_END = 686 * MiB;
constexpr int CW_BAR = 4096;
constexpr int CW_NSUM = 16384;

constexpr int LDS_BYTES = 160 * 1024;
constexpr int MISC_OFF = LDS_BYTES - 256;
constexpr int HY_ZBYTES = (SEQ + 32) * 16, HY_ZA = 0, HY_ZB = HY_ZBYTES, HY_FB = 2 * HY_ZBYTES;
constexpr int TBL_OFF = 131072;

__device__ __forceinline__ unsigned f2bf(float f) { unsigned u = __builtin_bit_cast(unsigned, f); return (u + 0x7fffu + ((u >> 16) & 1u)) >> 16; }
__device__ __forceinline__ unsigned pk2(float lo, float hi) { return f2bf(lo) | (f2bf(hi) << 16); }
__device__ __forceinline__ float bf2f(unsigned short h) { return __builtin_bit_cast(float, (unsigned)h << 16); }
__device__ __forceinline__ float bflo(unsigned w) { return __builtin_bit_cast(float, w << 16); }
__device__ __forceinline__ float bfhi(unsigned w) { return __builtin_bit_cast(float, w & 0xffff0000u); }
__device__ __forceinline__ float wave_sum(float v) {
#pragma unroll
    for (int o = 1; o < 64; o <<= 1) v += __shfl_xor(v, o);
    return v;
}
#define LDS_WAIT() asm volatile("s_waitcnt lgkmcnt(0)" ::: "memory")
__device__ __forceinline__ int lane_id_v() { int l; asm volatile("v_mbcnt_lo_u32_b32 %0, -1, 0\n\tv_mbcnt_hi_u32_b32 %0, -1, %0" : "=v"(l)); return l; }
#define PHASE_IDS() const int wave = wave_s; int tid_o = wave_s * 64 + lane_id_v(); asm volatile("" : "+v"(tid_o)); const int tid = tid_o, lane = tid & 63, gw = blockIdx.x * 8 + wave; (void)lane; (void)gw

namespace pg8 {
constexpr int BM = 256, BK = 64, HALF = 128, HTB = HALF * BK * 2, STAGE_BYTES = 8 * HTB, NXCD = 8, WGM = 8;
__host__ __device__ __forceinline__ int lds_byte(int r, int c) { const int st = (r >> 4) * 2 + (c >> 5), rr = r & 15, cc = c & 31, ob = rr * 64 + cc * 2; return st * 1024 + (ob ^ (((ob >> 9) & 1) << 5)); }
__host__ __device__ __forceinline__ void stage_rc(int b, int& R, int& C) { const int st = b / 1024, sb = b % 1024, swz = sb ^ (((sb >> 9) & 1) << 5); R = (st >> 1) * 16 + swz / 64; C = (st & 1) * 32 + (swz % 64) / 2; }
__host__ __device__ __forceinline__ int perm32(int rho) { const int n = rho >> 4, i = rho & 15; return 8 * (i >> 2) + 4 * n + (i & 3); }
struct Unit { int pm, pn; };

struct TileOrder {
    int nM, nN, nwg, G, c;
    __device__ void init(int nM_, int nN_, int G_, int c_) { nM = nM_; nN = nN_; nwg = nM * nN; G = G_; c = c_; }
    __device__ bool next(int i, Unit& u) const {
        const long L = (long)i * G + c; if (L >= nwg) return false;
        int wgid = (int)L; { const int q = nwg / NXCD, r = nwg % NXCD, xcd = wgid % NXCD, off = wgid / NXCD; wgid = (xcd < r ? xcd * (q + 1) : r * (q + 1) + (xcd - r) * q) + off; }
        const int nig = WGM * nN, gid = wgid / nig, fm = gid * WGM, gsz = (nM - fm) < WGM ? (nM - fm) : WGM;
        u.pm = fm + ((wgid % nig) % gsz); u.pn = (wgid % nig) / gsz; return true;
    }
};
__device__ __forceinline__ unsigned cvt_pk_bf16(float lo, float hi) { unsigned r; asm volatile("v_cvt_pk_bf16_f32 %0, %1, %2" : "=v"(r) : "v"(lo), "v"(hi)); return r; }

struct EpiBf16 {
    static constexpr bool PERM = true;
    bf16_t* O; int ldc; int scols; float sc;
    __device__ __forceinline__ void operator()(const f32x4 (&acc)[2][2][4][2], const Unit& u, int wr, int wc, int fr, int fq) const {
        const int row0 = u.pm * BM + wr * 64 + fr, col0 = u.pn * BM + wc * 32 + 8 * fq;
        const float s = (u.pn * BM < scols) ? sc : 1.f;
#pragma unroll
        for (int ai = 0; ai < 2; ++ai)
#pragma unroll
            for (int m = 0; m < 4; ++m) { bf16_t* rowp = O + (size_t)(row0 + ai * HALF + m * 16) * ldc + col0;
#pragma unroll
                for (int bj = 0; bj < 2; ++bj) { const f32x4 v0 = acc[ai][bj][m][0] * s, v1 = acc[ai][bj][m][1] * s;
                    u32x4 w; w.x = cvt_pk_bf16(v0[0], v0[1]); w.y = cvt_pk_bf16(v0[2], v0[3]); w.z = cvt_pk_bf16(v1[0], v1[1]); w.w = cvt_pk_bf16(v1[2], v1[3]);
                    *(u32x4*)(rowp + bj * HALF) = w; } }
    }
};
struct EpiResF32 {
    static constexpr bool PERM = false;
    const float* R; float* C; int ldc;
    __device__ __forceinline__ void operator()(const f32x4 (&acc)[2][2][4][2], const Unit& u, int wr, int wc, int fr, int fq) const {
        const int row0 = u.pm * BM + wr * 64 + fr, col0 = u.pn * BM + wc * 32 + 4 * fq;
#pragma unroll
        for (int ai = 0; ai < 2; ++ai)
#pragma unroll
            for (int m = 0; m < 4; ++m) { const size_t off = (size_t)(row0 + ai * HALF + m * 16) * ldc + col0;
#pragma unroll
                for (int bj = 0; bj < 2; ++bj)
#pragma unroll
                    for (int n = 0; n < 2; ++n) { const f32x4 r = *(const f32x4*)(R + off + bj * HALF + n * 16); *(f32x4*)(C + off + bj * HALF + n * 16) = r + acc[ai][bj][m][n]; } }
    }
};
struct EpiSwiGLU {
    static constexpr bool PERM = true;
    bf16_t* O; int ldc;
    __device__ __forceinline__ void operator()(const f32x4 (&acc)[2][2][4][2], const Unit& u, int wr, int wc, int fr, int fq) const {
        const int row0 = u.pm * BM + wr * 64 + fr, col0 = u.pn * HALF + wc * 32 + 8 * fq;
#pragma unroll
        for (int ai = 0; ai < 2; ++ai)
#pragma unroll
            for (int m = 0; m < 4; ++m) { bf16_t* rowp = O + (size_t)(row0 + ai * HALF + m * 16) * ldc + col0;
                float o[8];
#pragma unroll
                for (int n = 0; n < 2; ++n)
#pragma unroll
                    for (int j = 0; j < 4; ++j) { const float g = acc[ai][0][m][n][j], up = acc[ai][1][m][n][j];
                        o[n * 4 + j] = g * __builtin_amdgcn_rcpf(1.f + __builtin_amdgcn_exp2f(-g * LOG2E)) * up; }
                u32x4 w; w.x = cvt_pk_bf16(o[0], o[1]); w.y = cvt_pk_bf16(o[2], o[3]); w.z = cvt_pk_bf16(o[4], o[5]); w.w = cvt_pk_bf16(o[6], o[7]);
                *(u32x4*)rowp = w; }
    }
};

struct GeoPlain {
    static constexpr bool GATHER = false;
    const bf16_t* A; const bf16_t* Bt; int K; TileOrder ord;
    __device__ __forceinline__ bool next(int i, Unit& u) const { return ord.next(i, u); }
    __device__ __forceinline__ const char* a_ptr(const Unit& u) const { return (const char*)A + (size_t)u.pm * BM * K * 2; }
    __device__ __forceinline__ const char* b_ptr(const Unit& u) const { return (const char*)Bt + (size_t)u.pn * BM * K * 2; }
    __device__ __forceinline__ size_t hstepA() const { return (size_t)HALF * K * 2; }
    __device__ __forceinline__ size_t hstepB() const { return (size_t)HALF * K * 2; }
    __device__ __forceinline__ unsigned a_voff(int R, int C) const { return (unsigned)(R * K + C) * 2u; }
    __device__ __forceinline__ unsigned b_voff(int R, int C) const { return (unsigned)(R * K + C) * 2u; }
    __device__ __forceinline__ void fill_table(LAS unsigned*, const Unit&, int) const {}
};
struct GeoTokPerm {
    static constexpr bool GATHER = false;
    const bf16_t* A; const bf16_t* X; int K; TileOrder ord;
    __device__ __forceinline__ bool next(int i, Unit& u) const { return ord.next(i, u); }
    __device__ __forceinline__ const char* a_ptr(const Unit& u) const { return (const char*)A + (size_t)u.pm * BM * K * 2; }
    __device__ __forceinline__ const char* b_ptr(const Unit& u) const { return (const char*)X + (size_t)u.pn * 32 * K * 2; }
    __device__ __forceinline__ size_t hstepA() const { return (size_t)HALF * K * 2; }
    __device__ __forceinline__ size_t hstepB() const { return (size_t)16 * K * 2; }
    __device__ __forceinline__ unsigned a_voff(int R, int C) const { return (unsigned)(R * K + C) * 2u; }
    __device__ __forceinline__ unsigned b_voff(int R, int C) const { return (unsigned)(((R & 7) * SEQ + (R >> 3)) * K + C) * 2u; }
    __device__ __forceinline__ void fill_table(LAS unsigned*, const Unit&, int) const {}
};
template <bool G> struct GeoExpert {
    static constexpr bool GATHER = G;
    const bf16_t* A; const bf16_t* Bt; int K; size_t bexp;    const int* tok; TileOrder ord;
    __device__ __forceinline__ bool next(int i, Unit& u) const { return ord.next(i, u); }
    __device__ __forceinline__ const char* a_ptr(const Unit& u) const { return G ? (const char*)A : (const char*)A + (size_t)u.pm * BM * K * 2; }
    __device__ __forceinline__ const char* b_ptr(const Unit& u) const { return (const char*)Bt + (size_t)(u.pm >> 4) * bexp + (size_t)u.pn * BM * K * 2; }
    __device__ __forceinline__ size_t hstepA() const { return (size_t)HALF * K * 2; }
    __device__ __forceinline__ size_t hstepB() const { return (size_t)HALF * K * 2; }
    __device__ __forceinline__ unsigned a_voff(int R, int C) const { return (unsigned)(R * K + C) * 2u; }
    __device__ __forceinline__ unsigned b_voff(int R, int C) const { return (unsigned)(R * K + C) * 2u; }
    __device__ __forceinline__ void fill_table(LAS unsigned* tb, const Unit& u, int tid) const { if (G) { int t_ = tid; asm volatile("" : "+v"(t_));
#pragma unroll
        for (int i = 0; i < 2; ++i) { int R, C; stage_rc(t_ * 16 + i * 8192, R, C);
#pragma unroll
            for (int h = 0; h < 2; ++h) tb[h * 1024 + i * 512 + tid] = (unsigned)tok[u.pm * 256 + h * 128 + R] * (unsigned)(K * 2) + (unsigned)C * 2u; } } }
};

template <class Epi, class Geo>
__device__ __forceinline__ void gemm_phase(LAS unsigned char* lds, LAS unsigned* tbl, const Geo& S, const Epi& E, int wave_s) {
    int tid_ = wave_s * 64 + lane_id_v(); asm volatile("" : "+v"(tid_));
    const int tid = tid_, wid = wave_s, lane = tid & 63, wr = wid >> 2, wc = wid & 3, fr = lane & 15, fq = lane >> 4;
    const int K = S.K, nt = K / BK;
    unsigned voffA[2], voffB[2];
#pragma unroll
    for (int i = 0; i < 2; ++i) { int R, C; stage_rc(tid * 16 + i * 8192, R, C); const int Rb = Epi::PERM ? ((R & ~31) + perm32(R & 31)) : R;
        voffA[i] = S.a_voff(R, C); voffB[i] = S.b_voff(Rb, C); }
    const size_t kstep = (size_t)(BK * 2);
    const size_t hstepA = S.hstepA(), hstepB = S.hstepB();
    const unsigned ldsw = (unsigned)wid * 1024u;
    const int aoff = lds_byte(wr * 64 + fr, fq * 8), boff = lds_byte(wc * 32 + fr, fq * 8);
#define PG8_SA(b, h) (((b) * 2 + (h)) * HTB)
#define PG8_SB(b, h) ((4 + (b) * 2 + (h)) * HTB)
#define PG8_STAGE(bufoff, gbase, voff) do { _Pragma("unroll") for (int _i = 0; _i < 2; ++_i) \
        __builtin_amdgcn_global_load_lds((const unsigned*)((const char*)(gbase) + (voff)[_i]), (LAS unsigned*)(lds + (bufoff) + ldsw + _i * 8192), 16, 0, 0); } while (0)
#define PG8_STAGE_A(bufoff, gbase, h, nx) do { if constexpr (Geo::GATHER) { const LAS unsigned* _tb = tbl + (((ui + ((nx) ? 1 : 0)) & 1) * 2048) + (h) * 1024 + tid; unsigned _vo[2]; \
        _vo[0] = _tb[0]; _vo[1] = _tb[512]; PG8_STAGE(bufoff, gbase, _vo); } else { PG8_STAGE(bufoff, (gbase) + (h) * hstepA, voffA); } } while (0)
#define PG8_LDA(dst, b, h) do { _Pragma("unroll") for (int m = 0; m < 4; ++m) _Pragma("unroll") for (int k = 0; k < 2; ++k) dst[m][k] = *(const LAS bf16x8*)(lds + PG8_SA(b, h) + aoff + m * 2048 + k * 1024); } while (0)
#define PG8_LDB(dst, b, h) do { _Pragma("unroll") for (int n = 0; n < 2; ++n) _Pragma("unroll") for (int k = 0; k < 2; ++k) dst[n][k] = *(const LAS bf16x8*)(lds + PG8_SB(b, h) + boff + n * 2048 + k * 1024); } while (0)
#define PG8_MMA(ai, bj, At, Bt) do { __builtin_amdgcn_s_setprio(1); _Pragma("unroll") for (int m = 0; m < 4; ++m) _Pragma("unroll") for (int n = 0; n < 2; ++n) _Pragma("unroll") for (int k = 0; k < 2; ++k) \
        acc[ai][bj][m][n] = __builtin_amdgcn_mfma_f32_16x16x32_bf16(Bt[n][k], At[m][k], acc[ai][bj][m][n], 0, 0, 0); __builtin_amdgcn_s_setprio(0); } while (0)
#define PG8_WAIT_V(n) asm volatile("s_waitcnt vmcnt(" #n ")" ::: "memory")
#define PG8_WAIT_L(n) asm volatile("s_waitcnt lgkmcnt(" #n ")" ::: "memory")
#define PG8_BAR __builtin_amdgcn_s_barrier()
#define PG8_SCHED __builtin_amdgcn_sched_barrier(0)
    Unit cur, nxt; int ui = 0;
    if (!S.next(0, cur)) return;
    f32x4 acc[2][2][4][2];
#pragma unroll
    for (int a = 0; a < 2; ++a)
#pragma unroll
        for (int b = 0; b < 2; ++b)
#pragma unroll
            for (int m = 0; m < 4; ++m)
#pragma unroll
                for (int n = 0; n < 2; ++n) acc[a][b][m][n] = (f32x4){0.f, 0.f, 0.f, 0.f};
    bf16x8 At[4][2], B0[2][2], B1[2][2];
    const char* cA = S.a_ptr(cur); const char* cB = S.b_ptr(cur);
    if constexpr (Geo::GATHER) {
        S.fill_table(tbl, cur, tid);
        Unit u1; if (S.next(1, u1)) S.fill_table(tbl + 2048, u1, tid);
        asm volatile("s_waitcnt vmcnt(0) lgkmcnt(0)" ::: "memory"); PG8_BAR; asm volatile("" ::: "memory");
    }
    PG8_STAGE(PG8_SB(0, 0), cB, voffB); PG8_STAGE(PG8_SB(0, 1), cB + hstepB, voffB); PG8_STAGE_A(PG8_SA(0, 0), cA, 0, false); PG8_STAGE_A(PG8_SA(0, 1), cA, 1, false);
    if (wr == 1) PG8_BAR;
    PG8_WAIT_V(2); PG8_BAR;
    PG8_STAGE(PG8_SB(1, 0), cB + kstep, voffB); PG8_STAGE_A(PG8_SA(1, 0), cA + kstep, 0, false); PG8_STAGE(PG8_SB(1, 1), cB + hstepB + kstep, voffB);
    PG8_WAIT_V(6); PG8_BAR;
    for (;;) {
        const bool has_next = S.next(ui + 1, nxt);
        const char* nA = has_next ? S.a_ptr(nxt) : cA; const char* nB = has_next ? S.b_ptr(nxt) : cB;
        for (int t = 0; t < nt; t += 2) {
            const bool last = (t == nt - 2);
            const bool lastn = last && has_next;
            const char* a1 = cA + (size_t)(t + 1) * kstep;
            const char* a2 = last ? nA : cA + (size_t)(t + 2) * kstep; const char* b2 = last ? nB : cB + (size_t)(t + 2) * kstep;
            const char* a3 = a2 + kstep; const char* b3 = b2 + kstep;
            if constexpr (Geo::GATHER) { if (t == 2 && ui > 0) { Unit u2; if (S.next(ui + 1, u2)) S.fill_table(tbl + (((ui + 1) & 1) * 2048), u2, tid); } }
            PG8_LDB(B0, 0, 0); PG8_LDB(B1, 0, 1); PG8_SCHED; PG8_LDA(At, 0, 0); PG8_STAGE_A(PG8_SA(1, 1), a1, 1, false);
            PG8_WAIT_V(8); PG8_WAIT_L(0); PG8_BAR; PG8_MMA(0, 0, At, B0); PG8_MMA(0, 1, At, B1); PG8_BAR; PG8_SCHED;
            PG8_LDA(At, 0, 1); PG8_STAGE(PG8_SB(0, 0), b2, voffB); PG8_STAGE(PG8_SB(0, 1), b2 + hstepB, voffB); PG8_STAGE_A(PG8_SA(0, 0), a2, 0, lastn);
            PG8_WAIT_V(8); PG8_WAIT_L(0); PG8_BAR; PG8_MMA(1, 0, At, B0); PG8_MMA(1, 1, At, B1); PG8_BAR; PG8_SCHED;
            PG8_LDB(B0, 1, 0); PG8_LDB(B1, 1, 1); PG8_SCHED; PG8_LDA(At, 1, 0); PG8_STAGE_A(PG8_SA(0, 1), a2, 1, lastn);
            PG8_WAIT_V(8); PG8_WAIT_L(0); PG8_BAR; PG8_MMA(0, 0, At, B0); PG8_MMA(0, 1, At, B1); PG8_BAR; PG8_SCHED;
            PG8_LDA(At, 1, 1); PG8_STAGE(PG8_SB(1, 0), b3, voffB); PG8_STAGE(PG8_SB(1, 1), b3 + hstepB, voffB); PG8_STAGE_A(PG8_SA(1, 0), a3, 0, lastn);
            PG8_WAIT_V(8); PG8_WAIT_L(0); PG8_BAR; PG8_MMA(1, 0, At, B0); PG8_MMA(1, 1, At, B1); PG8_BAR; PG8_SCHED;
        }
        if (wr == 0) PG8_BAR;
        E(acc, cur, wr, wc, fr, fq);
        if (!has_next) break;
#pragma unroll
        for (int a = 0; a < 2; ++a)
#pragma unroll
            for (int b = 0; b < 2; ++b)
#pragma unroll
                for (int m = 0; m < 4; ++m)
#pragma unroll
                    for (int n = 0; n < 2; ++n) acc[a][b][m][n] = (f32x4){0.f, 0.f, 0.f, 0.f};
        cur = nxt; cA = nA; cB = nB; ++ui;
        if (wr == 1) PG8_BAR;
    }
    PG8_WAIT_V(0);
    PG8_BAR;
#undef PG8_SA
#undef PG8_SB
#undef PG8_STAGE
#undef PG8_STAGE_A
#undef PG8_LDA
#undef PG8_LDB
#undef PG8_MMA
#undef PG8_WAIT_V
#undef PG8_WAIT_L
#undef PG8_BAR
#undef PG8_SCHED
}
}

namespace att {
constexpr int KVBLK = 64, LDQKV = ACOLS;
constexpr int SHM_V = KVBLK * 128 * 2, SHM_K = KVBLK * 64 * 2, OFF_V = 0, OFF_K = 2 * SHM_V, OFF_WS = OFF_K + 2 * SHM_K, LDS_TOTAL = OFF_WS + 8 * 64 * 4;
constexpr float THR = 8.f;
#define KSWZ64(row, colB) ((row) * 128 + ((colB) ^ ((((row) >> 1) & 7) << 4)))
#define SBAR() __builtin_amdgcn_sched_barrier(0)
__device__ __forceinline__ int crow(int r, int hi) { return (r & 3) + 8 * (r >> 2) + 4 * hi; }
__device__ __forceinline__ unsigned cvtpk(float lo, float hi) { unsigned r; asm volatile("v_cvt_pk_bf16_f32 %0, %1, %2" : "=v"(r) : "v"(lo), "v"(hi)); return r; }
__device__ __forceinline__ int v_st(int k, int c) { const int kk = (k & ~0xC) | ((k & 4) << 1) | ((k & 8) >> 1); return ((kk >> 3) * 4 + (c >> 5)) * 512 + ((kk & 7) * 32 + (c & 31)) * 2; }
__device__ __forceinline__ int v_rd_base(int lane) { return ((lane & 3) << 3) | (((lane >> 2) & 3) << 6) | (((lane >> 4) & 1) << 5) | (((lane >> 5) & 1) << 8); }
constexpr int v_rd_off(int d0, int ks, int half) { return d0 * 512 + ks * 4096 + half * 2048; }
template <int OFF> __device__ __forceinline__ v4i16_t tr_read(int vb) { v4i16_t r; asm volatile("ds_read_b64_tr_b16 %0, %1 offset:%2" : "=&v"(r) : "v"(vb), "i"(OFF) : "memory"); return r; }
template <int D0> __device__ __forceinline__ void pv_one(f32x16& od, int vb, bf16x8 pa0, bf16x8 pa1, bf16x8 pa2, bf16x8 pa3) {
    const v4i16_t l0 = tr_read<v_rd_off(D0, 0, 0)>(vb), h0 = tr_read<v_rd_off(D0, 0, 1)>(vb), l1 = tr_read<v_rd_off(D0, 1, 0)>(vb), h1 = tr_read<v_rd_off(D0, 1, 1)>(vb);
    const v4i16_t l2 = tr_read<v_rd_off(D0, 2, 0)>(vb), h2 = tr_read<v_rd_off(D0, 2, 1)>(vb), l3 = tr_read<v_rd_off(D0, 3, 0)>(vb), h3 = tr_read<v_rd_off(D0, 3, 1)>(vb);
    asm volatile("s_waitcnt lgkmcnt(0)" ::: "memory"); SBAR();
#define PK(L, H) (bf16x8){L[0], L[1], L[2], L[3], H[0], H[1], H[2], H[3]}
    od = __builtin_amdgcn_mfma_f32_32x32x16_bf16(pa0, PK(l0, h0), od, 0, 0, 0);
    od = __builtin_amdgcn_mfma_f32_32x32x16_bf16(pa1, PK(l1, h1), od, 0, 0, 0);
    od = __builtin_amdgcn_mfma_f32_32x32x16_bf16(pa2, PK(l2, h2), od, 0, 0, 0);
    od = __builtin_amdgcn_mfma_f32_32x32x16_bf16(pa3, PK(l3, h3), od, 0, 0, 0);
#undef PK
}
__device__ __forceinline__ void pv_d0(f32x16* o, int vb, bf16x8 pa0, bf16x8 pa1, bf16x8 pa2, bf16x8 pa3) {
    pv_one<0>(o[0], vb, pa0, pa1, pa2, pa3); pv_one<1>(o[1], vb, pa0, pa1, pa2, pa3); pv_one<2>(o[2], vb, pa0, pa1, pa2, pa3); pv_one<3>(o[3], vb, pa0, pa1, pa2, pa3);
}
__device__ __forceinline__ void qkt(f32x16& p0, f32x16& p1, const char* Ks, const bf16x8* qr, const f32x16& negm, int r32, int hi, float dq, float slope2) {
#pragma unroll
    for (int d0 = 0; d0 < 4; ++d0) { const int cb = (d0 * 16 + hi * 8) * 2;
        const bf16x8 b0 = *reinterpret_cast<const bf16x8*>(Ks + KSWZ64(r32, cb));
        const bf16x8 b1 = *reinterpret_cast<const bf16x8*>(Ks + KSWZ64(32 + r32, cb));
        if (d0 == 0) { p0 = __builtin_amdgcn_mfma_f32_32x32x16_bf16(b0, qr[0], negm, 0, 0, 0); p1 = __builtin_amdgcn_mfma_f32_32x32x16_bf16(b1, qr[0], negm, 0, 0, 0); }
        else { p0 = __builtin_amdgcn_mfma_f32_32x32x16_bf16(b0, qr[d0], p0, 0, 0, 0); p1 = __builtin_amdgcn_mfma_f32_32x32x16_bf16(b1, qr[d0], p1, 0, 0, 0); } }
    asm volatile("" : "+v"(dq), "+v"(p0), "+v"(p1));
#pragma unroll
    for (int r = 0; r < 16; ++r) { const float cr = (float)((r & 3) + 8 * (r >> 2)); p0[r] = fmaf(-slope2, fabsf(dq - cr), p0[r]); p1[r] = fmaf(-slope2, fabsf(dq - 32.f - cr), p1[r]); }
}
__device__ __forceinline__ void partialSM(f32x16& p0, f32x16& p1, f32x16& negm, float& alpha) {
    float pmax = p0[0];
#pragma unroll
    for (int r = 1; r < 16; ++r) pmax = fmaxf(pmax, p0[r]);
#pragma unroll
    for (int r = 0; r < 16; ++r) pmax = fmaxf(pmax, p1[r]);
    { auto rr = __builtin_amdgcn_permlane32_swap(__float_as_uint(pmax), __float_as_uint(pmax), false, false); pmax = fmaxf(__uint_as_float(rr[0]), __uint_as_float(rr[1])); }
    if (__builtin_expect(!__any(pmax > THR), 1)) { alpha = 1.f; }
    else { const float dl = fmaxf(pmax, 0.f); alpha = __builtin_amdgcn_exp2f(-dl);
#pragma unroll
        for (int r = 0; r < 16; ++r) { p0[r] -= dl; p1[r] -= dl; negm[r] -= dl; } }
#pragma unroll
    for (int r = 0; r < 16; ++r) p0[r] = __builtin_amdgcn_exp2f(p0[r]);
}
__device__ __forceinline__ void finishSM(f32x16& p0, f32x16& p1, float alpha, float& l_reg, bf16x8& pa0, bf16x8& pa1, bf16x8& pa2, bf16x8& pa3) {
#pragma unroll
    for (int r = 0; r < 16; ++r) p1[r] = __builtin_amdgcn_exp2f(p1[r]);
    float ps = 0.f;
#pragma unroll
    for (int r = 0; r < 16; ++r) ps += p0[r];
#pragma unroll
    for (int r = 0; r < 16; ++r) ps += p1[r];
    { auto rr = __builtin_amdgcn_permlane32_swap(__float_as_uint(ps), __float_as_uint(ps), false, false); ps = __uint_as_float(rr[0]) + __uint_as_float(rr[1]); }
    l_reg = l_reg * alpha + ps;
#define PK4(P, BASE, OUT) do { const unsigned a0 = cvtpk(P[BASE + 0], P[BASE + 1]), a1 = cvtpk(P[BASE + 2], P[BASE + 3]), b0 = cvtpk(P[BASE + 4], P[BASE + 5]), b1 = cvtpk(P[BASE + 6], P[BASE + 7]); \
        auto r0 = __builtin_amdgcn_permlane32_swap(a0, b0, false, false); auto r1 = __builtin_amdgcn_permlane32_swap(a1, b1, false, false); \
        u32x4 w = {r0[0], r1[0], r0[1], r1[1]}; OUT = __builtin_bit_cast(bf16x8, w); } while (0)
    PK4(p0, 0, pa0); PK4(p0, 8, pa1); PK4(p1, 0, pa2); PK4(p1, 8, pa3);
#undef PK4
}
__device__ __forceinline__ void pass(f32x16 (&o)[4], const bf16_t* Qw, const bf16_t* Kh, const bf16_t* Vh, int qpos, int qb, float slope2, char* lds, int tid) {
    const int wid = tid >> 6, lane = tid & 63, r32 = lane & 31, hi = lane >> 5;
    char* V_lds = lds + OFF_V; char* K_lds = lds + OFF_K;
    float* ws = (float*)(lds + OFF_WS) + wid * 64; float* li_l = ws; float* al_l = ws + 32;
    float l_reg = 0.f; bf16x8 qr[4];
#pragma unroll
    for (int d = 0; d < 4; ++d)
#pragma unroll
        for (int r = 0; r < 16; ++r) o[d][r] = 0.f;
    f32x16 negm;
#pragma unroll
    for (int r = 0; r < 16; ++r) negm[r] = 0.f;
#pragma unroll
    for (int d0 = 0; d0 < 4; ++d0) qr[d0] = *reinterpret_cast<const bf16x8*>(Qw + d0 * 16);
    const int kr = tid >> 3, kc = (tid & 7) * 8, kst = KSWZ64(kr, kc * 2);
    const int sr = tid >> 4, sc = (tid & 15) * 8, vst0 = v_st(sr, sc), vst1 = v_st(32 + sr, sc);
    const int vb0 = (int)(uintptr_t)V_lds + v_rd_base(lane);
    const unsigned voff0 = (unsigned)(sr * LDQKV + sc), koff0 = (unsigned)(kr * LDQKV + kc);
    struct { bf16x8 vs0, vs1, ks; } st_[2];
    constexpr int NT = SEQ / KVBLK;
    const int nd = 4 * qb;
#define KT(i) ((i) < 4 ? nd + (i) : ((i) < 4 + nd ? nd + 3 - (i) : (i)))
#define SLOAD(i, tile) do { const unsigned k0_ = (unsigned)((tile) * KVBLK * LDQKV); st_[i].vs0 = *reinterpret_cast<const bf16x8*>(Vh + (k0_ + voff0)); st_[i].vs1 = *reinterpret_cast<const bf16x8*>(Vh + (k0_ + voff0 + 32u * LDQKV)); \
        st_[i].ks = *reinterpret_cast<const bf16x8*>(Kh + (k0_ + koff0)); } while (0)
#define SWRITE(b, i) do { *(bf16x8*)(V_lds + (b) * SHM_V + vst0) = st_[i].vs0; *(bf16x8*)(V_lds + (b) * SHM_V + vst1) = st_[i].vs1; *(bf16x8*)(K_lds + (b) * SHM_K + kst) = st_[i].ks; } while (0)
#define SWAIT() asm volatile("s_waitcnt vmcnt(3)" ::: "memory")
#define RESC(a) do { if (__any((a) < 1.f)) { if (hi == 0) al_l[r32] = (a); asm volatile("s_waitcnt lgkmcnt(0)" ::: "memory"); \
        _Pragma("unroll") for (int d = 0; d < 4; ++d) _Pragma("unroll") for (int r = 0; r < 16; ++r) o[d][r] *= al_l[crow(r, hi)]; } } while (0)
#define DQ(tile) ((float)(qpos - (tile) * KVBLK - 4 * hi))
    f32x16 pA0, pA1, pB0, pB1; float alA, alB; bf16x8 pa0, pa1, pa2, pa3;
    SLOAD(0, KT(0)); asm volatile("s_waitcnt vmcnt(0)" ::: "memory"); SWRITE(0, 0); __syncthreads();
    qkt(pA0, pA1, K_lds, qr, negm, r32, hi, DQ(KT(0)), slope2); partialSM(pA0, pA1, negm, alA);
    SLOAD(1, KT(1)); SLOAD(0, KT(2));
    SWAIT(); SWRITE(1, 1); __syncthreads();
    for (int j = 1; j + 1 < NT; j += 2) {
        SBAR(); qkt(pB0, pB1, K_lds + SHM_K, qr, negm, r32, hi, DQ(KT(j)), slope2);
        finishSM(pA0, pA1, alA, l_reg, pa0, pa1, pa2, pa3); SBAR();
        SLOAD(1, KT(j + 2)); SBAR();
        pv_d0(o, vb0, pa0, pa1, pa2, pa3); partialSM(pB0, pB1, negm, alB);
        __syncthreads(); SWAIT(); SWRITE(0, 0);
        RESC(alB); __syncthreads();
        SBAR(); qkt(pA0, pA1, K_lds, qr, negm, r32, hi, DQ(KT(j + 1)), slope2);
        finishSM(pB0, pB1, alB, l_reg, pa0, pa1, pa2, pa3); SBAR();
        if (j + 3 < NT) SLOAD(0, KT(j + 3)); SBAR();
        pv_d0(o, vb0 + SHM_V, pa0, pa1, pa2, pa3); partialSM(pA0, pA1, negm, alA);
        __syncthreads(); SWAIT(); SWRITE(1, 1);
        RESC(alA); __syncthreads();
    }
    SBAR(); qkt(pB0, pB1, K_lds + SHM_K, qr, negm, r32, hi, DQ(KT(NT - 1)), slope2);
    finishSM(pA0, pA1, alA, l_reg, pa0, pa1, pa2, pa3); SBAR();
    pv_d0(o, vb0, pa0, pa1, pa2, pa3); partialSM(pB0, pB1, negm, alB);
    __syncthreads(); RESC(alB);
    finishSM(pB0, pB1, alB, l_reg, pa0, pa1, pa2, pa3); SBAR();
    pv_d0(o, vb0 + SHM_V, pa0, pa1, pa2, pa3);
    if (hi == 0) li_l[r32] = l_reg; asm volatile("s_waitcnt lgkmcnt(0)" ::: "memory");
#pragma unroll
    for (int r = 0; r < 16; ++r) { const float rl = __builtin_amdgcn_rcpf(li_l[crow(r, hi)]);
#pragma unroll
        for (int d = 0; d < 4; ++d) o[d][r] *= rl; }
    __syncthreads();
#undef KT
#undef SLOAD
#undef SWRITE
#undef SWAIT
#undef RESC
#undef DQ
}
#undef SBAR
}

typedef GAS unsigned gu32;
#define XB_TMO      128
#define XB_XCNT(j)  (256  + 64 * (j))
#define XB_XSUB(j)  (1280 + 64 * (j))
#define XB_XGEN(j)  (2304 + 64 * (j))
#define XB_TOP      3328
#define XB_TOPGEN   3392
#define XCD_BAR_WORDS 3456
#define XB_SPIN_CAP (1u << 23)
__device__ __forceinline__ unsigned xb_ld(unsigned* p)              { return __hip_atomic_load(p, __ATOMIC_RELAXED, __HIP_MEMORY_SCOPE_AGENT); }
__device__ __forceinline__ unsigned xb_add(unsigned* p, unsigned v) { return __hip_atomic_fetch_add(p, v, __ATOMIC_RELAXED, __HIP_MEMORY_SCOPE_AGENT); }
__device__ __forceinline__ unsigned xb_xcc_id() { return (unsigned)__builtin_amdgcn_s_getreg((3 << 11) | 20) & 0xFu; }
#define XB_SPIN(cond, bar) do { unsigned _sp = 0; while (cond) { __builtin_amdgcn_s_sleep(1); \
    if ((++_sp & 255u) == 0u) { if (xb_ld(&(bar)[XB_TMO])) break; if (_sp > XB_SPIN_CAP) { atomicAdd(&(bar)[XB_TMO], 1u); break; } } } } while (0)
struct XcdBarrier { unsigned* bar; unsigned x; volatile LAS unsigned* st; int wave; };
__device__ __forceinline__ XcdBarrier xcd_barrier_post(unsigned* bar, volatile LAS unsigned* st, int wave) {
    XcdBarrier b; b.bar = bar; b.x = xb_xcc_id(); b.st = st; b.wave = wave;
    if (wave == 0 && lane_id_v() == 0) (void)xb_add(&bar[XB_XCNT(b.x)], 1u);
    return b;
}
__device__ __forceinline__ void xcd_barrier_complete(unsigned* bar, unsigned x, unsigned& nloc, unsigned& nx) {
    const unsigned G = gridDim.x * gridDim.y * gridDim.z;
    unsigned sum, cnt, mine, sp = 0u;
    for (;;) {
        sum = 0u; cnt = 0u; mine = 0u;
#pragma unroll
        for (unsigned j = 0; j < 16; ++j) { const unsigned c = xb_ld(&bar[XB_XCNT(j)]); sum += c; cnt += (c > 0u) ? 1u : 0u; mine = (j == x) ? c : mine; }
        if (sum == G) break;
        __builtin_amdgcn_s_sleep(1);
        if ((++sp & 255u) == 0u) { if (xb_ld(&bar[XB_TMO])) break; if (sp > XB_SPIN_CAP) { atomicAdd(&bar[XB_TMO], 1u); break; } }
    }
    nloc = mine > 0u ? mine : 1u; nx = cnt > 0u ? cnt : 1u;
}
__device__ __forceinline__ void xcd_barrier(const XcdBarrier& b) {
    asm volatile("s_waitcnt vmcnt(0)" ::: "memory");
    __syncthreads();
    if (b.wave == 0 && lane_id_v() == 0) {
        unsigned* bar = b.bar;
        __builtin_amdgcn_s_waitcnt(0);
        unsigned nloc = b.st[0], nx = b.st[1];
        if (nloc == 0u) { xcd_barrier_complete(bar, b.x, nloc, nx); b.st[0] = nloc; b.st[1] = nx; }
        const unsigned old = xb_add(&bar[XB_XSUB(b.x)], 1u);
        const unsigned gen = old / nloc;
        if (old + 1u == (gen + 1u) * nloc) {
            __builtin_amdgcn_fence(__ATOMIC_RELEASE, "agent");
            asm volatile("s_waitcnt vmcnt(0)" ::: "memory");
            const unsigned og = xb_add(&bar[XB_TOP], 1u);
            const unsigned tg = og / nx;
            if (og + 1u == (tg + 1u) * nx) xb_add(&bar[XB_TOPGEN], 1u);
            else XB_SPIN(xb_ld(&bar[XB_TOPGEN]) == tg, bar);
            __builtin_amdgcn_fence(__ATOMIC_ACQUIRE, "agent");
            xb_add(&bar[XB_XGEN(b.x)], 1u);
            asm volatile("s_waitcnt vmcnt(0)" ::: "memory");
        } else {
            XB_SPIN(xb_ld(&bar[XB_XGEN(b.x)]) == gen, bar);
            __builtin_amdgcn_fence(__ATOMIC_ACQUIRE, "agent");
            asm volatile("s_waitcnt vmcnt(0)" ::: "memory");
        }
    }
    __syncthreads();
}

__device__ __forceinline__ void p0_transpose_item(const float* W, int K, int N, bf16_t* WT, int k0, int n0, int orow0, LAS float* scr, int lane) {
#pragma unroll 8
    for (int i = 0; i < 32; ++i) { const int kk = 2 * i + (lane >> 5); scr[kk * 33 + (lane & 31)] = W[(size_t)(k0 + kk) * N + n0 + (lane & 31)]; }
    LDS_WAIT(); asm volatile("" ::: "memory");
    const int c = lane & 7;
#pragma unroll
    for (int j = 0; j < 4; ++j) { const int n = (lane >> 3) + 8 * j; const LAS float* s = scr + (8 * c) * 33 + n;
        u32x4 o; o.x = pk2(s[0 * 33], s[1 * 33]); o.y = pk2(s[2 * 33], s[3 * 33]); o.z = pk2(s[4 * 33], s[5 * 33]); o.w = pk2(s[6 * 33], s[7 * 33]);
        *(GAS u32x4*)(WT + (size_t)(orow0 + n) * K + k0 + 8 * c) = o; }
    LDS_WAIT(); asm volatile("" ::: "memory");
}

struct Args { const float* in[25]; float* out; unsigned char* ws; };

__global__ void __launch_bounds__(512, 2) mega_fwd(Args args) {
    extern __shared__ __attribute__((aligned(16))) unsigned char lds_raw[];
    LAS unsigned char* lds = (LAS unsigned char*)lds_raw;
    volatile LAS unsigned* MISC = (volatile LAS unsigned*)(lds + MISC_OFF);
    const int G = gridDim.x, bx = blockIdx.x, NGW = G * 8;
    const int wave_s = __builtin_amdgcn_readfirstlane(threadIdx.x >> 6);
    unsigned char* ws = args.ws;
    gu32* ctl = (gu32*)(ws + WS_CTL);
    const float* x = args.in[0];
    float* out = args.out;
    bf16_t* WGU = (bf16_t*)(ws + WS_WGU); bf16_t* WD = (bf16_t*)(ws + WS_WD); bf16_t* WIN = (bf16_t*)(ws + WS_WIN); bf16_t* WOUT = (bf16_t*)(ws + WS_WOUT);
    bf16_t* XN = (bf16_t*)(ws + WS_XN); bf16_t* H2 = (bf16_t*)(ws + WS_H2); bf16_t* GF = (bf16_t*)(ws + WS_GF);
    bf16_t* HP = (bf16_t*)(ws + WS_HP); bf16_t* QKV = (bf16_t*)(ws + WS_QKV); bf16_t* HZ = (bf16_t*)(ws + WS_HZ); bf16_t* MIX = (bf16_t*)(ws + WS_MIX);
    bf16_t* ACT = (bf16_t*)(ws + WS_ACT); bf16_t* Y = (bf16_t*)(ws + WS_Y);
    float* AFF = (float*)(ws + WS_AFF); int* TOK = (int*)(ws + WS_TOK); float* GSEL = (float*)(ws + WS_GSEL); unsigned short* INV = (unsigned short*)(ws + WS_INV);
    float* NSUM = (float*)(ws + WS_CTL) + CW_NSUM;

    if (wave_s == 0) ((LAS unsigned*)(lds + MISC_OFF))[lane_id_v()] = 0u;
    __syncthreads();
    XcdBarrier bar = xcd_barrier_post((unsigned*)(ctl + CW_BAR), MISC + 8, wave_s);

    {
        PHASE_IDS();
        LAS float* scr = (LAS float*)(lds + wave * 16384);
        constexpr int I_IN = (DM / 64) * (INC / 32), I_OUT = (DM / 64) * (DM / 32), I_GU = (DM / 64) * (FF / 32), I_DN = (FF / 64) * (DM / 32);
        constexpr int NITEMS = I_IN + I_OUT + NE * (2 * I_GU + I_DN);
        for (int it = gw; it < NITEMS; it += NGW) {
            int r = it;
            if (r < I_IN) { const int nblk = INC / 32, kb = r / nblk, nb = r % nblk; p0_transpose_item(args.in[2], DM, INC, WIN, 64 * kb, 32 * nb, 32 * nb, scr, lane); continue; } r -= I_IN;
            if (r < I_OUT) { const int nblk = DM / 32, kb = r / nblk, nb = r % nblk; p0_transpose_item(args.in[18], DM, DM, WOUT, 64 * kb, 32 * nb, 32 * nb, scr, lane); continue; } r -= I_OUT;
            const int e = r / (2 * I_GU + I_DN); r -= e * (2 * I_GU + I_DN);
            if (r < 2 * I_GU) { const int up = r >= I_GU; if (up) r -= I_GU; const int nblk = FF / 32, kb = r / nblk, nb = r % nblk, f0 = 32 * nb;
                const int orow = (f0 >> 7) * 256 + up * 128 + (f0 & 127);
                p0_transpose_item(args.in[up ? 22 : 21] + (size_t)e * DM * FF, DM, FF, WGU + (size_t)e * 2 * FF * DM, 64 * kb, f0, orow, scr, lane); continue; }
            r -= 2 * I_GU;
            { const int nblk = DM / 32, kb = r / nblk, nb = r % nblk; p0_transpose_item(args.in[23] + (size_t)e * FF * DM, FF, DM, WD + (size_t)e * DM * FF, 64 * kb, 32 * nb, 32 * nb, scr, lane); }
        }
        const float* g = args.in[1];
        for (int m = gw; m < NTOK; m += NGW) {
            const GAS f32x4* xr = (const GAS f32x4*)(x + (size_t)m * DM) + lane;
            f32x4 v[4]; float s = 0.f;
#pragma unroll
            for (int j = 0; j < 4; ++j) { v[j] = xr[64 * j]; s += (v[j].x * v[j].x + v[j].y * v[j].y) + (v[j].z * v[j].z + v[j].w * v[j].w); }
            const float rstd = rsqrtf(wave_sum(s) * (1.f / DM) + EPS);
            GAS u32x2* o8 = (GAS u32x2*)(XN + (size_t)m * DM) + lane;
#pragma unroll
            for (int j = 0; j < 4; ++j) { const f32x4 gg = ((const GAS f32x4*)g)[lane + 64 * j]; u32x2 w; w.x = pk2(v[j].x * rstd * gg.x, v[j].y * rstd * gg.y); w.y = pk2(v[j].z * rstd * gg.z, v[j].w * rstd * gg.w); o8[64 * j] = w; }
        }
        __syncthreads();
        for (int it = bx; it < 256; it += G) {
            const int ib = it >> 2, dn = it & 3, dir = dn >> 1, n = dn & 1, i0 = ib * 64;
            LAS float* zz = (LAS float*)lds;
            LAS float* h1 = zz + 64 * 33;
            LAS float* h2 = h1 + 64 * 64;
            const float* w1 = args.in[5]; const float* b1 = args.in[6]; const float* w2 = args.in[7]; const float* b2 = args.in[8]; const float* w3 = args.in[9]; const float* fr = args.in[10];
            for (int q = tid; q < 64 * 33; q += 512) { const int p = q / 33, j = q % 33, i = i0 + p;
                const float t = (float)i / (float)(SEQ - 1), w = 6.283185307179586f * (float)i / (float)SEQ; float v;
                if (j == 0) v = t; else { const float band = 1e-4f + (float)((j - 1) & 15) * ((15.f - 1e-4f) / 15.f); v = (j <= 16) ? cosf(band * w) : -sinf(band * w); }
                zz[q] = v; }
            __syncthreads();
            for (int q = tid; q < 64 * 64; q += 512) { const int p = q >> 6, j = q & 63; float a = b1[j]; for (int k = 0; k < 33; ++k) a += zz[p * 33 + k] * w1[k * 64 + j]; h1[q] = sinf(fr[j] * a); }
            __syncthreads();
            for (int q = tid; q < 64 * 64; q += 512) { const int p = q >> 6, j = q & 63; float a = b2[j]; for (int k = 0; k < 64; ++k) a += h1[p * 64 + k] * w2[k * 64 + j]; h2[q] = sinf(fr[j] * a); }
            __syncthreads();
            const int c = tid, col = dn * 512 + c;
            const float mind = logf(1e-2f) / 1.5f, maxd = logf(1e-2f) / 0.3f;
            const float delta = fabsf(mind + (float)c * ((maxd - mind) / 511.f));
            bf16_t* gf = GF + (size_t)(n * 512 + c) * GLEN;
            float asum = 0.f;
            for (int p0 = 0; p0 < 64; p0 += 16) {
                float hv[16];
#pragma unroll
                for (int p = 0; p < 16; ++p) hv[p] = 0.f;
                for (int k = 0; k < 64; ++k) { const float wk = w3[k * 2048 + col];
#pragma unroll
                    for (int p = 0; p < 16; ++p) hv[p] += h2[(p0 + p) * 64 + k] * wk; }
#pragma unroll
                for (int p = 0; p < 16; ++p) { const int i = i0 + p0 + p; const float t = (float)i / (float)(SEQ - 1); const float h = hv[p] * expf(-t * delta);
                    const unsigned hb = f2bf(h); const float hr = __builtin_bit_cast(float, hb << 16);
                    if (dir == 0) { gf[GOFF - i] = (bf16_t)hb; asum += fabsf(hr); } else if (i > 0) { gf[GOFF + i] = (bf16_t)hb; asum += fabsf(hr); } }
            }
            if (ib == 63) { if (dir == 0) { for (int q = 0; q < GOFF - 4095; ++q) gf[q] = 0; } else { for (int q = GOFF + 4096; q < GLEN; ++q) gf[q] = 0; } }
            atomicAdd(&NSUM[n * 512 + c], asum);
            __syncthreads();
        }
    }
    xcd_barrier(bar);

    {
        pg8::GeoTokPerm S; S.A = WIN; S.X = XN; S.K = DM; S.ord.init(HCOLS / 256, NTOK / 256, G, bx);
        pg8::EpiBf16 E{HP, NTOK, 0, 1.f};
        pg8::gemm_phase(lds, (LAS unsigned*)(lds + TBL_OFF), S, E, wave_s);
    }
    {
        pg8::GeoPlain S; S.A = XN; S.Bt = WIN + (size_t)HCOLS * DM; S.K = DM; S.ord.init(NTOK / 256, ACOLS / 256, G, bx);
        pg8::EpiBf16 E{QKV, ACOLS, 512, QSCALE};
        pg8::gemm_phase(lds, (LAS unsigned*)(lds + TBL_OFF), S, E, wave_s);
    }
    xcd_barrier(bar);

    {
        PHASE_IDS();
        {
            const float* conv_w = args.in[3]; const float* conv_b = args.in[4]; const float* skip = args.in[11];
            if (tid < 64) { const int bufi = tid >> 5, row = tid & 31, rr = row < 16 ? row : SEQ + row; *(LAS u32x4*)(lds + bufi * HY_ZBYTES + rr * 16) = (u32x4){0u, 0u, 0u, 0u}; }
            const int r32 = lane & 31, hi = lane >> 5;
            const int tr_lane = (2 * ((lane >> 4) & 1) + ((lane & 3) >> 1) + 8 * hi + ((lane & 15) >> 2)) * 16 + 8 * (lane & 1);
            for (int unit = bx; unit < HW; unit += G) {
                const int c = unit;
                __syncthreads();
                {
                    const int col = 1024 + c; const float w0 = conv_w[col], w1 = conv_w[HCOLS + col], w2 = conv_w[2 * HCOLS + col], cb = conv_b[col];
                    const bf16_t* hp = HP + (size_t)col * SEQ * 8;
#pragma unroll 2
                    for (int i = 0; i < 8; ++i) { const int t = tid + 512 * i;
                        const u32x4 z4 = (u32x4){0u, 0u, 0u, 0u};
                        const u32x4 pm = t > 0 ? *(const GAS u32x4*)(hp + (size_t)(t - 1) * 8) : z4, p0 = *(const GAS u32x4*)(hp + (size_t)t * 8), pp = t < SEQ - 1 ? *(const GAS u32x4*)(hp + (size_t)(t + 1) * 8) : z4;
                        u32x4 o;
#pragma unroll
                        for (int k = 0; k < 4; ++k) { const float lo = cb + w0 * bflo(pm[k]) + w1 * bflo(p0[k]) + w2 * bflo(pp[k]), hh = cb + w0 * bfhi(pm[k]) + w1 * bfhi(p0[k]) + w2 * bfhi(pp[k]); o[k] = pk2(lo, hh); }
                        *(LAS u32x4*)(lds + HY_ZA + (t + 16) * 16) = o; }
                }
                for (int n = 0; n < 2; ++n) {
                    {
                        const GAS u32x4* gsrc = (const GAS u32x4*)(GF + (size_t)(n * 512 + c) * GLEN);
                        for (int q = tid; q < GLEN * 2 / 16; q += 512) *(LAS u32x4*)(lds + HY_FB + q * 16) = gsrc[q];
                    }
                    __syncthreads();
                    f32x16 acc[2][2];
#pragma unroll
                    for (int a = 0; a < 2; ++a)
#pragma unroll
                        for (int b = 0; b < 2; ++b)
#pragma unroll
                            for (int k = 0; k < 16; ++k) acc[a][b][k] = 0.f;
                    const LAS unsigned char* za = lds + (n == 0 ? HY_ZA : HY_ZB) + tr_lane;
                    const LAS unsigned char* fbp = lds + HY_FB + 2 * GOFF - 32 + 16 * (hi - r32) - 512 * (2 * wave);
#define HY_STEP(OFFA, OFFB) do { \
                        const v4i16_t x0 = __builtin_amdgcn_ds_read_tr16_b64_v4i16((LAS v4i16_t*)(za + (OFFA))); \
                        const v4i16_t x1 = __builtin_amdgcn_ds_read_tr16_b64_v4i16((LAS v4i16_t*)(za + (OFFA) + 64)); \
                        const v4i16_t x2 = __builtin_amdgcn_ds_read_tr16_b64_v4i16((LAS v4i16_t*)(za + (OFFA) + 128)); \
                        const bf16x8 b0 = *(const LAS bf16x8*)(fbp + (OFFB)), b1 = *(const LAS bf16x8*)(fbp + (OFFB) - 512); \
                        const bf16x8 a0 = (bf16x8){x0[0], x0[1], x0[2], x0[3], x1[0], x1[1], x1[2], x1[3]}, a1 = (bf16x8){x1[0], x1[1], x1[2], x1[3], x2[0], x2[1], x2[2], x2[3]}; \
                        acc[0][0] = __builtin_amdgcn_mfma_f32_32x32x16_bf16(a0, b0, acc[0][0], 0, 0, 0); \
                        acc[0][1] = __builtin_amdgcn_mfma_f32_32x32x16_bf16(a1, b0, acc[0][1], 0, 0, 0); \
                        acc[1][0] = __builtin_amdgcn_mfma_f32_32x32x16_bf16(a0, b1, acc[1][0], 0, 0, 0); \
                        acc[1][1] = __builtin_amdgcn_mfma_f32_32x32x16_bf16(a1, b1, acc[1][1], 0, 0, 0); } while (0)
#pragma clang loop unroll(disable)
                    for (int c4 = 0; c4 < 64; ++c4) {
                        HY_STEP(0, 0); HY_STEP(256, 32); HY_STEP(512, 64); HY_STEP(768, 96);
                        za += 1024; fbp += 128;
                    }
                    HY_STEP(0, 0);
#undef HY_STEP
                    const int gcol = n * 512 + c; const float w0 = conv_w[gcol], w1 = conv_w[HCOLS + gcol], w2 = conv_w[2 * HCOLS + gcol], cb = conv_b[gcol];
                    const float inv = 1.f / NSUM[n * 512 + c], sk = skip[n * 512 + c];
                    const bf16_t* hp = HP + (size_t)gcol * SEQ * 8 + 4 * hi;
                    const LAS unsigned char* zin = lds + (n == 0 ? HY_ZA : HY_ZB) + 8 * hi;
#pragma unroll
                    for (int sp = 0; sp < 2; ++sp) {
                        const int tb = 256 * (2 * wave + sp) + 8 * r32;
                        u32x2 P[10];
#pragma unroll
                        for (int k = 0; k < 10; ++k) { const int tq = tb - 1 + k; P[k] = (tq >= 0 && tq < SEQ) ? *(const GAS u32x2*)(hp + (size_t)tq * 8) : (u32x2){0u, 0u}; }
#pragma unroll
                        for (int tt = 0; tt < 8; ++tt) {
                            const int t = tb + tt; const u32x2 zi = *(const LAS u32x2*)(zin + (t + 16) * 16);
                            const float zv[4] = {bflo(zi.x), bfhi(zi.x), bflo(zi.y), bfhi(zi.y)};
                            const float pm[4] = {bflo(P[tt].x), bfhi(P[tt].x), bflo(P[tt].y), bfhi(P[tt].y)};
                            const float pc[4] = {bflo(P[tt + 1].x), bfhi(P[tt + 1].x), bflo(P[tt + 1].y), bfhi(P[tt + 1].y)};
                            const float pp[4] = {bflo(P[tt + 2].x), bfhi(P[tt + 2].x), bflo(P[tt + 2].y), bfhi(P[tt + 2].y)};
                            float zo[4];
#pragma unroll
                            for (int bb = 0; bb < 4; ++bb) { const float gate = cb + w0 * pm[bb] + w1 * pc[bb] + w2 * pp[bb]; zo[bb] = gate * (acc[sp][tt >> 2][(tt & 3) * 4 + bb] * inv + sk * zv[bb]); }
                            u32x2 w; w.x = pk2(zo[0], zo[1]); w.y = pk2(zo[2], zo[3]);
                            if (n == 0) *(LAS u32x2*)(lds + HY_ZB + (t + 16) * 16 + 8 * hi) = w;
                            else *(GAS u32x2*)(HZ + ((size_t)c * SEQ + t) * 8 + 4 * hi) = w;
                        }
                    }
                    __syncthreads();
                }
            }
        }
        __syncthreads();
        {
            const int wid = wave, r32 = lane & 31, hi = lane >> 5;
            for (int unit = bx; unit < NB * 4 * 16; unit += G) {
                const int qb = unit & 15, h = (unit >> 4) & 3, b = unit >> 6, q0 = qb * 256;
                const bf16_t* pb = QKV + (size_t)b * SEQ * ACOLS;
                const float slope2 = exp2f(-2.f * (float)(h + 1)) * LOG2E;
                const int qpos = q0 + wid * 32 + r32;
                f32x16 o[4];
#pragma clang loop unroll(disable)
                for (int mp = 0; mp < 2; ++mp) {
                    att::pass(o, pb + (size_t)qpos * ACOLS + h * 128 + mp * 64 + hi * 8, pb + 512 + h * 128 + mp * 64, pb + 1024 + h * 128, qpos, qb, slope2, (char*)lds_raw, tid);
                    if (mp == 0) {
                        int z2 = 0; asm volatile("" : "+s"(z2));
                        GAS f32x4* pk = (GAS f32x4*)((float*)(ws + WS_PARK) + (size_t)(bx * 8 + wid) * 4096 + lane * 64 + z2);
#pragma unroll
                        for (int d = 0; d < 4; ++d)
#pragma unroll
                            for (int k = 0; k < 4; ++k) pk[d * 4 + k] = (f32x4){o[d][4 * k], o[d][4 * k + 1], o[d][4 * k + 2], o[d][4 * k + 3]};
                    }
                    __builtin_amdgcn_sched_barrier(0);
                }
                asm volatile("s_waitcnt vmcnt(0)" ::: "memory");
                int zz = 0; asm volatile("" : "+s"(zz));
                float lam;
                { float s1 = 0.f, s2 = 0.f; for (int i = 0; i < 64; ++i) { s1 += args.in[13][i + zz] * args.in[14][i + zz]; s2 += args.in[15][i + zz] * args.in[16][i + zz]; } lam = expf(s1) - expf(s2) + 0.2f; }
                const float* subg = args.in[17] + zz;
                int lane_c = lane; asm volatile("" : "+v"(lane_c)); const int r32c = lane_c & 31, hic = lane_c >> 5;
                {
                    const GAS f32x4* pk = (const GAS f32x4*)((float*)(ws + WS_PARK) + (size_t)(bx * 8 + wid) * 4096 + lane_c * 64 + zz);
#pragma unroll
                    for (int d = 0; d < 4; ++d)
#pragma unroll
                        for (int k = 0; k < 4; ++k) { const f32x4 pv = pk[d * 4 + k];
#pragma unroll
                            for (int q = 0; q < 4; ++q) o[d][4 * k + q] = pv[q] - lam * o[d][4 * k + q]; }
                }
#pragma unroll
                for (int r = 0; r < 16; ++r) {
                    float ss = 0.f;
#pragma unroll
                    for (int d = 0; d < 4; ++d) ss += o[d][r] * o[d][r];
                    ss += __shfl_xor(ss, 1); ss += __shfl_xor(ss, 2); ss += __shfl_xor(ss, 4); ss += __shfl_xor(ss, 8); ss += __shfl_xor(ss, 16);
                    const float rs = rsqrtf(ss * (1.f / 128.f) + EPS) * 0.8f;
                    bf16_t* op = MIX + ((size_t)b * SEQ + q0 + wid * 32 + att::crow(r, hic)) * DM + 512 + h * 128 + r32c;
#pragma unroll
                    for (int d = 0; d < 4; ++d) op[d * 32] = (bf16_t)f2bf(o[d][r] * rs * subg[d * 32 + r32c]);
                }
            }
        }
    }
    xcd_barrier(bar);

    {
        PHASE_IDS();
        const float* hg = args.in[12];
        LAS unsigned short* tile = (LAS unsigned short*)lds;
        LAS float* rs = (LAS float*)(lds + 32768);
        for (int it = bx; it < 8 * 128; it += G) {
            const int g = it & 7, tb = it >> 3, t0 = tb * 32;
            __syncthreads();
            for (int q = tid; q < 64 * 32; q += 512) { const int ch = q >> 5, seg = q & 31;
                const u32x4 v = *(const GAS u32x4*)(HZ + ((size_t)(g * 64 + ch) * SEQ + t0 + seg) * 8);
                *(LAS u32x4*)(tile + ch * 256 + seg * 8) = v; }
            __syncthreads();
            if (tid < 256) { float s = 0.f; for (int ch = 0; ch < 64; ++ch) { const float v = bf2f(tile[ch * 256 + tid]); s += v * v; } rs[tid] = rsqrtf(s * (1.f / 64.f) + EPS); }
            __syncthreads();
            for (int q = tid; q < 256 * 8; q += 512) { const int tk = q >> 3, c8 = (q & 7) * 8;
                const float r = rs[tk]; const int t = t0 + (tk >> 3), b = tk & 7;
                float v[8];
#pragma unroll
                for (int j = 0; j < 8; ++j) v[j] = bf2f(tile[(c8 + j) * 256 + tk]) * r * hg[g * 64 + c8 + j];
                u32x4 w; w.x = pk2(v[0], v[1]); w.y = pk2(v[2], v[3]); w.z = pk2(v[4], v[5]); w.w = pk2(v[6], v[7]);
                *(GAS u32x4*)(MIX + ((size_t)b * SEQ + t) * DM + g * 64 + c8) = w; }
        }
        __syncthreads();
    }
    xcd_barrier(bar);

    {
        pg8::GeoPlain S; S.A = MIX; S.Bt = WOUT; S.K = DM; S.ord.init(NTOK / 256, DM / 256, G, bx);
        pg8::EpiResF32 E{x, out, DM};
        pg8::gemm_phase(lds, (LAS unsigned*)(lds + TBL_OFF), S, E, wave_s);
    }
    xcd_barrier(bar);

    {
        PHASE_IDS();
        const float* g = args.in[19]; const float* wr = args.in[20];
        for (int m = gw; m < NTOK; m += NGW) {
            const GAS f32x4* xr = (const GAS f32x4*)(out + (size_t)m * DM) + lane;
            f32x4 v[4]; float s = 0.f;
#pragma unroll
            for (int j = 0; j < 4; ++j) { v[j] = xr[64 * j]; s += (v[j].x * v[j].x + v[j].y * v[j].y) + (v[j].z * v[j].z + v[j].w * v[j].w); }
            const float r = rsqrtf(wave_sum(s) * (1.f / DM) + EPS);
            float lg[16];
#pragma unroll
            for (int e = 0; e < 16; ++e) lg[e] = 0.f;
            GAS u32x2* o8 = (GAS u32x2*)(H2 + (size_t)m * DM) + lane;
#pragma unroll
            for (int j = 0; j < 4; ++j) {
                const f32x4 gg = ((const GAS f32x4*)g)[lane + 64 * j];
                const float hx[4] = {v[j].x * r * gg.x, v[j].y * r * gg.y, v[j].z * r * gg.z, v[j].w * r * gg.w};
                u32x2 w; w.x = pk2(hx[0], hx[1]); w.y = pk2(hx[2], hx[3]); o8[64 * j] = w;
                const int d0 = (lane + 64 * j) * 4;
#pragma unroll
                for (int q = 0; q < 4; ++q) { const GAS f32x4* wp = (const GAS f32x4*)(wr + (size_t)(d0 + q) * 16);
#pragma unroll
                    for (int e4 = 0; e4 < 4; ++e4) { const f32x4 ww = wp[e4]; lg[e4 * 4 + 0] += hx[q] * ww.x; lg[e4 * 4 + 1] += hx[q] * ww.y; lg[e4 * 4 + 2] += hx[q] * ww.z; lg[e4 * 4 + 3] += hx[q] * ww.w; } }
            }
            float mx = -1e30f;
#pragma unroll
            for (int e = 0; e < 16; ++e) { lg[e] = wave_sum(lg[e]); mx = fmaxf(mx, lg[e]); }
            float den = 0.f;
#pragma unroll
            for (int e = 0; e < 16; ++e) { lg[e] = expf(lg[e] - mx); den += lg[e]; }
            const int b = m >> 12, t = m & 4095;
            float mine = 0.f;
#pragma unroll
            for (int e = 0; e < 16; ++e) mine = (lane == e) ? lg[e] : mine;
            if (lane < 16) { AFF[((size_t)lane * NB + b) * SEQ + t] = mine / den; INV[(size_t)m * 16 + lane] = 0xffffu; }
        }
    }
    xcd_barrier(bar);

    {
        PHASE_IDS();
        LAS unsigned* hist = (LAS unsigned*)lds; LAS unsigned* scan = hist + 256; LAS unsigned* selw = scan + 512;
        for (int eb = bx; eb < NE * NB; eb += G) {
            const int b = eb & 7, e = eb >> 3;
            const float* a = AFF + (size_t)eb * SEQ;
            unsigned v[8];
#pragma unroll
            for (int j = 0; j < 8; ++j) v[j] = __float_as_uint(a[tid * 8 + j]);
            unsigned prefix = 0, mask = 0, need = CAP;
            __syncthreads();
            for (int pass = 0; pass < 4; ++pass) {
                const int shift = 24 - 8 * pass;
                if (tid < 256) hist[tid] = 0;
                __syncthreads();
#pragma unroll
                for (int j = 0; j < 8; ++j) if ((v[j] & mask) == prefix) atomicAdd((unsigned*)&hist[(v[j] >> shift) & 255u], 1u);
                __syncthreads();
                if (tid == 0) { unsigned cum = 0; int bin = 255; for (; bin > 0; --bin) { if (cum + hist[bin] >= need) break; cum += hist[bin]; } selw[0] = (unsigned)bin; selw[1] = need - cum; }
                __syncthreads();
                prefix |= selw[0] << shift; mask |= 255u << shift; need = selw[1];
                __syncthreads();
            }
            unsigned cg = 0, ce = 0;
#pragma unroll
            for (int j = 0; j < 8; ++j) { cg += v[j] > prefix; ce += v[j] == prefix; }
            scan[tid] = (cg << 16) | ce;
            __syncthreads();
            for (int off = 1; off < 512; off <<= 1) { const unsigned xx = tid >= off ? scan[tid - off] : 0u; __syncthreads(); scan[tid] += xx; __syncthreads(); }
            const unsigned incl = scan[tid]; unsigned pg = (incl >> 16) - cg, pe = (incl & 0xffffu) - ce;
#pragma unroll
            for (int j = 0; j < 8; ++j) {
                const bool isg = v[j] > prefix, ise = v[j] == prefix;
                if (isg || (ise && pe < need)) {
                    const unsigned pos = pg + (pe < need ? pe : need); const int token = b * SEQ + tid * 8 + j;
                    TOK[(size_t)eb * CAP + pos] = token; GSEL[(size_t)eb * CAP + pos] = __uint_as_float(v[j]); INV[(size_t)token * 16 + e] = (unsigned short)pos;
                }
                pg += isg; pe += ise;
            }
            __syncthreads();
        }
    }
    xcd_barrier(bar);

    {
        pg8::GeoExpert<true> S; S.A = H2; S.Bt = WGU; S.K = DM; S.bexp = (size_t)2 * FF * DM * 2; S.tok = TOK; S.ord.init(NSLOT / 256, 2 * FF / 256, G, bx);
        pg8::EpiSwiGLU E{ACT, FF};
        pg8::gemm_phase(lds, (LAS unsigned*)(lds + TBL_OFF), S, E, wave_s);
    }
    xcd_barrier(bar);

    {
        pg8::GeoExpert<false> S; S.A = ACT; S.Bt = WD; S.K = FF; S.bexp = (size_t)DM * FF * 2; S.tok = nullptr; S.ord.init(NSLOT / 256, DM / 256, G, bx);
        pg8::EpiBf16 E{Y, DM, 0, 1.f};
        pg8::gemm_phase(lds, (LAS unsigned*)(lds + TBL_OFF), S, E, wave_s);
    }
    xcd_barrier(bar);

    {
        PHASE_IDS();
        const float* g = args.in[24];
        for (int m = gw; m < NTOK; m += NGW) {
            const GAS f32x4* xr = (const GAS f32x4*)(out + (size_t)m * DM) + lane;
            f32x4 v[4];
#pragma unroll
            for (int j = 0; j < 4; ++j) v[j] = xr[64 * j];
            const int b = m >> 12;
            const unsigned short myinv = INV[(size_t)m * 16 + (lane & 15)];
            for (int e = 0; e < 16; ++e) {
                const unsigned s = (unsigned)__shfl((int)myinv, e);
                if (s != 0xffffu) {
                    const size_t slot = ((size_t)e * NB + b) * CAP + s;
                    const float gv = GSEL[slot];
                    const GAS u32x2* yr = (const GAS u32x2*)(Y + slot * DM) + lane;
#pragma unroll
                    for (int j = 0; j < 4; ++j) { const u32x2 w = yr[64 * j]; v[j].x += gv * bflo(w.x); v[j].y += gv * bfhi(w.x); v[j].z += gv * bflo(w.y); v[j].w += gv * bfhi(w.y); }
                }
            }
            float s = 0.f;
#pragma unroll
            for (int j = 0; j < 4; ++j) s += (v[j].x * v[j].x + v[j].y * v[j].y) + (v[j].z * v[j].z + v[j].w * v[j].w);
            const float r = rsqrtf(wave_sum(s) * (1.f / DM) + EPS);
            GAS f32x4* o = (GAS f32x4*)(out + (size_t)m * DM) + lane;
#pragma unroll
            for (int j = 0; j < 4; ++j) { const f32x4 gg = ((const GAS f32x4*)g)[lane + 64 * j]; o[64 * j] = (f32x4){v[j].x * r * gg.x, v[j].y * r * gg.y, v[j].z * r * gg.z, v[j].w * r * gg.w}; }
        }
    }
}

extern "C" void kernel_launch(void* const* d_in, const int* in_sizes, int n_in, void* d_out, int out_size, void* d_ws, size_t ws_size, hipStream_t stream) {
    static int grid = 0;
    if (grid == 0) {
        if (n_in != 25 || ws_size < WS_END) { fprintf(stderr, "kernel_launch: unexpected n_in %d / ws %zu\n", n_in, ws_size); grid = -1; return; }
        int dev = 0, cus = 0;
        if (hipGetDevice(&dev) != hipSuccess || hipDeviceGetAttribute(&cus, hipDeviceAttributeMultiprocessorCount, dev) != hipSuccess) { grid = -1; return; }
        if (hipFuncSetAttribute((const void*)mega_fwd, hipFuncAttributeMaxDynamicSharedMemorySize, LDS_BYTES) != hipSuccess) { fprintf(stderr, "kernel_launch: hipFuncSetAttribute failed\n"); grid = -1; return; }
        int per_cu = 0;
        if (hipOccupancyMaxActiveBlocksPerMultiprocessor(&per_cu, (const void*)mega_fwd, 512, LDS_BYTES) != hipSuccess || per_cu < 1) fprintf(stderr, "kernel_launch: occupancy query says %d\n", per_cu);
        (void)hipGetLastError();
        grid = cus;
    }
    if (grid < 0) return;
    (void)hipMemsetAsync((char*)d_ws + WS_CTL, 0, CTL_BYTES, stream);
    Args a; memset(&a, 0, sizeof a);
    for (int i = 0; i < 25; ++i) a.in[i] = (const float*)d_in[i];
    a.out = (float*)d_out; a.ws = (unsigned char*)d_ws;
    hipLaunchKernelGGL(mega_fwd, dim3(grid), dim3(512), LDS_BYTES, stream, a);
}
```

```cpp
#include <hip/hip_runtime.h>
#include <cstdio>
#include <cstdint>
#include <cstring>

#define GAS __attribute__((address_space(1)))
#define LAS __attribute__((address_space(3)))
typedef unsigned short bf16_t;
typedef short bf16x8 __attribute__((ext_vector_type(8)));
typedef float f32x4 __attribute__((ext_vector_type(4)));
typedef float f32x2 __attribute__((ext_vector_type(2)));
typedef unsigned u32x4 __attribute__((ext_vector_type(4)));
typedef unsigned u32x2 __attribute__((ext_vector_type(2)));
typedef short v4i16_t __attribute__((ext_vector_type(4)));
typedef float f32x16 __attribute__((ext_vector_type(16)));

constexpr int DM = 1024, NB = 8, SEQ = 4096, NTOK = NB * SEQ;
constexpr int HW = 512, HCOLS = 1536, INC = 3072, ACOLS = 1536;
constexpr int NE = 16, CAP = 512, FF = 2816, NSLOT = NE * NB * CAP;
constexpr float EPS = 1e-6f;
constexpr float LOG2E = 1.4426950408889634f;
constexpr float QSCALE = 0.125f * LOG2E;
constexpr int GOFF = 4352, GLEN = 8704;

constexpr size_t MiB = 1u << 20;
constexpr size_t WS_CTL = 0, CTL_BYTES = 1 * MiB;
constexpr size_t WS_WGU = 2 * MiB;
constexpr size_t WS_Y = WS_WGU;
constexpr size_t WS_WD = 178 * MiB;
constexpr size_t WS_AFF = 266 * MiB;
constexpr size_t WS_TOK = 268 * MiB;
constexpr size_t WS_GSEL = WS_TOK + 256 * 1024;
constexpr size_t WS_INV = 269 * MiB;
constexpr size_t WS_XN = 270 * MiB;
constexpr size_t WS_H2 = WS_XN;
constexpr size_t WS_ACT = 334 * MiB;
constexpr size_t WS_WIN = 334 * MiB;
constexpr size_t WS_WOUT = 340 * MiB;
constexpr size_t WS_GF = 342 * MiB;
constexpr size_t WS_HP = 360 * MiB;
constexpr size_t WS_QKV = 456 * MiB;
constexpr size_t WS_HZ = 552 * MiB;
constexpr size_t WS_MIX = 584 * MiB;
constexpr size_t WS_PARK = 648 * MiB;
constexpr size_t WS_END = 686 * MiB;
constexpr int CW_BAR = 4096;
constexpr int CW_NSUM = 16384;

constexpr int REP_XN = 1, REP_P3A = 1, REP_P4A = 1, REP_P4B = 1;
constexpr int REP_P0W = 1, REP_P1 = 1, REP_HY = 1, REP_AT = 1, REP_P3B = 1, REP_P5 = 1, REP_P6 = 1;
constexpr int LDS_BYTES = 160 * 1024;
constexpr int MISC_OFF = LDS_BYTES - 256;
constexpr int HY_ZBYTES = (SEQ + 32) * 16, HY_ZA = 0, HY_ZB = HY_ZBYTES, HY_FB = 2 * HY_ZBYTES;
constexpr int TBL_OFF = 131072;

__device__ __forceinline__ unsigned f2bf(float f) { unsigned u = __builtin_bit_cast(unsigned, f); return (u + 0x7fffu + ((u >> 16) & 1u)) >> 16; }
__device__ __forceinline__ unsigned pk2(float lo, float hi) { return f2bf(lo) | (f2bf(hi) << 16); }
__device__ __forceinline__ float bf2f(unsigned short h) { return __builtin_bit_cast(float, (unsigned)h << 16); }
__device__ __forceinline__ float bflo(unsigned w) { return __builtin_bit_cast(float, w << 16); }
__device__ __forceinline__ float bfhi(unsigned w) { return __builtin_bit_cast(float, w & 0xffff0000u); }
__device__ __forceinline__ float wave_sum(float v) {
#pragma unroll
    for (int o = 1; o < 64; o <<= 1) v += __shfl_xor(v, o);
    return v;
}
#define LDS_WAIT() asm volatile("s_waitcnt lgkmcnt(0)" ::: "memory")
__device__ __forceinline__ int lane_id_v() { int l; asm volatile("v_mbcnt_lo_u32_b32 %0, -1, 0\n\tv_mbcnt_hi_u32_b32 %0, -1, %0" : "=v"(l)); return l; }
#define PHASE_IDS() const int wave = wave_s; int tid_o = wave_s * 64 + lane_id_v(); asm volatile("" : "+v"(tid_o)); const int tid = tid_o, lane = tid & 63, gw = blockIdx.x * 8 + wave; (void)lane; (void)gw

namespace pg8 {
constexpr int BM = 256, BK = 64, HALF = 128, HTB = HALF * BK * 2, STAGE_BYTES = 8 * HTB, NXCD = 8, WGM = 8;
__host__ __device__ __forceinline__ int lds_byte(int r, int c) { const int st = (r >> 4) * 2 + (c >> 5), rr = r & 15, cc = c & 31, ob = rr * 64 + cc * 2; return st * 1024 + (ob ^ (((ob >> 9) & 1) << 5)); }
__host__ __device__ __forceinline__ void stage_rc(int b, int& R, int& C) { const int st = b / 1024, sb = b % 1024, swz = sb ^ (((sb >> 9) & 1) << 5); R = (st >> 1) * 16 + swz / 64; C = (st & 1) * 32 + (swz % 64) / 2; }
__host__ __device__ __forceinline__ int perm32(int rho) { const int n = rho >> 4, i = rho & 15; return 8 * (i >> 2) + 4 * n + (i & 3); }
struct Unit { int pm, pn; };

struct TileOrder {
    int nM, nN, nwg, G, c;
    __device__ void init(int nM_, int nN_, int G_, int c_) { nM = nM_; nN = nN_; nwg = nM * nN; G = G_; c = c_; }
    __device__ bool next(int i, Unit& u) const {
        const long L = (long)i * G + c; if (L >= nwg) return false;
        int wgid = (int)L; { const int q = nwg / NXCD, r = nwg % NXCD, xcd = wgid % NXCD, off = wgid / NXCD; wgid = (xcd < r ? xcd * (q + 1) : r * (q + 1) + (xcd - r) * q) + off; }
        const int nig = WGM * nN, gid = wgid / nig, fm = gid * WGM, gsz = (nM - fm) < WGM ? (nM - fm) : WGM;
        u.pm = fm + ((wgid % nig) % gsz); u.pn = (wgid % nig) / gsz; return true;
    }
};
__device__ __forceinline__ unsigned cvt_pk_bf16(float lo, float hi) { unsigned r; asm volatile("v_cvt_pk_bf16_f32 %0, %1, %2" : "=v"(r) : "v"(lo), "v"(hi)); return r; }

struct EpiBf16 {
    static constexpr bool PERM = true;
    bf16_t* O; int ldc; int scols; float sc;
    __device__ __forceinline__ void operator()(const f32x4 (&acc)[2][2][4][2], const Unit& u, int wr, int wc, int fr, int fq) const {
        const int row0 = u.pm * BM + wr * 64 + fr, col0 = u.pn * BM + wc * 32 + 8 * fq;
        const float s = (u.pn * BM < scols) ? sc : 1.f;
#pragma unroll
        for (int ai = 0; ai < 2; ++ai)
#pragma unroll
            for (int m = 0; m < 4; ++m) { bf16_t* rowp = O + (size_t)(row0 + ai * HALF + m * 16) * ldc + col0;
#pragma unroll
                for (int bj = 0; bj < 2; ++bj) { const f32x4 v0 = acc[ai][bj][m][0] * s, v1 = acc[ai][bj][m][1] * s;
                    u32x4 w; w.x = cvt_pk_bf16(v0[0], v0[1]); w.y = cvt_pk_bf16(v0[2], v0[3]); w.z = cvt_pk_bf16(v1[0], v1[1]); w.w = cvt_pk_bf16(v1[2], v1[3]);
                    *(u32x4*)(rowp + bj * HALF) = w; } }
    }
};
struct EpiResF32 {
    static constexpr bool PERM = false;
    const float* R; float* C; int ldc;
    __device__ __forceinline__ void operator()(const f32x4 (&acc)[2][2][4][2], const Unit& u, int wr, int wc, int fr, int fq) const {
        const int row0 = u.pm * BM + wr * 64 + fr, col0 = u.pn * BM + wc * 32 + 4 * fq;
#pragma unroll
        for (int ai = 0; ai < 2; ++ai)
#pragma unroll
            for (int m = 0; m < 4; ++m) { const size_t off = (size_t)(row0 + ai * HALF + m * 16) * ldc + col0;
#pragma unroll
                for (int bj = 0; bj < 2; ++bj)
#pragma unroll
                    for (int n = 0; n < 2; ++n) { const f32x4 r = *(const f32x4*)(R + off + bj * HALF + n * 16); *(f32x4*)(C + off + bj * HALF + n * 16) = r + acc[ai][bj][m][n]; } }
    }
};
struct EpiSwiGLU {
    static constexpr bool PERM = true;
    bf16_t* O; int ldc;
    __device__ __forceinline__ void operator()(const f32x4 (&acc)[2][2][4][2], const Unit& u, int wr, int wc, int fr, int fq) const {
        const int row0 = u.pm * BM + wr * 64 + fr, col0 = u.pn * HALF + wc * 32 + 8 * fq;
#pragma unroll
        for (int ai = 0; ai < 2; ++ai)
#pragma unroll
            for (int m = 0; m < 4; ++m) { bf16_t* rowp = O + (size_t)(row0 + ai * HALF + m * 16) * ldc + col0;
                float o[8];
#pragma unroll
                for (int n = 0; n < 2; ++n)
#pragma unroll
                    for (int j = 0; j < 4; ++j) { const float g = acc[ai][0][m][n][j], up = acc[ai][1][m][n][j];
                        o[n * 4 + j] = g * __builtin_amdgcn_rcpf(1.f + __builtin_amdgcn_exp2f(-g * LOG2E)) * up; }
                u32x4 w; w.x = cvt_pk_bf16(o[0], o[1]); w.y = cvt_pk_bf16(o[2], o[3]); w.z = cvt_pk_bf16(o[4], o[5]); w.w = cvt_pk_bf16(o[6], o[7]);
                *(u32x4*)rowp = w; }
    }
};

struct GeoPlain {
    static constexpr bool GATHER = false;
    const bf16_t* A; const bf16_t* Bt; int K; TileOrder ord;
    __device__ __forceinline__ bool next(int i, Unit& u) const { return ord.next(i, u); }
    __device__ __forceinline__ const char* a_ptr(const Unit& u) const { return (const char*)A + (size_t)u.pm * BM * K * 2; }
    __device__ __forceinline__ const char* b_ptr(const Unit& u) const { return (const char*)Bt + (size_t)u.pn * BM * K * 2; }
    __device__ __forceinline__ size_t hstepA() const { return (size_t)HALF * K * 2; }
    __device__ __forceinline__ size_t hstepB() const { return (size_t)HALF * K * 2; }
    __device__ __forceinline__ unsigned a_voff(int R, int C) const { return (unsigned)(R * K + C) * 2u; }
    __device__ __forceinline__ unsigned b_voff(int R, int C) const { return (unsigned)(R * K + C) * 2u; }
    __device__ __forceinline__ void fill_table(LAS unsigned*, const Unit&, int) const {}
};
struct GeoTokPerm {
    static constexpr bool GATHER = false;
    const bf16_t* A; const bf16_t* X; int K; TileOrder ord;
    __device__ __forceinline__ bool next(int i, Unit& u) const { return ord.next(i, u); }
    __device__ __forceinline__ const char* a_ptr(const Unit& u) const { return (const char*)A + (size_t)u.pm * BM * K * 2; }
    __device__ __forceinline__ const char* b_ptr(const Unit& u) const { return (const char*)X + (size_t)u.pn * 32 * K * 2; }
    __device__ __forceinline__ size_t hstepA() const { return (size_t)HALF * K * 2; }
    __device__ __forceinline__ size_t hstepB() const { return (size_t)16 * K * 2; }
    __device__ __forceinline__ unsigned a_voff(int R, int C) const { return (unsigned)(R * K + C) * 2u; }
    __device__ __forceinline__ unsigned b_voff(int R, int C) const { return (unsigned)(((R & 7) * SEQ + (R >> 3)) * K + C) * 2u; }
    __device__ __forceinline__ void fill_table(LAS unsigned*, const Unit&, int) const {}
};
template <bool G> struct GeoExpert {
    static constexpr bool GATHER = G;
    const bf16_t* A; const bf16_t* Bt; int K; size_t bexp;    const int* tok; TileOrder ord;
    __device__ __forceinline__ bool next(int i, Unit& u) const { return ord.next(i, u); }
    __device__ __forceinline__ const char* a_ptr(const Unit& u) const { return G ? (const char*)A : (const char*)A + (size_t)u.pm * BM * K * 2; }
    __device__ __forceinline__ const char* b_ptr(const Unit& u) const { return (const char*)Bt + (size_t)(u.pm >> 4) * bexp + (size_t)u.pn * BM * K * 2; }
    __device__ __forceinline__ size_t hstepA() const { return (size_t)HALF * K * 2; }
    __device__ __forceinline__ size_t hstepB() const { return (size_t)HALF * K * 2; }
    __device__ __forceinline__ unsigned a_voff(int R, int C) const { return (unsigned)(R * K + C) * 2u; }
    __device__ __forceinline__ unsigned b_voff(int R, int C) const { return (unsigned)(R * K + C) * 2u; }
    __device__ __forceinline__ void fill_table(LAS unsigned* tb, const Unit& u, int tid) const { if (G) { int t_ = tid; asm volatile("" : "+v"(t_));
#pragma unroll
        for (int i = 0; i < 2; ++i) { int R, C; stage_rc(t_ * 16 + i * 8192, R, C);
#pragma unroll
            for (int h = 0; h < 2; ++h) tb[h * 1024 + i * 512 + tid] = (unsigned)tok[u.pm * 256 + h * 128 + R] * (unsigned)(K * 2) + (unsigned)C * 2u; } } }
};

template <class Epi, class Geo>
__device__ __forceinline__ void gemm_phase(LAS unsigned char* lds, LAS unsigned* tbl, const Geo& S, const Epi& E, int wave_s) {
    int tid_ = wave_s * 64 + lane_id_v(); asm volatile("" : "+v"(tid_));
    const int tid = tid_, wid = wave_s, lane = tid & 63, wr = wid >> 2, wc = wid & 3, fr = lane & 15, fq = lane >> 4;
    const int K = S.K, nt = K / BK;
    unsigned voffA[2], voffB[2];
#pragma unroll
    for (int i = 0; i < 2; ++i) { int R, C; stage_rc(tid * 16 + i * 8192, R, C); const int Rb = Epi::PERM ? ((R & ~31) + perm32(R & 31)) : R;
        voffA[i] = S.a_voff(R, C); voffB[i] = S.b_voff(Rb, C); }
    const size_t kstep = (size_t)(BK * 2);
    const size_t hstepA = S.hstepA(), hstepB = S.hstepB();
    const unsigned ldsw = (unsigned)wid * 1024u;
    const int aoff = lds_byte(wr * 64 + fr, fq * 8), boff = lds_byte(wc * 32 + fr, fq * 8);
#define PG8_SA(b, h) (((b) * 2 + (h)) * HTB)
#define PG8_SB(b, h) ((4 + (b) * 2 + (h)) * HTB)
#define PG8_STAGE(bufoff, gbase, voff) do { _Pragma("unroll") for (int _i = 0; _i < 2; ++_i) \
        __builtin_amdgcn_global_load_lds((const unsigned*)((const char*)(gbase) + (voff)[_i]), (LAS unsigned*)(lds + (bufoff) + ldsw + _i * 8192), 16, 0, 0); } while (0)
#define PG8_STAGE_A(bufoff, gbase, h, nx) do { if constexpr (Geo::GATHER) { const LAS unsigned* _tb = tbl + (((ui + ((nx) ? 1 : 0)) & 1) * 2048) + (h) * 1024 + tid; unsigned _vo[2]; \
        _vo[0] = _tb[0]; _vo[1] = _tb[512]; PG8_STAGE(bufoff, gbase, _vo); } else { PG8_STAGE(bufoff, (gbase) + (h) * hstepA, voffA); } } while (0)
#define PG8_LDA(dst, b, h) do { _Pragma("unroll") for (int m = 0; m < 4; ++m) _Pragma("unroll") for (int k = 0; k < 2; ++k) dst[m][k] = *(const LAS bf16x8*)(lds + PG8_SA(b, h) + aoff + m * 2048 + k * 1024); } while (0)
#define PG8_LDB(dst, b, h) do { _Pragma("unroll") for (int n = 0; n < 2; ++n) _Pragma("unroll") for (int k = 0; k < 2; ++k) dst[n][k] = *(const LAS bf16x8*)(lds + PG8_SB(b, h) + boff + n * 2048 + k * 1024); } while (0)
#define PG8_MMA(ai, bj, At, Bt) do { __builtin_amdgcn_s_setprio(1); _Pragma("unroll") for (int m = 0; m < 4; ++m) _Pragma("unroll") for (int n = 0; n < 2; ++n) _Pragma("unroll") for (int k = 0; k < 2; ++k) \
        acc[ai][bj][m][n] = __builtin_amdgcn_mfma_f32_16x16x32_bf16(Bt[n][k], At[m][k], acc[ai][bj][m][n], 0, 0, 0); __builtin_amdgcn_s_setprio(0); } while (0)
#define PG8_WAIT_V(n) asm volatile("s_waitcnt vmcnt(" #n ")" ::: "memory")
#define PG8_WAIT_L(n) asm volatile("s_waitcnt lgkmcnt(" #n ")" ::: "memory")
#define PG8_BAR __builtin_amdgcn_s_barrier()
#define PG8_SCHED __builtin_amdgcn_sched_barrier(0)
    Unit cur, nxt; int ui = 0;
    if (!S.next(0, cur)) return;
    f32x4 acc[2][2][4][2];
#pragma unroll
    for (int a = 0; a < 2; ++a)
#pragma unroll
        for (int b = 0; b < 2; ++b)
#pragma unroll
            for (int m = 0; m < 4; ++m)
#pragma unroll
                for (int n = 0; n < 2; ++n) acc[a][b][m][n] = (f32x4){0.f, 0.f, 0.f, 0.f};
    bf16x8 At[4][2], B0[2][2], B1[2][2];
    const char* cA = S.a_ptr(cur); const char* cB = S.b_ptr(cur);
    if constexpr (Geo::GATHER) {
        S.fill_table(tbl, cur, tid);
        Unit u1; if (S.next(1, u1)) S.fill_table(tbl + 2048, u1, tid);
        asm volatile("s_waitcnt vmcnt(0) lgkmcnt(0)" ::: "memory"); PG8_BAR; asm volatile("" ::: "memory");
    }
    PG8_STAGE(PG8_SB(0, 0), cB, voffB); PG8_STAGE(PG8_SB(0, 1), cB + hstepB, voffB); PG8_STAGE_A(PG8_SA(0, 0), cA, 0, false); PG8_STAGE_A(PG8_SA(0, 1), cA, 1, false);
    if (wr == 1) PG8_BAR;
    PG8_WAIT_V(2); PG8_BAR;
    PG8_STAGE(PG8_SB(1, 0), cB + kstep, voffB); PG8_STAGE_A(PG8_SA(1, 0), cA + kstep, 0, false); PG8_STAGE(PG8_SB(1, 1), cB + hstepB + kstep, voffB);
    PG8_WAIT_V(6); PG8_BAR;
    for (;;) {
        const bool has_next = S.next(ui + 1, nxt);
        const char* nA = has_next ? S.a_ptr(nxt) : cA; const char* nB = has_next ? S.b_ptr(nxt) : cB;
        for (int t = 0; t < nt; t += 2) {
            const bool last = (t == nt - 2);
            const bool lastn = last && has_next;
            const char* a1 = cA + (size_t)(t + 1) * kstep;
            const char* a2 = last ? nA : cA + (size_t)(t + 2) * kstep; const char* b2 = last ? nB : cB + (size_t)(t + 2) * kstep;
            const char* a3 = a2 + kstep; const char* b3 = b2 + kstep;
            if constexpr (Geo::GATHER) { if (t == 2 && ui > 0) { Unit u2; if (S.next(ui + 1, u2)) S.fill_table(tbl + (((ui + 1) & 1) * 2048), u2, tid); } }
            PG8_LDB(B0, 0, 0); PG8_LDB(B1, 0, 1); PG8_SCHED; PG8_LDA(At, 0, 0); PG8_STAGE_A(PG8_SA(1, 1), a1, 1, false);
            PG8_WAIT_V(8); PG8_WAIT_L(0); PG8_BAR; PG8_MMA(0, 0, At, B0); PG8_MMA(0, 1, At, B1); PG8_BAR; PG8_SCHED;
            PG8_LDA(At, 0, 1); PG8_STAGE(PG8_SB(0, 0), b2, voffB); PG8_STAGE(PG8_SB(0, 1), b2 + hstepB, voffB); PG8_STAGE_A(PG8_SA(0, 0), a2, 0, lastn);
            PG8_WAIT_V(8); PG8_WAIT_L(0); PG8_BAR; PG8_MMA(1, 0, At, B0); PG8_MMA(1, 1, At, B1); PG8_BAR; PG8_SCHED;
            PG8_LDB(B0, 1, 0); PG8_LDB(B1, 1, 1); PG8_SCHED; PG8_LDA(At, 1, 0); PG8_STAGE_A(PG8_SA(0, 1), a2, 1, lastn);
            PG8_WAIT_V(8); PG8_WAIT_L(0); PG8_BAR; PG8_MMA(0, 0, At, B0); PG8_MMA(0, 1, At, B1); PG8_BAR; PG8_SCHED;
            PG8_LDA(At, 1, 1); PG8_STAGE(PG8_SB(1, 0), b3, voffB); PG8_STAGE(PG8_SB(1, 1), b3 + hstepB, voffB); PG8_STAGE_A(PG8_SA(1, 0), a3, 0, lastn);
            PG8_WAIT_V(8); PG8_WAIT_L(0); PG8_BAR; PG8_MMA(1, 0, At, B0); PG8_MMA(1, 1, At, B1); PG8_BAR; PG8_SCHED;
        }
        if (wr == 0) PG8_BAR;
        E(acc, cur, wr, wc, fr, fq);
        if (!has_next) break;
#pragma unroll
        for (int a = 0; a < 2; ++a)
#pragma unroll
            for (int b = 0; b < 2; ++b)
#pragma unroll
                for (int m = 0; m < 4; ++m)
#pragma unroll
                    for (int n = 0; n < 2; ++n) acc[a][b][m][n] = (f32x4){0.f, 0.f, 0.f, 0.f};
        cur = nxt; cA = nA; cB = nB; ++ui;
        if (wr == 1) PG8_BAR;
    }
    PG8_WAIT_V(0);
    PG8_BAR;
#undef PG8_SA
#undef PG8_SB
#undef PG8_STAGE
#undef PG8_STAGE_A
#undef PG8_LDA
#undef PG8_LDB
#undef PG8_MMA
#undef PG8_WAIT_V
#undef PG8_WAIT_L
#undef PG8_BAR
#undef PG8_SCHED
}
}

namespace att {
constexpr int KVBLK = 64, LDQKV = ACOLS;
constexpr int SHM_V = KVBLK * 128 * 2, SHM_K = KVBLK * 64 * 2, OFF_V = 0, OFF_K = 2 * SHM_V, OFF_WS = OFF_K + 2 * SHM_K, LDS_TOTAL = OFF_WS + 8 * 64 * 4;
constexpr float THR = 8.f;
#define KSWZ64(row, colB) ((row) * 128 + ((colB) ^ ((((row) >> 1) & 7) << 4)))
#define SBAR() __builtin_amdgcn_sched_barrier(0)
__device__ __forceinline__ int crow(int r, int hi) { return (r & 3) + 8 * (r >> 2) + 4 * hi; }
__device__ __forceinline__ unsigned cvtpk(float lo, float hi) { unsigned r; asm volatile("v_cvt_pk_bf16_f32 %0, %1, %2" : "=v"(r) : "v"(lo), "v"(hi)); return r; }
__device__ __forceinline__ int v_st(int k, int c) { const int kk = (k & ~0xC) | ((k & 4) << 1) | ((k & 8) >> 1); return ((kk >> 3) * 4 + (c >> 5)) * 512 + ((kk & 7) * 32 + (c & 31)) * 2; }
__device__ __forceinline__ int v_rd_base(int lane) { return ((lane & 3) << 3) | (((lane >> 2) & 3) << 6) | (((lane >> 4) & 1) << 5) | (((lane >> 5) & 1) << 8); }
constexpr int v_rd_off(int d0, int ks, int half) { return d0 * 512 + ks * 4096 + half * 2048; }
template <int OFF> __device__ __forceinline__ v4i16_t tr_read(int vb) { v4i16_t r; asm volatile("ds_read_b64_tr_b16 %0, %1 offset:%2" : "=&v"(r) : "v"(vb), "i"(OFF) : "memory"); return r; }
template <int D0> __device__ __forceinline__ void pv_one(f32x16& od, int vb, bf16x8 pa0, bf16x8 pa1, bf16x8 pa2, bf16x8 pa3) {
    const v4i16_t l0 = tr_read<v_rd_off(D0, 0, 0)>(vb), h0 = tr_read<v_rd_off(D0, 0, 1)>(vb), l1 = tr_read<v_rd_off(D0, 1, 0)>(vb), h1 = tr_read<v_rd_off(D0, 1, 1)>(vb);
    const v4i16_t l2 = tr_read<v_rd_off(D0, 2, 0)>(vb), h2 = tr_read<v_rd_off(D0, 2, 1)>(vb), l3 = tr_read<v_rd_off(D0, 3, 0)>(vb), h3 = tr_read<v_rd_off(D0, 3, 1)>(vb);
    asm volatile("s_waitcnt lgkmcnt(0)" ::: "memory"); SBAR();
#define PK(L, H) (bf16x8){L[0], L[1], L[2], L[3], H[0], H[1], H[2], H[3]}
    od = __builtin_amdgcn_mfma_f32_32x32x16_bf16(pa0, PK(l0, h0), od, 0, 0, 0);
    od = __builtin_amdgcn_mfma_f32_32x32x16_bf16(pa1, PK(l1, h1), od, 0, 0, 0);
    od = __builtin_amdgcn_mfma_f32_32x32x16_bf16(pa2, PK(l2, h2), od, 0, 0, 0);
    od = __builtin_amdgcn_mfma_f32_32x32x16_bf16(pa3, PK(l3, h3), od, 0, 0, 0);
#undef PK
}
__device__ __forceinline__ void pv_d0(f32x16* o, int vb, bf16x8 pa0, bf16x8 pa1, bf16x8 pa2, bf16x8 pa3) {
    pv_one<0>(o[0], vb, pa0, pa1, pa2, pa3); pv_one<1>(o[1], vb, pa0, pa1, pa2, pa3); pv_one<2>(o[2], vb, pa0, pa1, pa2, pa3); pv_one<3>(o[3], vb, pa0, pa1, pa2, pa3);
}
__device__ __forceinline__ void qkt(f32x16& p0, f32x16& p1, const char* Ks, const bf16x8* qr, const f32x16& negm, int r32, int hi, float dq, float slope2) {
#pragma unroll
    for (int d0 = 0; d0 < 4; ++d0) { const int cb = (d0 * 16 + hi * 8) * 2;
        const bf16x8 b0 = *reinterpret_cast<const bf16x8*>(Ks + KSWZ64(r32, cb));
        const bf16x8 b1 = *reinterpret_cast<const bf16x8*>(Ks + KSWZ64(32 + r32, cb));
        if (d0 == 0) { p0 = __builtin_amdgcn_mfma_f32_32x32x16_bf16(b0, qr[0], negm, 0, 0, 0); p1 = __builtin_amdgcn_mfma_f32_32x32x16_bf16(b1, qr[0], negm, 0, 0, 0); }
        else { p0 = __builtin_amdgcn_mfma_f32_32x32x16_bf16(b0, qr[d0], p0, 0, 0, 0); p1 = __builtin_amdgcn_mfma_f32_32x32x16_bf16(b1, qr[d0], p1, 0, 0, 0); } }
    asm volatile("" : "+v"(dq), "+v"(p0), "+v"(p1));
#pragma unroll
    for (int r = 0; r < 16; ++r) { const float cr = (float)((r & 3) + 8 * (r >> 2)); p0[r] = fmaf(-slope2, fabsf(dq - cr), p0[r]); p1[r] = fmaf(-slope2, fabsf(dq - 32.f - cr), p1[r]); }
}
__device__ __forceinline__ void partialSM(f32x16& p0, f32x16& p1, f32x16& negm, float& alpha) {
    float pmax = p0[0];
#pragma unroll
    for (int r = 1; r < 16; ++r) pmax = fmaxf(pmax, p0[r]);
#pragma unroll
    for (int r = 0; r < 16; ++r) pmax = fmaxf(pmax, p1[r]);
    { auto rr = __builtin_amdgcn_permlane32_swap(__float_as_uint(pmax), __float_as_uint(pmax), false, false); pmax = fmaxf(__uint_as_float(rr[0]), __uint_as_float(rr[1])); }
    if (__builtin_expect(!__any(pmax > THR), 1)) { alpha = 1.f; }
    else { const float dl = fmaxf(pmax, 0.f); alpha = __builtin_amdgcn_exp2f(-dl);
#pragma unroll
        for (int r = 0; r < 16; ++r) { p0[r] -= dl; p1[r] -= dl; negm[r] -= dl; } }
#pragma unroll
    for (int r = 0; r < 16; ++r) p0[r] = __builtin_amdgcn_exp2f(p0[r]);
}
__device__ __forceinline__ void finishSM(f32x16& p0, f32x16& p1, float alpha, float& l_reg, bf16x8& pa0, bf16x8& pa1, bf16x8& pa2, bf16x8& pa3) {
#pragma unroll
    for (int r = 0; r < 16; ++r) p1[r] = __builtin_amdgcn_exp2f(p1[r]);
    float ps = 0.f;
#pragma unroll
    for (int r = 0; r < 16; ++r) ps += p0[r];
#pragma unroll
    for (int r = 0; r < 16; ++r) ps += p1[r];
    { auto rr = __builtin_amdgcn_permlane32_swap(__float_as_uint(ps), __float_as_uint(ps), false, false); ps = __uint_as_float(rr[0]) + __uint_as_float(rr[1]); }
    l_reg = l_reg * alpha + ps;
#define PK4(P, BASE, OUT) do { const unsigned a0 = cvtpk(P[BASE + 0], P[BASE + 1]), a1 = cvtpk(P[BASE + 2], P[BASE + 3]), b0 = cvtpk(P[BASE + 4], P[BASE + 5]), b1 = cvtpk(P[BASE + 6], P[BASE + 7]); \
        auto r0 = __builtin_amdgcn_permlane32_swap(a0, b0, false, false); auto r1 = __builtin_amdgcn_permlane32_swap(a1, b1, false, false); \
        u32x4 w = {r0[0], r1[0], r0[1], r1[1]}; OUT = __builtin_bit_cast(bf16x8, w); } while (0)
    PK4(p0, 0, pa0); PK4(p0, 8, pa1); PK4(p1, 0, pa2); PK4(p1, 8, pa3);
#undef PK4
}
__device__ __forceinline__ void pass(f32x16 (&o)[4], const bf16_t* Qw, const bf16_t* Kh, const bf16_t* Vh, int qpos, int qb, float slope2, char* lds, int tid) {
    const int wid = tid >> 6, lane = tid & 63, r32 = lane & 31, hi = lane >> 5;
    char* V_lds = lds + OFF_V; char* K_lds = lds + OFF_K;
    float* ws = (float*)(lds + OFF_WS) + wid * 64; float* li_l = ws; float* al_l = ws + 32;
    float l_reg = 0.f; bf16x8 qr[4];
#pragma unroll
    for (int d = 0; d < 4; ++d)
#pragma unroll
        for (int r = 0; r < 16; ++r) o[d][r] = 0.f;
    f32x16 negm;
#pragma unroll
    for (int r = 0; r < 16; ++r) negm[r] = 0.f;
#pragma unroll
    for (int d0 = 0; d0 < 4; ++d0) qr[d0] = *reinterpret_cast<const bf16x8*>(Qw + d0 * 16);
    const int kr = tid >> 3, kc = (tid & 7) * 8, kst = KSWZ64(kr, kc * 2);
    const int sr = tid >> 4, sc = (tid & 15) * 8, vst0 = v_st(sr, sc), vst1 = v_st(32 + sr, sc);
    const int vb0 = (int)(uintptr_t)V_lds + v_rd_base(lane);
    const unsigned voff0 = (unsigned)(sr * LDQKV + sc), koff0 = (unsigned)(kr * LDQKV + kc);
    struct { bf16x8 vs0, vs1, ks; } st_[2];
    constexpr int NT = SEQ / KVBLK;
    const int nd = 4 * qb;
#define KT(i) ((i) < 4 ? nd + (i) : ((i) < 4 + nd ? nd + 3 - (i) : (i)))
#define SLOAD(i, tile) do { const unsigned k0_ = (unsigned)((tile) * KVBLK * LDQKV); st_[i].vs0 = *reinterpret_cast<const bf16x8*>(Vh + (k0_ + voff0)); st_[i].vs1 = *reinterpret_cast<const bf16x8*>(Vh + (k0_ + voff0 + 32u * LDQKV)); \
        st_[i].ks = *reinterpret_cast<const bf16x8*>(Kh + (k0_ + koff0)); } while (0)
#define SWRITE(b, i) do { *(bf16x8*)(V_lds + (b) * SHM_V + vst0) = st_[i].vs0; *(bf16x8*)(V_lds + (b) * SHM_V + vst1) = st_[i].vs1; *(bf16x8*)(K_lds + (b) * SHM_K + kst) = st_[i].ks; } while (0)
#define SWAIT() asm volatile("s_waitcnt vmcnt(3)" ::: "memory")
#define RESC(a) do { if (__any((a) < 1.f)) { if (hi == 0) al_l[r32] = (a); asm volatile("s_waitcnt lgkmcnt(0)" ::: "memory"); \
        _Pragma("unroll") for (int d = 0; d < 4; ++d) _Pragma("unroll") for (int r = 0; r < 16; ++r) o[d][r] *= al_l[crow(r, hi)]; } } while (0)
#define DQ(tile) ((float)(qpos - (tile) * KVBLK - 4 * hi))
    f32x16 pA0, pA1, pB0, pB1; float alA, alB; bf16x8 pa0, pa1, pa2, pa3;
    SLOAD(0, KT(0)); asm volatile("s_waitcnt vmcnt(0)" ::: "memory"); SWRITE(0, 0); __syncthreads();
    qkt(pA0, pA1, K_lds, qr, negm, r32, hi, DQ(KT(0)), slope2); partialSM(pA0, pA1, negm, alA);
    SLOAD(1, KT(1)); SLOAD(0, KT(2));
    SWAIT(); SWRITE(1, 1); __syncthreads();
    for (int j = 1; j + 1 < NT; j += 2) {
        SBAR(); qkt(pB0, pB1, K_lds + SHM_K, qr, negm, r32, hi, DQ(KT(j)), slope2);
        finishSM(pA0, pA1, alA, l_reg, pa0, pa1, pa2, pa3); SBAR();
        SLOAD(1, KT(j + 2)); SBAR();
        pv_d0(o, vb0, pa0, pa1, pa2, pa3); partialSM(pB0, pB1, negm, alB);
        __syncthreads(); SWAIT(); SWRITE(0, 0);
        RESC(alB); __syncthreads();
        SBAR(); qkt(pA0, pA1, K_lds, qr, negm, r32, hi, DQ(KT(j + 1)), slope2);
        finishSM(pB0, pB1, alB, l_reg, pa0, pa1, pa2, pa3); SBAR();
        if (j + 3 < NT) SLOAD(0, KT(j + 3)); SBAR();
        pv_d0(o, vb0 + SHM_V, pa0, pa1, pa2, pa3); partialSM(pA0, pA1, negm, alA);
        __syncthreads(); SWAIT(); SWRITE(1, 1);
        RESC(alA); __syncthreads();
    }
    SBAR(); qkt(pB0, pB1, K_lds + SHM_K, qr, negm, r32, hi, DQ(KT(NT - 1)), slope2);
    finishSM(pA0, pA1, alA, l_reg, pa0, pa1, pa2, pa3); SBAR();
    pv_d0(o, vb0, pa0, pa1, pa2, pa3); partialSM(pB0, pB1, negm, alB);
    __syncthreads(); RESC(alB);
    finishSM(pB0, pB1, alB, l_reg, pa0, pa1, pa2, pa3); SBAR();
    pv_d0(o, vb0 + SHM_V, pa0, pa1, pa2, pa3);
    if (hi == 0) li_l[r32] = l_reg; asm volatile("s_waitcnt lgkmcnt(0)" ::: "memory");
#pragma unroll
    for (int r = 0; r < 16; ++r) { const float rl = __builtin_amdgcn_rcpf(li_l[crow(r, hi)]);
#pragma unroll
        for (int d = 0; d < 4; ++d) o[d][r] *= rl; }
    __syncthreads();
#undef KT
#undef SLOAD
#undef SWRITE
#undef SWAIT
#undef RESC
#undef DQ
}
#undef SBAR
}

typedef GAS unsigned gu32;
#define XB_TMO      128
#define XB_XCNT(j)  (256  + 64 * (j))
#define XB_XSUB(j)  (1280 + 64 * (j))
#define XB_XGEN(j)  (2304 + 64 * (j))
#define XB_TOP      3328
#define XB_TOPGEN   3392
#define XCD_BAR_WORDS 3456
#define XB_SPIN_CAP (1u << 23)
__device__ __forceinline__ unsigned xb_ld(unsigned* p)              { return __hip_atomic_load(p, __ATOMIC_RELAXED, __HIP_MEMORY_SCOPE_AGENT); }
__device__ __forceinline__ unsigned xb_add(unsigned* p, unsigned v) { return __hip_atomic_fetch_add(p, v, __ATOMIC_RELAXED, __HIP_MEMORY_SCOPE_AGENT); }
__device__ __forceinline__ unsigned xb_xcc_id() { return (unsigned)__builtin_amdgcn_s_getreg((3 << 11) | 20) & 0xFu; }
#define XB_SPIN(cond, bar) do { unsigned _sp = 0; while (cond) { __builtin_amdgcn_s_sleep(1); \
    if ((++_sp & 255u) == 0u) { if (xb_ld(&(bar)[XB_TMO])) break; if (_sp > XB_SPIN_CAP) { atomicAdd(&(bar)[XB_TMO], 1u); break; } } } } while (0)
struct XcdBarrier { unsigned* bar; unsigned x; volatile LAS unsigned* st; int wave; };
__device__ __forceinline__ XcdBarrier xcd_barrier_post(unsigned* bar, volatile LAS unsigned* st, int wave) {
    XcdBarrier b; b.bar = bar; b.x = xb_xcc_id(); b.st = st; b.wave = wave;
    if (wave == 0 && lane_id_v() == 0) (void)xb_add(&bar[XB_XCNT(b.x)], 1u);
    return b;
}
__device__ __forceinline__ void xcd_barrier_complete(unsigned* bar, unsigned x, unsigned& nloc, unsigned& nx) {
    const unsigned G = gridDim.x * gridDim.y * gridDim.z;
    unsigned sum, cnt, mine, sp = 0u;
    for (;;) {
        sum = 0u; cnt = 0u; mine = 0u;
#pragma unroll
        for (unsigned j = 0; j < 16; ++j) { const unsigned c = xb_ld(&bar[XB_XCNT(j)]); sum += c; cnt += (c > 0u) ? 1u : 0u; mine = (j == x) ? c : mine; }
        if (sum == G) break;
        __builtin_amdgcn_s_sleep(1);
        if ((++sp & 255u) == 0u) { if (xb_ld(&bar[XB_TMO])) break; if (sp > XB_SPIN_CAP) { atomicAdd(&bar[XB_TMO], 1u); break; } }
    }
    nloc = mine > 0u ? mine : 1u; nx = cnt > 0u ? cnt : 1u;
}
__device__ __forceinline__ void xcd_barrier(const XcdBarrier& b) {
    asm volatile("s_waitcnt vmcnt(0)" ::: "memory");
    __syncthreads();
    if (b.wave == 0 && lane_id_v() == 0) {
        unsigned* bar = b.bar;
        __builtin_amdgcn_s_waitcnt(0);
        unsigned nloc = b.st[0], nx = b.st[1];
        if (nloc == 0u) { xcd_barrier_complete(bar, b.x, nloc, nx); b.st[0] = nloc; b.st[1] = nx; }
        const unsigned old = xb_add(&bar[XB_XSUB(b.x)], 1u);
        const unsigned gen = old / nloc;
        if (old + 1u == (gen + 1u) * nloc) {
            __builtin_amdgcn_fence(__ATOMIC_RELEASE, "agent");
            asm volatile("s_waitcnt vmcnt(0)" ::: "memory");
            const unsigned og = xb_add(&bar[XB_TOP], 1u);
            const unsigned tg = og / nx;
            if (og + 1u == (tg + 1u) * nx) xb_add(&bar[XB_TOPGEN], 1u);
            else XB_SPIN(xb_ld(&bar[XB_TOPGEN]) == tg, bar);
            __builtin_amdgcn_fence(__ATOMIC_ACQUIRE, "agent");
            xb_add(&bar[XB_XGEN(b.x)], 1u);
            asm volatile("s_waitcnt vmcnt(0)" ::: "memory");
        } else {
            XB_SPIN(xb_ld(&bar[XB_XGEN(b.x)]) == gen, bar);
            __builtin_amdgcn_fence(__ATOMIC_ACQUIRE, "agent");
            asm volatile("s_waitcnt vmcnt(0)" ::: "memory");
        }
    }
    __syncthreads();
}

__device__ __forceinline__ void p0_transpose_item(const float* W, int K, int N, bf16_t* WT, int k0, int n0, int orow0, LAS float* scr, int lane) {
#pragma unroll
    for (int i = 0; i < 8; ++i) { const int kk = 8 * i + (lane >> 3), n4 = (lane & 7) * 4; const f32x4 v = *(const GAS f32x4*)(W + (size_t)(k0 + kk) * N + n0 + n4);
        LAS float* d = scr + kk * 33 + n4; d[0] = v.x; d[1] = v.y; d[2] = v.z; d[3] = v.w; }
    LDS_WAIT(); asm volatile("" ::: "memory");
    const int c = lane & 7;
#pragma unroll
    for (int j = 0; j < 4; ++j) { const int n = (lane >> 3) + 8 * j; const LAS float* s = scr + (8 * c) * 33 + n;
        u32x4 o; o.x = pk2(s[0 * 33], s[1 * 33]); o.y = pk2(s[2 * 33], s[3 * 33]); o.z = pk2(s[4 * 33], s[5 * 33]); o.w = pk2(s[6 * 33], s[7 * 33]);
        *(GAS u32x4*)(WT + (size_t)(orow0 + n) * K + k0 + 8 * c) = o; }
    LDS_WAIT(); asm volatile("" ::: "memory");
}

struct Args { const float* in[25]; float* out; unsigned char* ws; };

__global__ void __launch_bounds__(512, 2) mega_fwd(Args args) {
    extern __shared__ __attribute__((aligned(16))) unsigned char lds_raw[];
    LAS unsigned char* lds = (LAS unsigned char*)lds_raw;
    volatile LAS unsigned* MISC = (volatile LAS unsigned*)(lds + MISC_OFF);
    const int G = gridDim.x, bx = blockIdx.x, NGW = G * 8;
    const int wave_s = __builtin_amdgcn_readfirstlane(threadIdx.x >> 6);
    unsigned char* ws = args.ws;
    gu32* ctl = (gu32*)(ws + WS_CTL);
    const float* x = args.in[0];
    float* out = args.out;
    bf16_t* WGU = (bf16_t*)(ws + WS_WGU); bf16_t* WD = (bf16_t*)(ws + WS_WD); bf16_t* WIN = (bf16_t*)(ws + WS_WIN); bf16_t* WOUT = (bf16_t*)(ws + WS_WOUT);
    bf16_t* XN = (bf16_t*)(ws + WS_XN); bf16_t* H2 = (bf16_t*)(ws + WS_H2); bf16_t* GF = (bf16_t*)(ws + WS_GF);
    bf16_t* HP = (bf16_t*)(ws + WS_HP); bf16_t* QKV = (bf16_t*)(ws + WS_QKV); bf16_t* HZ = (bf16_t*)(ws + WS_HZ); bf16_t* MIX = (bf16_t*)(ws + WS_MIX);
    bf16_t* ACT = (bf16_t*)(ws + WS_ACT); bf16_t* Y = (bf16_t*)(ws + WS_Y);
    float* AFF = (float*)(ws + WS_AFF); int* TOK = (int*)(ws + WS_TOK); float* GSEL = (float*)(ws + WS_GSEL); unsigned short* INV = (unsigned short*)(ws + WS_INV);
    float* NSUM = (float*)(ws + WS_CTL) + CW_NSUM;

    if (wave_s == 0) ((LAS unsigned*)(lds + MISC_OFF))[lane_id_v()] = 0u;
    __syncthreads();
    XcdBarrier bar = xcd_barrier_post((unsigned*)(ctl + CW_BAR), MISC + 8, wave_s);

    {
        PHASE_IDS();
        LAS float* scr = (LAS float*)(lds + wave * 16384);
        constexpr int I_IN = (DM / 64) * (INC / 32), I_OUT = (DM / 64) * (DM / 32), I_GU = (DM / 64) * (FF / 32), I_DN = (FF / 64) * (DM / 32);
        constexpr int NITEMS = I_IN + I_OUT + NE * (2 * I_GU + I_DN);
        for (int rep_ = 0; rep_ < REP_P0W; ++rep_)
        for (int it = gw; it < NITEMS; it += NGW) {
            int r = it;
            if (r < I_IN) { const int nblk = INC / 32, kb = r / nblk, nb = r % nblk; p0_transpose_item(args.in[2], DM, INC, WIN, 64 * kb, 32 * nb, 32 * nb, scr, lane); continue; } r -= I_IN;
            if (r < I_OUT) { const int nblk = DM / 32, kb = r / nblk, nb = r % nblk; p0_transpose_item(args.in[18], DM, DM, WOUT, 64 * kb, 32 * nb, 32 * nb, scr, lane); continue; } r -= I_OUT;
            const int e = r / (2 * I_GU + I_DN); r -= e * (2 * I_GU + I_DN);
            if (r < 2 * I_GU) { const int up = r >= I_GU; if (up) r -= I_GU; const int nblk = FF / 32, kb = r / nblk, nb = r % nblk, f0 = 32 * nb;
                const int orow = (f0 >> 7) * 256 + up * 128 + (f0 & 127);
                p0_transpose_item(args.in[up ? 22 : 21] + (size_t)e * DM * FF, DM, FF, WGU + (size_t)e * 2 * FF * DM, 64 * kb, f0, orow, scr, lane); continue; }
            r -= 2 * I_GU;
            { const int nblk = DM / 32, kb = r / nblk, nb = r % nblk; p0_transpose_item(args.in[23] + (size_t)e * FF * DM, FF, DM, WD + (size_t)e * DM * FF, 64 * kb, 32 * nb, 32 * nb, scr, lane); }
        }
        const float* g = args.in[1];
        int rep_xn = REP_XN; asm volatile("" : "+s"(rep_xn));
        for (int rep_ = 0; rep_ < rep_xn; ++rep_)
        for (int m = gw; m < NTOK; m += NGW) {
            const GAS f32x4* xr = (const GAS f32x4*)(x + (size_t)m * DM) + lane;
            f32x4 v[4]; float s = 0.f;
#pragma unroll
            for (int j = 0; j < 4; ++j) { v[j] = xr[64 * j]; s += (v[j].x * v[j].x + v[j].y * v[j].y) + (v[j].z * v[j].z + v[j].w * v[j].w); }
            const float rstd = rsqrtf(wave_sum(s) * (1.f / DM) + EPS);
            GAS u32x2* o8 = (GAS u32x2*)(XN + (size_t)m * DM) + lane;
#pragma unroll
            for (int j = 0; j < 4; ++j) { const f32x4 gg = ((const GAS f32x4*)g)[lane + 64 * j]; u32x2 w; w.x = pk2(v[j].x * rstd * gg.x, v[j].y * rstd * gg.y); w.y = pk2(v[j].z * rstd * gg.z, v[j].w * rstd * gg.w); o8[64 * j] = w; }
        }
        __syncthreads();
        for (int it = bx; it < 256; it += G) {
            const int ib = it >> 2, dn = it & 3, dir = dn >> 1, n = dn & 1, i0 = ib * 64;
            LAS float* zz = (LAS float*)lds;
            LAS float* h1 = zz + 64 * 33;
            LAS float* h2 = h1 + 64 * 64;
            const float* w1 = args.in[5]; const float* b1 = args.in[6]; const float* w2 = args.in[7]; const float* b2 = args.in[8]; const float* w3 = args.in[9]; const float* fr = args.in[10];
            for (int q = tid; q < 64 * 33; q += 512) { const int p = q / 33, j = q % 33, i = i0 + p;
                const float t = (float)i / (float)(SEQ - 1), w = 6.283185307179586f * (float)i / (float)SEQ; float v;
                if (j == 0) v = t; else { const float band = 1e-4f + (float)((j - 1) & 15) * ((15.f - 1e-4f) / 15.f); v = (j <= 16) ? cosf(band * w) : -sinf(band * w); }
                zz[q] = v; }
            __syncthreads();
            for (int q = tid; q < 64 * 64; q += 512) { const int p = q >> 6, j = q & 63; float a = b1[j]; for (int k = 0; k < 33; ++k) a += zz[p * 33 + k] * w1[k * 64 + j]; h1[q] = sinf(fr[j] * a); }
            __syncthreads();
            for (int q = tid; q < 64 * 64; q += 512) { const int p = q >> 6, j = q & 63; float a = b2[j]; for (int k = 0; k < 64; ++k) a += h1[p * 64 + k] * w2[k * 64 + j]; h2[q] = sinf(fr[j] * a); }
            __syncthreads();
            const int c = tid, col = dn * 512 + c;
            const float mind = logf(1e-2f) / 1.5f, maxd = logf(1e-2f) / 0.3f;
            const float delta = fabsf(mind + (float)c * ((maxd - mind) / 511.f));
            bf16_t* gf = GF + (size_t)(n * 512 + c) * GLEN;
            float asum = 0.f;
            for (int p0 = 0; p0 < 64; p0 += 16) {
                float hv[16];
#pragma unroll
                for (int p = 0; p < 16; ++p) hv[p] = 0.f;
                for (int k = 0; k < 64; ++k) { const float wk = w3[k * 2048 + col];
#pragma unroll
                    for (int p = 0; p < 16; ++p) hv[p] += h2[(p0 + p) * 64 + k] * wk; }
#pragma unroll
                for (int p = 0; p < 16; ++p) { const int i = i0 + p0 + p; const float t = (float)i / (float)(SEQ - 1); const float h = hv[p] * expf(-t * delta);
                    const unsigned hb = f2bf(h); const float hr = __builtin_bit_cast(float, hb << 16);
                    if (dir == 0) { gf[GOFF - i] = (bf16_t)hb; asum += fabsf(hr); } else if (i > 0) { gf[GOFF + i] = (bf16_t)hb; asum += fabsf(hr); } }
            }
            if (ib == 63) { if (dir == 0) { for (int q = 0; q < GOFF - 4095; ++q) gf[q] = 0; } else { for (int q = GOFF + 4096; q < GLEN; ++q) gf[q] = 0; } }
            atomicAdd(&NSUM[n * 512 + c], asum);
            __syncthreads();
        }
    }
    xcd_barrier(bar);

    int rep_p1 = REP_P1; asm volatile("" : "+s"(rep_p1));
    for (int rep_ = 0; rep_ < rep_p1; ++rep_) {
    {
        pg8::GeoTokPerm S; S.A = WIN; S.X = XN; S.K = DM; S.ord.init(HCOLS / 256, NTOK / 256, G, bx);
        pg8::EpiBf16 E{HP, NTOK, 0, 1.f};
        pg8::gemm_phase(lds, (LAS unsigned*)(lds + TBL_OFF), S, E, wave_s);
    }
    {
        pg8::GeoPlain S; S.A = XN; S.Bt = WIN + (size_t)HCOLS * DM; S.K = DM; S.ord.init(NTOK / 256, ACOLS / 256, G, bx);
        pg8::EpiBf16 E{QKV, ACOLS, 512, QSCALE};
        pg8::gemm_phase(lds, (LAS unsigned*)(lds + TBL_OFF), S, E, wave_s);
    }
    }
    xcd_barrier(bar);

    {
        PHASE_IDS();
        {
            const float* conv_w = args.in[3]; const float* conv_b = args.in[4]; const float* skip = args.in[11];
            if (tid < 64) { const int bufi = tid >> 5, row = tid & 31, rr = row < 16 ? row : SEQ + row; *(LAS u32x4*)(lds + bufi * HY_ZBYTES + rr * 16) = (u32x4){0u, 0u, 0u, 0u}; }
            const int r32 = lane & 31, hi = lane >> 5;
            const int tr_lane = (2 * ((lane >> 4) & 1) + ((lane & 3) >> 1) + 8 * hi + ((lane & 15) >> 2)) * 16 + 8 * (lane & 1);
            int rep_hy = REP_HY; asm volatile("" : "+s"(rep_hy));
            for (int rep_ = 0; rep_ < rep_hy; ++rep_)
            for (int unit = bx; unit < HW; unit += G) {
                const int c = unit;
                __syncthreads();
                {
                    const int col = 1024 + c; const float w0 = conv_w[col], w1 = conv_w[HCOLS + col], w2 = conv_w[2 * HCOLS + col], cb = conv_b[col];
                    const bf16_t* hp = HP + (size_t)col * SEQ * 8;
#pragma unroll 2
                    for (int i = 0; i < 8; ++i) { const int t = tid + 512 * i;
                        const u32x4 z4 = (u32x4){0u, 0u, 0u, 0u};
                        const u32x4 pm = t > 0 ? *(const GAS u32x4*)(hp + (size_t)(t - 1) * 8) : z4, p0 = *(const GAS u32x4*)(hp + (size_t)t * 8), pp = t < SEQ - 1 ? *(const GAS u32x4*)(hp + (size_t)(t + 1) * 8) : z4;
                        u32x4 o;
#pragma unroll
                        for (int k = 0; k < 4; ++k) { const float lo = cb + w0 * bflo(pm[k]) + w1 * bflo(p0[k]) + w2 * bflo(pp[k]), hh = cb + w0 * bfhi(pm[k]) + w1 * bfhi(p0[k]) + w2 * bfhi(pp[k]); o[k] = pk2(lo, hh); }
                        *(LAS u32x4*)(lds + HY_ZA + (t + 16) * 16) = o; }
                }
                for (int n = 0; n < 2; ++n) {
                    {
                        const GAS u32x4* gsrc = (const GAS u32x4*)(GF + (size_t)(n * 512 + c) * GLEN);
                        for (int q = tid; q < GLEN * 2 / 16; q += 512) *(LAS u32x4*)(lds + HY_FB + q * 16) = gsrc[q];
                    }
                    __syncthreads();
                    f32x16 acc[2][2];
#pragma unroll
                    for (int a = 0; a < 2; ++a)
#pragma unroll
                        for (int b = 0; b < 2; ++b)
#pragma unroll
                            for (int k = 0; k < 16; ++k) acc[a][b][k] = 0.f;
                    const LAS unsigned char* za = lds + (n == 0 ? HY_ZA : HY_ZB) + tr_lane;
                    const LAS unsigned char* fbp = lds + HY_FB + 2 * GOFF - 32 + 16 * (hi - r32) - 512 * (2 * wave);
#define HY_STEP(OFFA, OFFB) do { \
                        const v4i16_t x0 = __builtin_amdgcn_ds_read_tr16_b64_v4i16((LAS v4i16_t*)(za + (OFFA))); \
                        const v4i16_t x1 = __builtin_amdgcn_ds_read_tr16_b64_v4i16((LAS v4i16_t*)(za + (OFFA) + 64)); \
                        const v4i16_t x2 = __builtin_amdgcn_ds_read_tr16_b64_v4i16((LAS v4i16_t*)(za + (OFFA) + 128)); \
                        const bf16x8 b0 = *(const LAS bf16x8*)(fbp + (OFFB)), b1 = *(const LAS bf16x8*)(fbp + (OFFB) - 512); \
                        const bf16x8 a0 = (bf16x8){x0[0], x0[1], x0[2], x0[3], x1[0], x1[1], x1[2], x1[3]}, a1 = (bf16x8){x1[0], x1[1], x1[2], x1[3], x2[0], x2[1], x2[2], x2[3]}; \
                        acc[0][0] = __builtin_amdgcn_mfma_f32_32x32x16_bf16(a0, b0, acc[0][0], 0, 0, 0); \
                        acc[0][1] = __builtin_amdgcn_mfma_f32_32x32x16_bf16(a1, b0, acc[0][1], 0, 0, 0); \
                        acc[1][0] = __builtin_amdgcn_mfma_f32_32x32x16_bf16(a0, b1, acc[1][0], 0, 0, 0); \
                        acc[1][1] = __builtin_amdgcn_mfma_f32_32x32x16_bf16(a1, b1, acc[1][1], 0, 0, 0); } while (0)
#pragma clang loop unroll(disable)
                    for (int c4 = 0; c4 < 64; ++c4) {
                        HY_STEP(0, 0); HY_STEP(256, 32); HY_STEP(512, 64); HY_STEP(768, 96);
                        za += 1024; fbp += 128;
                    }
                    HY_STEP(0, 0);
#undef HY_STEP
                    const int gcol = n * 512 + c; const float w0 = conv_w[gcol], w1 = conv_w[HCOLS + gcol], w2 = conv_w[2 * HCOLS + gcol], cb = conv_b[gcol];
                    const float inv = 1.f / NSUM[n * 512 + c], sk = skip[n * 512 + c];
                    const bf16_t* hp = HP + (size_t)gcol * SEQ * 8 + 4 * hi;
                    const LAS unsigned char* zin = lds + (n == 0 ? HY_ZA : HY_ZB) + 8 * hi;
#pragma unroll
                    for (int sp = 0; sp < 2; ++sp) {
                        const int tb = 256 * (2 * wave + sp) + 8 * r32;
                        u32x2 P[10];
#pragma unroll
                        for (int k = 0; k < 10; ++k) { const int tq = tb - 1 + k; P[k] = (tq >= 0 && tq < SEQ) ? *(const GAS u32x2*)(hp + (size_t)tq * 8) : (u32x2){0u, 0u}; }
#pragma unroll
                        for (int tt = 0; tt < 8; ++tt) {
                            const int t = tb + tt; const u32x2 zi = *(const LAS u32x2*)(zin + (t + 16) * 16);
                            const float zv[4] = {bflo(zi.x), bfhi(zi.x), bflo(zi.y), bfhi(zi.y)};
                            const float pm[4] = {bflo(P[tt].x), bfhi(P[tt].x), bflo(P[tt].y), bfhi(P[tt].y)};
                            const float pc[4] = {bflo(P[tt + 1].x), bfhi(P[tt + 1].x), bflo(P[tt + 1].y), bfhi(P[tt + 1].y)};
                            const float pp[4] = {bflo(P[tt + 2].x), bfhi(P[tt + 2].x), bflo(P[tt + 2].y), bfhi(P[tt + 2].y)};
                            float zo[4];
#pragma unroll
                            for (int bb = 0; bb < 4; ++bb) { const float gate = cb + w0 * pm[bb] + w1 * pc[bb] + w2 * pp[bb]; zo[bb] = gate * (acc[sp][tt >> 2][(tt & 3) * 4 + bb] * inv + sk * zv[bb]); }
                            u32x2 w; w.x = pk2(zo[0], zo[1]); w.y = pk2(zo[2], zo[3]);
                            if (n == 0) *(LAS u32x2*)(lds + HY_ZB + (t + 16) * 16 + 8 * hi) = w;
                            else *(GAS u32x2*)(HZ + ((size_t)c * SEQ + t) * 8 + 4 * hi) = w;
                        }
                    }
                    __syncthreads();
                }
            }
        }
        __syncthreads();
        {
            const int wid = wave, r32 = lane & 31, hi = lane >> 5;
            for (int rep_ = 0; rep_ < REP_AT; ++rep_)
            for (int unit = bx; unit < NB * 4 * 16; unit += G) {
                const int qb = unit & 15, h = (unit >> 4) & 3, b = unit >> 6, q0 = qb * 256;
                const bf16_t* pb = QKV + (size_t)b * SEQ * ACOLS;
                const float slope2 = exp2f(-2.f * (float)(h + 1)) * LOG2E;
                const int qpos = q0 + wid * 32 + r32;
                f32x16 o[4];
#pragma clang loop unroll(disable)
                for (int mp = 0; mp < 2; ++mp) {
                    att::pass(o, pb + (size_t)qpos * ACOLS + h * 128 + mp * 64 + hi * 8, pb + 512 + h * 128 + mp * 64, pb + 1024 + h * 128, qpos, qb, slope2, (char*)lds_raw, tid);
                    if (mp == 0) {
                        int z2 = 0; asm volatile("" : "+s"(z2));
                        GAS f32x4* pk = (GAS f32x4*)((float*)(ws + WS_PARK) + (size_t)(bx * 8 + wid) * 4096 + lane * 64 + z2);
#pragma unroll
                        for (int d = 0; d < 4; ++d)
#pragma unroll
                            for (int k = 0; k < 4; ++k) pk[d * 4 + k] = (f32x4){o[d][4 * k], o[d][4 * k + 1], o[d][4 * k + 2], o[d][4 * k + 3]};
                    }
                    __builtin_amdgcn_sched_barrier(0);
                }
                asm volatile("s_waitcnt vmcnt(0)" ::: "memory");
                int zz = 0; asm volatile("" : "+s"(zz));
                float lam;
                { float s1 = 0.f, s2 = 0.f; for (int i = 0; i < 64; ++i) { s1 += args.in[13][i + zz] * args.in[14][i + zz]; s2 += args.in[15][i + zz] * args.in[16][i + zz]; } lam = expf(s1) - expf(s2) + 0.2f; }
                const float* subg = args.in[17] + zz;
                int lane_c = lane; asm volatile("" : "+v"(lane_c)); const int r32c = lane_c & 31, hic = lane_c >> 5;
                {
                    const GAS f32x4* pk = (const GAS f32x4*)((float*)(ws + WS_PARK) + (size_t)(bx * 8 + wid) * 4096 + lane_c * 64 + zz);
#pragma unroll
                    for (int d = 0; d < 4; ++d)
#pragma unroll
                        for (int k = 0; k < 4; ++k) { const f32x4 pv = pk[d * 4 + k];
#pragma unroll
                            for (int q = 0; q < 4; ++q) o[d][4 * k + q] = pv[q] - lam * o[d][4 * k + q]; }
                }
#pragma unroll
                for (int r = 0; r < 16; ++r) {
                    float ss = 0.f;
#pragma unroll
                    for (int d = 0; d < 4; ++d) ss += o[d][r] * o[d][r];
                    ss += __shfl_xor(ss, 1); ss += __shfl_xor(ss, 2); ss += __shfl_xor(ss, 4); ss += __shfl_xor(ss, 8); ss += __shfl_xor(ss, 16);
                    const float rs = rsqrtf(ss * (1.f / 128.f) + EPS) * 0.8f;
                    bf16_t* op = MIX + ((size_t)b * SEQ + q0 + wid * 32 + att::crow(r, hic)) * DM + 512 + h * 128 + r32c;
#pragma unroll
                    for (int d = 0; d < 4; ++d) op[d * 32] = (bf16_t)f2bf(o[d][r] * rs * subg[d * 32 + r32c]);
                }
            }
        }
    }
    xcd_barrier(bar);

    {
        PHASE_IDS();
        const float* hg = args.in[12];
        LAS unsigned short* tile = (LAS unsigned short*)lds;
        LAS float* rs = (LAS float*)(lds + 32768);
        int rep_3a = REP_P3A; asm volatile("" : "+s"(rep_3a));
        for (int rep_ = 0; rep_ < rep_3a; ++rep_)
        for (int it = bx; it < 8 * 128; it += G) {
            const int g = it & 7, tb = it >> 3, t0 = tb * 32;
            __syncthreads();
            for (int q = tid; q < 64 * 32; q += 512) { const int ch = q >> 5, seg = q & 31;
                const u32x4 v = *(const GAS u32x4*)(HZ + ((size_t)(g * 64 + ch) * SEQ + t0 + seg) * 8);
                *(LAS u32x4*)(tile + ch * 256 + seg * 8) = v; }
            __syncthreads();
            if (tid < 256) { float s = 0.f; for (int ch = 0; ch < 64; ++ch) { const float v = bf2f(tile[ch * 256 + tid]); s += v * v; } rs[tid] = rsqrtf(s * (1.f / 64.f) + EPS); }
            __syncthreads();
            for (int q = tid; q < 256 * 8; q += 512) { const int tk = q >> 3, c8 = (q & 7) * 8;
                const float r = rs[tk]; const int t = t0 + (tk >> 3), b = tk & 7;
                float v[8];
#pragma unroll
                for (int j = 0; j < 8; ++j) v[j] = bf2f(tile[(c8 + j) * 256 + tk]) * r * hg[g * 64 + c8 + j];
                u32x4 w; w.x = pk2(v[0], v[1]); w.y = pk2(v[2], v[3]); w.z = pk2(v[4], v[5]); w.w = pk2(v[6], v[7]);
                *(GAS u32x4*)(MIX + ((size_t)b * SEQ + t) * DM + g * 64 + c8) = w; }
        }
        __syncthreads();
    }
    xcd_barrier(bar);

    {
        pg8::GeoPlain S; S.A = MIX; S.Bt = WOUT; S.K = DM; S.ord.init(NTOK / 256, DM / 256, G, bx);
        pg8::EpiResF32 E{x, out, DM};
        for (int rep_ = 0; rep_ < REP_P3B; ++rep_) pg8::gemm_phase(lds, (LAS unsigned*)(lds + TBL_OFF), S, E, wave_s);
    }
    xcd_barrier(bar);

    {
        PHASE_IDS();
        const float* g = args.in[19]; const float* wr = args.in[20];
        LAS float* gwl = (LAS float*)lds;
        for (int q = tid; q < DM * 4; q += 512) { const f32x4 w4 = ((const GAS f32x4*)wr)[q]; const float gd = g[q >> 2]; *(LAS f32x4*)(gwl + (q >> 2) * 20 + (q & 3) * 4) = w4 * gd; }
        __syncthreads();
        const int i16 = lane & 15, q4 = lane >> 4;
        int rep_4a = REP_P4A; asm volatile("" : "+s"(rep_4a));
        for (int rep_ = 0; rep_ < rep_4a; ++rep_)
        for (int grp = gw; grp < NTOK / 16; grp += NGW) {
            const int tok0 = grp * 16;
            const float* xrow = out + (size_t)(tok0 + i16) * DM + 4 * q4;
            const LAS float* bp = gwl + (4 * q4) * 20 + i16;
            f32x4 acc = (f32x4){0.f, 0.f, 0.f, 0.f}; float ss = 0.f;
#pragma unroll 8
            for (int kk = 0; kk < 64; ++kk) {
                const f32x4 a = *(const GAS f32x4*)(xrow + 16 * kk);
                ss += (a.x * a.x + a.y * a.y) + (a.z * a.z + a.w * a.w);
                const LAS float* b = bp + kk * 320;
                acc = __builtin_amdgcn_mfma_f32_16x16x4f32(a.x, b[0], acc, 0, 0, 0);
                acc = __builtin_amdgcn_mfma_f32_16x16x4f32(a.y, b[20], acc, 0, 0, 0);
                acc = __builtin_amdgcn_mfma_f32_16x16x4f32(a.z, b[40], acc, 0, 0, 0);
                acc = __builtin_amdgcn_mfma_f32_16x16x4f32(a.w, b[60], acc, 0, 0, 0);
            }
            ss += __shfl_xor(ss, 16); ss += __shfl_xor(ss, 32);
            const float r = rsqrtf(ss * (1.f / DM) + EPS);
            f32x4 af;
#pragma unroll
            for (int reg = 0; reg < 4; ++reg) {
                const float lg = acc[reg] * __shfl(r, 4 * q4 + reg);
                float mx = lg; mx = fmaxf(mx, __shfl_xor(mx, 1)); mx = fmaxf(mx, __shfl_xor(mx, 2)); mx = fmaxf(mx, __shfl_xor(mx, 4)); mx = fmaxf(mx, __shfl_xor(mx, 8));
                const float ex = expf(lg - mx); float den = ex; den += __shfl_xor(den, 1); den += __shfl_xor(den, 2); den += __shfl_xor(den, 4); den += __shfl_xor(den, 8);
                af[reg] = ex / den;
            }
            const int b = tok0 >> 12, t0 = tok0 & 4095;
            *(GAS f32x4*)(AFF + ((size_t)i16 * NB + b) * SEQ + t0 + 4 * q4) = af;
            *(GAS u32x2*)(INV + (size_t)tok0 * 16 + lane * 4) = (u32x2){0xffffffffu, 0xffffffffu};
            for (int i = 0; i < 16; ++i) {
                const float ri = __shfl(r, i);
                const GAS f32x4* xr = (const GAS f32x4*)(out + (size_t)(tok0 + i) * DM) + lane;
                GAS u32x2* o8 = (GAS u32x2*)(H2 + (size_t)(tok0 + i) * DM) + lane;
#pragma unroll
                for (int j = 0; j < 4; ++j) { const f32x4 v = xr[64 * j]; const f32x4 gg = ((const GAS f32x4*)g)[lane + 64 * j];
                    u32x2 w; w.x = pk2(v.x * ri * gg.x, v.y * ri * gg.y); w.y = pk2(v.z * ri * gg.z, v.w * ri * gg.w); o8[64 * j] = w; }
            }
        }
        __syncthreads();
    }
    xcd_barrier(bar);

    {
        PHASE_IDS();
        LAS unsigned* hist = (LAS unsigned*)lds; LAS unsigned* scan = hist + 256; LAS unsigned* selw = scan + 512;
        int rep_4b = REP_P4B; asm volatile("" : "+s"(rep_4b));
        for (int rep_ = 0; rep_ < rep_4b; ++rep_)
        for (int eb = bx; eb < NE * NB; eb += G) {
            const int b = eb & 7, e = eb >> 3;
            const float* a = AFF + (size_t)eb * SEQ;
            unsigned v[8];
#pragma unroll
            for (int j = 0; j < 8; ++j) v[j] = __float_as_uint(a[tid * 8 + j]);
            unsigned prefix = 0, mask = 0, need = CAP;
            __syncthreads();
            for (int pass = 0; pass < 4; ++pass) {
                const int shift = 24 - 8 * pass;
                if (tid < 256) hist[tid] = 0;
                __syncthreads();
#pragma unroll
                for (int j = 0; j < 8; ++j) if ((v[j] & mask) == prefix) atomicAdd((unsigned*)&hist[(v[j] >> shift) & 255u], 1u);
                __syncthreads();
                if (tid < 256) scan[tid] = hist[tid];
                __syncthreads();
                for (int off = 1; off < 256; off <<= 1) { const unsigned xx = (tid < 256 && tid + off < 256) ? scan[tid + off] : 0u; __syncthreads(); if (tid < 256) scan[tid] += xx; __syncthreads(); }
                if (tid < 256) { const unsigned above = tid < 255 ? scan[tid + 1] : 0u; if (above < need && need <= scan[tid]) { selw[0] = (unsigned)tid; selw[1] = need - above; } }
                __syncthreads();
                prefix |= selw[0] << shift; mask |= 255u << shift; need = selw[1];
                __syncthreads();
            }
            unsigned cg = 0, ce = 0;
#pragma unroll
            for (int j = 0; j < 8; ++j) { cg += v[j] > prefix; ce += v[j] == prefix; }
            scan[tid] = (cg << 16) | ce;
            __syncthreads();
            for (int off = 1; off < 512; off <<= 1) { const unsigned xx = tid >= off ? scan[tid - off] : 0u; __syncthreads(); scan[tid] += xx; __syncthreads(); }
            const unsigned incl = scan[tid]; unsigned pg = (incl >> 16) - cg, pe = (incl & 0xffffu) - ce;
#pragma unroll
            for (int j = 0; j < 8; ++j) {
                const bool isg = v[j] > prefix, ise = v[j] == prefix;
                if (isg || (ise && pe < need)) {
                    const unsigned pos = pg + (pe < need ? pe : need); const int token = b * SEQ + tid * 8 + j;
                    TOK[(size_t)eb * CAP + pos] = token; GSEL[(size_t)eb * CAP + pos] = __uint_as_float(v[j]); INV[(size_t)token * 16 + e] = (unsigned short)pos;
                }
                pg += isg; pe += ise;
            }
            __syncthreads();
        }
    }
    xcd_barrier(bar);

    {
        pg8::GeoExpert<true> S; S.A = H2; S.Bt = WGU; S.K = DM; S.bexp = (size_t)2 * FF * DM * 2; S.tok = TOK; S.ord.init(NSLOT / 256, 2 * FF / 256, G, bx);
        pg8::EpiSwiGLU E{ACT, FF};
        for (int rep_ = 0; rep_ < REP_P5; ++rep_) pg8::gemm_phase(lds, (LAS unsigned*)(lds + TBL_OFF), S, E, wave_s);
    }
    xcd_barrier(bar);

    {
        pg8::GeoExpert<false> S; S.A = ACT; S.Bt = WD; S.K = FF; S.bexp = (size_t)DM * FF * 2; S.tok = nullptr; S.ord.init(NSLOT / 256, DM / 256, G, bx);
        pg8::EpiBf16 E{Y, DM, 0, 1.f};
        for (int rep_ = 0; rep_ < REP_P6; ++rep_) pg8::gemm_phase(lds, (LAS unsigned*)(lds + TBL_OFF), S, E, wave_s);
    }
    xcd_barrier(bar);

    {
        PHASE_IDS();
        const float* g = args.in[24];
        for (int m = gw; m < NTOK; m += NGW) {
            const GAS f32x4* xr = (const GAS f32x4*)(out + (size_t)m * DM) + lane;
            f32x4 v[4];
#pragma unroll
            for (int j = 0; j < 4; ++j) v[j] = xr[64 * j];
            const int b = m >> 12;
            const unsigned short myinv = INV[(size_t)m * 16 + (lane & 15)];
            for (int e = 0; e < 16; ++e) {
                const unsigned s = (unsigned)__shfl((int)myinv, e);
                if (s != 0xffffu) {
                    const size_t slot = ((size_t)e * NB + b) * CAP + s;
                    const float gv = GSEL[slot];
                    const GAS u32x2* yr = (const GAS u32x2*)(Y + slot * DM) + lane;
#pragma unroll
                    for (int j = 0; j < 4; ++j) { const u32x2 w = yr[64 * j]; v[j].x += gv * bflo(w.x); v[j].y += gv * bfhi(w.x); v[j].z += gv * bflo(w.y); v[j].w += gv * bfhi(w.y); }
                }
            }
            float s = 0.f;
#pragma unroll
            for (int j = 0; j < 4; ++j) s += (v[j].x * v[j].x + v[j].y * v[j].y) + (v[j].z * v[j].z + v[j].w * v[j].w);
            const float r = rsqrtf(wave_sum(s) * (1.f / DM) + EPS);
            GAS f32x4* o = (GAS f32x4*)(out + (size_t)m * DM) + lane;
#pragma unroll
            for (int j = 0; j < 4; ++j) { const f32x4 gg = ((const GAS f32x4*)g)[lane + 64 * j]; o[64 * j] = (f32x4){v[j].x * r * gg.x, v[j].y * r * gg.y, v[j].z * r * gg.z, v[j].w * r * gg.w}; }
        }
    }
}

extern "C" void kernel_launch(void* const* d_in, const int* in_sizes, int n_in, void* d_out, int out_size, void* d_ws, size_t ws_size, hipStream_t stream) {
    static int grid = 0;
    if (grid == 0) {
        if (n_in != 25 || ws_size < WS_END) { fprintf(stderr, "kernel_launch: unexpected n_in %d / ws %zu\n", n_in, ws_size); grid = -1; return; }
        int dev = 0, cus = 0;
        if (hipGetDevice(&dev) != hipSuccess || hipDeviceGetAttribute(&cus, hipDeviceAttributeMultiprocessorCount, dev) != hipSuccess) { grid = -1; return; }
        if (hipFuncSetAttribute((const void*)mega_fwd, hipFuncAttributeMaxDynamicSharedMemorySize, LDS_BYTES) != hipSuccess) { fprintf(stderr, "kernel_launch: hipFuncSetAttribute failed\n"); grid = -1; return; }
        int per_cu = 0;
        if (hipOccupancyMaxActiveBlocksPerMultiprocessor(&per_cu, (const void*)mega_fwd, 512, LDS_BYTES) != hipSuccess || per_cu < 1) fprintf(stderr, "kernel_launch: occupancy query says %d\n", per_cu);
        (void)hipGetLastError();
        grid = cus;
    }
    if (grid < 0) return;
    (void)hipMemsetAsync((char*)d_ws + WS_CTL, 0, CTL_BYTES, stream);
    Args a; memset(&a, 0, sizeof a);
    for (int i = 0; i < 25; ++i) a.in[i] = (const float*)d_in[i];
    a.out = (float*)d_out; a.ws = (unsigned char*)d_ws;
    hipLaunchKernelGGL(mega_fwd, dim3(grid), dim3(512), LDS_BYTES, stream, a);
}
```

```cpp
#include <hip/hip_runtime.h>
#include <cstdio>
#include <cstdint>
#include <cstring>

#define GAS __attribute__((address_space(1)))
#define LAS __attribute__((address_space(3)))
typedef unsigned short bf16_t;
typedef short bf16x8 __attribute__((ext_vector_type(8)));
typedef float f32x4 __attribute__((ext_vector_type(4)));
typedef float f32x2 __attribute__((ext_vector_type(2)));
typedef unsigned u32x4 __attribute__((ext_vector_type(4)));
typedef unsigned u32x2 __attribute__((ext_vector_type(2)));
typedef short v4i16_t __attribute__((ext_vector_type(4)));
typedef int i32x4 __attribute__((ext_vector_type(4)));
typedef int i32x8 __attribute__((ext_vector_type(8)));
constexpr int F8_SCALES = 127 | (122 << 8);
typedef float f32x16 __attribute__((ext_vector_type(16)));

constexpr int DM = 1024, NB = 8, SEQ = 4096, NTOK = NB * SEQ;
constexpr int HW = 512, HCOLS = 1536, INC = 3072, ACOLS = 1536;
constexpr int NE = 16, CAP = 512, FF = 2816, NSLOT = NE * NB * CAP;
constexpr float EPS = 1e-6f;
constexpr float LOG2E = 1.4426950408889634f;
constexpr float QSCALE = 0.125f * LOG2E;
constexpr int GOFF = 4352, GLEN = 8704;

constexpr size_t MiB = 1u << 20;
constexpr size_t WS_CTL = 0, CTL_BYTES = 1 * MiB;
constexpr size_t WS_WGU = 2 * MiB;
constexpr size_t WS_WD = 90 * MiB;
constexpr size_t WS_AFF = 134 * MiB;
constexpr size_t WS_TOK = 136 * MiB;
constexpr size_t WS_GSEL = WS_TOK + 256 * 1024;
constexpr size_t WS_INV = 137 * MiB;
constexpr size_t WS_XN = 138 * MiB;
constexpr size_t WS_H2 = WS_XN;
constexpr size_t WS_WIN = 202 * MiB;
constexpr size_t WS_WOUT = 208 * MiB;
constexpr size_t WS_GF = 210 * MiB;
constexpr size_t WS_HP = 228 * MiB;
constexpr size_t WS_QKV = 324 * MiB;
constexpr size_t WS_ACT = 228 * MiB;
constexpr size_t WS_HZ = 420 * MiB;
constexpr size_t WS_MIX = 452 * MiB;
constexpr size_t WS_PARK = 516 * MiB;
constexpr size_t WS_Y = 420 * MiB;
constexpr size_t WS_END = 548 * MiB;
constexpr int CW_BAR = 4096;
constexpr int CW_NSUM = 16384;

constexpr int REP_XN = 1, REP_P3A = 1, REP_P4A = 1, REP_P4B = 1;
constexpr int REP_P0W = 1, REP_P1 = 1, REP_HY = 1, REP_AT = 1, REP_P3B = 1, REP_P5 = 1, REP_P6 = 1;
constexpr int LDS_BYTES = 160 * 1024;
constexpr int MISC_OFF = LDS_BYTES - 256;
constexpr int HY_ZBYTES = (SEQ + 32) * 16, HY_ZA = 0, HY_ZB = HY_ZBYTES, HY_FB = 2 * HY_ZBYTES;
constexpr int TBL_OFF = 131072;

__device__ __forceinline__ unsigned f2bf(float f) { unsigned u = __builtin_bit_cast(unsigned, f); return (u + 0x7fffu + ((u >> 16) & 1u)) >> 16; }
__device__ __forceinline__ unsigned pk2(float lo, float hi) { return f2bf(lo) | (f2bf(hi) << 16); }
__device__ __forceinline__ float bf2f(unsigned short h) { return __builtin_bit_cast(float, (unsigned)h << 16); }
__device__ __forceinline__ float bflo(unsigned w) { return __builtin_bit_cast(float, w << 16); }
__device__ __forceinline__ float bfhi(unsigned w) { return __builtin_bit_cast(float, w & 0xffff0000u); }
__device__ __forceinline__ float wave_sum(float v) {
#pragma unroll
    for (int o = 1; o < 64; o <<= 1) v += __shfl_xor(v, o);
    return v;
}
#define LDS_WAIT() asm volatile("s_waitcnt lgkmcnt(0)" ::: "memory")
__device__ __forceinline__ int lane_id_v() { int l; asm volatile("v_mbcnt_lo_u32_b32 %0, -1, 0\n\tv_mbcnt_hi_u32_b32 %0, -1, %0" : "=v"(l)); return l; }
#define PHASE_IDS() const int wave = wave_s; int tid_o = wave_s * 64 + lane_id_v(); asm volatile("" : "+v"(tid_o)); const int tid = tid_o, lane = tid & 63, gw = blockIdx.x * 8 + wave; (void)lane; (void)gw

namespace pg8 {
constexpr int BM = 256, BK = 64, HALF = 128, HTB = HALF * BK * 2, STAGE_BYTES = 8 * HTB, NXCD = 8, WGM = 8;
__host__ __device__ __forceinline__ int lds_byte(int r, int c) { const int st = (r >> 4) * 2 + (c >> 5), rr = r & 15, cc = c & 31, ob = rr * 64 + cc * 2; return st * 1024 + (ob ^ (((ob >> 9) & 1) << 5)); }
__host__ __device__ __forceinline__ void stage_rc(int b, int& R, int& C) { const int st = b / 1024, sb = b % 1024, swz = sb ^ (((sb >> 9) & 1) << 5); R = (st >> 1) * 16 + swz / 64; C = (st & 1) * 32 + (swz % 64) / 2; }
__host__ __device__ __forceinline__ int perm32(int rho) { const int n = rho >> 4, i = rho & 15; return 8 * (i >> 2) + 4 * n + (i & 3); }
struct Unit { int pm, pn; };

struct TileOrder {
    int nM, nN, nwg, G, c;
    __device__ void init(int nM_, int nN_, int G_, int c_) { nM = nM_; nN = nN_; nwg = nM * nN; G = G_; c = c_; }
    __device__ bool next(int i, Unit& u) const {
        const long L = (long)i * G + c; if (L >= nwg) return false;
        int wgid = (int)L; { const int q = nwg / NXCD, r = nwg % NXCD, xcd = wgid % NXCD, off = wgid / NXCD; wgid = (xcd < r ? xcd * (q + 1) : r * (q + 1) + (xcd - r) * q) + off; }
        const int nig = WGM * nN, gid = wgid / nig, fm = gid * WGM, gsz = (nM - fm) < WGM ? (nM - fm) : WGM;
        u.pm = fm + ((wgid % nig) % gsz); u.pn = (wgid % nig) / gsz; return true;
    }
};
__device__ __forceinline__ unsigned cvt_pk_bf16(float lo, float hi) { unsigned r; asm volatile("v_cvt_pk_bf16_f32 %0, %1, %2" : "=v"(r) : "v"(lo), "v"(hi)); return r; }

struct EpiBf16 {
    static constexpr bool PERM = true;
    bf16_t* O; int ldc; int scols; float sc;
    __device__ __forceinline__ void operator()(const f32x4 (&acc)[2][2][4][2], const Unit& u, int wr, int wc, int fr, int fq) const {
        const int row0 = u.pm * BM + wr * 64 + fr, col0 = u.pn * BM + wc * 32 + 8 * fq;
        const float s = (u.pn * BM < scols) ? sc : 1.f;
#pragma unroll
        for (int ai = 0; ai < 2; ++ai)
#pragma unroll
            for (int m = 0; m < 4; ++m) { bf16_t* rowp = O + (size_t)(row0 + ai * HALF + m * 16) * ldc + col0;
#pragma unroll
                for (int bj = 0; bj < 2; ++bj) { const f32x4 v0 = acc[ai][bj][m][0] * s, v1 = acc[ai][bj][m][1] * s;
                    u32x4 w; w.x = cvt_pk_bf16(v0[0], v0[1]); w.y = cvt_pk_bf16(v0[2], v0[3]); w.z = cvt_pk_bf16(v1[0], v1[1]); w.w = cvt_pk_bf16(v1[2], v1[3]);
                    *(u32x4*)(rowp + bj * HALF) = w; } }
    }
};
struct EpiResF32 {
    static constexpr bool PERM = false;
    const float* R; float* C; int ldc;
    __device__ __forceinline__ void operator()(const f32x4 (&acc)[2][2][4][2], const Unit& u, int wr, int wc, int fr, int fq) const {
        const int row0 = u.pm * BM + wr * 64 + fr, col0 = u.pn * BM + wc * 32 + 4 * fq;
#pragma unroll
        for (int ai = 0; ai < 2; ++ai)
#pragma unroll
            for (int m = 0; m < 4; ++m) { const size_t off = (size_t)(row0 + ai * HALF + m * 16) * ldc + col0;
#pragma unroll
                for (int bj = 0; bj < 2; ++bj)
#pragma unroll
                    for (int n = 0; n < 2; ++n) { const f32x4 r = *(const f32x4*)(R + off + bj * HALF + n * 16); *(f32x4*)(C + off + bj * HALF + n * 16) = r + acc[ai][bj][m][n]; } }
    }
};
struct EpiSwiGLU {
    static constexpr bool PERM = true;
    unsigned char* O; int ldc;
    __device__ __forceinline__ void operator()(const f32x4 (&acc)[2][2][4][2], const Unit& u, int wr, int wc, int fr, int fq) const {
        const int row0 = u.pm * BM + wr * 64 + fr, col0 = u.pn * HALF + wc * 32 + 8 * fq;
#pragma unroll
        for (int ai = 0; ai < 2; ++ai)
#pragma unroll
            for (int m = 0; m < 4; ++m) { unsigned char* rowp = O + (size_t)(row0 + ai * HALF + m * 16) * ldc + col0;
                float o[8];
#pragma unroll
                for (int n = 0; n < 2; ++n)
#pragma unroll
                    for (int j = 0; j < 4; ++j) { const float g = acc[ai][0][m][n][j], up = acc[ai][1][m][n][j];
                        o[n * 4 + j] = g * __builtin_amdgcn_rcpf(1.f + __builtin_amdgcn_exp2f(-g * LOG2E)) * up; }
                u32x2 w; int t0 = __builtin_amdgcn_cvt_pk_fp8_f32(o[0], o[1], 0, false); t0 = __builtin_amdgcn_cvt_pk_fp8_f32(o[2], o[3], t0, true);
                int t1 = __builtin_amdgcn_cvt_pk_fp8_f32(o[4], o[5], 0, false); t1 = __builtin_amdgcn_cvt_pk_fp8_f32(o[6], o[7], t1, true);
                w.x = (unsigned)t0; w.y = (unsigned)t1; *(u32x2*)rowp = w; }
    }
};

struct GeoPlain {
    static constexpr bool GATHER = false;
    const bf16_t* A; const bf16_t* Bt; int KB; TileOrder ord;
    __device__ __forceinline__ bool next(int i, Unit& u) const { return ord.next(i, u); }
    __device__ __forceinline__ const char* a_ptr(const Unit& u) const { return (const char*)A + (size_t)u.pm * BM * KB; }
    __device__ __forceinline__ const char* b_ptr(const Unit& u) const { return (const char*)Bt + (size_t)u.pn * BM * KB; }
    __device__ __forceinline__ size_t hstepA() const { return (size_t)HALF * KB; }
    __device__ __forceinline__ size_t hstepB() const { return (size_t)HALF * KB; }
    __device__ __forceinline__ size_t istepA() const { return (size_t)64 * KB; }
    __device__ __forceinline__ size_t istepB() const { return (size_t)64 * KB; }
    __device__ __forceinline__ unsigned a_voff(int R, int C) const { return (unsigned)(R * KB + C * 2); }
    __device__ __forceinline__ unsigned b_voff(int R, int C) const { return (unsigned)(R * KB + C * 2); }
    __device__ __forceinline__ void fill_table(LAS unsigned*, const Unit&, int) const {}
};
struct GeoTokPerm {
    static constexpr bool GATHER = false;
    const bf16_t* A; const bf16_t* X; int KB; TileOrder ord;
    __device__ __forceinline__ bool next(int i, Unit& u) const { return ord.next(i, u); }
    __device__ __forceinline__ const char* a_ptr(const Unit& u) const { return (const char*)A + (size_t)u.pm * BM * KB; }
    __device__ __forceinline__ const char* b_ptr(const Unit& u) const { return (const char*)X + (size_t)u.pn * 32 * KB; }
    __device__ __forceinline__ size_t hstepA() const { return (size_t)HALF * KB; }
    __device__ __forceinline__ size_t hstepB() const { return (size_t)16 * KB; }
    __device__ __forceinline__ size_t istepA() const { return (size_t)64 * KB; }
    __device__ __forceinline__ size_t istepB() const { return (size_t)8 * KB; }
    __device__ __forceinline__ unsigned a_voff(int R, int C) const { return (unsigned)(R * KB + C * 2); }
    __device__ __forceinline__ unsigned b_voff(int R, int C) const { return (unsigned)(((R & 7) * SEQ + (R >> 3)) * KB + C * 2); }
    __device__ __forceinline__ void fill_table(LAS unsigned*, const Unit&, int) const {}
};
template <bool G> struct GeoExpert {
    static constexpr bool GATHER = G;
    const void* A; const void* Bt; int KB; size_t bexp;    const int* tok; TileOrder ord;
    __device__ __forceinline__ bool next(int i, Unit& u) const { return ord.next(i, u); }
    __device__ __forceinline__ const char* a_ptr(const Unit& u) const { return G ? (const char*)A : (const char*)A + (size_t)u.pm * BM * KB; }
    __device__ __forceinline__ const char* b_ptr(const Unit& u) const { return (const char*)Bt + (size_t)(u.pm >> 4) * bexp + (size_t)u.pn * BM * KB; }
    __device__ __forceinline__ size_t hstepA() const { return (size_t)HALF * KB; }
    __device__ __forceinline__ size_t hstepB() const { return (size_t)HALF * KB; }
    __device__ __forceinline__ size_t istepA() const { return (size_t)64 * KB; }
    __device__ __forceinline__ size_t istepB() const { return (size_t)64 * KB; }
    __device__ __forceinline__ unsigned a_voff(int R, int C) const { return (unsigned)(R * KB + C * 2); }
    __device__ __forceinline__ unsigned b_voff(int R, int C) const { return (unsigned)(R * KB + C * 2); }
    __device__ __forceinline__ void fill_table(LAS unsigned* tb, const Unit& u, int tid) const { if (G) { int t_ = tid; asm volatile("" : "+v"(t_));
#pragma unroll
        for (int i = 0; i < 2; ++i) { int R, C; stage_rc(t_ * 16 + i * 8192, R, C);
#pragma unroll
            for (int h = 0; h < 2; ++h) tb[h * 1024 + i * 512 + tid] = (unsigned)tok[u.pm * 256 + h * 128 + R] * (unsigned)KB + (unsigned)C * 2u; } } }
};

template <bool F8, class Epi, class Geo>
__device__ __forceinline__ void gemm_phase(LAS unsigned char* lds, LAS unsigned* tbl, const Geo& S, const Epi& E, int wave_s) {
    int tid_ = wave_s * 64 + lane_id_v(); asm volatile("" : "+v"(tid_));
    const int tid = tid_, wid = wave_s, lane = tid & 63, wr = wid >> 2, wc = wid & 3, fr = lane & 15, fq = lane >> 4;
    const int nt = S.KB / (BK * 2);
    unsigned voffA, voffB;
    { int R, C; stage_rc(tid * 16, R, C); const int Rb = Epi::PERM ? ((R & ~31) + perm32(R & 31)) : R; voffA = S.a_voff(R, C); voffB = S.b_voff(Rb, C); }
    const size_t istepA = S.istepA(), istepB = S.istepB();
    const size_t kstep = (size_t)(BK * 2);
    const size_t hstepA = S.hstepA(), hstepB = S.hstepB();
    const unsigned ldsw = (unsigned)wid * 1024u;
    const int aoff = lds_byte(wr * 64 + fr, fq * 8), boff = lds_byte(wc * 32 + fr, fq * 8);
    const LAS unsigned char* ldsB = lds + 4 * HTB + boff;
#define PG8_SA(b, h) (((b) * 2 + (h)) * HTB)
#define PG8_SB(b, h) ((4 + (b) * 2 + (h)) * HTB)
#define PG8_GLDS(bufoff, gptr, i_) __builtin_amdgcn_global_load_lds((const unsigned*)(gptr), (LAS unsigned*)(lds + (bufoff) + ldsw + (i_) * 8192), 16, 0, 0)
#define PG8_STAGE_B(bufoff, gbase) do { PG8_GLDS(bufoff, (const char*)(gbase) + voffB, 0); PG8_GLDS(bufoff, (const char*)(gbase) + istepB + voffB, 1); } while (0)
#define PG8_STAGE_A(bufoff, gbase, h, nx) do { if constexpr (Geo::GATHER) { const LAS unsigned* _tb = tbl + (((ui + ((nx) ? 1 : 0)) & 1) * 2048) + (h) * 1024 + tid; \
        const unsigned _v0 = _tb[0], _v1 = _tb[512]; PG8_GLDS(bufoff, (const char*)(gbase) + _v0, 0); PG8_GLDS(bufoff, (const char*)(gbase) + _v1, 1); } \
        else { PG8_GLDS(bufoff, (const char*)(gbase) + (h) * hstepA + voffA, 0); PG8_GLDS(bufoff, (const char*)(gbase) + (h) * hstepA + istepA + voffA, 1); } } while (0)
#define PG8_LD16(off) (*(const LAS i32x4*)(lds + (off)))
#define PG8_LDA(dst, b, h) do { _Pragma("unroll") for (int m = 0; m < 4; ++m) dst[m] = __builtin_shufflevector(PG8_LD16(PG8_SA(b, h) + aoff + m * 2048), PG8_LD16(PG8_SA(b, h) + aoff + m * 2048 + 1024), 0, 1, 2, 3, 4, 5, 6, 7); } while (0)
#define PG8_LDB(dst, b, h) do { _Pragma("unroll") for (int n = 0; n < 2; ++n) dst[n] = __builtin_shufflevector(*(const LAS i32x4*)(ldsB + ((b) * 2 + (h)) * HTB + n * 2048), *(const LAS i32x4*)(ldsB + ((b) * 2 + (h)) * HTB + n * 2048 + 1024), 0, 1, 2, 3, 4, 5, 6, 7); } while (0)
#define PG8_LO(v) __builtin_bit_cast(bf16x8, __builtin_shufflevector(v, v, 0, 1, 2, 3))
#define PG8_HI(v) __builtin_bit_cast(bf16x8, __builtin_shufflevector(v, v, 4, 5, 6, 7))
#define PG8_MMA(ai, bj, At, Bt) do { __builtin_amdgcn_s_setprio(1); _Pragma("unroll") for (int m = 0; m < 4; ++m) _Pragma("unroll") for (int n = 0; n < 2; ++n) { \
        if constexpr (F8) { acc[ai][bj][m][n] = __builtin_amdgcn_mfma_scale_f32_16x16x128_f8f6f4(Bt[n], At[m], acc[ai][bj][m][n], 0, 0, 1, F8_SCALES, 0, F8_SCALES); } \
        else { acc[ai][bj][m][n] = __builtin_amdgcn_mfma_f32_16x16x32_bf16(PG8_LO(Bt[n]), PG8_LO(At[m]), acc[ai][bj][m][n], 0, 0, 0); \
               acc[ai][bj][m][n] = __builtin_amdgcn_mfma_f32_16x16x32_bf16(PG8_HI(Bt[n]), PG8_HI(At[m]), acc[ai][bj][m][n], 0, 0, 0); } } \
        __builtin_amdgcn_s_setprio(0); } while (0)
#define PG8_WAIT_V(n) asm volatile("s_waitcnt vmcnt(" #n ")" ::: "memory")
#define PG8_WAIT_L(n) asm volatile("s_waitcnt lgkmcnt(" #n ")" ::: "memory")
#define PG8_BAR __builtin_amdgcn_s_barrier()
#define PG8_SCHED __builtin_amdgcn_sched_barrier(0)
    Unit cur, nxt; int ui = 0;
    if (!S.next(0, cur)) return;
    f32x4 acc[2][2][4][2];
#pragma unroll
    for (int a = 0; a < 2; ++a)
#pragma unroll
        for (int b = 0; b < 2; ++b)
#pragma unroll
            for (int m = 0; m < 4; ++m)
#pragma unroll
                for (int n = 0; n < 2; ++n) acc[a][b][m][n] = (f32x4){0.f, 0.f, 0.f, 0.f};
    i32x8 At[4], B0[2], B1[2];
    const char* cA = S.a_ptr(cur); const char* cB = S.b_ptr(cur);
    if constexpr (Geo::GATHER) {
        S.fill_table(tbl, cur, tid);
        Unit u1; if (S.next(1, u1)) S.fill_table(tbl + 2048, u1, tid);
        asm volatile("s_waitcnt vmcnt(0) lgkmcnt(0)" ::: "memory"); PG8_BAR; asm volatile("" ::: "memory");
    }
    PG8_STAGE_B(PG8_SB(0, 0), cB); PG8_STAGE_B(PG8_SB(0, 1), cB + hstepB); PG8_STAGE_A(PG8_SA(0, 0), cA, 0, false); PG8_STAGE_A(PG8_SA(0, 1), cA, 1, false);
    if (wr == 1) PG8_BAR;
    PG8_WAIT_V(2); PG8_BAR;
    PG8_STAGE_B(PG8_SB(1, 0), cB + kstep); PG8_STAGE_A(PG8_SA(1, 0), cA + kstep, 0, false); PG8_STAGE_B(PG8_SB(1, 1), cB + hstepB + kstep);
    PG8_WAIT_V(6); PG8_BAR;
    for (;;) {
        const bool has_next = S.next(ui + 1, nxt);
        const char* nA = has_next ? S.a_ptr(nxt) : cA; const char* nB = has_next ? S.b_ptr(nxt) : cB;
#pragma clang loop unroll(disable)
        for (int t = 0; t < nt; t += 2) {
            const bool last = (t == nt - 2);
            const bool lastn = last && has_next;
            const char* a1 = cA + (size_t)(t + 1) * kstep;
            const char* a2 = last ? nA : cA + (size_t)(t + 2) * kstep; const char* b2 = last ? nB : cB + (size_t)(t + 2) * kstep;
            const char* a3 = a2 + kstep; const char* b3 = b2 + kstep;
            if constexpr (Geo::GATHER) { if (t == 2 && ui > 0) { Unit u2; if (S.next(ui + 1, u2)) S.fill_table(tbl + (((ui + 1) & 1) * 2048), u2, tid); } }
            PG8_LDB(B0, 0, 0); PG8_LDB(B1, 0, 1); PG8_SCHED; PG8_LDA(At, 0, 0); PG8_STAGE_A(PG8_SA(1, 1), a1, 1, false);
            PG8_WAIT_V(8); PG8_WAIT_L(0); PG8_BAR; PG8_MMA(0, 0, At, B0); PG8_MMA(0, 1, At, B1); PG8_BAR; PG8_SCHED;
            PG8_LDA(At, 0, 1); PG8_STAGE_B(PG8_SB(0, 0), b2); PG8_STAGE_B(PG8_SB(0, 1), b2 + hstepB); PG8_STAGE_A(PG8_SA(0, 0), a2, 0, lastn);
            PG8_WAIT_V(8); PG8_WAIT_L(0); PG8_BAR; PG8_MMA(1, 0, At, B0); PG8_MMA(1, 1, At, B1); PG8_BAR; PG8_SCHED;
            PG8_LDB(B0, 1, 0); PG8_LDB(B1, 1, 1); PG8_SCHED; PG8_LDA(At, 1, 0); PG8_STAGE_A(PG8_SA(0, 1), a2, 1, lastn);
            PG8_WAIT_V(8); PG8_WAIT_L(0); PG8_BAR; PG8_MMA(0, 0, At, B0); PG8_MMA(0, 1, At, B1); PG8_BAR; PG8_SCHED;
            PG8_LDA(At, 1, 1); PG8_STAGE_B(PG8_SB(1, 0), b3); PG8_STAGE_B(PG8_SB(1, 1), b3 + hstepB); PG8_STAGE_A(PG8_SA(1, 0), a3, 0, lastn);
            PG8_WAIT_V(8); PG8_WAIT_L(0); PG8_BAR; PG8_MMA(1, 0, At, B0); PG8_MMA(1, 1, At, B1); PG8_BAR; PG8_SCHED;
        }
        if (wr == 0) PG8_BAR;
        { const int l_e = lane_id_v();
          E(acc, cur, wr, wc, l_e & 15, l_e >> 4); }
        if (!has_next) break;
#pragma unroll
        for (int a = 0; a < 2; ++a)
#pragma unroll
            for (int b = 0; b < 2; ++b)
#pragma unroll
                for (int m = 0; m < 4; ++m)
#pragma unroll
                    for (int n = 0; n < 2; ++n) acc[a][b][m][n] = (f32x4){0.f, 0.f, 0.f, 0.f};
        cur = nxt; cA = nA; cB = nB; ++ui;
        if (wr == 1) PG8_BAR;
    }
    PG8_WAIT_V(0);
    PG8_BAR;
#undef PG8_SA
#undef PG8_SB
#undef PG8_GLDS
#undef PG8_STAGE_B
#undef PG8_STAGE_A
#undef PG8_LDA
#undef PG8_LDB
#undef PG8_LD16
#undef PG8_LO
#undef PG8_HI
#undef PG8_MMA
#undef PG8_WAIT_V
#undef PG8_WAIT_L
#undef PG8_BAR
#undef PG8_SCHED
}
}

namespace att {
constexpr int KVBLK = 64, LDQKV = ACOLS;
constexpr int SHM_V = KVBLK * 128 * 2, SHM_K = KVBLK * 64 * 2, OFF_V = 0, OFF_K = 2 * SHM_V, OFF_WS = OFF_K + 2 * SHM_K, LDS_TOTAL = OFF_WS + 8 * 64 * 4;
constexpr float THR = 8.f;
#define KSWZ64(row, colB) ((row) * 128 + ((colB) ^ ((((row) >> 1) & 7) << 4)))
#define SBAR() __builtin_amdgcn_sched_barrier(0)
__device__ __forceinline__ int crow(int r, int hi) { return (r & 3) + 8 * (r >> 2) + 4 * hi; }
__device__ __forceinline__ unsigned cvtpk(float lo, float hi) { unsigned r; asm volatile("v_cvt_pk_bf16_f32 %0, %1, %2" : "=v"(r) : "v"(lo), "v"(hi)); return r; }
__device__ __forceinline__ int v_st(int k, int c) { const int kk = (k & ~0xC) | ((k & 4) << 1) | ((k & 8) >> 1); return ((kk >> 3) * 4 + (c >> 5)) * 512 + ((kk & 7) * 32 + (c & 31)) * 2; }
__device__ __forceinline__ int v_rd_base(int lane) { return ((lane & 3) << 3) | (((lane >> 2) & 3) << 6) | (((lane >> 4) & 1) << 5) | (((lane >> 5) & 1) << 8); }
constexpr int v_rd_off(int d0, int ks, int half) { return d0 * 512 + ks * 4096 + half * 2048; }
template <int OFF> __device__ __forceinline__ v4i16_t tr_read(int vb) { v4i16_t r; asm volatile("ds_read_b64_tr_b16 %0, %1 offset:%2" : "=&v"(r) : "v"(vb), "i"(OFF) : "memory"); return r; }
template <int D0> __device__ __forceinline__ void pv_one(f32x16& od, int vb, bf16x8 pa0, bf16x8 pa1, bf16x8 pa2, bf16x8 pa3) {
    const v4i16_t l0 = tr_read<v_rd_off(D0, 0, 0)>(vb), h0 = tr_read<v_rd_off(D0, 0, 1)>(vb), l1 = tr_read<v_rd_off(D0, 1, 0)>(vb), h1 = tr_read<v_rd_off(D0, 1, 1)>(vb);
    const v4i16_t l2 = tr_read<v_rd_off(D0, 2, 0)>(vb), h2 = tr_read<v_rd_off(D0, 2, 1)>(vb), l3 = tr_read<v_rd_off(D0, 3, 0)>(vb), h3 = tr_read<v_rd_off(D0, 3, 1)>(vb);
    asm volatile("s_waitcnt lgkmcnt(0)" ::: "memory"); SBAR();
#define PK(L, H) (bf16x8){L[0], L[1], L[2], L[3], H[0], H[1], H[2], H[3]}
    od = __builtin_amdgcn_mfma_f32_32x32x16_bf16(pa0, PK(l0, h0), od, 0, 0, 0);
    od = __builtin_amdgcn_mfma_f32_32x32x16_bf16(pa1, PK(l1, h1), od, 0, 0, 0);
    od = __builtin_amdgcn_mfma_f32_32x32x16_bf16(pa2, PK(l2, h2), od, 0, 0, 0);
    od = __builtin_amdgcn_mfma_f32_32x32x16_bf16(pa3, PK(l3, h3), od, 0, 0, 0);
#undef PK
}
__device__ __forceinline__ void pv_d0(f32x16* o, int vb, bf16x8 pa0, bf16x8 pa1, bf16x8 pa2, bf16x8 pa3) {
    pv_one<0>(o[0], vb, pa0, pa1, pa2, pa3); pv_one<1>(o[1], vb, pa0, pa1, pa2, pa3); pv_one<2>(o[2], vb, pa0, pa1, pa2, pa3); pv_one<3>(o[3], vb, pa0, pa1, pa2, pa3);
}
__device__ __forceinline__ void qkt(f32x16& p0, f32x16& p1, const char* Ks, const bf16x8* qr, const f32x16& negm, int r32, int hi, float dq, float slope2) {
#pragma unroll
    for (int d0 = 0; d0 < 4; ++d0) { const int cb = (d0 * 16 + hi * 8) * 2;
        const bf16x8 b0 = *reinterpret_cast<const bf16x8*>(Ks + KSWZ64(r32, cb));
        const bf16x8 b1 = *reinterpret_cast<const bf16x8*>(Ks + KSWZ64(32 + r32, cb));
        if (d0 == 0) { p0 = __builtin_amdgcn_mfma_f32_32x32x16_bf16(b0, qr[0], negm, 0, 0, 0); p1 = __builtin_amdgcn_mfma_f32_32x32x16_bf16(b1, qr[0], negm, 0, 0, 0); }
        else { p0 = __builtin_amdgcn_mfma_f32_32x32x16_bf16(b0, qr[d0], p0, 0, 0, 0); p1 = __builtin_amdgcn_mfma_f32_32x32x16_bf16(b1, qr[d0], p1, 0, 0, 0); } }
    asm volatile("" : "+v"(dq), "+v"(p0), "+v"(p1));
#pragma unroll
    for (int r = 0; r < 16; ++r) { const float cr = (float)((r & 3) + 8 * (r >> 2)); p0[r] = fmaf(-slope2, fabsf(dq - cr), p0[r]); p1[r] = fmaf(-slope2, fabsf(dq - 32.f - cr), p1[r]); }
}
__device__ __forceinline__ void partialSM(f32x16& p0, f32x16& p1, f32x16& negm, float& alpha) {
    float pmax = p0[0];
#pragma unroll
    for (int r = 1; r < 16; ++r) pmax = fmaxf(pmax, p0[r]);
#pragma unroll
    for (int r = 0; r < 16; ++r) pmax = fmaxf(pmax, p1[r]);
    { auto rr = __builtin_amdgcn_permlane32_swap(__float_as_uint(pmax), __float_as_uint(pmax), false, false); pmax = fmaxf(__uint_as_float(rr[0]), __uint_as_float(rr[1])); }
    if (__builtin_expect(!__any(pmax > THR), 1)) { alpha = 1.f; }
    else { const float dl = fmaxf(pmax, 0.f); alpha = __builtin_amdgcn_exp2f(-dl);
#pragma unroll
        for (int r = 0; r < 16; ++r) { p0[r] -= dl; p1[r] -= dl; negm[r] -= dl; } }
#pragma unroll
    for (int r = 0; r < 16; ++r) p0[r] = __builtin_amdgcn_exp2f(p0[r]);
}
__device__ __forceinline__ void finishSM(f32x16& p0, f32x16& p1, float alpha, float& l_reg, bf16x8& pa0, bf16x8& pa1, bf16x8& pa2, bf16x8& pa3) {
#pragma unroll
    for (int r = 0; r < 16; ++r) p1[r] = __builtin_amdgcn_exp2f(p1[r]);
    float ps = 0.f;
#pragma unroll
    for (int r = 0; r < 16; ++r) ps += p0[r];
#pragma unroll
    for (int r = 0; r < 16; ++r) ps += p1[r];
    { auto rr = __builtin_amdgcn_permlane32_swap(__float_as_uint(ps), __float_as_uint(ps), false, false); ps = __uint_as_float(rr[0]) + __uint_as_float(rr[1]); }
    l_reg = l_reg * alpha + ps;
#define PK4(P, BASE, OUT) do { const unsigned a0 = cvtpk(P[BASE + 0], P[BASE + 1]), a1 = cvtpk(P[BASE + 2], P[BASE + 3]), b0 = cvtpk(P[BASE + 4], P[BASE + 5]), b1 = cvtpk(P[BASE + 6], P[BASE + 7]); \
        auto r0 = __builtin_amdgcn_permlane32_swap(a0, b0, false, false); auto r1 = __builtin_amdgcn_permlane32_swap(a1, b1, false, false); \
        u32x4 w = {r0[0], r1[0], r0[1], r1[1]}; OUT = __builtin_bit_cast(bf16x8, w); } while (0)
    PK4(p0, 0, pa0); PK4(p0, 8, pa1); PK4(p1, 0, pa2); PK4(p1, 8, pa3);
#undef PK4
}
__device__ __forceinline__ void pass(f32x16 (&o)[4], const bf16_t* Qw, const bf16_t* Kh, const bf16_t* Vh, int qpos, int qb, float slope2, char* lds, int tid) {
    const int wid = tid >> 6, lane = tid & 63, r32 = lane & 31, hi = lane >> 5;
    char* V_lds = lds + OFF_V; char* K_lds = lds + OFF_K;
    float* ws = (float*)(lds + OFF_WS) + wid * 64; float* li_l = ws; float* al_l = ws + 32;
    float l_reg = 0.f; bf16x8 qr[4];
#pragma unroll
    for (int d = 0; d < 4; ++d)
#pragma unroll
        for (int r = 0; r < 16; ++r) o[d][r] = 0.f;
    f32x16 negm;
#pragma unroll
    for (int r = 0; r < 16; ++r) negm[r] = 0.f;
#pragma unroll
    for (int d0 = 0; d0 < 4; ++d0) qr[d0] = *reinterpret_cast<const bf16x8*>(Qw + d0 * 16);
    const int kr = tid >> 3, kc = (tid & 7) * 8, kst = KSWZ64(kr, kc * 2);
    const int sr = tid >> 4, sc = (tid & 15) * 8, vst0 = v_st(sr, sc), vst1 = v_st(32 + sr, sc);
    const int vb0 = (int)(uintptr_t)V_lds + v_rd_base(lane);
    const unsigned voff0 = (unsigned)(sr * LDQKV + sc), koff0 = (unsigned)(kr * LDQKV + kc);
    struct { bf16x8 vs0, vs1, ks; } st_[2];
    constexpr int NT = SEQ / KVBLK;
    const int nd = 4 * qb;
#define KT(i) ((i) < 4 ? nd + (i) : ((i) < 4 + nd ? nd + 3 - (i) : (i)))
#define SLOAD(i, tile) do { const unsigned k0_ = (unsigned)((tile) * KVBLK * LDQKV); st_[i].vs0 = *reinterpret_cast<const bf16x8*>(Vh + (k0_ + voff0)); st_[i].vs1 = *reinterpret_cast<const bf16x8*>(Vh + (k0_ + voff0 + 32u * LDQKV)); \
        st_[i].ks = *reinterpret_cast<const bf16x8*>(Kh + (k0_ + koff0)); } while (0)
#define SWRITE(b, i) do { *(bf16x8*)(V_lds + (b) * SHM_V + vst0) = st_[i].vs0; *(bf16x8*)(V_lds + (b) * SHM_V + vst1) = st_[i].vs1; *(bf16x8*)(K_lds + (b) * SHM_K + kst) = st_[i].ks; } while (0)
#define SWAIT() asm volatile("s_waitcnt vmcnt(3)" ::: "memory")
#define RESC(a) do { if (__any((a) < 1.f)) { if (hi == 0) al_l[r32] = (a); asm volatile("s_waitcnt lgkmcnt(0)" ::: "memory"); \
        _Pragma("unroll") for (int d = 0; d < 4; ++d) _Pragma("unroll") for (int r = 0; r < 16; ++r) o[d][r] *= al_l[crow(r, hi)]; } } while (0)
#define DQ(tile) ((float)(qpos - (tile) * KVBLK - 4 * hi))
    f32x16 pA0, pA1, pB0, pB1; float alA, alB; bf16x8 pa0, pa1, pa2, pa3;
    SLOAD(0, KT(0)); asm volatile("s_waitcnt vmcnt(0)" ::: "memory"); SWRITE(0, 0); __syncthreads();
    qkt(pA0, pA1, K_lds, qr, negm, r32, hi, DQ(KT(0)), slope2); partialSM(pA0, pA1, negm, alA);
    SLOAD(1, KT(1)); SLOAD(0, KT(2));
    SWAIT(); SWRITE(1, 1); __syncthreads();
    for (int j = 1; j + 1 < NT; j += 2) {
        SBAR(); qkt(pB0, pB1, K_lds + SHM_K, qr, negm, r32, hi, DQ(KT(j)), slope2);
        finishSM(pA0, pA1, alA, l_reg, pa0, pa1, pa2, pa3); SBAR();
        SLOAD(1, KT(j + 2)); SBAR();
        pv_d0(o, vb0, pa0, pa1, pa2, pa3); partialSM(pB0, pB1, negm, alB);
        __syncthreads(); SWAIT(); SWRITE(0, 0);
        RESC(alB); __syncthreads();
        SBAR(); qkt(pA0, pA1, K_lds, qr, negm, r32, hi, DQ(KT(j + 1)), slope2);
        finishSM(pB0, pB1, alB, l_reg, pa0, pa1, pa2, pa3); SBAR();
        if (j + 3 < NT) SLOAD(0, KT(j + 3)); SBAR();
        pv_d0(o, vb0 + SHM_V, pa0, pa1, pa2, pa3); partialSM(pA0, pA1, negm, alA);
        __syncthreads(); SWAIT(); SWRITE(1, 1);
        RESC(alA); __syncthreads();
    }
    SBAR(); qkt(pB0, pB1, K_lds + SHM_K, qr, negm, r32, hi, DQ(KT(NT - 1)), slope2);
    finishSM(pA0, pA1, alA, l_reg, pa0, pa1, pa2, pa3); SBAR();
    pv_d0(o, vb0, pa0, pa1, pa2, pa3); partialSM(pB0, pB1, negm, alB);
    __syncthreads(); RESC(alB);
    finishSM(pB0, pB1, alB, l_reg, pa0, pa1, pa2, pa3); SBAR();
    pv_d0(o, vb0 + SHM_V, pa0, pa1, pa2, pa3);
    if (hi == 0) li_l[r32] = l_reg; asm volatile("s_waitcnt lgkmcnt(0)" ::: "memory");
#pragma unroll
    for (int r = 0; r < 16; ++r) { const float rl = __builtin_amdgcn_rcpf(li_l[crow(r, hi)]);
#pragma unroll
        for (int d = 0; d < 4; ++d) o[d][r] *= rl; }
    __syncthreads();
#undef KT
#undef SLOAD
#undef SWRITE
#undef SWAIT
#undef RESC
#undef DQ
}
#undef SBAR
}

typedef GAS unsigned gu32;
#define XB_TMO      128
#define XB_XCNT(j)  (256  + 64 * (j))
#define XB_XSUB(j)  (1280 + 64 * (j))
#define XB_XGEN(j)  (2304 + 64 * (j))
#define XB_TOP      3328
#define XB_TOPGEN   3392
#define XCD_BAR_WORDS 3456
#define XB_SPIN_CAP (1u << 23)
__device__ __forceinline__ unsigned xb_ld(unsigned* p)              { return __hip_atomic_load(p, __ATOMIC_RELAXED, __HIP_MEMORY_SCOPE_AGENT); }
__device__ __forceinline__ unsigned xb_add(unsigned* p, unsigned v) { return __hip_atomic_fetch_add(p, v, __ATOMIC_RELAXED, __HIP_MEMORY_SCOPE_AGENT); }
__device__ __forceinline__ unsigned xb_xcc_id() { return (unsigned)__builtin_amdgcn_s_getreg((3 << 11) | 20) & 0xFu; }
#define XB_SPIN(cond, bar) do { unsigned _sp = 0; while (cond) { __builtin_amdgcn_s_sleep(1); \
    if ((++_sp & 255u) == 0u) { if (xb_ld(&(bar)[XB_TMO])) break; if (_sp > XB_SPIN_CAP) { atomicAdd(&(bar)[XB_TMO], 1u); break; } } } } while (0)
struct XcdBarrier { unsigned* bar; unsigned x; volatile LAS unsigned* st; int wave; };
__device__ __forceinline__ XcdBarrier xcd_barrier_post(unsigned* bar, volatile LAS unsigned* st, int wave) {
    XcdBarrier b; b.bar = bar; b.x = xb_xcc_id(); b.st = st; b.wave = wave;
    if (wave == 0 && lane_id_v() == 0) (void)xb_add(&bar[XB_XCNT(b.x)], 1u);
    return b;
}
__device__ __forceinline__ void xcd_barrier_complete(unsigned* bar, unsigned x, unsigned& nloc, unsigned& nx) {
    const unsigned G = gridDim.x * gridDim.y * gridDim.z;
    unsigned sum, cnt, mine, sp = 0u;
    for (;;) {
        sum = 0u; cnt = 0u; mine = 0u;
#pragma unroll
        for (unsigned j = 0; j < 16; ++j) { const unsigned c = xb_ld(&bar[XB_XCNT(j)]); sum += c; cnt += (c > 0u) ? 1u : 0u; mine = (j == x) ? c : mine; }
        if (sum == G) break;
        __builtin_amdgcn_s_sleep(1);
        if ((++sp & 255u) == 0u) { if (xb_ld(&bar[XB_TMO])) break; if (sp > XB_SPIN_CAP) { atomicAdd(&bar[XB_TMO], 1u); break; } }
    }
    nloc = mine > 0u ? mine : 1u; nx = cnt > 0u ? cnt : 1u;
}
__device__ __forceinline__ void xcd_barrier(const XcdBarrier& b) {
    asm volatile("s_waitcnt vmcnt(0)" ::: "memory");
    __syncthreads();
    if (b.wave == 0 && lane_id_v() == 0) {
        unsigned* bar = b.bar;
        __builtin_amdgcn_s_waitcnt(0);
        unsigned nloc = b.st[0], nx = b.st[1];
        if (nloc == 0u) { xcd_barrier_complete(bar, b.x, nloc, nx); b.st[0] = nloc; b.st[1] = nx; }
        const unsigned old = xb_add(&bar[XB_XSUB(b.x)], 1u);
        const unsigned gen = old / nloc;
        if (old + 1u == (gen + 1u) * nloc) {
            __builtin_amdgcn_fence(__ATOMIC_RELEASE, "agent");
            asm volatile("s_waitcnt vmcnt(0)" ::: "memory");
            const unsigned og = xb_add(&bar[XB_TOP], 1u);
            const unsigned tg = og / nx;
            if (og + 1u == (tg + 1u) * nx) xb_add(&bar[XB_TOPGEN], 1u);
            else XB_SPIN(xb_ld(&bar[XB_TOPGEN]) == tg, bar);
            __builtin_amdgcn_fence(__ATOMIC_ACQUIRE, "agent");
            xb_add(&bar[XB_XGEN(b.x)], 1u);
            asm volatile("s_waitcnt vmcnt(0)" ::: "memory");
        } else {
            XB_SPIN(xb_ld(&bar[XB_XGEN(b.x)]) == gen, bar);
            __builtin_amdgcn_fence(__ATOMIC_ACQUIRE, "agent");
            asm volatile("s_waitcnt vmcnt(0)" ::: "memory");
        }
    }
    __syncthreads();
}

template <bool F8>
__device__ __forceinline__ void p0_transpose_item(const float* W, int K, int N, void* WTv, int k0, int n0, int orow0, LAS float* scr, int lane) {
#pragma unroll
    for (int i = 0; i < 8; ++i) { const int kk = 8 * i + (lane >> 3), n4 = (lane & 7) * 4; const f32x4 v = *(const GAS f32x4*)(W + (size_t)(k0 + kk) * N + n0 + n4);
        LAS float* d = scr + kk * 33 + n4; d[0] = v.x; d[1] = v.y; d[2] = v.z; d[3] = v.w; }
    LDS_WAIT(); asm volatile("" ::: "memory");
    const int c = lane & 7;
#pragma unroll
    for (int j = 0; j < 4; ++j) { const int n = (lane >> 3) + 8 * j; const LAS float* s = scr + (8 * c) * 33 + n;
        if constexpr (F8) {
            int t0 = __builtin_amdgcn_cvt_pk_fp8_f32(s[0 * 33] * 32.f, s[1 * 33] * 32.f, 0, false); t0 = __builtin_amdgcn_cvt_pk_fp8_f32(s[2 * 33] * 32.f, s[3 * 33] * 32.f, t0, true);
            int t1 = __builtin_amdgcn_cvt_pk_fp8_f32(s[4 * 33] * 32.f, s[5 * 33] * 32.f, 0, false); t1 = __builtin_amdgcn_cvt_pk_fp8_f32(s[6 * 33] * 32.f, s[7 * 33] * 32.f, t1, true);
            *(GAS u32x2*)((unsigned char*)WTv + (size_t)(orow0 + n) * K + k0 + 8 * c) = (u32x2){(unsigned)t0, (unsigned)t1};
        } else {
            u32x4 o; o.x = pk2(s[0 * 33], s[1 * 33]); o.y = pk2(s[2 * 33], s[3 * 33]); o.z = pk2(s[4 * 33], s[5 * 33]); o.w = pk2(s[6 * 33], s[7 * 33]);
            *(GAS u32x4*)((bf16_t*)WTv + (size_t)(orow0 + n) * K + k0 + 8 * c) = o; } }
    LDS_WAIT(); asm volatile("" ::: "memory");
}

struct Args { const float* in[25]; float* out; unsigned char* ws; };

__global__ void __launch_bounds__(512, 2) mega_fwd(Args args) {
    extern __shared__ __attribute__((aligned(16))) unsigned char lds_raw[];
    LAS unsigned char* lds = (LAS unsigned char*)lds_raw;
    volatile LAS unsigned* MISC = (volatile LAS unsigned*)(lds + MISC_OFF);
    const int G = gridDim.x, bx = blockIdx.x, NGW = G * 8;
    const int wave_s = __builtin_amdgcn_readfirstlane(threadIdx.x >> 6);
    unsigned char* ws = args.ws;
    gu32* ctl = (gu32*)(ws + WS_CTL);
    const float* x = args.in[0];
    float* out = args.out;
    unsigned char* WGU = ws + WS_WGU; unsigned char* WD = ws + WS_WD; bf16_t* WIN = (bf16_t*)(ws + WS_WIN); bf16_t* WOUT = (bf16_t*)(ws + WS_WOUT);
    bf16_t* XN = (bf16_t*)(ws + WS_XN); unsigned char* H2 = ws + WS_H2; bf16_t* GF = (bf16_t*)(ws + WS_GF);
    bf16_t* HP = (bf16_t*)(ws + WS_HP); bf16_t* QKV = (bf16_t*)(ws + WS_QKV); bf16_t* HZ = (bf16_t*)(ws + WS_HZ); bf16_t* MIX = (bf16_t*)(ws + WS_MIX);
    unsigned char* ACT = ws + WS_ACT; bf16_t* Y = (bf16_t*)(ws + WS_Y);
    float* AFF = (float*)(ws + WS_AFF); int* TOK = (int*)(ws + WS_TOK); float* GSEL = (float*)(ws + WS_GSEL); unsigned short* INV = (unsigned short*)(ws + WS_INV);
    float* NSUM = (float*)(ws + WS_CTL) + CW_NSUM;

    if (wave_s == 0) ((LAS unsigned*)(lds + MISC_OFF))[lane_id_v()] = 0u;
    __syncthreads();
    XcdBarrier bar = xcd_barrier_post((unsigned*)(ctl + CW_BAR), MISC + 8, wave_s);

    {
        PHASE_IDS();
        LAS float* scr = (LAS float*)(lds + wave * 16384);
        constexpr int I_IN = (DM / 64) * (INC / 32), I_OUT = (DM / 64) * (DM / 32), I_GU = (DM / 64) * (FF / 32), I_DN = (FF / 64) * (DM / 32);
        constexpr int NITEMS = I_IN + I_OUT + NE * (2 * I_GU + I_DN);
        for (int rep_ = 0; rep_ < REP_P0W; ++rep_)
        for (int it = gw; it < NITEMS; it += NGW) {
            int r = it;
            if (r < I_IN) { const int nblk = INC / 32, kb = r / nblk, nb = r % nblk; p0_transpose_item<false>(args.in[2], DM, INC, WIN, 64 * kb, 32 * nb, 32 * nb, scr, lane); continue; } r -= I_IN;
            if (r < I_OUT) { const int nblk = DM / 32, kb = r / nblk, nb = r % nblk; p0_transpose_item<false>(args.in[18], DM, DM, WOUT, 64 * kb, 32 * nb, 32 * nb, scr, lane); continue; } r -= I_OUT;
            const int e = r / (2 * I_GU + I_DN); r -= e * (2 * I_GU + I_DN);
            if (r < 2 * I_GU) { const int up = r >= I_GU; if (up) r -= I_GU; const int nblk = FF / 32, kb = r / nblk, nb = r % nblk, f0 = 32 * nb;
                const int orow = (f0 >> 7) * 256 + up * 128 + (f0 & 127);
                p0_transpose_item<true>(args.in[up ? 22 : 21] + (size_t)e * DM * FF, DM, FF, WGU + (size_t)e * 2 * FF * DM, 64 * kb, f0, orow, scr, lane); continue; }
            r -= 2 * I_GU;
            { const int nblk = DM / 32, kb = r / nblk, nb = r % nblk; p0_transpose_item<true>(args.in[23] + (size_t)e * FF * DM, FF, DM, WD + (size_t)e * DM * FF, 64 * kb, 32 * nb, 32 * nb, scr, lane); }
        }
        const float* g = args.in[1];
        int rep_xn = REP_XN; asm volatile("" : "+s"(rep_xn));
        for (int rep_ = 0; rep_ < rep_xn; ++rep_)
        for (int m = gw; m < NTOK; m += NGW) {
            const GAS f32x4* xr = (const GAS f32x4*)(x + (size_t)m * DM) + lane;
            f32x4 v[4]; float s = 0.f;
#pragma unroll
            for (int j = 0; j < 4; ++j) { v[j] = xr[64 * j]; s += (v[j].x * v[j].x + v[j].y * v[j].y) + (v[j].z * v[j].z + v[j].w * v[j].w); }
            const float rstd = rsqrtf(wave_sum(s) * (1.f / DM) + EPS);
            GAS u32x2* o8 = (GAS u32x2*)(XN + (size_t)m * DM) + lane;
#pragma unroll
            for (int j = 0; j < 4; ++j) { const f32x4 gg = ((const GAS f32x4*)g)[lane + 64 * j]; u32x2 w; w.x = pk2(v[j].x * rstd * gg.x, v[j].y * rstd * gg.y); w.y = pk2(v[j].z * rstd * gg.z, v[j].w * rstd * gg.w); o8[64 * j] = w; }
        }
        __syncthreads();
        for (int it = bx; it < 256; it += G) {
            const int ib = it >> 2, dn = it & 3, dir = dn >> 1, n = dn & 1, i0 = ib * 64;
            LAS float* zz = (LAS float*)lds;
            LAS float* h1 = zz + 64 * 33;
            LAS float* h2 = h1 + 64 * 64;
            const float* w1 = args.in[5]; const float* b1 = args.in[6]; const float* w2 = args.in[7]; const float* b2 = args.in[8]; const float* w3 = args.in[9]; const float* fr = args.in[10];
            for (int q = tid; q < 64 * 33; q += 512) { const int p = q / 33, j = q % 33, i = i0 + p;
                const float t = (float)i / (float)(SEQ - 1), w = 6.283185307179586f * (float)i / (float)SEQ; float v;
                if (j == 0) v = t; else { const float band = 1e-4f + (float)((j - 1) & 15) * ((15.f - 1e-4f) / 15.f); v = (j <= 16) ? cosf(band * w) : -sinf(band * w); }
                zz[q] = v; }
            __syncthreads();
            for (int q = tid; q < 64 * 64; q += 512) { const int p = q >> 6, j = q & 63; float a = b1[j]; for (int k = 0; k < 33; ++k) a += zz[p * 33 + k] * w1[k * 64 + j]; h1[q] = sinf(fr[j] * a); }
            __syncthreads();
            for (int q = tid; q < 64 * 64; q += 512) { const int p = q >> 6, j = q & 63; float a = b2[j]; for (int k = 0; k < 64; ++k) a += h1[p * 64 + k] * w2[k * 64 + j]; h2[q] = sinf(fr[j] * a); }
            __syncthreads();
            const int c = tid, col = dn * 512 + c;
            const float mind = logf(1e-2f) / 1.5f, maxd = logf(1e-2f) / 0.3f;
            const float delta = fabsf(mind + (float)c * ((maxd - mind) / 511.f));
            bf16_t* gf = GF + (size_t)(n * 512 + c) * GLEN;
            float asum = 0.f;
            for (int p0 = 0; p0 < 64; p0 += 16) {
                float hv[16];
#pragma unroll
                for (int p = 0; p < 16; ++p) hv[p] = 0.f;
                for (int k = 0; k < 64; ++k) { const float wk = w3[k * 2048 + col];
#pragma unroll
                    for (int p = 0; p < 16; ++p) hv[p] += h2[(p0 + p) * 64 + k] * wk; }
#pragma unroll
                for (int p = 0; p < 16; ++p) { const int i = i0 + p0 + p; const float t = (float)i / (float)(SEQ - 1); const float h = hv[p] * expf(-t * delta);
                    const unsigned hb = f2bf(h); const float hr = __builtin_bit_cast(float, hb << 16);
                    if (dir == 0) { gf[GOFF - i] = (bf16_t)hb; asum += fabsf(hr); } else if (i > 0) { gf[GOFF + i] = (bf16_t)hb; asum += fabsf(hr); } }
            }
            if (ib == 63) { if (dir == 0) { for (int q = 0; q < GOFF - 4095; ++q) gf[q] = 0; } else { for (int q = GOFF + 4096; q < GLEN; ++q) gf[q] = 0; } }
            atomicAdd(&NSUM[n * 512 + c], asum);
            __syncthreads();
        }
    }
    xcd_barrier(bar);

    int rep_p1 = REP_P1; asm volatile("" : "+s"(rep_p1));
    for (int rep_ = 0; rep_ < rep_p1; ++rep_) {
    {
        pg8::GeoTokPerm S; S.A = WIN; S.X = XN; S.KB = DM * 2; S.ord.init(HCOLS / 256, NTOK / 256, G, bx);
        pg8::EpiBf16 E{HP, NTOK, 0, 1.f};
        pg8::gemm_phase<false>(lds, (LAS unsigned*)(lds + TBL_OFF), S, E, wave_s);
    }
    {
        pg8::GeoPlain S; S.A = XN; S.Bt = WIN + (size_t)HCOLS * DM; S.KB = DM * 2; S.ord.init(NTOK / 256, ACOLS / 256, G, bx);
        pg8::EpiBf16 E{QKV, ACOLS, 512, QSCALE};
        pg8::gemm_phase<false>(lds, (LAS unsigned*)(lds + TBL_OFF), S, E, wave_s);
    }
    }
    xcd_barrier(bar);

    {
        PHASE_IDS();
        {
            const float* conv_w = args.in[3]; const float* conv_b = args.in[4]; const float* skip = args.in[11];
            if (tid < 64) { const int bufi = tid >> 5, row = tid & 31, rr = row < 16 ? row : SEQ + row; *(LAS u32x4*)(lds + bufi * HY_ZBYTES + rr * 16) = (u32x4){0u, 0u, 0u, 0u}; }
            const int r32 = lane & 31, hi = lane >> 5;
            const int tr_lane = (2 * ((lane >> 4) & 1) + ((lane & 3) >> 1) + 8 * hi + ((lane & 15) >> 2)) * 16 + 8 * (lane & 1);
            int rep_hy = REP_HY; asm volatile("" : "+s"(rep_hy));
            for (int rep_ = 0; rep_ < rep_hy; ++rep_)
            for (int unit = bx; unit < HW; unit += G) {
                const int c = unit;
                __syncthreads();
                {
                    const int col = 1024 + c; const float w0 = conv_w[col], w1 = conv_w[HCOLS + col], w2 = conv_w[2 * HCOLS + col], cb = conv_b[col];
                    const bf16_t* hp = HP + (size_t)col * SEQ * 8;
#pragma unroll 2
                    for (int i = 0; i < 8; ++i) { const int t = tid + 512 * i;
                        const u32x4 z4 = (u32x4){0u, 0u, 0u, 0u};
                        const u32x4 pm = t > 0 ? *(const GAS u32x4*)(hp + (size_t)(t - 1) * 8) : z4, p0 = *(const GAS u32x4*)(hp + (size_t)t * 8), pp = t < SEQ - 1 ? *(const GAS u32x4*)(hp + (size_t)(t + 1) * 8) : z4;
                        u32x4 o;
#pragma unroll
                        for (int k = 0; k < 4; ++k) { const float lo = cb + w0 * bflo(pm[k]) + w1 * bflo(p0[k]) + w2 * bflo(pp[k]), hh = cb + w0 * bfhi(pm[k]) + w1 * bfhi(p0[k]) + w2 * bfhi(pp[k]); o[k] = pk2(lo, hh); }
                        *(LAS u32x4*)(lds + HY_ZA + (t + 16) * 16) = o; }
                }
                for (int n = 0; n < 2; ++n) {
                    {
                        const GAS u32x4* gsrc = (const GAS u32x4*)(GF + (size_t)(n * 512 + c) * GLEN);
                        for (int q = tid; q < GLEN * 2 / 16; q += 512) *(LAS u32x4*)(lds + HY_FB + q * 16) = gsrc[q];
                    }
                    __syncthreads();
                    f32x16 acc[2][2];
#pragma unroll
                    for (int a = 0; a < 2; ++a)
#pragma unroll
                        for (int b = 0; b < 2; ++b)
#pragma unroll
                            for (int k = 0; k < 16; ++k) acc[a][b][k] = 0.f;
                    const LAS unsigned char* za = lds + (n == 0 ? HY_ZA : HY_ZB) + tr_lane;
                    const LAS unsigned char* fbp = lds + HY_FB + 2 * GOFF - 32 + 16 * (hi - r32) - 512 * (2 * wave);
#define HY_STEP(OFFA, OFFB) do { \
                        const v4i16_t x0 = __builtin_amdgcn_ds_read_tr16_b64_v4i16((LAS v4i16_t*)(za + (OFFA))); \
                        const v4i16_t x1 = __builtin_amdgcn_ds_read_tr16_b64_v4i16((LAS v4i16_t*)(za + (OFFA) + 64)); \
                        const v4i16_t x2 = __builtin_amdgcn_ds_read_tr16_b64_v4i16((LAS v4i16_t*)(za + (OFFA) + 128)); \
                        const bf16x8 b0 = *(const LAS bf16x8*)(fbp + (OFFB)), b1 = *(const LAS bf16x8*)(fbp + (OFFB) - 512); \
                        const bf16x8 a0 = (bf16x8){x0[0], x0[1], x0[2], x0[3], x1[0], x1[1], x1[2], x1[3]}, a1 = (bf16x8){x1[0], x1[1], x1[2], x1[3], x2[0], x2[1], x2[2], x2[3]}; \
                        acc[0][0] = __builtin_amdgcn_mfma_f32_32x32x16_bf16(a0, b0, acc[0][0], 0, 0, 0); \
                        acc[0][1] = __builtin_amdgcn_mfma_f32_32x32x16_bf16(a1, b0, acc[0][1], 0, 0, 0); \
                        acc[1][0] = __builtin_amdgcn_mfma_f32_32x32x16_bf16(a0, b1, acc[1][0], 0, 0, 0); \
                        acc[1][1] = __builtin_amdgcn_mfma_f32_32x32x16_bf16(a1, b1, acc[1][1], 0, 0, 0); } while (0)
#pragma clang loop unroll(disable)
                    for (int c4 = 0; c4 < 64; ++c4) {
                        HY_STEP(0, 0); HY_STEP(256, 32); HY_STEP(512, 64); HY_STEP(768, 96);
                        za += 1024; fbp += 128;
                    }
                    HY_STEP(0, 0);
#undef HY_STEP
                    const int gcol = n * 512 + c; const float w0 = conv_w[gcol], w1 = conv_w[HCOLS + gcol], w2 = conv_w[2 * HCOLS + gcol], cb = conv_b[gcol];
                    const float inv = 1.f / NSUM[n * 512 + c], sk = skip[n * 512 + c];
                    const bf16_t* hp = HP + (size_t)gcol * SEQ * 8 + 4 * hi;
                    const LAS unsigned char* zin = lds + (n == 0 ? HY_ZA : HY_ZB) + 8 * hi;
#pragma unroll
                    for (int sp = 0; sp < 2; ++sp) {
                        const int tb = 256 * (2 * wave + sp) + 8 * r32;
                        u32x2 P[10];
#pragma unroll
                        for (int k = 0; k < 10; ++k) { const int tq = tb - 1 + k; P[k] = (tq >= 0 && tq < SEQ) ? *(const GAS u32x2*)(hp + (size_t)tq * 8) : (u32x2){0u, 0u}; }
#pragma unroll
                        for (int tt = 0; tt < 8; ++tt) {
                            const int t = tb + tt; const u32x2 zi = *(const LAS u32x2*)(zin + (t + 16) * 16);
                            const float zv[4] = {bflo(zi.x), bfhi(zi.x), bflo(zi.y), bfhi(zi.y)};
                            const float pm[4] = {bflo(P[tt].x), bfhi(P[tt].x), bflo(P[tt].y), bfhi(P[tt].y)};
                            const float pc[4] = {bflo(P[tt + 1].x), bfhi(P[tt + 1].x), bflo(P[tt + 1].y), bfhi(P[tt + 1].y)};
                            const float pp[4] = {bflo(P[tt + 2].x), bfhi(P[tt + 2].x), bflo(P[tt + 2].y), bfhi(P[tt + 2].y)};
                            float zo[4];
#pragma unroll
                            for (int bb = 0; bb < 4; ++bb) { const float gate = cb + w0 * pm[bb] + w1 * pc[bb] + w2 * pp[bb]; zo[bb] = gate * (acc[sp][tt >> 2][(tt & 3) * 4 + bb] * inv + sk * zv[bb]); }
                            u32x2 w; w.x = pk2(zo[0], zo[1]); w.y = pk2(zo[2], zo[3]);
                            if (n == 0) *(LAS u32x2*)(lds + HY_ZB + (t + 16) * 16 + 8 * hi) = w;
                            else *(GAS u32x2*)(HZ + ((size_t)c * SEQ + t) * 8 + 4 * hi) = w;
                        }
                    }
                    __syncthreads();
                }
            }
        }
        __syncthreads();
        {
            const int wid = wave, r32 = lane & 31, hi = lane >> 5;
            for (int rep_ = 0; rep_ < REP_AT; ++rep_)
            for (int unit = bx; unit < NB * 4 * 16; unit += G) {
                const int qb = unit & 15, h = (unit >> 4) & 3, b = unit >> 6, q0 = qb * 256;
                const bf16_t* pb = QKV + (size_t)b * SEQ * ACOLS;
                const float slope2 = exp2f(-2.f * (float)(h + 1)) * LOG2E;
                const int l_u = lane_id_v(), r32u = l_u & 31, hiu = l_u >> 5;
                const int qpos = q0 + wid * 32 + r32u;
                f32x16 o[4];
#pragma clang loop unroll(disable)
                for (int mp = 0; mp < 2; ++mp) {
                    att::pass(o, pb + (size_t)qpos * ACOLS + h * 128 + mp * 64 + hiu * 8, pb + 512 + h * 128 + mp * 64, pb + 1024 + h * 128, qpos, qb, slope2, (char*)lds_raw, tid);
                    if (mp == 0) {
                        int z2 = 0; asm volatile("" : "+s"(z2));
                        GAS f32x4* pk = (GAS f32x4*)((float*)(ws + WS_PARK) + (size_t)(bx * 8 + wid) * 4096 + lane * 64 + z2);
#pragma unroll
                        for (int d = 0; d < 4; ++d)
#pragma unroll
                            for (int k = 0; k < 4; ++k) pk[d * 4 + k] = (f32x4){o[d][4 * k], o[d][4 * k + 1], o[d][4 * k + 2], o[d][4 * k + 3]};
                    }
                    __builtin_amdgcn_sched_barrier(0);
                }
                asm volatile("s_waitcnt vmcnt(0)" ::: "memory");
                int zz = 0; asm volatile("" : "+s"(zz));
                float lam;
                { float s1 = 0.f, s2 = 0.f; for (int i = 0; i < 64; ++i) { s1 += args.in[13][i + zz] * args.in[14][i + zz]; s2 += args.in[15][i + zz] * args.in[16][i + zz]; } lam = expf(s1) - expf(s2) + 0.2f; }
                const float* subg = args.in[17] + zz;
                int lane_c = lane; asm volatile("" : "+v"(lane_c)); const int r32c = lane_c & 31, hic = lane_c >> 5;
                {
                    const GAS f32x4* pk = (const GAS f32x4*)((float*)(ws + WS_PARK) + (size_t)(bx * 8 + wid) * 4096 + lane_c * 64 + zz);
#pragma unroll
                    for (int d = 0; d < 4; ++d)
#pragma unroll
                        for (int k = 0; k < 4; ++k) { const f32x4 pv = pk[d * 4 + k];
#pragma unroll
                            for (int q = 0; q < 4; ++q) o[d][4 * k + q] = pv[q] - lam * o[d][4 * k + q]; }
                }
#pragma unroll
                for (int r = 0; r < 16; ++r) {
                    float ss = 0.f;
#pragma unroll
                    for (int d = 0; d < 4; ++d) ss += o[d][r] * o[d][r];
                    ss += __shfl_xor(ss, 1); ss += __shfl_xor(ss, 2); ss += __shfl_xor(ss, 4); ss += __shfl_xor(ss, 8); ss += __shfl_xor(ss, 16);
                    const float rs = rsqrtf(ss * (1.f / 128.f) + EPS) * 0.8f;
                    bf16_t* op = MIX + ((size_t)b * SEQ + q0 + wid * 32 + att::crow(r, hic)) * DM + 512 + h * 128 + r32c;
#pragma unroll
                    for (int d = 0; d < 4; ++d) op[d * 32] = (bf16_t)f2bf(o[d][r] * rs * subg[d * 32 + r32c]);
                }
            }
        }
    }
    xcd_barrier(bar);

    {
        PHASE_IDS();
        const float* hg = args.in[12];
        LAS unsigned short* tile = (LAS unsigned short*)lds;
        LAS float* rs = (LAS float*)(lds + 32768);
        int rep_3a = REP_P3A; asm volatile("" : "+s"(rep_3a));
        for (int rep_ = 0; rep_ < rep_3a; ++rep_)
        for (int it = bx; it < 8 * 128; it += G) {
            const int g = it & 7, tb = it >> 3, t0 = tb * 32;
            __syncthreads();
            for (int q = tid; q < 64 * 32; q += 512) { const int ch = q >> 5, seg = q & 31;
                const u32x4 v = *(const GAS u32x4*)(HZ + ((size_t)(g * 64 + ch) * SEQ + t0 + seg) * 8);
                *(LAS u32x4*)(tile + ch * 256 + seg * 8) = v; }
            __syncthreads();
            if (tid < 256) { float s = 0.f; for (int ch = 0; ch < 64; ++ch) { const float v = bf2f(tile[ch * 256 + tid]); s += v * v; } rs[tid] = rsqrtf(s * (1.f / 64.f) + EPS); }
            __syncthreads();
            for (int q = tid; q < 256 * 8; q += 512) { const int tk = q >> 3, c8 = (q & 7) * 8;
                const float r = rs[tk]; const int t = t0 + (tk >> 3), b = tk & 7;
                float v[8];
#pragma unroll
                for (int j = 0; j < 8; ++j) v[j] = bf2f(tile[(c8 + j) * 256 + tk]) * r * hg[g * 64 + c8 + j];
                u32x4 w; w.x = pk2(v[0], v[1]); w.y = pk2(v[2], v[3]); w.z = pk2(v[4], v[5]); w.w = pk2(v[6], v[7]);
                *(GAS u32x4*)(MIX + ((size_t)b * SEQ + t) * DM + g * 64 + c8) = w; }
        }
        __syncthreads();
    }
    xcd_barrier(bar);

    {
        pg8::GeoPlain S; S.A = MIX; S.Bt = WOUT; S.KB = DM * 2; S.ord.init(NTOK / 256, DM / 256, G, bx);
        pg8::EpiResF32 E{x, out, DM};
        for (int rep_ = 0; rep_ < REP_P3B; ++rep_) pg8::gemm_phase<false>(lds, (LAS unsigned*)(lds + TBL_OFF), S, E, wave_s);
    }
    xcd_barrier(bar);

    {
        PHASE_IDS();
        const float* g = args.in[19]; const float* wr = args.in[20];
        LAS float* gwl = (LAS float*)lds;
        for (int q = tid; q < DM * 4; q += 512) { const f32x4 w4 = ((const GAS f32x4*)wr)[q]; const float gd = g[q >> 2]; *(LAS f32x4*)(gwl + (q >> 2) * 20 + (q & 3) * 4) = w4 * gd; }
        __syncthreads();
        const int i16 = lane & 15, q4 = lane >> 4;
        int rep_4a = REP_P4A; asm volatile("" : "+s"(rep_4a));
        for (int rep_ = 0; rep_ < rep_4a; ++rep_)
        for (int grp = gw; grp < NTOK / 16; grp += NGW) {
            const int tok0 = grp * 16;
            const float* xrow = out + (size_t)(tok0 + i16) * DM + 4 * q4;
            const LAS float* bp = gwl + (4 * q4) * 20 + i16;
            f32x4 acc = (f32x4){0.f, 0.f, 0.f, 0.f}; float ss = 0.f;
#pragma unroll 8
            for (int kk = 0; kk < 64; ++kk) {
                const f32x4 a = *(const GAS f32x4*)(xrow + 16 * kk);
                ss += (a.x * a.x + a.y * a.y) + (a.z * a.z + a.w * a.w);
                const LAS float* b = bp + kk * 320;
                acc = __builtin_amdgcn_mfma_f32_16x16x4f32(a.x, b[0], acc, 0, 0, 0);
                acc = __builtin_amdgcn_mfma_f32_16x16x4f32(a.y, b[20], acc, 0, 0, 0);
                acc = __builtin_amdgcn_mfma_f32_16x16x4f32(a.z, b[40], acc, 0, 0, 0);
                acc = __builtin_amdgcn_mfma_f32_16x16x4f32(a.w, b[60], acc, 0, 0, 0);
            }
            ss += __shfl_xor(ss, 16); ss += __shfl_xor(ss, 32);
            const float r = rsqrtf(ss * (1.f / DM) + EPS);
            f32x4 af;
#pragma unroll
            for (int reg = 0; reg < 4; ++reg) {
                const float lg = acc[reg] * __shfl(r, 4 * q4 + reg);
                float mx = lg; mx = fmaxf(mx, __shfl_xor(mx, 1)); mx = fmaxf(mx, __shfl_xor(mx, 2)); mx = fmaxf(mx, __shfl_xor(mx, 4)); mx = fmaxf(mx, __shfl_xor(mx, 8));
                const float ex = expf(lg - mx); float den = ex; den += __shfl_xor(den, 1); den += __shfl_xor(den, 2); den += __shfl_xor(den, 4); den += __shfl_xor(den, 8);
                af[reg] = ex / den;
            }
            const int b = tok0 >> 12, t0 = tok0 & 4095;
            *(GAS f32x4*)(AFF + ((size_t)i16 * NB + b) * SEQ + t0 + 4 * q4) = af;
            *(GAS u32x2*)(INV + (size_t)tok0 * 16 + lane * 4) = (u32x2){0xffffffffu, 0xffffffffu};
            for (int i = 0; i < 16; ++i) {
                const float ri = __shfl(r, i);
                const GAS f32x4* xr = (const GAS f32x4*)(out + (size_t)(tok0 + i) * DM) + lane;
                GAS unsigned* o4 = (GAS unsigned*)(H2 + (size_t)(tok0 + i) * DM) + lane;
#pragma unroll
                for (int j = 0; j < 4; ++j) { const f32x4 v = xr[64 * j]; const f32x4 gg = ((const GAS f32x4*)g)[lane + 64 * j];
                    int t = __builtin_amdgcn_cvt_pk_fp8_f32(v.x * ri * gg.x, v.y * ri * gg.y, 0, false); t = __builtin_amdgcn_cvt_pk_fp8_f32(v.z * ri * gg.z, v.w * ri * gg.w, t, true); o4[64 * j] = (unsigned)t; }
            }
        }
        __syncthreads();
    }
    xcd_barrier(bar);

    {
        PHASE_IDS();
        LAS unsigned* hist = (LAS unsigned*)lds; LAS unsigned* scan = hist + 256; LAS unsigned* selw = scan + 512;
        int rep_4b = REP_P4B; asm volatile("" : "+s"(rep_4b));
        for (int rep_ = 0; rep_ < rep_4b; ++rep_)
        for (int eb = bx; eb < NE * NB; eb += G) {
            const int b = eb & 7, e = eb >> 3;
            const float* a = AFF + (size_t)eb * SEQ;
            unsigned v[8];
#pragma unroll
            for (int j = 0; j < 8; ++j) v[j] = __float_as_uint(a[tid * 8 + j]);
            unsigned prefix = 0, mask = 0, need = CAP;
            __syncthreads();
            for (int pass = 0; pass < 4; ++pass) {
                const int shift = 24 - 8 * pass;
                if (tid < 256) hist[tid] = 0;
                __syncthreads();
#pragma unroll
                for (int j = 0; j < 8; ++j) if ((v[j] & mask) == prefix) atomicAdd((unsigned*)&hist[(v[j] >> shift) & 255u], 1u);
                __syncthreads();
                if (tid < 256) scan[tid] = hist[tid];
                __syncthreads();
                for (int off = 1; off < 256; off <<= 1) { const unsigned xx = (tid < 256 && tid + off < 256) ? scan[tid + off] : 0u; __syncthreads(); if (tid < 256) scan[tid] += xx; __syncthreads(); }
                if (tid < 256) { const unsigned above = tid < 255 ? scan[tid + 1] : 0u; if (above < need && need <= scan[tid]) { selw[0] = (unsigned)tid; selw[1] = need - above; } }
                __syncthreads();
                prefix |= selw[0] << shift; mask |= 255u << shift; need = selw[1];
                __syncthreads();
            }
            unsigned cg = 0, ce = 0;
#pragma unroll
            for (int j = 0; j < 8; ++j) { cg += v[j] > prefix; ce += v[j] == prefix; }
            scan[tid] = (cg << 16) | ce;
            __syncthreads();
            for (int off = 1; off < 512; off <<= 1) { const unsigned xx = tid >= off ? scan[tid - off] : 0u; __syncthreads(); scan[tid] += xx; __syncthreads(); }
            const unsigned incl = scan[tid]; unsigned pg = (incl >> 16) - cg, pe = (incl & 0xffffu) - ce;
#pragma unroll
            for (int j = 0; j < 8; ++j) {
                const bool isg = v[j] > prefix, ise = v[j] == prefix;
                if (isg || (ise && pe < need)) {
                    const unsigned pos = pg + (pe < need ? pe : need); const int token = b * SEQ + tid * 8 + j;
                    TOK[(size_t)eb * CAP + pos] = token; GSEL[(size_t)eb * CAP + pos] = __uint_as_float(v[j]); INV[(size_t)token * 16 + e] = (unsigned short)pos;
                }
                pg += isg; pe += ise;
            }
            __syncthreads();
        }
    }
    xcd_barrier(bar);

    {
        pg8::GeoExpert<true> S; S.A = H2; S.Bt = WGU; S.KB = DM; S.bexp = (size_t)2 * FF * DM; S.tok = TOK; S.ord.init(NSLOT / 256, 2 * FF / 256, G, bx);
        pg8::EpiSwiGLU E{ACT, FF};
        for (int rep_ = 0; rep_ < REP_P5; ++rep_) pg8::gemm_phase<true>(lds, (LAS unsigned*)(lds + TBL_OFF), S, E, wave_s);
    }
    xcd_barrier(bar);

    {
        pg8::GeoExpert<false> S; S.A = ACT; S.Bt = WD; S.KB = FF; S.bexp = (size_t)DM * FF; S.tok = nullptr; S.ord.init(NSLOT / 256, DM / 256, G, bx);
        pg8::EpiBf16 E{Y, DM, 0, 1.f};
        for (int rep_ = 0; rep_ < REP_P6; ++rep_) pg8::gemm_phase<true>(lds, (LAS unsigned*)(lds + TBL_OFF), S, E, wave_s);
    }
    xcd_barrier(bar);

    {
        PHASE_IDS();
        const float* g = args.in[24];
        for (int m = gw; m < NTOK; m += NGW) {
            const GAS f32x4* xr = (const GAS f32x4*)(out + (size_t)m * DM) + lane;
            f32x4 v[4];
#pragma unroll
            for (int j = 0; j < 4; ++j) v[j] = xr[64 * j];
            const int b = m >> 12;
            const unsigned short myinv = INV[(size_t)m * 16 + (lane & 15)];
            for (int e = 0; e < 16; ++e) {
                const unsigned s = (unsigned)__shfl((int)myinv, e);
                if (s != 0xffffu) {
                    const size_t slot = ((size_t)e * NB + b) * CAP + s;
                    const float gv = GSEL[slot];
                    const GAS u32x2* yr = (const GAS u32x2*)(Y + slot * DM) + lane;
#pragma unroll
                    for (int j = 0; j < 4; ++j) { const u32x2 w = yr[64 * j]; v[j].x += gv * bflo(w.x); v[j].y += gv * bfhi(w.x); v[j].z += gv * bflo(w.y); v[j].w += gv * bfhi(w.y); }
                }
            }
            float s = 0.f;
#pragma unroll
            for (int j = 0; j < 4; ++j) s += (v[j].x * v[j].x + v[j].y * v[j].y) + (v[j].z * v[j].z + v[j].w * v[j].w);
            const float r = rsqrtf(wave_sum(s) * (1.f / DM) + EPS);
            GAS f32x4* o = (GAS f32x4*)(out + (size_t)m * DM) + lane;
#pragma unroll
            for (int j = 0; j < 4; ++j) { const f32x4 gg = ((const GAS f32x4*)g)[lane + 64 * j]; o[64 * j] = (f32x4){v[j].x * r * gg.x, v[j].y * r * gg.y, v[j].z * r * gg.z, v[j].w * r * gg.w}; }
        }
    }
}

extern "C" void kernel_launch(void* const* d_in, const int* in_sizes, int n_in, void* d_out, int out_size, void* d_ws, size_t ws_size, hipStream_t stream) {
    static int grid = 0;
    if (grid == 0) {
        if (n_in != 25 || ws_size < WS_END) { fprintf(stderr, "kernel_launch: unexpected n_in %d / ws %zu\n", n_in, ws_size); grid = -1; return; }
        int dev = 0, cus = 0;
        if (hipGetDevice(&dev) != hipSuccess || hipDeviceGetAttribute(&cus, hipDeviceAttributeMultiprocessorCount, dev) != hipSuccess) { grid = -1; return; }
        if (hipFuncSetAttribute((const void*)mega_fwd, hipFuncAttributeMaxDynamicSharedMemorySize, LDS_BYTES) != hipSuccess) { fprintf(stderr, "kernel_launch: hipFuncSetAttribute failed\n"); grid = -1; return; }
        int per_cu = 0;
        if (hipOccupancyMaxActiveBlocksPerMultiprocessor(&per_cu, (const void*)mega_fwd, 512, LDS_BYTES) != hipSuccess || per_cu < 1) fprintf(stderr, "kernel_launch: occupancy query says %d\n", per_cu);
        (void)hipGetLastError();
        grid = cus;
    }
    if (grid < 0) return;
    (void)hipMemsetAsync((char*)d_ws + WS_CTL, 0, CTL_BYTES, stream);
    Args a; memset(&a, 0, sizeof a);
    for (int i = 0; i < 25; ++i) a.in[i] = (const float*)d_in[i];
    a.out = (float*)d_out; a.ws = (unsigned char*)d_ws;
    hipLaunchKernelGGL(mega_fwd, dim3(grid), dim3(512), LDS_BYTES, stream, a);
}
```

```cpp
#include <hip/hip_runtime.h>
#include <cstdio>
#include <cstdint>
#include <cstring>

#define GAS __attribute__((address_space(1)))
#define LAS __attribute__((address_space(3)))
typedef unsigned short bf16_t;
typedef short bf16x8 __attribute__((ext_vector_type(8)));
typedef float f32x4 __attribute__((ext_vector_type(4)));
typedef float f32x2 __attribute__((ext_vector_type(2)));
typedef unsigned u32x4 __attribute__((ext_vector_type(4)));
typedef unsigned u32x2 __attribute__((ext_vector_type(2)));
typedef short v4i16_t __attribute__((ext_vector_type(4)));
typedef int i32x4 __attribute__((ext_vector_type(4)));
typedef int i32x8 __attribute__((ext_vector_type(8)));
constexpr int F8_SCALES = 127 | (122 << 8);
typedef float f32x16 __attribute__((ext_vector_type(16)));

constexpr int DM = 1024, NB = 8, SEQ = 4096, NTOK = NB * SEQ;
constexpr int HW = 512, HCOLS = 1536, INC = 3072, ACOLS = 1536;
constexpr int NE = 16, CAP = 512, FF = 2816, NSLOT = NE * NB * CAP;
constexpr float EPS = 1e-6f;
constexpr float LOG2E = 1.4426950408889634f;
constexpr float QSCALE = 0.125f * LOG2E;
constexpr int GOFF = 4352, GLEN = 8704;

constexpr size_t MiB = 1u << 20;
constexpr size_t WS_CTL = 0, CTL_BYTES = 1 * MiB;
constexpr size_t WS_WGU = 2 * MiB;
constexpr size_t WS_WD = 90 * MiB;
constexpr size_t WS_AFF = 134 * MiB;
constexpr size_t WS_TOK = 136 * MiB;
constexpr size_t WS_GSEL = WS_TOK + 256 * 1024;
constexpr size_t WS_INV = 137 * MiB;
constexpr size_t WS_XN = 138 * MiB;
constexpr size_t WS_H2 = WS_XN;
constexpr size_t WS_WIN = 202 * MiB;
constexpr size_t WS_WOUT = 208 * MiB;
constexpr size_t WS_GF = 210 * MiB;
constexpr size_t WS_HP = 228 * MiB;
constexpr size_t WS_QKV = 324 * MiB;
constexpr size_t WS_ACT = 228 * MiB;
constexpr size_t WS_HZ = 420 * MiB;
constexpr size_t WS_MIX = 452 * MiB;
constexpr size_t WS_PARK = 516 * MiB;
constexpr size_t WS_Y = 420 * MiB;
constexpr size_t WS_END = 548 * MiB;
constexpr int CW_BAR = 4096;
constexpr int CW_NSUM = 16384;

constexpr int REP_XN = 1, REP_P3A = 1, REP_P4A = 1, REP_P4B = 1;
constexpr int REP_P0W = 1, REP_P1 = 1, REP_HY = 1, REP_AT = 1, REP_P3B = 1, REP_P5 = 1, REP_P6 = 1;
constexpr int LDS_BYTES = 160 * 1024;
constexpr int MISC_OFF = LDS_BYTES - 256;
constexpr int HY_ZBYTES = (SEQ + 32) * 16, HY_ZA = 0, HY_ZB = HY_ZBYTES, HY_FB = 2 * HY_ZBYTES;
constexpr int TBL_OFF = 131072;

__device__ __forceinline__ unsigned f2bf(float f) { unsigned u = __builtin_bit_cast(unsigned, f); return (u + 0x7fffu + ((u >> 16) & 1u)) >> 16; }
__device__ __forceinline__ unsigned pk2(float lo, float hi) { return f2bf(lo) | (f2bf(hi) << 16); }
__device__ __forceinline__ float bf2f(unsigned short h) { return __builtin_bit_cast(float, (unsigned)h << 16); }
__device__ __forceinline__ float bflo(unsigned w) { return __builtin_bit_cast(float, w << 16); }
__device__ __forceinline__ float bfhi(unsigned w) { return __builtin_bit_cast(float, w & 0xffff0000u); }
template <int M> __device__ __forceinline__ float sx(float v) { static_assert(M >= 1 && M <= 16, "sx: xor mask 1..16"); return __int_as_float(__builtin_amdgcn_ds_swizzle(__float_as_int(v), (M << 10) | 0x1f)); }
__device__ __forceinline__ float sum32x(float v) { auto r = __builtin_amdgcn_permlane32_swap(__float_as_uint(v), __float_as_uint(v), false, false); return __uint_as_float(r[0]) + __uint_as_float(r[1]); }
__device__ __forceinline__ float max32x(float v) { auto r = __builtin_amdgcn_permlane32_swap(__float_as_uint(v), __float_as_uint(v), false, false); return fmaxf(__uint_as_float(r[0]), __uint_as_float(r[1])); }
__device__ __forceinline__ float lane_read(float v, int src) { return __int_as_float(__builtin_amdgcn_ds_bpermute(src << 2, __float_as_int(v))); }
__device__ __forceinline__ int lane_read_i(int v, int src) { return __builtin_amdgcn_ds_bpermute(src << 2, v); }
__device__ __forceinline__ float wave_sum(float v) { v += sx<1>(v); v += sx<2>(v); v += sx<4>(v); v += sx<8>(v); v += sx<16>(v); return sum32x(v); }
__device__ __forceinline__ float wave_max(float v) { v = fmaxf(v, sx<1>(v)); v = fmaxf(v, sx<2>(v)); v = fmaxf(v, sx<4>(v)); v = fmaxf(v, sx<8>(v)); v = fmaxf(v, sx<16>(v)); return max32x(v); }
#define LDS_WAIT() asm volatile("s_waitcnt lgkmcnt(0)" ::: "memory")
__device__ __forceinline__ int lane_id_v() { int l; asm volatile("v_mbcnt_lo_u32_b32 %0, -1, 0\n\tv_mbcnt_hi_u32_b32 %0, -1, %0" : "=v"(l)); return l; }
#define PHASE_IDS() const int wave = wave_s; int tid_o = wave_s * 64 + lane_id_v(); asm volatile("" : "+v"(tid_o)); const int tid = tid_o, lane = tid & 63, gw = blockIdx.x * 8 + wave; (void)lane; (void)gw

namespace pg8 {
constexpr int BM = 256, BK = 64, HALF = 128, HTB = HALF * BK * 2, STAGE_BYTES = 8 * HTB, NXCD = 8, WGM = 8;
__host__ __device__ __forceinline__ int lds_byte(int r, int c) { const int st = (r >> 4) * 2 + (c >> 5), rr = r & 15, cc = c & 31, ob = rr * 64 + cc * 2; return st * 1024 + (ob ^ (((ob >> 9) & 1) << 5)); }
__host__ __device__ __forceinline__ void stage_rc(int b, int& R, int& C) { const int st = b / 1024, sb = b % 1024, swz = sb ^ (((sb >> 9) & 1) << 5); R = (st >> 1) * 16 + swz / 64; C = (st & 1) * 32 + (swz % 64) / 2; }
__host__ __device__ __forceinline__ int perm32(int rho) { const int n = rho >> 4, i = rho & 15; return 8 * (i >> 2) + 4 * n + (i & 3); }
struct Unit { int pm, pn; };

struct TileOrder {
    int nM, nN, nwg, G, c;
    __device__ void init(int nM_, int nN_, int G_, int c_) { nM = nM_; nN = nN_; nwg = nM * nN; G = G_; c = c_; }
    __device__ bool next(int i, Unit& u) const {
        const long L = (long)i * G + c; if (L >= nwg) return false;
        int wgid = (int)L; { const int q = nwg / NXCD, r = nwg % NXCD, xcd = wgid % NXCD, off = wgid / NXCD; wgid = (xcd < r ? xcd * (q + 1) : r * (q + 1) + (xcd - r) * q) + off; }
        const int nig = WGM * nN, gid = wgid / nig, fm = gid * WGM, gsz = (nM - fm) < WGM ? (nM - fm) : WGM;
        u.pm = fm + ((wgid % nig) % gsz); u.pn = (wgid % nig) / gsz; return true;
    }
};
__device__ __forceinline__ unsigned cvt_pk_bf16(float lo, float hi) { unsigned r; asm volatile("v_cvt_pk_bf16_f32 %0, %1, %2" : "=v"(r) : "v"(lo), "v"(hi)); return r; }

struct EpiBf16 {
    static constexpr bool PERM = true;
    bf16_t* O; int ldc; int scols; float sc;
    __device__ __forceinline__ void operator()(const f32x4 (&acc)[2][2][4][2], const Unit& u, int wr, int wc, int fr, int fq) const {
        const int row0 = u.pm * BM + wr * 64 + fr, col0 = u.pn * BM + wc * 32 + 8 * fq;
        const float s = (u.pn * BM < scols) ? sc : 1.f;
#pragma unroll
        for (int ai = 0; ai < 2; ++ai)
#pragma unroll
            for (int m = 0; m < 4; ++m) { bf16_t* rowp = O + (size_t)(row0 + ai * HALF + m * 16) * ldc + col0;
#pragma unroll
                for (int bj = 0; bj < 2; ++bj) { const f32x4 v0 = acc[ai][bj][m][0] * s, v1 = acc[ai][bj][m][1] * s;
                    u32x4 w; w.x = cvt_pk_bf16(v0[0], v0[1]); w.y = cvt_pk_bf16(v0[2], v0[3]); w.z = cvt_pk_bf16(v1[0], v1[1]); w.w = cvt_pk_bf16(v1[2], v1[3]);
                    *(u32x4*)(rowp + bj * HALF) = w; } }
    }
};
struct EpiResF32 {
    static constexpr bool PERM = false;
    const float* R; float* C; int ldc;
    __device__ __forceinline__ void operator()(const f32x4 (&acc)[2][2][4][2], const Unit& u, int wr, int wc, int fr, int fq) const {
        const int row0 = u.pm * BM + wr * 64 + fr, col0 = u.pn * BM + wc * 32 + 4 * fq;
#pragma unroll
        for (int ai = 0; ai < 2; ++ai)
#pragma unroll
            for (int m = 0; m < 4; ++m) { const size_t off = (size_t)(row0 + ai * HALF + m * 16) * ldc + col0;
#pragma unroll
                for (int bj = 0; bj < 2; ++bj)
#pragma unroll
                    for (int n = 0; n < 2; ++n) { const f32x4 r = *(const f32x4*)(R + off + bj * HALF + n * 16); *(f32x4*)(C + off + bj * HALF + n * 16) = r + acc[ai][bj][m][n]; } }
    }
};
struct EpiSwiGLU {
    static constexpr bool PERM = true;
    unsigned char* O; int ldc;
    __device__ __forceinline__ void operator()(const f32x4 (&acc)[2][2][4][2], const Unit& u, int wr, int wc, int fr, int fq) const {
        const int row0 = u.pm * BM + wr * 64 + fr, col0 = u.pn * HALF + wc * 32 + 8 * fq;
#pragma unroll
        for (int ai = 0; ai < 2; ++ai)
#pragma unroll
            for (int m = 0; m < 4; ++m) { unsigned char* rowp = O + (size_t)(row0 + ai * HALF + m * 16) * ldc + col0;
                float o[8];
#pragma unroll
                for (int n = 0; n < 2; ++n)
#pragma unroll
                    for (int j = 0; j < 4; ++j) { const float g = acc[ai][0][m][n][j], up = acc[ai][1][m][n][j];
                        o[n * 4 + j] = g * __builtin_amdgcn_rcpf(1.f + __builtin_amdgcn_exp2f(-g * LOG2E)) * up; }
                u32x2 w; int t0 = __builtin_amdgcn_cvt_pk_fp8_f32(o[0], o[1], 0, false); t0 = __builtin_amdgcn_cvt_pk_fp8_f32(o[2], o[3], t0, true);
                int t1 = __builtin_amdgcn_cvt_pk_fp8_f32(o[4], o[5], 0, false); t1 = __builtin_amdgcn_cvt_pk_fp8_f32(o[6], o[7], t1, true);
                w.x = (unsigned)t0; w.y = (unsigned)t1; *(u32x2*)rowp = w; }
    }
};

struct GeoPlain {
    static constexpr bool GATHER = false;
    const bf16_t* A; const bf16_t* Bt; int KB; TileOrder ord;
    __device__ __forceinline__ bool next(int i, Unit& u) const { return ord.next(i, u); }
    __device__ __forceinline__ const char* a_ptr(const Unit& u) const { return (const char*)A + (size_t)u.pm * BM * KB; }
    __device__ __forceinline__ const char* b_ptr(const Unit& u) const { return (const char*)Bt + (size_t)u.pn * BM * KB; }
    __device__ __forceinline__ size_t hstepA() const { return (size_t)HALF * KB; }
    __device__ __forceinline__ size_t hstepB() const { return (size_t)HALF * KB; }
    __device__ __forceinline__ size_t istepA() const { return (size_t)64 * KB; }
    __device__ __forceinline__ size_t istepB() const { return (size_t)64 * KB; }
    __device__ __forceinline__ unsigned a_voff(int R, int C) const { return (unsigned)(R * KB + C * 2); }
    __device__ __forceinline__ unsigned b_voff(int R, int C) const { return (unsigned)(R * KB + C * 2); }
    __device__ __forceinline__ void fill_table(LAS unsigned*, const Unit&, int) const {}
};
struct GeoTokPerm {
    static constexpr bool GATHER = false;
    const bf16_t* A; const bf16_t* X; int KB; TileOrder ord;
    __device__ __forceinline__ bool next(int i, Unit& u) const { return ord.next(i, u); }
    __device__ __forceinline__ const char* a_ptr(const Unit& u) const { return (const char*)A + (size_t)u.pm * BM * KB; }
    __device__ __forceinline__ const char* b_ptr(const Unit& u) const { return (const char*)X + (size_t)u.pn * 32 * KB; }
    __device__ __forceinline__ size_t hstepA() const { return (size_t)HALF * KB; }
    __device__ __forceinline__ size_t hstepB() const { return (size_t)16 * KB; }
    __device__ __forceinline__ size_t istepA() const { return (size_t)64 * KB; }
    __device__ __forceinline__ size_t istepB() const { return (size_t)8 * KB; }
    __device__ __forceinline__ unsigned a_voff(int R, int C) const { return (unsigned)(R * KB + C * 2); }
    __device__ __forceinline__ unsigned b_voff(int R, int C) const { return (unsigned)(((R & 7) * SEQ + (R >> 3)) * KB + C * 2); }
    __device__ __forceinline__ void fill_table(LAS unsigned*, const Unit&, int) const {}
};
template <bool G> struct GeoExpert {
    static constexpr bool GATHER = G;
    const void* A; const void* Bt; int KB; size_t bexp;    const int* tok; TileOrder ord;
    __device__ __forceinline__ bool next(int i, Unit& u) const { return ord.next(i, u); }
    __device__ __forceinline__ const char* a_ptr(const Unit& u) const { return G ? (const char*)A : (const char*)A + (size_t)u.pm * BM * KB; }
    __device__ __forceinline__ const char* b_ptr(const Unit& u) const { return (const char*)Bt + (size_t)(u.pm >> 4) * bexp + (size_t)u.pn * BM * KB; }
    __device__ __forceinline__ size_t hstepA() const { return (size_t)HALF * KB; }
    __device__ __forceinline__ size_t hstepB() const { return (size_t)HALF * KB; }
    __device__ __forceinline__ size_t istepA() const { return (size_t)64 * KB; }
    __device__ __forceinline__ size_t istepB() const { return (size_t)64 * KB; }
    __device__ __forceinline__ unsigned a_voff(int R, int C) const { return (unsigned)(R * KB + C * 2); }
    __device__ __forceinline__ unsigned b_voff(int R, int C) const { return (unsigned)(R * KB + C * 2); }
    __device__ __forceinline__ void fill_table(LAS unsigned* tb, const Unit& u, int tid) const { if (G) { int t_ = tid; asm volatile("" : "+v"(t_));
#pragma unroll
        for (int i = 0; i < 2; ++i) { int R, C; stage_rc(t_ * 16 + i * 8192, R, C);
#pragma unroll
            for (int h = 0; h < 2; ++h) tb[h * 1024 + i * 512 + tid] = (unsigned)tok[u.pm * 256 + h * 128 + R] * (unsigned)KB + (unsigned)C * 2u; } } }
};

template <bool F8, class Epi, class Geo>
__device__ __forceinline__ void gemm_phase(LAS unsigned char* lds, LAS unsigned* tbl, const Geo& S, const Epi& E, int wave_s) {
    int tid_ = wave_s * 64 + lane_id_v(); asm volatile("" : "+v"(tid_));
    const int tid = tid_, wid = wave_s, lane = tid & 63, wr = wid >> 2, wc = wid & 3, fr = lane & 15, fq = lane >> 4;
    const int nt = S.KB / (BK * 2);
    unsigned voffA, voffB;
    { int R, C; stage_rc(tid * 16, R, C); const int Rb = Epi::PERM ? ((R & ~31) + perm32(R & 31)) : R; voffA = S.a_voff(R, C); voffB = S.b_voff(Rb, C); }
    const size_t istepA = S.istepA(), istepB = S.istepB();
    const size_t kstep = (size_t)(BK * 2);
    const size_t hstepA = S.hstepA(), hstepB = S.hstepB();
    const unsigned ldsw = (unsigned)wid * 1024u;
    const int aoff = lds_byte(wr * 64 + fr, fq * 8), boff = lds_byte(wc * 32 + fr, fq * 8);
    const LAS unsigned char* ldsB = lds + 4 * HTB + boff;
#define PG8_SA(b, h) (((b) * 2 + (h)) * HTB)
#define PG8_SB(b, h) ((4 + (b) * 2 + (h)) * HTB)
#define PG8_GLDS(bufoff, gptr, i_) __builtin_amdgcn_global_load_lds((const unsigned*)(gptr), (LAS unsigned*)(lds + (bufoff) + ldsw + (i_) * 8192), 16, 0, 0)
#define PG8_STAGE_B(bufoff, gbase) do { PG8_GLDS(bufoff, (const char*)(gbase) + voffB, 0); PG8_GLDS(bufoff, (const char*)(gbase) + istepB + voffB, 1); } while (0)
#define PG8_STAGE_A(bufoff, gbase, h, nx) do { if constexpr (Geo::GATHER) { const LAS unsigned* _tb = tbl + (((ui + ((nx) ? 1 : 0)) & 1) * 2048) + (h) * 1024 + tid; \
        const unsigned _v0 = _tb[0], _v1 = _tb[512]; PG8_GLDS(bufoff, (const char*)(gbase) + _v0, 0); PG8_GLDS(bufoff, (const char*)(gbase) + _v1, 1); } \
        else { PG8_GLDS(bufoff, (const char*)(gbase) + (h) * hstepA + voffA, 0); PG8_GLDS(bufoff, (const char*)(gbase) + (h) * hstepA + istepA + voffA, 1); } } while (0)
#define PG8_LD16(off) (*(const LAS i32x4*)(lds + (off)))
#define PG8_LDA(dst, b, h) do { _Pragma("unroll") for (int m = 0; m < 4; ++m) dst[m] = __builtin_shufflevector(PG8_LD16(PG8_SA(b, h) + aoff + m * 2048), PG8_LD16(PG8_SA(b, h) + aoff + m * 2048 + 1024), 0, 1, 2, 3, 4, 5, 6, 7); } while (0)
#define PG8_LDB(dst, b, h) do { _Pragma("unroll") for (int n = 0; n < 2; ++n) dst[n] = __builtin_shufflevector(*(const LAS i32x4*)(ldsB + ((b) * 2 + (h)) * HTB + n * 2048), *(const LAS i32x4*)(ldsB + ((b) * 2 + (h)) * HTB + n * 2048 + 1024), 0, 1, 2, 3, 4, 5, 6, 7); } while (0)
#define PG8_LO(v) __builtin_bit_cast(bf16x8, __builtin_shufflevector(v, v, 0, 1, 2, 3))
#define PG8_HI(v) __builtin_bit_cast(bf16x8, __builtin_shufflevector(v, v, 4, 5, 6, 7))
#define PG8_MMA(ai, bj, At, Bt) do { __builtin_amdgcn_s_setprio(1); _Pragma("unroll") for (int m = 0; m < 4; ++m) _Pragma("unroll") for (int n = 0; n < 2; ++n) { \
        if constexpr (F8) { acc[ai][bj][m][n] = __builtin_amdgcn_mfma_scale_f32_16x16x128_f8f6f4(Bt[n], At[m], acc[ai][bj][m][n], 0, 0, 1, F8_SCALES, 0, F8_SCALES); } \
        else { acc[ai][bj][m][n] = __builtin_amdgcn_mfma_f32_16x16x32_bf16(PG8_LO(Bt[n]), PG8_LO(At[m]), acc[ai][bj][m][n], 0, 0, 0); \
               acc[ai][bj][m][n] = __builtin_amdgcn_mfma_f32_16x16x32_bf16(PG8_HI(Bt[n]), PG8_HI(At[m]), acc[ai][bj][m][n], 0, 0, 0); } } \
        __builtin_amdgcn_s_setprio(0); } while (0)
#define PG8_WAIT_V(n) asm volatile("s_waitcnt vmcnt(" #n ")" ::: "memory")
#define PG8_WAIT_L(n) asm volatile("s_waitcnt lgkmcnt(" #n ")" ::: "memory")
#define PG8_BAR __builtin_amdgcn_s_barrier()
#define PG8_SCHED __builtin_amdgcn_sched_barrier(0)
    Unit cur, nxt; int ui = 0;
    if (!S.next(0, cur)) return;
    f32x4 acc[2][2][4][2];
#pragma unroll
    for (int a = 0; a < 2; ++a)
#pragma unroll
        for (int b = 0; b < 2; ++b)
#pragma unroll
            for (int m = 0; m < 4; ++m)
#pragma unroll
                for (int n = 0; n < 2; ++n) acc[a][b][m][n] = (f32x4){0.f, 0.f, 0.f, 0.f};
    i32x8 At[4], B0[2], B1[2];
    const char* cA = S.a_ptr(cur); const char* cB = S.b_ptr(cur);
    if constexpr (Geo::GATHER) {
        S.fill_table(tbl, cur, tid);
        Unit u1; if (S.next(1, u1)) S.fill_table(tbl + 2048, u1, tid);
        asm volatile("s_waitcnt vmcnt(0) lgkmcnt(0)" ::: "memory"); PG8_BAR; asm volatile("" ::: "memory");
    }
    PG8_STAGE_B(PG8_SB(0, 0), cB); PG8_STAGE_B(PG8_SB(0, 1), cB + hstepB); PG8_STAGE_A(PG8_SA(0, 0), cA, 0, false); PG8_STAGE_A(PG8_SA(0, 1), cA, 1, false);
    if (wr == 1) PG8_BAR;
    PG8_WAIT_V(2); PG8_BAR;
    PG8_STAGE_B(PG8_SB(1, 0), cB + kstep); PG8_STAGE_A(PG8_SA(1, 0), cA + kstep, 0, false); PG8_STAGE_B(PG8_SB(1, 1), cB + hstepB + kstep);
    PG8_WAIT_V(6); PG8_BAR;
    for (;;) {
        const bool has_next = S.next(ui + 1, nxt);
        const char* nA = has_next ? S.a_ptr(nxt) : cA; const char* nB = has_next ? S.b_ptr(nxt) : cB;
#pragma clang loop unroll(disable)
        for (int t = 0; t < nt; t += 2) {
            const bool last = (t == nt - 2);
            const bool lastn = last && has_next;
            const char* a1 = cA + (size_t)(t + 1) * kstep;
            const char* a2 = last ? nA : cA + (size_t)(t + 2) * kstep; const char* b2 = last ? nB : cB + (size_t)(t + 2) * kstep;
            const char* a3 = a2 + kstep; const char* b3 = b2 + kstep;
            if constexpr (Geo::GATHER) { if (t == 2 && ui > 0) { Unit u2; if (S.next(ui + 1, u2)) S.fill_table(tbl + (((ui + 1) & 1) * 2048), u2, tid); } }
            PG8_LDB(B0, 0, 0); PG8_LDB(B1, 0, 1); PG8_SCHED; PG8_LDA(At, 0, 0); PG8_STAGE_A(PG8_SA(1, 1), a1, 1, false);
            PG8_WAIT_V(8); PG8_WAIT_L(0); PG8_BAR; PG8_MMA(0, 0, At, B0); PG8_MMA(0, 1, At, B1); PG8_BAR; PG8_SCHED;
            PG8_LDA(At, 0, 1); PG8_STAGE_B(PG8_SB(0, 0), b2); PG8_STAGE_B(PG8_SB(0, 1), b2 + hstepB); PG8_STAGE_A(PG8_SA(0, 0), a2, 0, lastn);
            PG8_WAIT_V(8); PG8_WAIT_L(0); PG8_BAR; PG8_MMA(1, 0, At, B0); PG8_MMA(1, 1, At, B1); PG8_BAR; PG8_SCHED;
            PG8_LDB(B0, 1, 0); PG8_LDB(B1, 1, 1); PG8_SCHED; PG8_LDA(At, 1, 0); PG8_STAGE_A(PG8_SA(0, 1), a2, 1, lastn);
            PG8_WAIT_V(8); PG8_WAIT_L(0); PG8_BAR; PG8_MMA(0, 0, At, B0); PG8_MMA(0, 1, At, B1); PG8_BAR; PG8_SCHED;
            PG8_LDA(At, 1, 1); PG8_STAGE_B(PG8_SB(1, 0), b3); PG8_STAGE_B(PG8_SB(1, 1), b3 + hstepB); PG8_STAGE_A(PG8_SA(1, 0), a3, 0, lastn);
            PG8_WAIT_V(8); PG8_WAIT_L(0); PG8_BAR; PG8_MMA(1, 0, At, B0); PG8_MMA(1, 1, At, B1); PG8_BAR; PG8_SCHED;
        }
        if (wr == 0) PG8_BAR;
        { const int l_e = lane_id_v();
          E(acc, cur, wr, wc, l_e & 15, l_e >> 4); }
        if (!has_next) break;
#pragma unroll
        for (int a = 0; a < 2; ++a)
#pragma unroll
            for (int b = 0; b < 2; ++b)
#pragma unroll
                for (int m = 0; m < 4; ++m)
#pragma unroll
                    for (int n = 0; n < 2; ++n) acc[a][b][m][n] = (f32x4){0.f, 0.f, 0.f, 0.f};
        cur = nxt; cA = nA; cB = nB; ++ui;
        if (wr == 1) PG8_BAR;
    }
    PG8_WAIT_V(0);
    PG8_BAR;
#undef PG8_SA
#undef PG8_SB
#undef PG8_GLDS
#undef PG8_STAGE_B
#undef PG8_STAGE_A
#undef PG8_LDA
#undef PG8_LDB
#undef PG8_LD16
#undef PG8_LO
#undef PG8_HI
#undef PG8_MMA
#undef PG8_WAIT_V
#undef PG8_WAIT_L
#undef PG8_BAR
#undef PG8_SCHED
}
}

namespace att {
constexpr int KVBLK = 64, LDQKV = ACOLS;
constexpr int SHM_V = KVBLK * 128 * 2, SHM_K = KVBLK * 64 * 2, OFF_V = 0, OFF_K = 2 * SHM_V, OFF_WS = OFF_K + 2 * SHM_K, LDS_TOTAL = OFF_WS + 8 * 64 * 4;
constexpr float THR = 8.f;
#define KSWZ64(row, colB) ((row) * 128 + ((colB) ^ ((((row) >> 1) & 7) << 4)))
#define SBAR() __builtin_amdgcn_sched_barrier(0)
__device__ __forceinline__ int crow(int r, int hi) { return (r & 3) + 8 * (r >> 2) + 4 * hi; }
__device__ __forceinline__ unsigned cvtpk(float lo, float hi) { unsigned r; asm volatile("v_cvt_pk_bf16_f32 %0, %1, %2" : "=v"(r) : "v"(lo), "v"(hi)); return r; }
__device__ __forceinline__ int v_st(int k, int c) { const int kk = (k & ~0xC) | ((k & 4) << 1) | ((k & 8) >> 1); return ((kk >> 3) * 4 + (c >> 5)) * 512 + ((kk & 7) * 32 + (c & 31)) * 2; }
__device__ __forceinline__ int v_rd_base(int lane) { return ((lane & 3) << 3) | (((lane >> 2) & 3) << 6) | (((lane >> 4) & 1) << 5) | (((lane >> 5) & 1) << 8); }
constexpr int v_rd_off(int d0, int ks, int half) { return d0 * 512 + ks * 4096 + half * 2048; }
template <int OFF> __device__ __forceinline__ v4i16_t tr_read(int vb) { v4i16_t r; asm volatile("ds_read_b64_tr_b16 %0, %1 offset:%2" : "=&v"(r) : "v"(vb), "i"(OFF) : "memory"); return r; }
template <int D0> __device__ __forceinline__ void pv_one(f32x16& od, int vb, bf16x8 pa0, bf16x8 pa1, bf16x8 pa2, bf16x8 pa3) {
    const v4i16_t l0 = tr_read<v_rd_off(D0, 0, 0)>(vb), h0 = tr_read<v_rd_off(D0, 0, 1)>(vb), l1 = tr_read<v_rd_off(D0, 1, 0)>(vb), h1 = tr_read<v_rd_off(D0, 1, 1)>(vb);
    const v4i16_t l2 = tr_read<v_rd_off(D0, 2, 0)>(vb), h2 = tr_read<v_rd_off(D0, 2, 1)>(vb), l3 = tr_read<v_rd_off(D0, 3, 0)>(vb), h3 = tr_read<v_rd_off(D0, 3, 1)>(vb);
    asm volatile("s_waitcnt lgkmcnt(0)" ::: "memory"); SBAR();
#define PK(L, H) (bf16x8){L[0], L[1], L[2], L[3], H[0], H[1], H[2], H[3]}
    od = __builtin_amdgcn_mfma_f32_32x32x16_bf16(pa0, PK(l0, h0), od, 0, 0, 0);
    od = __builtin_amdgcn_mfma_f32_32x32x16_bf16(pa1, PK(l1, h1), od, 0, 0, 0);
    od = __builtin_amdgcn_mfma_f32_32x32x16_bf16(pa2, PK(l2, h2), od, 0, 0, 0);
    od = __builtin_amdgcn_mfma_f32_32x32x16_bf16(pa3, PK(l3, h3), od, 0, 0, 0);
#undef PK
}
__device__ __forceinline__ void pv_d0(f32x16* o, int vb, bf16x8 pa0, bf16x8 pa1, bf16x8 pa2, bf16x8 pa3) {
    pv_one<0>(o[0], vb, pa0, pa1, pa2, pa3); pv_one<1>(o[1], vb, pa0, pa1, pa2, pa3); pv_one<2>(o[2], vb, pa0, pa1, pa2, pa3); pv_one<3>(o[3], vb, pa0, pa1, pa2, pa3);
}
__device__ __forceinline__ void qkt(f32x16& p0, f32x16& p1, const char* Ks, const bf16x8* qr, const f32x16& negm, int r32, int hi, float dq, float slope2) {
#pragma unroll
    for (int d0 = 0; d0 < 4; ++d0) { const int cb = (d0 * 16 + hi * 8) * 2;
        const bf16x8 b0 = *reinterpret_cast<const bf16x8*>(Ks + KSWZ64(r32, cb));
        const bf16x8 b1 = *reinterpret_cast<const bf16x8*>(Ks + KSWZ64(32 + r32, cb));
        if (d0 == 0) { p0 = __builtin_amdgcn_mfma_f32_32x32x16_bf16(b0, qr[0], negm, 0, 0, 0); p1 = __builtin_amdgcn_mfma_f32_32x32x16_bf16(b1, qr[0], negm, 0, 0, 0); }
        else { p0 = __builtin_amdgcn_mfma_f32_32x32x16_bf16(b0, qr[d0], p0, 0, 0, 0); p1 = __builtin_amdgcn_mfma_f32_32x32x16_bf16(b1, qr[d0], p1, 0, 0, 0); } }
    asm volatile("" : "+v"(dq), "+v"(p0), "+v"(p1));
#pragma unroll
    for (int r = 0; r < 16; ++r) { const float cr = (float)((r & 3) + 8 * (r >> 2)); p0[r] = fmaf(-slope2, fabsf(dq - cr), p0[r]); p1[r] = fmaf(-slope2, fabsf(dq - 32.f - cr), p1[r]); }
}
__device__ __forceinline__ void partialSM(f32x16& p0, f32x16& p1, f32x16& negm, float& alpha) {
    float pmax = p0[0];
#pragma unroll
    for (int r = 1; r < 16; ++r) pmax = fmaxf(pmax, p0[r]);
#pragma unroll
    for (int r = 0; r < 16; ++r) pmax = fmaxf(pmax, p1[r]);
    { auto rr = __builtin_amdgcn_permlane32_swap(__float_as_uint(pmax), __float_as_uint(pmax), false, false); pmax = fmaxf(__uint_as_float(rr[0]), __uint_as_float(rr[1])); }
    if (__builtin_expect(!__any(pmax > THR), 1)) { alpha = 1.f; }
    else { const float dl = fmaxf(pmax, 0.f); alpha = __builtin_amdgcn_exp2f(-dl);
#pragma unroll
        for (int r = 0; r < 16; ++r) { p0[r] -= dl; p1[r] -= dl; negm[r] -= dl; } }
#pragma unroll
    for (int r = 0; r < 16; ++r) p0[r] = __builtin_amdgcn_exp2f(p0[r]);
}
__device__ __forceinline__ void finishSM(f32x16& p0, f32x16& p1, float alpha, float& l_reg, bf16x8& pa0, bf16x8& pa1, bf16x8& pa2, bf16x8& pa3) {
#pragma unroll
    for (int r = 0; r < 16; ++r) p1[r] = __builtin_amdgcn_exp2f(p1[r]);
    float ps = 0.f;
#pragma unroll
    for (int r = 0; r < 16; ++r) ps += p0[r];
#pragma unroll
    for (int r = 0; r < 16; ++r) ps += p1[r];
    { auto rr = __builtin_amdgcn_permlane32_swap(__float_as_uint(ps), __float_as_uint(ps), false, false); ps = __uint_as_float(rr[0]) + __uint_as_float(rr[1]); }
    l_reg = l_reg * alpha + ps;
#define PK4(P, BASE, OUT) do { const unsigned a0 = cvtpk(P[BASE + 0], P[BASE + 1]), a1 = cvtpk(P[BASE + 2], P[BASE + 3]), b0 = cvtpk(P[BASE + 4], P[BASE + 5]), b1 = cvtpk(P[BASE + 6], P[BASE + 7]); \
        auto r0 = __builtin_amdgcn_permlane32_swap(a0, b0, false, false); auto r1 = __builtin_amdgcn_permlane32_swap(a1, b1, false, false); \
        u32x4 w = {r0[0], r1[0], r0[1], r1[1]}; OUT = __builtin_bit_cast(bf16x8, w); } while (0)
    PK4(p0, 0, pa0); PK4(p0, 8, pa1); PK4(p1, 0, pa2); PK4(p1, 8, pa3);
#undef PK4
}
__device__ __forceinline__ void pass(f32x16 (&o)[4], const bf16_t* Qw, const bf16_t* Kh, const bf16_t* Vh, int qpos, int qb, float slope2, char* lds, int tid, int nL, int NT) {
    const int wid = tid >> 6, lane = tid & 63, r32 = lane & 31, hi = lane >> 5;
    char* V_lds = lds + OFF_V; char* K_lds = lds + OFF_K;
    float* ws = (float*)(lds + OFF_WS) + wid * 64; float* li_l = ws; float* al_l = ws + 32;
    float l_reg = 0.f; bf16x8 qr[4];
#pragma unroll
    for (int d = 0; d < 4; ++d)
#pragma unroll
        for (int r = 0; r < 16; ++r) o[d][r] = 0.f;
    f32x16 negm;
#pragma unroll
    for (int r = 0; r < 16; ++r) negm[r] = 0.f;
#pragma unroll
    for (int d0 = 0; d0 < 4; ++d0) qr[d0] = *reinterpret_cast<const bf16x8*>(Qw + d0 * 16);
    const int kr = tid >> 3, kc = (tid & 7) * 8, kst = KSWZ64(kr, kc * 2);
    const int sr = tid >> 4, sc = (tid & 15) * 8, vst0 = v_st(sr, sc), vst1 = v_st(32 + sr, sc);
    const int vb0 = (int)(uintptr_t)V_lds + v_rd_base(lane);
    const unsigned voff0 = (unsigned)(sr * LDQKV + sc), koff0 = (unsigned)(kr * LDQKV + kc);
    struct { bf16x8 vs0, vs1, ks; } st_[2];
    const int nd = 4 * qb;
#define KT(i) ((i) < 4 ? nd + (i) : ((i) < 4 + nL ? nd + 3 - (i) : nd + (i) - nL))
#define SLOAD(i, tile) do { const unsigned k0_ = (unsigned)((tile) * KVBLK * LDQKV); st_[i].vs0 = *reinterpret_cast<const bf16x8*>(Vh + (k0_ + voff0)); st_[i].vs1 = *reinterpret_cast<const bf16x8*>(Vh + (k0_ + voff0 + 32u * LDQKV)); \
        st_[i].ks = *reinterpret_cast<const bf16x8*>(Kh + (k0_ + koff0)); } while (0)
#define SWRITE(b, i) do { *(bf16x8*)(V_lds + (b) * SHM_V + vst0) = st_[i].vs0; *(bf16x8*)(V_lds + (b) * SHM_V + vst1) = st_[i].vs1; *(bf16x8*)(K_lds + (b) * SHM_K + kst) = st_[i].ks; } while (0)
#define SWAIT() asm volatile("s_waitcnt vmcnt(3)" ::: "memory")
#define RESC(a) do { if (__any((a) < 1.f)) { if (hi == 0) al_l[r32] = (a); asm volatile("s_waitcnt lgkmcnt(0)" ::: "memory"); \
        _Pragma("unroll") for (int d = 0; d < 4; ++d) _Pragma("unroll") for (int r = 0; r < 16; ++r) o[d][r] *= al_l[crow(r, hi)]; } } while (0)
#define DQ(tile) ((float)(qpos - (tile) * KVBLK - 4 * hi))
    f32x16 pA0, pA1, pB0, pB1; float alA, alB; bf16x8 pa0, pa1, pa2, pa3;
    SLOAD(0, KT(0)); asm volatile("s_waitcnt vmcnt(0)" ::: "memory"); SWRITE(0, 0); __syncthreads();
    qkt(pA0, pA1, K_lds, qr, negm, r32, hi, DQ(KT(0)), slope2); partialSM(pA0, pA1, negm, alA);
    SLOAD(1, KT(1)); SLOAD(0, KT(2));
    SWAIT(); SWRITE(1, 1); __syncthreads();
    for (int j = 1; j + 1 < NT; j += 2) {
        SBAR(); qkt(pB0, pB1, K_lds + SHM_K, qr, negm, r32, hi, DQ(KT(j)), slope2);
        finishSM(pA0, pA1, alA, l_reg, pa0, pa1, pa2, pa3); SBAR();
        SLOAD(1, KT(j + 2)); SBAR();
        pv_d0(o, vb0, pa0, pa1, pa2, pa3); partialSM(pB0, pB1, negm, alB);
        __syncthreads(); SWAIT(); SWRITE(0, 0);
        RESC(alB); __syncthreads();
        SBAR(); qkt(pA0, pA1, K_lds, qr, negm, r32, hi, DQ(KT(j + 1)), slope2);
        finishSM(pB0, pB1, alB, l_reg, pa0, pa1, pa2, pa3); SBAR();
        if (j + 3 < NT) SLOAD(0, KT(j + 3)); SBAR();
        pv_d0(o, vb0 + SHM_V, pa0, pa1, pa2, pa3); partialSM(pA0, pA1, negm, alA);
        __syncthreads(); SWAIT(); SWRITE(1, 1);
        RESC(alA); __syncthreads();
    }
    SBAR(); qkt(pB0, pB1, K_lds + SHM_K, qr, negm, r32, hi, DQ(KT(NT - 1)), slope2);
    finishSM(pA0, pA1, alA, l_reg, pa0, pa1, pa2, pa3); SBAR();
    pv_d0(o, vb0, pa0, pa1, pa2, pa3); partialSM(pB0, pB1, negm, alB);
    __syncthreads(); RESC(alB);
    finishSM(pB0, pB1, alB, l_reg, pa0, pa1, pa2, pa3); SBAR();
    pv_d0(o, vb0 + SHM_V, pa0, pa1, pa2, pa3);
    if (hi == 0) li_l[r32] = l_reg; asm volatile("s_waitcnt lgkmcnt(0)" ::: "memory");
#pragma unroll
    for (int r = 0; r < 16; ++r) { const float rl = __builtin_amdgcn_rcpf(li_l[crow(r, hi)]);
#pragma unroll
        for (int d = 0; d < 4; ++d) o[d][r] *= rl; }
    __syncthreads();
#undef KT
#undef SLOAD
#undef SWRITE
#undef SWAIT
#undef RESC
#undef DQ
}
#undef SBAR
}

typedef GAS unsigned gu32;
#define XB_TMO      128
#define XB_XCNT(j)  (256  + 64 * (j))
#define XB_XSUB(j)  (1280 + 64 * (j))
#define XB_XGEN(j)  (2304 + 64 * (j))
#define XB_TOP      3328
#define XB_TOPGEN   3392
#define XCD_BAR_WORDS 3456
#define XB_SPIN_CAP (1u << 23)
__device__ __forceinline__ unsigned xb_ld(unsigned* p)              { return __hip_atomic_load(p, __ATOMIC_RELAXED, __HIP_MEMORY_SCOPE_AGENT); }
__device__ __forceinline__ unsigned xb_add(unsigned* p, unsigned v) { return __hip_atomic_fetch_add(p, v, __ATOMIC_RELAXED, __HIP_MEMORY_SCOPE_AGENT); }
__device__ __forceinline__ unsigned xb_xcc_id() { return (unsigned)__builtin_amdgcn_s_getreg((3 << 11) | 20) & 0xFu; }
#define XB_SPIN(cond, bar) do { unsigned _sp = 0; while (cond) { __builtin_amdgcn_s_sleep(1); \
    if ((++_sp & 255u) == 0u) { if (xb_ld(&(bar)[XB_TMO])) break; if (_sp > XB_SPIN_CAP) { atomicAdd(&(bar)[XB_TMO], 1u); break; } } } } while (0)
struct XcdBarrier { unsigned* bar; unsigned x; volatile LAS unsigned* st; int wave; };
__device__ __forceinline__ XcdBarrier xcd_barrier_post(unsigned* bar, volatile LAS unsigned* st, int wave) {
    XcdBarrier b; b.bar = bar; b.x = xb_xcc_id(); b.st = st; b.wave = wave;
    if (wave == 0 && lane_id_v() == 0) (void)xb_add(&bar[XB_XCNT(b.x)], 1u);
    return b;
}
__device__ __forceinline__ void xcd_barrier_complete(unsigned* bar, unsigned x, unsigned& nloc, unsigned& nx) {
    const unsigned G = gridDim.x * gridDim.y * gridDim.z;
    unsigned sum, cnt, mine, sp = 0u;
    for (;;) {
        sum = 0u; cnt = 0u; mine = 0u;
#pragma unroll
        for (unsigned j = 0; j < 16; ++j) { const unsigned c = xb_ld(&bar[XB_XCNT(j)]); sum += c; cnt += (c > 0u) ? 1u : 0u; mine = (j == x) ? c : mine; }
        if (sum == G) break;
        __builtin_amdgcn_s_sleep(1);
        if ((++sp & 255u) == 0u) { if (xb_ld(&bar[XB_TMO])) break; if (sp > XB_SPIN_CAP) { atomicAdd(&bar[XB_TMO], 1u); break; } }
    }
    nloc = mine > 0u ? mine : 1u; nx = cnt > 0u ? cnt : 1u;
}
__device__ __forceinline__ void xcd_barrier(const XcdBarrier& b) {
    asm volatile("s_waitcnt vmcnt(0)" ::: "memory");
    __syncthreads();
    if (b.wave == 0 && lane_id_v() == 0) {
        unsigned* bar = b.bar;
        __builtin_amdgcn_s_waitcnt(0);
        unsigned nloc = b.st[0], nx = b.st[1];
        if (nloc == 0u) { xcd_barrier_complete(bar, b.x, nloc, nx); b.st[0] = nloc; b.st[1] = nx; }
        const unsigned old = xb_add(&bar[XB_XSUB(b.x)], 1u);
        const unsigned gen = old / nloc;
        if (old + 1u == (gen + 1u) * nloc) {
            __builtin_amdgcn_fence(__ATOMIC_RELEASE, "agent");
            asm volatile("s_waitcnt vmcnt(0)" ::: "memory");
            const unsigned og = xb_add(&bar[XB_TOP], 1u);
            const unsigned tg = og / nx;
            if (og + 1u == (tg + 1u) * nx) xb_add(&bar[XB_TOPGEN], 1u);
            else XB_SPIN(xb_ld(&bar[XB_TOPGEN]) == tg, bar);
            __builtin_amdgcn_fence(__ATOMIC_ACQUIRE, "agent");
            xb_add(&bar[XB_XGEN(b.x)], 1u);
            asm volatile("s_waitcnt vmcnt(0)" ::: "memory");
        } else {
            XB_SPIN(xb_ld(&bar[XB_XGEN(b.x)]) == gen, bar);
            __builtin_amdgcn_fence(__ATOMIC_ACQUIRE, "agent");
            asm volatile("s_waitcnt vmcnt(0)" ::: "memory");
        }
    }
    __syncthreads();
}

template <bool F8>
__device__ __forceinline__ void p0_transpose_item(const float* W, int K, int N, void* WTv, int k0, int n0, int orow0, LAS float* scr, int lane) {
#pragma unroll
    for (int i = 0; i < 8; ++i) { const int kk = 8 * i + (lane >> 3), n4 = (lane & 7) * 4; const f32x4 v = *(const GAS f32x4*)(W + (size_t)(k0 + kk) * N + n0 + n4);
        LAS float* d = scr + kk * 33 + n4; d[0] = v.x; d[1] = v.y; d[2] = v.z; d[3] = v.w; }
    LDS_WAIT(); asm volatile("" ::: "memory");
    const int c = lane & 7;
#pragma unroll
    for (int j = 0; j < 4; ++j) { const int n = (lane >> 3) + 8 * j; const LAS float* s = scr + (8 * c) * 33 + n;
        if constexpr (F8) {
            int t0 = __builtin_amdgcn_cvt_pk_fp8_f32(s[0 * 33] * 32.f, s[1 * 33] * 32.f, 0, false); t0 = __builtin_amdgcn_cvt_pk_fp8_f32(s[2 * 33] * 32.f, s[3 * 33] * 32.f, t0, true);
            int t1 = __builtin_amdgcn_cvt_pk_fp8_f32(s[4 * 33] * 32.f, s[5 * 33] * 32.f, 0, false); t1 = __builtin_amdgcn_cvt_pk_fp8_f32(s[6 * 33] * 32.f, s[7 * 33] * 32.f, t1, true);
            *(GAS u32x2*)((unsigned char*)WTv + (size_t)(orow0 + n) * K + k0 + 8 * c) = (u32x2){(unsigned)t0, (unsigned)t1};
        } else {
            u32x4 o; o.x = pk2(s[0 * 33], s[1 * 33]); o.y = pk2(s[2 * 33], s[3 * 33]); o.z = pk2(s[4 * 33], s[5 * 33]); o.w = pk2(s[6 * 33], s[7 * 33]);
            *(GAS u32x4*)((bf16_t*)WTv + (size_t)(orow0 + n) * K + k0 + 8 * c) = o; } }
    LDS_WAIT(); asm volatile("" ::: "memory");
}

struct Args { const float* in[25]; float* out; unsigned char* ws; };

__global__ void __launch_bounds__(512, 2) mega_fwd(Args args) {
    extern __shared__ __attribute__((aligned(16))) unsigned char lds_raw[];
    LAS unsigned char* lds = (LAS unsigned char*)lds_raw;
    volatile LAS unsigned* MISC = (volatile LAS unsigned*)(lds + MISC_OFF);
    const int G = gridDim.x, bx = blockIdx.x, NGW = G * 8;
    const int wave_s = __builtin_amdgcn_readfirstlane(threadIdx.x >> 6);
    unsigned char* ws = args.ws;
    gu32* ctl = (gu32*)(ws + WS_CTL);
    const float* x = args.in[0];
    float* out = args.out;
    unsigned char* WGU = ws + WS_WGU; unsigned char* WD = ws + WS_WD; bf16_t* WIN = (bf16_t*)(ws + WS_WIN); bf16_t* WOUT = (bf16_t*)(ws + WS_WOUT);
    bf16_t* XN = (bf16_t*)(ws + WS_XN); unsigned char* H2 = ws + WS_H2; bf16_t* GF = (bf16_t*)(ws + WS_GF);
    bf16_t* HP = (bf16_t*)(ws + WS_HP); bf16_t* QKV = (bf16_t*)(ws + WS_QKV); bf16_t* HZ = (bf16_t*)(ws + WS_HZ); bf16_t* MIX = (bf16_t*)(ws + WS_MIX);
    unsigned char* ACT = ws + WS_ACT; bf16_t* Y = (bf16_t*)(ws + WS_Y);
    float* AFF = (float*)(ws + WS_AFF); int* TOK = (int*)(ws + WS_TOK); float* GSEL = (float*)(ws + WS_GSEL); unsigned short* INV = (unsigned short*)(ws + WS_INV);
    float* NSUM = (float*)(ws + WS_CTL) + CW_NSUM;

    if (wave_s == 0) ((LAS unsigned*)(lds + MISC_OFF))[lane_id_v()] = 0u;
    __syncthreads();
    XcdBarrier bar = xcd_barrier_post((unsigned*)(ctl + CW_BAR), MISC + 8, wave_s);

    {
        PHASE_IDS();
        LAS float* scr = (LAS float*)(lds + wave * 16384);
        constexpr int I_IN = (DM / 64) * (INC / 32), I_OUT = (DM / 64) * (DM / 32), I_GU = (DM / 64) * (FF / 32), I_DN = (FF / 64) * (DM / 32);
        constexpr int NITEMS = I_IN + I_OUT + NE * (2 * I_GU + I_DN);
        for (int rep_ = 0; rep_ < REP_P0W; ++rep_)
        for (int it = gw; it < NITEMS; it += NGW) {
            int r = it;
            if (r < I_IN) { const int nblk = INC / 32, kb = r / nblk, nb = r % nblk; p0_transpose_item<false>(args.in[2], DM, INC, WIN, 64 * kb, 32 * nb, 32 * nb, scr, lane); continue; } r -= I_IN;
            if (r < I_OUT) { const int nblk = DM / 32, kb = r / nblk, nb = r % nblk; p0_transpose_item<false>(args.in[18], DM, DM, WOUT, 64 * kb, 32 * nb, 32 * nb, scr, lane); continue; } r -= I_OUT;
            const int e = r / (2 * I_GU + I_DN); r -= e * (2 * I_GU + I_DN);
            if (r < 2 * I_GU) { const int up = r >= I_GU; if (up) r -= I_GU; const int nblk = FF / 32, kb = r / nblk, nb = r % nblk, f0 = 32 * nb;
                const int orow = (f0 >> 7) * 256 + up * 128 + (f0 & 127);
                p0_transpose_item<true>(args.in[up ? 22 : 21] + (size_t)e * DM * FF, DM, FF, WGU + (size_t)e * 2 * FF * DM, 64 * kb, f0, orow, scr, lane); continue; }
            r -= 2 * I_GU;
            { const int nblk = DM / 32, kb = r / nblk, nb = r % nblk; p0_transpose_item<true>(args.in[23] + (size_t)e * FF * DM, FF, DM, WD + (size_t)e * DM * FF, 64 * kb, 32 * nb, 32 * nb, scr, lane); }
        }
        const float* g = args.in[1];
        int rep_xn = REP_XN; asm volatile("" : "+s"(rep_xn));
        for (int rep_ = 0; rep_ < rep_xn; ++rep_)
        for (int m = gw; m < NTOK; m += NGW) {
            const GAS f32x4* xr = (const GAS f32x4*)(x + (size_t)m * DM) + lane;
            f32x4 v[4]; float s = 0.f;
#pragma unroll
            for (int j = 0; j < 4; ++j) { v[j] = xr[64 * j]; s += (v[j].x * v[j].x + v[j].y * v[j].y) + (v[j].z * v[j].z + v[j].w * v[j].w); }
            const float rstd = rsqrtf(wave_sum(s) * (1.f / DM) + EPS);
            GAS u32x2* o8 = (GAS u32x2*)(XN + (size_t)m * DM) + lane;
#pragma unroll
            for (int j = 0; j < 4; ++j) { const f32x4 gg = ((const GAS f32x4*)g)[lane + 64 * j]; u32x2 w; w.x = pk2(v[j].x * rstd * gg.x, v[j].y * rstd * gg.y); w.y = pk2(v[j].z * rstd * gg.z, v[j].w * rstd * gg.w); o8[64 * j] = w; }
        }
        __syncthreads();
        for (int it = bx; it < 256; it += G) {
            const int ib = it >> 2, dn = it & 3, dir = dn >> 1, n = dn & 1, i0 = ib * 64;
            LAS float* zz = (LAS float*)lds;
            LAS float* h1 = zz + 64 * 33;
            LAS float* h2 = h1 + 64 * 64;
            const float* w1 = args.in[5]; const float* b1 = args.in[6]; const float* w2 = args.in[7]; const float* b2 = args.in[8]; const float* w3 = args.in[9]; const float* fr = args.in[10];
            for (int q = tid; q < 64 * 33; q += 512) { const int p = q / 33, j = q % 33, i = i0 + p;
                const float t = (float)i / (float)(SEQ - 1), w = 6.283185307179586f * (float)i / (float)SEQ; float v;
                if (j == 0) v = t; else { const float band = 1e-4f + (float)((j - 1) & 15) * ((15.f - 1e-4f) / 15.f); v = (j <= 16) ? cosf(band * w) : -sinf(band * w); }
                zz[q] = v; }
            __syncthreads();
            for (int q = tid; q < 64 * 64; q += 512) { const int p = q >> 6, j = q & 63; float a = b1[j]; for (int k = 0; k < 33; ++k) a += zz[p * 33 + k] * w1[k * 64 + j]; h1[q] = sinf(fr[j] * a); }
            __syncthreads();
            for (int q = tid; q < 64 * 64; q += 512) { const int p = q >> 6, j = q & 63; float a = b2[j]; for (int k = 0; k < 64; ++k) a += h1[p * 64 + k] * w2[k * 64 + j]; h2[q] = sinf(fr[j] * a); }
            __syncthreads();
            const int c = tid, col = dn * 512 + c;
            const float mind = logf(1e-2f) / 1.5f, maxd = logf(1e-2f) / 0.3f;
            const float delta = fabsf(mind + (float)c * ((maxd - mind) / 511.f));
            bf16_t* gf = GF + (size_t)(n * 512 + c) * GLEN;
            float asum = 0.f;
            for (int p0 = 0; p0 < 64; p0 += 16) {
                float hv[16];
#pragma unroll
                for (int p = 0; p < 16; ++p) hv[p] = 0.f;
                for (int k = 0; k < 64; ++k) { const float wk = w3[k * 2048 + col];
#pragma unroll
                    for (int p = 0; p < 16; ++p) hv[p] += h2[(p0 + p) * 64 + k] * wk; }
#pragma unroll
                for (int p = 0; p < 16; ++p) { const int i = i0 + p0 + p; const float t = (float)i / (float)(SEQ - 1); const float h = hv[p] * expf(-t * delta);
                    const unsigned hb = f2bf(h); const float hr = __builtin_bit_cast(float, hb << 16);
                    if (dir == 0) { gf[GOFF - i] = (bf16_t)hb; asum += fabsf(hr); } else if (i > 0) { gf[GOFF + i] = (bf16_t)hb; asum += fabsf(hr); } }
            }
            if (ib == 63) { if (dir == 0) { for (int q = 0; q < GOFF - 4095; ++q) gf[q] = 0; } else { for (int q = GOFF + 4096; q < GLEN; ++q) gf[q] = 0; } }
            atomicAdd(&NSUM[n * 512 + c], asum);
            __syncthreads();
        }
    }
    xcd_barrier(bar);

    int rep_p1 = REP_P1; asm volatile("" : "+s"(rep_p1));
    for (int rep_ = 0; rep_ < rep_p1; ++rep_) {
    {
        pg8::GeoTokPerm S; S.A = WIN; S.X = XN; S.KB = DM * 2; S.ord.init(HCOLS / 256, NTOK / 256, G, bx);
        pg8::EpiBf16 E{HP, NTOK, 0, 1.f};
        pg8::gemm_phase<false>(lds, (LAS unsigned*)(lds + TBL_OFF), S, E, wave_s);
    }
    {
        pg8::GeoPlain S; S.A = XN; S.Bt = WIN + (size_t)HCOLS * DM; S.KB = DM * 2; S.ord.init(NTOK / 256, ACOLS / 256, G, bx);
        pg8::EpiBf16 E{QKV, ACOLS, 512, QSCALE};
        pg8::gemm_phase<false>(lds, (LAS unsigned*)(lds + TBL_OFF), S, E, wave_s);
    }
    }
    xcd_barrier(bar);

    {
        PHASE_IDS();
        LAS unsigned* red = (LAS unsigned*)lds;
        float* QN2 = (float*)(ws + WS_AFF); float* KN2 = QN2 + 4096;
        for (int it = bx; it < NB * 64; it += G) {
            const int b = it >> 6, tile = it & 63, row = tid >> 3, g = tid & 7;
            const bf16_t* rp = QKV + ((size_t)b * SEQ + tile * 64 + row) * ACOLS + g * 64;
            float sq = 0.f, sk = 0.f;
#pragma unroll
            for (int j = 0; j < 8; ++j) { const u32x4 v = *(const GAS u32x4*)(rp + j * 8), w = *(const GAS u32x4*)(rp + 512 + j * 8);
#pragma unroll
                for (int k = 0; k < 4; ++k) { sq += bflo(v[k]) * bflo(v[k]) + bfhi(v[k]) * bfhi(v[k]); sk += bflo(w[k]) * bflo(w[k]) + bfhi(w[k]) * bfhi(w[k]); } }
            if (tid < 16) red[tid] = 0u;
            __syncthreads();
            atomicMax((unsigned*)&red[g], __float_as_uint(sq)); atomicMax((unsigned*)&red[8 + g], __float_as_uint(sk));
            __syncthreads();
            if (tid < 8) QN2[(size_t)(b * 8 + tid) * 64 + tile] = __uint_as_float(red[tid]); else if (tid < 16) KN2[(size_t)(b * 8 + tid - 8) * 64 + tile] = __uint_as_float(red[tid]);
            __syncthreads();
        }
    }
    xcd_barrier(bar);

    {
        PHASE_IDS();
        {
            const float* conv_w = args.in[3]; const float* conv_b = args.in[4]; const float* skip = args.in[11];
            if (tid < 64) { const int bufi = tid >> 5, row = tid & 31, rr = row < 16 ? row : SEQ + row; *(LAS u32x4*)(lds + bufi * HY_ZBYTES + rr * 16) = (u32x4){0u, 0u, 0u, 0u}; }
            const int r32 = lane & 31, hi = lane >> 5;
            const int tr_lane = (2 * ((lane >> 4) & 1) + ((lane & 3) >> 1) + 8 * hi + ((lane & 15) >> 2)) * 16 + 8 * (lane & 1);
            int rep_hy = REP_HY; asm volatile("" : "+s"(rep_hy));
            for (int rep_ = 0; rep_ < rep_hy; ++rep_)
            for (int unit = bx; unit < HW; unit += G) {
                const int c = unit;
                __syncthreads();
                {
                    const int col = 1024 + c; const float w0 = conv_w[col], w1 = conv_w[HCOLS + col], w2 = conv_w[2 * HCOLS + col], cb = conv_b[col];
                    const bf16_t* hp = HP + (size_t)col * SEQ * 8;
#pragma unroll 2
                    for (int i = 0; i < 8; ++i) { const int t = tid + 512 * i;
                        const u32x4 z4 = (u32x4){0u, 0u, 0u, 0u};
                        const u32x4 pm = t > 0 ? *(const GAS u32x4*)(hp + (size_t)(t - 1) * 8) : z4, p0 = *(const GAS u32x4*)(hp + (size_t)t * 8), pp = t < SEQ - 1 ? *(const GAS u32x4*)(hp + (size_t)(t + 1) * 8) : z4;
                        u32x4 o;
#pragma unroll
                        for (int k = 0; k < 4; ++k) { const float lo = cb + w0 * bflo(pm[k]) + w1 * bflo(p0[k]) + w2 * bflo(pp[k]), hh = cb + w0 * bfhi(pm[k]) + w1 * bfhi(p0[k]) + w2 * bfhi(pp[k]); o[k] = pk2(lo, hh); }
                        *(LAS u32x4*)(lds + HY_ZA + (t + 16) * 16) = o; }
                }
                for (int n = 0; n < 2; ++n) {
                    {
                        const GAS u32x4* gsrc = (const GAS u32x4*)(GF + (size_t)(n * 512 + c) * GLEN);
                        for (int q = tid; q < GLEN * 2 / 16; q += 512) *(LAS u32x4*)(lds + HY_FB + q * 16) = gsrc[q];
                    }
                    __syncthreads();
                    f32x16 acc[2][2];
#pragma unroll
                    for (int a = 0; a < 2; ++a)
#pragma unroll
                        for (int b = 0; b < 2; ++b)
#pragma unroll
                            for (int k = 0; k < 16; ++k) acc[a][b][k] = 0.f;
                    const LAS unsigned char* za = lds + (n == 0 ? HY_ZA : HY_ZB) + tr_lane;
                    const LAS unsigned char* fbp = lds + HY_FB + 2 * GOFF - 32 + 16 * (hi - r32) - 512 * (2 * wave);
#define HY_STEP(OFFA, OFFB) do { \
                        const v4i16_t x0 = __builtin_amdgcn_ds_read_tr16_b64_v4i16((LAS v4i16_t*)(za + (OFFA))); \
                        const v4i16_t x1 = __builtin_amdgcn_ds_read_tr16_b64_v4i16((LAS v4i16_t*)(za + (OFFA) + 64)); \
                        const v4i16_t x2 = __builtin_amdgcn_ds_read_tr16_b64_v4i16((LAS v4i16_t*)(za + (OFFA) + 128)); \
                        const bf16x8 b0 = *(const LAS bf16x8*)(fbp + (OFFB)), b1 = *(const LAS bf16x8*)(fbp + (OFFB) - 512); \
                        const bf16x8 a0 = (bf16x8){x0[0], x0[1], x0[2], x0[3], x1[0], x1[1], x1[2], x1[3]}, a1 = (bf16x8){x1[0], x1[1], x1[2], x1[3], x2[0], x2[1], x2[2], x2[3]}; \
                        acc[0][0] = __builtin_amdgcn_mfma_f32_32x32x16_bf16(a0, b0, acc[0][0], 0, 0, 0); \
                        acc[0][1] = __builtin_amdgcn_mfma_f32_32x32x16_bf16(a1, b0, acc[0][1], 0, 0, 0); \
                        acc[1][0] = __builtin_amdgcn_mfma_f32_32x32x16_bf16(a0, b1, acc[1][0], 0, 0, 0); \
                        acc[1][1] = __builtin_amdgcn_mfma_f32_32x32x16_bf16(a1, b1, acc[1][1], 0, 0, 0); } while (0)
#pragma clang loop unroll(disable)
                    for (int c4 = 0; c4 < 64; ++c4) {
                        HY_STEP(0, 0); HY_STEP(256, 32); HY_STEP(512, 64); HY_STEP(768, 96);
                        za += 1024; fbp += 128;
                    }
                    HY_STEP(0, 0);
#undef HY_STEP
                    const int gcol = n * 512 + c; const float w0 = conv_w[gcol], w1 = conv_w[HCOLS + gcol], w2 = conv_w[2 * HCOLS + gcol], cb = conv_b[gcol];
                    const float inv = 1.f / NSUM[n * 512 + c], sk = skip[n * 512 + c];
                    const bf16_t* hp = HP + (size_t)gcol * SEQ * 8 + 4 * hi;
                    const LAS unsigned char* zin = lds + (n == 0 ? HY_ZA : HY_ZB) + 8 * hi;
#pragma unroll
                    for (int sp = 0; sp < 2; ++sp) {
                        const int tb = 256 * (2 * wave + sp) + 8 * r32;
                        u32x2 P[10];
#pragma unroll
                        for (int k = 0; k < 10; ++k) { const int tq = tb - 1 + k; P[k] = (tq >= 0 && tq < SEQ) ? *(const GAS u32x2*)(hp + (size_t)tq * 8) : (u32x2){0u, 0u}; }
#pragma unroll
                        for (int tt = 0; tt < 8; ++tt) {
                            const int t = tb + tt; const u32x2 zi = *(const LAS u32x2*)(zin + (t + 16) * 16);
                            const float zv[4] = {bflo(zi.x), bfhi(zi.x), bflo(zi.y), bfhi(zi.y)};
                            const float pm[4] = {bflo(P[tt].x), bfhi(P[tt].x), bflo(P[tt].y), bfhi(P[tt].y)};
                            const float pc[4] = {bflo(P[tt + 1].x), bfhi(P[tt + 1].x), bflo(P[tt + 1].y), bfhi(P[tt + 1].y)};
                            const float pp[4] = {bflo(P[tt + 2].x), bfhi(P[tt + 2].x), bflo(P[tt + 2].y), bfhi(P[tt + 2].y)};
                            float zo[4];
#pragma unroll
                            for (int bb = 0; bb < 4; ++bb) { const float gate = cb + w0 * pm[bb] + w1 * pc[bb] + w2 * pp[bb]; zo[bb] = gate * (acc[sp][tt >> 2][(tt & 3) * 4 + bb] * inv + sk * zv[bb]); }
                            u32x2 w; w.x = pk2(zo[0], zo[1]); w.y = pk2(zo[2], zo[3]);
                            if (n == 0) *(LAS u32x2*)(lds + HY_ZB + (t + 16) * 16 + 8 * hi) = w;
                            else *(GAS u32x2*)(HZ + ((size_t)c * SEQ + t) * 8 + 4 * hi) = w;
                        }
                    }
                    __syncthreads();
                }
            }
        }
        __syncthreads();
        {
            const int wid = wave, r32 = lane & 31, hi = lane >> 5;
            const float* QN2 = (const float*)(ws + WS_AFF); const float* KN2 = QN2 + 4096;
            for (int rep_ = 0; rep_ < REP_AT; ++rep_)
            for (int unit = bx; unit < NB * 4 * 16; unit += G) {
                const int v_ = unit & 127, qb = v_ & 15, b = v_ >> 4, h = unit < 256 ? 2 + (unit >> 7) : ((unit - 256) >> 7 ? 0 : 1), q0 = qb * 256;
                const bf16_t* pb = QKV + (size_t)b * SEQ * ACOLS;
                const float slope2 = exp2f(-2.f * (float)(h + 1)) * LOG2E;
                const int l_u = lane_id_v(), r32u = l_u & 31, hiu = l_u >> 5;
                const int qpos = q0 + wid * 32 + r32u;
                f32x16 o[4];
#pragma clang loop unroll(disable)
                for (int mp = 0; mp < 2; ++mp) {
                    int nL, NT;
                    { const float* qn = QN2 + ((size_t)(b * 8 + h * 2 + mp)) * 64; const float* kn = KN2 + ((size_t)(b * 8 + h * 2 + mp)) * 64;
                      float km = kn[lane_id_v()];
                      km = wave_max(km);
                      const float qm = fmaxf(fmaxf(qn[4 * qb], qn[4 * qb + 1]), fmaxf(qn[4 * qb + 2], qn[4 * qb + 3]));
                      const float rthr = (150.f + 2.f * sqrtf(qm * km)) / slope2;
                      const int side = __builtin_amdgcn_readfirstlane((int)fminf(rthr * (1.f / 64.f), 64.f)) + 2;
                      nL = min(4 * qb, side); int nR = min(60 - 4 * qb, side); NT = 4 + nL + nR;
                      if (NT & 1) { if (nL < 4 * qb) ++nL; else ++nR; ++NT; } }
                    att::pass(o, pb + (size_t)qpos * ACOLS + h * 128 + mp * 64 + hiu * 8, pb + 512 + h * 128 + mp * 64, pb + 1024 + h * 128, qpos, qb, slope2, (char*)lds_raw, tid, nL, NT);
                    if (mp == 0) {
                        int z2 = 0; asm volatile("" : "+s"(z2));
                        GAS f32x4* pk = (GAS f32x4*)((float*)(ws + WS_PARK) + (size_t)(bx * 8 + wid) * 4096 + lane * 64 + z2);
#pragma unroll
                        for (int d = 0; d < 4; ++d)
#pragma unroll
                            for (int k = 0; k < 4; ++k) pk[d * 4 + k] = (f32x4){o[d][4 * k], o[d][4 * k + 1], o[d][4 * k + 2], o[d][4 * k + 3]};
                    }
                    __builtin_amdgcn_sched_barrier(0);
                }
                asm volatile("s_waitcnt vmcnt(0)" ::: "memory");
                int zz = 0; asm volatile("" : "+s"(zz));
                float lam;
                { float s1 = 0.f, s2 = 0.f; for (int i = 0; i < 64; ++i) { s1 += args.in[13][i + zz] * args.in[14][i + zz]; s2 += args.in[15][i + zz] * args.in[16][i + zz]; } lam = expf(s1) - expf(s2) + 0.2f; }
                const float* subg = args.in[17] + zz;
                int lane_c = lane; asm volatile("" : "+v"(lane_c)); const int r32c = lane_c & 31, hic = lane_c >> 5;
                {
                    const GAS f32x4* pk = (const GAS f32x4*)((float*)(ws + WS_PARK) + (size_t)(bx * 8 + wid) * 4096 + lane_c * 64 + zz);
#pragma unroll
                    for (int d = 0; d < 4; ++d)
#pragma unroll
                        for (int k = 0; k < 4; ++k) { const f32x4 pv = pk[d * 4 + k];
#pragma unroll
                            for (int q = 0; q < 4; ++q) o[d][4 * k + q] = pv[q] - lam * o[d][4 * k + q]; }
                }
#pragma unroll
                for (int r = 0; r < 16; ++r) {
                    float ss = 0.f;
#pragma unroll
                    for (int d = 0; d < 4; ++d) ss += o[d][r] * o[d][r];
                    ss += sx<1>(ss); ss += sx<2>(ss); ss += sx<4>(ss); ss += sx<8>(ss); ss += sx<16>(ss);
                    const float rs = rsqrtf(ss * (1.f / 128.f) + EPS) * 0.8f;
                    bf16_t* op = MIX + ((size_t)b * SEQ + q0 + wid * 32 + att::crow(r, hic)) * DM + 512 + h * 128 + r32c;
#pragma unroll
                    for (int d = 0; d < 4; ++d) op[d * 32] = (bf16_t)f2bf(o[d][r] * rs * subg[d * 32 + r32c]);
                }
            }
        }
    }
    xcd_barrier(bar);

    {
        PHASE_IDS();
        const float* hg = args.in[12];
        LAS unsigned short* tile = (LAS unsigned short*)lds;
        LAS float* rs = (LAS float*)(lds + 32768);
        int rep_3a = REP_P3A; asm volatile("" : "+s"(rep_3a));
        for (int rep_ = 0; rep_ < rep_3a; ++rep_)
        for (int it = bx; it < 8 * 128; it += G) {
            const int g = it & 7, tb = it >> 3, t0 = tb * 32;
            __syncthreads();
            for (int q = tid; q < 64 * 32; q += 512) { const int ch = q >> 5, seg = q & 31;
                const u32x4 v = *(const GAS u32x4*)(HZ + ((size_t)(g * 64 + ch) * SEQ + t0 + seg) * 8);
                *(LAS u32x4*)(tile + ch * 256 + seg * 8) = v; }
            __syncthreads();
            if (tid < 256) { float s = 0.f; for (int ch = 0; ch < 64; ++ch) { const float v = bf2f(tile[ch * 256 + tid]); s += v * v; } rs[tid] = rsqrtf(s * (1.f / 64.f) + EPS); }
            __syncthreads();
            for (int q = tid; q < 256 * 8; q += 512) { const int tk = q >> 3, c8 = (q & 7) * 8;
                const float r = rs[tk]; const int t = t0 + (tk >> 3), b = tk & 7;
                float v[8];
#pragma unroll
                for (int j = 0; j < 8; ++j) v[j] = bf2f(tile[(c8 + j) * 256 + tk]) * r * hg[g * 64 + c8 + j];
                u32x4 w; w.x = pk2(v[0], v[1]); w.y = pk2(v[2], v[3]); w.z = pk2(v[4], v[5]); w.w = pk2(v[6], v[7]);
                *(GAS u32x4*)(MIX + ((size_t)b * SEQ + t) * DM + g * 64 + c8) = w; }
        }
        __syncthreads();
    }
    xcd_barrier(bar);

    {
        pg8::GeoPlain S; S.A = MIX; S.Bt = WOUT; S.KB = DM * 2; S.ord.init(NTOK / 256, DM / 256, G, bx);
        pg8::EpiResF32 E{x, out, DM};
        for (int rep_ = 0; rep_ < REP_P3B; ++rep_) pg8::gemm_phase<false>(lds, (LAS unsigned*)(lds + TBL_OFF), S, E, wave_s);
    }
    xcd_barrier(bar);

    {
        PHASE_IDS();
        const float* g = args.in[19]; const float* wr = args.in[20];
        LAS float* gwl = (LAS float*)lds;
        for (int q = tid; q < DM * 4; q += 512) { const f32x4 w4 = ((const GAS f32x4*)wr)[q]; const float gd = g[q >> 2]; *(LAS f32x4*)(gwl + (q >> 2) * 20 + (q & 3) * 4) = w4 * gd; }
        __syncthreads();
        const int i16 = lane & 15, q4 = lane >> 4;
        int rep_4a = REP_P4A; asm volatile("" : "+s"(rep_4a));
        for (int rep_ = 0; rep_ < rep_4a; ++rep_)
        for (int grp = gw; grp < NTOK / 16; grp += NGW) {
            const int tok0 = grp * 16;
            const float* xrow = out + (size_t)(tok0 + i16) * DM + 4 * q4;
            const LAS float* bp = gwl + (4 * q4) * 20 + i16;
            f32x4 acc = (f32x4){0.f, 0.f, 0.f, 0.f}; float ss = 0.f;
#pragma unroll 8
            for (int kk = 0; kk < 64; ++kk) {
                const f32x4 a = *(const GAS f32x4*)(xrow + 16 * kk);
                ss += (a.x * a.x + a.y * a.y) + (a.z * a.z + a.w * a.w);
                const LAS float* b = bp + kk * 320;
                acc = __builtin_amdgcn_mfma_f32_16x16x4f32(a.x, b[0], acc, 0, 0, 0);
                acc = __builtin_amdgcn_mfma_f32_16x16x4f32(a.y, b[20], acc, 0, 0, 0);
                acc = __builtin_amdgcn_mfma_f32_16x16x4f32(a.z, b[40], acc, 0, 0, 0);
                acc = __builtin_amdgcn_mfma_f32_16x16x4f32(a.w, b[60], acc, 0, 0, 0);
            }
            ss += sx<16>(ss); ss = sum32x(ss);
            const float r = rsqrtf(ss * (1.f / DM) + EPS);
            f32x4 af;
#pragma unroll
            for (int reg = 0; reg < 4; ++reg) {
                const float lg = acc[reg] * lane_read(r, 4 * q4 + reg);
                float mx = lg; mx = fmaxf(mx, sx<1>(mx)); mx = fmaxf(mx, sx<2>(mx)); mx = fmaxf(mx, sx<4>(mx)); mx = fmaxf(mx, sx<8>(mx));
                const float ex = expf(lg - mx); float den = ex; den += sx<1>(den); den += sx<2>(den); den += sx<4>(den); den += sx<8>(den);
                af[reg] = ex / den;
            }
            const int b = tok0 >> 12, t0 = tok0 & 4095;
            *(GAS f32x4*)(AFF + ((size_t)i16 * NB + b) * SEQ + t0 + 4 * q4) = af;
            *(GAS u32x2*)(INV + (size_t)tok0 * 16 + lane * 4) = (u32x2){0xffffffffu, 0xffffffffu};
            for (int i = 0; i < 16; ++i) {
                const float ri = lane_read(r, i);
                const GAS f32x4* xr = (const GAS f32x4*)(out + (size_t)(tok0 + i) * DM) + lane;
                GAS unsigned* o4 = (GAS unsigned*)(H2 + (size_t)(tok0 + i) * DM) + lane;
#pragma unroll
                for (int j = 0; j < 4; ++j) { const f32x4 v = xr[64 * j]; const f32x4 gg = ((const GAS f32x4*)g)[lane + 64 * j];
                    int t = __builtin_amdgcn_cvt_pk_fp8_f32(v.x * ri * gg.x, v.y * ri * gg.y, 0, false); t = __builtin_amdgcn_cvt_pk_fp8_f32(v.z * ri * gg.z, v.w * ri * gg.w, t, true); o4[64 * j] = (unsigned)t; }
            }
        }
        __syncthreads();
    }
    xcd_barrier(bar);

    {
        PHASE_IDS();
        LAS unsigned* hist = (LAS unsigned*)lds; LAS unsigned* scan = hist + 256; LAS unsigned* selw = scan + 512;
        int rep_4b = REP_P4B; asm volatile("" : "+s"(rep_4b));
        for (int rep_ = 0; rep_ < rep_4b; ++rep_)
        for (int eb = bx; eb < NE * NB; eb += G) {
            const int b = eb & 7, e = eb >> 3;
            const float* a = AFF + (size_t)eb * SEQ;
            unsigned v[8];
#pragma unroll
            for (int j = 0; j < 8; ++j) v[j] = __float_as_uint(a[tid * 8 + j]);
            unsigned prefix = 0, mask = 0, need = CAP;
            __syncthreads();
            for (int pass = 0; pass < 4; ++pass) {
                const int shift = 24 - 8 * pass;
                if (tid < 256) hist[tid] = 0;
                __syncthreads();
#pragma unroll
                for (int j = 0; j < 8; ++j) if ((v[j] & mask) == prefix) atomicAdd((unsigned*)&hist[(v[j] >> shift) & 255u], 1u);
                __syncthreads();
                if (tid < 256) scan[tid] = hist[tid];
                __syncthreads();
                for (int off = 1; off < 256; off <<= 1) { const unsigned xx = (tid < 256 && tid + off < 256) ? scan[tid + off] : 0u; __syncthreads(); if (tid < 256) scan[tid] += xx; __syncthreads(); }
                if (tid < 256) { const unsigned above = tid < 255 ? scan[tid + 1] : 0u; if (above < need && need <= scan[tid]) { selw[0] = (unsigned)tid; selw[1] = need - above; } }
                __syncthreads();
                prefix |= selw[0] << shift; mask |= 255u << shift; need = selw[1];
                __syncthreads();
            }
            unsigned cg = 0, ce = 0;
#pragma unroll
            for (int j = 0; j < 8; ++j) { cg += v[j] > prefix; ce += v[j] == prefix; }
            scan[tid] = (cg << 16) | ce;
            __syncthreads();
            for (int off = 1; off < 512; off <<= 1) { const unsigned xx = tid >= off ? scan[tid - off] : 0u; __syncthreads(); scan[tid] += xx; __syncthreads(); }
            const unsigned incl = scan[tid]; unsigned pg = (incl >> 16) - cg, pe = (incl & 0xffffu) - ce;
#pragma unroll
            for (int j = 0; j < 8; ++j) {
                const bool isg = v[j] > prefix, ise = v[j] == prefix;
                if (isg || (ise && pe < need)) {
                    const unsigned pos = pg + (pe < need ? pe : need); const int token = b * SEQ + tid * 8 + j;
                    TOK[(size_t)eb * CAP + pos] = token; GSEL[(size_t)eb * CAP + pos] = __uint_as_float(v[j]); INV[(size_t)token * 16 + e] = (unsigned short)pos;
                }
                pg += isg; pe += ise;
            }
            __syncthreads();
        }
    }
    xcd_barrier(bar);

    {
        pg8::GeoExpert<true> S; S.A = H2; S.Bt = WGU; S.KB = DM; S.bexp = (size_t)2 * FF * DM; S.tok = TOK; S.ord.init(NSLOT / 256, 2 * FF / 256, G, bx);
        pg8::EpiSwiGLU E{ACT, FF};
        for (int rep_ = 0; rep_ < REP_P5; ++rep_) pg8::gemm_phase<true>(lds, (LAS unsigned*)(lds + TBL_OFF), S, E, wave_s);
    }
    xcd_barrier(bar);

    {
        pg8::GeoExpert<false> S; S.A = ACT; S.Bt = WD; S.KB = FF; S.bexp = (size_t)DM * FF; S.tok = nullptr; S.ord.init(NSLOT / 256, DM / 256, G, bx);
        pg8::EpiBf16 E{Y, DM, 0, 1.f};
        for (int rep_ = 0; rep_ < REP_P6; ++rep_) pg8::gemm_phase<true>(lds, (LAS unsigned*)(lds + TBL_OFF), S, E, wave_s);
    }
    xcd_barrier(bar);

    {
        PHASE_IDS();
        const float* g = args.in[24];
        for (int m = gw; m < NTOK; m += NGW) {
            const GAS f32x4* xr = (const GAS f32x4*)(out + (size_t)m * DM) + lane;
            f32x4 v[4];
#pragma unroll
            for (int j = 0; j < 4; ++j) v[j] = xr[64 * j];
            const int b = m >> 12;
            const unsigned short myinv = INV[(size_t)m * 16 + (lane & 15)];
            for (int e = 0; e < 16; ++e) {
                const unsigned s = (unsigned)lane_read_i((int)myinv, e);
                if (s != 0xffffu) {
                    const size_t slot = ((size_t)e * NB + b) * CAP + s;
                    const float gv = GSEL[slot];
                    const GAS u32x2* yr = (const GAS u32x2*)(Y + slot * DM) + lane;
#pragma unroll
                    for (int j = 0; j < 4; ++j) { const u32x2 w = yr[64 * j]; v[j].x += gv * bflo(w.x); v[j].y += gv * bfhi(w.x); v[j].z += gv * bflo(w.y); v[j].w += gv * bfhi(w.y); }
                }
            }
            float s = 0.f;
#pragma unroll
            for (int j = 0; j < 4; ++j) s += (v[j].x * v[j].x + v[j].y * v[j].y) + (v[j].z * v[j].z + v[j].w * v[j].w);
            const float r = rsqrtf(wave_sum(s) * (1.f / DM) + EPS);
            GAS f32x4* o = (GAS f32x4*)(out + (size_t)m * DM) + lane;
#pragma unroll
            for (int j = 0; j < 4; ++j) { const f32x4 gg = ((const GAS f32x4*)g)[lane + 64 * j]; o[64 * j] = (f32x4){v[j].x * r * gg.x, v[j].y * r * gg.y, v[j].z * r * gg.z, v[j].w * r * gg.w}; }
        }
    }
}

extern "C" void kernel_launch(void* const* d_in, const int* in_sizes, int n_in, void* d_out, int out_size, void* d_ws, size_t ws_size, hipStream_t stream) {
    static int grid = 0;
    if (grid == 0) {
        if (n_in != 25 || ws_size < WS_END) { fprintf(stderr, "kernel_launch: unexpected n_in %d / ws %zu\n", n_in, ws_size); grid = -1; return; }
        int dev = 0, cus = 0;
        if (hipGetDevice(&dev) != hipSuccess || hipDeviceGetAttribute(&cus, hipDeviceAttributeMultiprocessorCount, dev) != hipSuccess) { grid = -1; return; }
        if (hipFuncSetAttribute((const void*)mega_fwd, hipFuncAttributeMaxDynamicSharedMemorySize, LDS_BYTES) != hipSuccess) { fprintf(stderr, "kernel_launch: hipFuncSetAttribute failed\n"); grid = -1; return; }
        int per_cu = 0;
        if (hipOccupancyMaxActiveBlocksPerMultiprocessor(&per_cu, (const void*)mega_fwd, 512, LDS_BYTES) != hipSuccess || per_cu < 1) fprintf(stderr, "kernel_launch: occupancy query says %d\n", per_cu);
        (void)hipGetLastError();
        grid = cus;
    }
    if (grid < 0) return;
    (void)hipMemsetAsync((char*)d_ws + WS_CTL, 0, CTL_BYTES, stream);
    Args a; memset(&a, 0, sizeof a);
    for (int i = 0; i < 25; ++i) a.in[i] = (const float*)d_in[i];
    a.out = (float*)d_out; a.ws = (unsigned char*)d_ws;
    hipLaunchKernelGGL(mega_fwd, dim3(grid), dim3(512), LDS_BYTES, stream, a);
}
```

```cpp
#include <hip/hip_runtime.h>
#include <cstdio>
#include <cstdint>
#include <cstring>

#define GAS __attribute__((address_space(1)))
#define LAS __attribute__((address_space(3)))
typedef unsigned short bf16_t;
typedef short bf16x8 __attribute__((ext_vector_type(8)));
typedef float f32x4 __attribute__((ext_vector_type(4)));
typedef float f32x2 __attribute__((ext_vector_type(2)));
typedef unsigned u32x4 __attribute__((ext_vector_type(4)));
typedef unsigned u32x2 __attribute__((ext_vector_type(2)));
typedef short v4i16_t __attribute__((ext_vector_type(4)));
typedef int i32x4 __attribute__((ext_vector_type(4)));
typedef int i32x8 __attribute__((ext_vector_type(8)));
constexpr int F8_SCALES = 127 | (122 << 8);
typedef float f32x16 __attribute__((ext_vector_type(16)));

constexpr int DM = 1024, NB = 8, SEQ = 4096, NTOK = NB * SEQ;
constexpr int HW = 512, HCOLS = 1536, INC = 3072, ACOLS = 1536;
constexpr int NE = 16, CAP = 512, FF = 2816, NSLOT = NE * NB * CAP;
constexpr float EPS = 1e-6f;
constexpr float LOG2E = 1.4426950408889634f;
constexpr float QSCALE = 0.125f * LOG2E;
constexpr int GOFF = 4352, GLEN = 8704;

constexpr size_t MiB = 1u << 20;
constexpr size_t WS_CTL = 0, CTL_BYTES = 1 * MiB;
constexpr size_t WS_WGU = 2 * MiB;
constexpr size_t WS_WD = 90 * MiB;
constexpr size_t WS_AFF = 134 * MiB;
constexpr size_t WS_TOK = 136 * MiB;
constexpr size_t WS_GSEL = WS_TOK + 256 * 1024;
constexpr size_t WS_INV = 137 * MiB;
constexpr size_t WS_XN = 138 * MiB;
constexpr size_t WS_H2 = WS_XN;
constexpr size_t WS_WIN = 202 * MiB;
constexpr size_t WS_WOUT = 208 * MiB;
constexpr size_t WS_GF = 210 * MiB;
constexpr size_t WS_HP = 228 * MiB;
constexpr size_t WS_QKV = 324 * MiB;
constexpr size_t WS_ACT = 228 * MiB;
constexpr size_t WS_HZ = 420 * MiB;
constexpr size_t WS_MIX = 452 * MiB;
constexpr size_t WS_PARK = 516 * MiB;
constexpr size_t WS_Y = 420 * MiB;
constexpr size_t WS_END = 548 * MiB;
constexpr int CW_BAR = 4096;
constexpr int CW_NSUM = 16384;

constexpr int REP_XN = 1, REP_P3A = 1, REP_P4A = 1, REP_P4B = 1;
constexpr int REP_P0W = 1, REP_P1 = 1, REP_HY = 1, REP_AT = 1, REP_P3B = 1, REP_P5 = 1, REP_P6 = 1;
constexpr int LDS_BYTES = 160 * 1024;
constexpr int MISC_OFF = LDS_BYTES - 256;
constexpr int HY_ZBYTES = (SEQ + 32) * 16, HY_ZA = 0, HY_ZB = HY_ZBYTES, HY_FB = 2 * HY_ZBYTES;
constexpr int TBL_OFF = 131072;

__device__ __forceinline__ unsigned f2bf(float f) { unsigned u = __builtin_bit_cast(unsigned, f); return (u + 0x7fffu + ((u >> 16) & 1u)) >> 16; }
__device__ __forceinline__ unsigned pk2(float lo, float hi) { return f2bf(lo) | (f2bf(hi) << 16); }
__device__ __forceinline__ float bf2f(unsigned short h) { return __builtin_bit_cast(float, (unsigned)h << 16); }
__device__ __forceinline__ float bflo(unsigned w) { return __builtin_bit_cast(float, w << 16); }
__device__ __forceinline__ float bfhi(unsigned w) { return __builtin_bit_cast(float, w & 0xffff0000u); }
template <int M> __device__ __forceinline__ float sx(float v) { static_assert(M >= 1 && M <= 16, "sx: xor mask 1..16"); return __int_as_float(__builtin_amdgcn_ds_swizzle(__float_as_int(v), (M << 10) | 0x1f)); }
__device__ __forceinline__ float sum32x(float v) { auto r = __builtin_amdgcn_permlane32_swap(__float_as_uint(v), __float_as_uint(v), false, false); return __uint_as_float(r[0]) + __uint_as_float(r[1]); }
__device__ __forceinline__ float max32x(float v) { auto r = __builtin_amdgcn_permlane32_swap(__float_as_uint(v), __float_as_uint(v), false, false); return fmaxf(__uint_as_float(r[0]), __uint_as_float(r[1])); }
__device__ __forceinline__ float lane_read(float v, int src) { return __int_as_float(__builtin_amdgcn_ds_bpermute(src << 2, __float_as_int(v))); }
__device__ __forceinline__ int lane_read_i(int v, int src) { return __builtin_amdgcn_ds_bpermute(src << 2, v); }
__device__ __forceinline__ float wave_sum(float v) { v += sx<1>(v); v += sx<2>(v); v += sx<4>(v); v += sx<8>(v); v += sx<16>(v); return sum32x(v); }
__device__ __forceinline__ float wave_max(float v) { v = fmaxf(v, sx<1>(v)); v = fmaxf(v, sx<2>(v)); v = fmaxf(v, sx<4>(v)); v = fmaxf(v, sx<8>(v)); v = fmaxf(v, sx<16>(v)); return max32x(v); }
#define LDS_WAIT() asm volatile("s_waitcnt lgkmcnt(0)" ::: "memory")
__device__ __forceinline__ int lane_id_v() { int l; asm volatile("v_mbcnt_lo_u32_b32 %0, -1, 0\n\tv_mbcnt_hi_u32_b32 %0, -1, %0" : "=v"(l)); return l; }
#define PHASE_IDS() const int wave = wave_s; int tid_o = wave_s * 64 + lane_id_v(); asm volatile("" : "+v"(tid_o)); const int tid = tid_o, lane = tid & 63, gw = blockIdx.x * 8 + wave; (void)lane; (void)gw

namespace pg8 {
constexpr int BM = 256, BK = 64, HALF = 128, HTB = HALF * BK * 2, STAGE_BYTES = 8 * HTB, NXCD = 8, WGM = 8;
__host__ __device__ __forceinline__ int lds_byte(int r, int c) { const int st = (r >> 4) * 2 + (c >> 5), rr = r & 15, cc = c & 31, ob = rr * 64 + cc * 2; return st * 1024 + (ob ^ (((ob >> 9) & 1) << 5)); }
__host__ __device__ __forceinline__ void stage_rc(int b, int& R, int& C) { const int st = b / 1024, sb = b % 1024, swz = sb ^ (((sb >> 9) & 1) << 5); R = (st >> 1) * 16 + swz / 64; C = (st & 1) * 32 + (swz % 64) / 2; }
__host__ __device__ __forceinline__ int perm32(int rho) { const int n = rho >> 4, i = rho & 15; return 8 * (i >> 2) + 4 * n + (i & 3); }
struct Unit { int pm, pn; };

struct TileOrder {
    int nM, nN, nwg, G, c;
    __device__ void init(int nM_, int nN_, int G_, int c_) { nM = nM_; nN = nN_; nwg = nM * nN; G = G_; c = c_; }
    __device__ bool next(int i, Unit& u) const {
        const long L = (long)i * G + c; if (L >= nwg) return false;
        int wgid = (int)L; { const int q = nwg / NXCD, r = nwg % NXCD, xcd = wgid % NXCD, off = wgid / NXCD; wgid = (xcd < r ? xcd * (q + 1) : r * (q + 1) + (xcd - r) * q) + off; }
        const int nig = WGM * nN, gid = wgid / nig, fm = gid * WGM, gsz = (nM - fm) < WGM ? (nM - fm) : WGM;
        u.pm = fm + ((wgid % nig) % gsz); u.pn = (wgid % nig) / gsz; return true;
    }
};
__device__ __forceinline__ unsigned cvt_pk_bf16(float lo, float hi) { unsigned r; asm volatile("v_cvt_pk_bf16_f32 %0, %1, %2" : "=v"(r) : "v"(lo), "v"(hi)); return r; }

struct EpiBf16 {
    static constexpr bool PERM = true;
    bf16_t* O; int ldc; int scols; float sc;
    __device__ __forceinline__ void operator()(const f32x4 (&acc)[2][2][4][2], const Unit& u, int wr, int wc, int fr, int fq) const {
        const int row0 = u.pm * BM + wr * 64 + fr, col0 = u.pn * BM + wc * 32 + 8 * fq;
        const float s = (u.pn * BM < scols) ? sc : 1.f;
#pragma unroll
        for (int ai = 0; ai < 2; ++ai)
#pragma unroll
            for (int m = 0; m < 4; ++m) { bf16_t* rowp = O + (size_t)(row0 + ai * HALF + m * 16) * ldc + col0;
#pragma unroll
                for (int bj = 0; bj < 2; ++bj) { const f32x4 v0 = acc[ai][bj][m][0] * s, v1 = acc[ai][bj][m][1] * s;
                    u32x4 w; w.x = cvt_pk_bf16(v0[0], v0[1]); w.y = cvt_pk_bf16(v0[2], v0[3]); w.z = cvt_pk_bf16(v1[0], v1[1]); w.w = cvt_pk_bf16(v1[2], v1[3]);
                    *(u32x4*)(rowp + bj * HALF) = w; } }
    }
};
struct EpiResF32 {
    static constexpr bool PERM = false;
    const float* R; float* C; int ldc;
    __device__ __forceinline__ void operator()(const f32x4 (&acc)[2][2][4][2], const Unit& u, int wr, int wc, int fr, int fq) const {
        const int row0 = u.pm * BM + wr * 64 + fr, col0 = u.pn * BM + wc * 32 + 4 * fq;
#pragma unroll
        for (int ai = 0; ai < 2; ++ai)
#pragma unroll
            for (int m = 0; m < 4; ++m) { const size_t off = (size_t)(row0 + ai * HALF + m * 16) * ldc + col0;
#pragma unroll
                for (int bj = 0; bj < 2; ++bj)
#pragma unroll
                    for (int n = 0; n < 2; ++n) { const f32x4 r = *(const f32x4*)(R + off + bj * HALF + n * 16); *(f32x4*)(C + off + bj * HALF + n * 16) = r + acc[ai][bj][m][n]; } }
    }
};
struct EpiSwiGLU {
    static constexpr bool PERM = true;
    unsigned char* O; int ldc;
    __device__ __forceinline__ void operator()(const f32x4 (&acc)[2][2][4][2], const Unit& u, int wr, int wc, int fr, int fq) const {
        const int row0 = u.pm * BM + wr * 64 + fr, col0 = u.pn * HALF + wc * 32 + 8 * fq;
#pragma unroll
        for (int ai = 0; ai < 2; ++ai)
#pragma unroll
            for (int m = 0; m < 4; ++m) { unsigned char* rowp = O + (size_t)(row0 + ai * HALF + m * 16) * ldc + col0;
                float o[8];
#pragma unroll
                for (int n = 0; n < 2; ++n)
#pragma unroll
                    for (int j = 0; j < 4; ++j) { const float g = acc[ai][0][m][n][j], up = acc[ai][1][m][n][j];
                        o[n * 4 + j] = g * __builtin_amdgcn_rcpf(1.f + __builtin_amdgcn_exp2f(-g * LOG2E)) * up; }
                u32x2 w; int t0 = __builtin_amdgcn_cvt_pk_fp8_f32(o[0], o[1], 0, false); t0 = __builtin_amdgcn_cvt_pk_fp8_f32(o[2], o[3], t0, true);
                int t1 = __builtin_amdgcn_cvt_pk_fp8_f32(o[4], o[5], 0, false); t1 = __builtin_amdgcn_cvt_pk_fp8_f32(o[6], o[7], t1, true);
                w.x = (unsigned)t0; w.y = (unsigned)t1; *(u32x2*)rowp = w; }
    }
};

struct GeoPlain {
    static constexpr bool GATHER = false;
    const bf16_t* A; const bf16_t* Bt; int KB; TileOrder ord;
    __device__ __forceinline__ bool next(int i, Unit& u) const { return ord.next(i, u); }
    __device__ __forceinline__ const char* a_ptr(const Unit& u) const { return (const char*)A + (size_t)u.pm * BM * KB; }
    __device__ __forceinline__ const char* b_ptr(const Unit& u) const { return (const char*)Bt + (size_t)u.pn * BM * KB; }
    __device__ __forceinline__ size_t hstepA() const { return (size_t)HALF * KB; }
    __device__ __forceinline__ size_t hstepB() const { return (size_t)HALF * KB; }
    __device__ __forceinline__ size_t istepA() const { return (size_t)64 * KB; }
    __device__ __forceinline__ size_t istepB() const { return (size_t)64 * KB; }
    __device__ __forceinline__ unsigned a_voff(int R, int C) const { return (unsigned)(R * KB + C * 2); }
    __device__ __forceinline__ unsigned b_voff(int R, int C) const { return (unsigned)(R * KB + C * 2); }
    __device__ __forceinline__ void fill_table(LAS unsigned*, const Unit&, int) const {}
};
struct GeoTokPerm {
    static constexpr bool GATHER = false;
    const bf16_t* A; const bf16_t* X; int KB; TileOrder ord;
    __device__ __forceinline__ bool next(int i, Unit& u) const { return ord.next(i, u); }
    __device__ __forceinline__ const char* a_ptr(const Unit& u) const { return (const char*)A + (size_t)u.pm * BM * KB; }
    __device__ __forceinline__ const char* b_ptr(const Unit& u) const { return (const char*)X + (size_t)u.pn * 32 * KB; }
    __device__ __forceinline__ size_t hstepA() const { return (size_t)HALF * KB; }
    __device__ __forceinline__ size_t hstepB() const { return (size_t)16 * KB; }
    __device__ __forceinline__ size_t istepA() const { return (size_t)64 * KB; }
    __device__ __forceinline__ size_t istepB() const { return (size_t)8 * KB; }
    __device__ __forceinline__ unsigned a_voff(int R, int C) const { return (unsigned)(R * KB + C * 2); }
    __device__ __forceinline__ unsigned b_voff(int R, int C) const { return (unsigned)(((R & 7) * SEQ + (R >> 3)) * KB + C * 2); }
    __device__ __forceinline__ void fill_table(LAS unsigned*, const Unit&, int) const {}
};
template <bool G> struct GeoExpert {
    static constexpr bool GATHER = G;
    const void* A; const void* Bt; int KB; size_t bexp;    const int* tok; TileOrder ord;
    __device__ __forceinline__ bool next(int i, Unit& u) const { return ord.next(i, u); }
    __device__ __forceinline__ const char* a_ptr(const Unit& u) const { return G ? (const char*)A : (const char*)A + (size_t)u.pm * BM * KB; }
    __device__ __forceinline__ const char* b_ptr(const Unit& u) const { return (const char*)Bt + (size_t)(u.pm >> 4) * bexp + (size_t)u.pn * BM * KB; }
    __device__ __forceinline__ size_t hstepA() const { return (size_t)HALF * KB; }
    __device__ __forceinline__ size_t hstepB() const { return (size_t)HALF * KB; }
    __device__ __forceinline__ size_t istepA() const { return (size_t)64 * KB; }
    __device__ __forceinline__ size_t istepB() const { return (size_t)64 * KB; }
    __device__ __forceinline__ unsigned a_voff(int R, int C) const { return (unsigned)(R * KB + C * 2); }
    __device__ __forceinline__ unsigned b_voff(int R, int C) const { return (unsigned)(R * KB + C * 2); }
    __device__ __forceinline__ void fill_table(LAS unsigned* tb, const Unit& u, int tid) const { if (G) { int t_ = tid; asm volatile("" : "+v"(t_));
#pragma unroll
        for (int i = 0; i < 2; ++i) { int R, C; stage_rc(t_ * 16 + i * 8192, R, C);
#pragma unroll
            for (int h = 0; h < 2; ++h) tb[h * 1024 + i * 512 + tid] = (unsigned)tok[u.pm * 256 + h * 128 + R] * (unsigned)KB + (unsigned)C * 2u; } } }
};

template <bool F8, class Epi, class Geo>
__device__ __forceinline__ void gemm_phase(LAS unsigned char* lds, LAS unsigned* tbl, const Geo& S, const Epi& E, int wave_s) {
    int tid_ = wave_s * 64 + lane_id_v(); asm volatile("" : "+v"(tid_));
    const int tid = tid_, wid = wave_s, lane = tid & 63, wr = wid >> 2, wc = wid & 3, fr = lane & 15, fq = lane >> 4;
    const int nt = S.KB / (BK * 2);
    unsigned voffA, voffB;
    { int R, C; stage_rc(tid * 16, R, C); const int Rb = Epi::PERM ? ((R & ~31) + perm32(R & 31)) : R; voffA = S.a_voff(R, C); voffB = S.b_voff(Rb, C); }
    const size_t istepA = S.istepA(), istepB = S.istepB();
    const size_t kstep = (size_t)(BK * 2);
    const size_t hstepA = S.hstepA(), hstepB = S.hstepB();
    const unsigned ldsw = (unsigned)wid * 1024u;
    const int aoff = lds_byte(wr * 64 + fr, fq * 8), boff = lds_byte(wc * 32 + fr, fq * 8);
    const LAS unsigned char* ldsB = lds + 4 * HTB + boff;
#define PG8_SA(b, h) (((b) * 2 + (h)) * HTB)
#define PG8_SB(b, h) ((4 + (b) * 2 + (h)) * HTB)
#define PG8_GLDS(bufoff, gptr, i_) __builtin_amdgcn_global_load_lds((const unsigned*)(gptr), (LAS unsigned*)(lds + (bufoff) + ldsw + (i_) * 8192), 16, 0, 0)
#define PG8_STAGE_B(bufoff, gbase) do { PG8_GLDS(bufoff, (const char*)(gbase) + voffB, 0); PG8_GLDS(bufoff, (const char*)(gbase) + istepB + voffB, 1); } while (0)
#define PG8_STAGE_A(bufoff, gbase, h, nx) do { if constexpr (Geo::GATHER) { const LAS unsigned* _tb = tbl + (((ui + ((nx) ? 1 : 0)) & 1) * 2048) + (h) * 1024 + tid; \
        const unsigned _v0 = _tb[0], _v1 = _tb[512]; PG8_GLDS(bufoff, (const char*)(gbase) + _v0, 0); PG8_GLDS(bufoff, (const char*)(gbase) + _v1, 1); } \
        else { PG8_GLDS(bufoff, (const char*)(gbase) + (h) * hstepA + voffA, 0); PG8_GLDS(bufoff, (const char*)(gbase) + (h) * hstepA + istepA + voffA, 1); } } while (0)
#define PG8_LD16(off) (*(const LAS i32x4*)(lds + (off)))
#define PG8_LDA(dst, b, h) do { _Pragma("unroll") for (int m = 0; m < 4; ++m) dst[m] = __builtin_shufflevector(PG8_LD16(PG8_SA(b, h) + aoff + m * 2048), PG8_LD16(PG8_SA(b, h) + aoff + m * 2048 + 1024), 0, 1, 2, 3, 4, 5, 6, 7); } while (0)
#define PG8_LDB(dst, b, h) do { _Pragma("unroll") for (int n = 0; n < 2; ++n) dst[n] = __builtin_shufflevector(*(const LAS i32x4*)(ldsB + ((b) * 2 + (h)) * HTB + n * 2048), *(const LAS i32x4*)(ldsB + ((b) * 2 + (h)) * HTB + n * 2048 + 1024), 0, 1, 2, 3, 4, 5, 6, 7); } while (0)
#define PG8_LO(v) __builtin_bit_cast(bf16x8, __builtin_shufflevector(v, v, 0, 1, 2, 3))
#define PG8_HI(v) __builtin_bit_cast(bf16x8, __builtin_shufflevector(v, v, 4, 5, 6, 7))
#define PG8_MMA(ai, bj, At, Bt) do { __builtin_amdgcn_s_setprio(1); _Pragma("unroll") for (int m = 0; m < 4; ++m) _Pragma("unroll") for (int n = 0; n < 2; ++n) { \
        if constexpr (F8) { acc[ai][bj][m][n] = __builtin_amdgcn_mfma_scale_f32_16x16x128_f8f6f4(Bt[n], At[m], acc[ai][bj][m][n], 0, 0, 1, F8_SCALES, 0, F8_SCALES); } \
        else { acc[ai][bj][m][n] = __builtin_amdgcn_mfma_f32_16x16x32_bf16(PG8_LO(Bt[n]), PG8_LO(At[m]), acc[ai][bj][m][n], 0, 0, 0); \
               acc[ai][bj][m][n] = __builtin_amdgcn_mfma_f32_16x16x32_bf16(PG8_HI(Bt[n]), PG8_HI(At[m]), acc[ai][bj][m][n], 0, 0, 0); } } \
        __builtin_amdgcn_s_setprio(0); } while (0)
#define PG8_WAIT_V(n) asm volatile("s_waitcnt vmcnt(" #n ")" ::: "memory")
#define PG8_WAIT_L(n) asm volatile("s_waitcnt lgkmcnt(" #n ")" ::: "memory")
#define PG8_BAR __builtin_amdgcn_s_barrier()
#define PG8_SCHED __builtin_amdgcn_sched_barrier(0)
    Unit cur, nxt; int ui = 0;
    if (!S.next(0, cur)) return;
    f32x4 acc[2][2][4][2];
#pragma unroll
    for (int a = 0; a < 2; ++a)
#pragma unroll
        for (int b = 0; b < 2; ++b)
#pragma unroll
            for (int m = 0; m < 4; ++m)
#pragma unroll
                for (int n = 0; n < 2; ++n) acc[a][b][m][n] = (f32x4){0.f, 0.f, 0.f, 0.f};
    i32x8 At[4], B0[2], B1[2];
    const char* cA = S.a_ptr(cur); const char* cB = S.b_ptr(cur);
    if constexpr (Geo::GATHER) {
        S.fill_table(tbl, cur, tid);
        Unit u1; if (S.next(1, u1)) S.fill_table(tbl + 2048, u1, tid);
        asm volatile("s_waitcnt vmcnt(0) lgkmcnt(0)" ::: "memory"); PG8_BAR; asm volatile("" ::: "memory");
    }
    PG8_STAGE_B(PG8_SB(0, 0), cB); PG8_STAGE_B(PG8_SB(0, 1), cB + hstepB); PG8_STAGE_A(PG8_SA(0, 0), cA, 0, false); PG8_STAGE_A(PG8_SA(0, 1), cA, 1, false);
    if (wr == 1) PG8_BAR;
    PG8_WAIT_V(2); PG8_BAR;
    PG8_STAGE_B(PG8_SB(1, 0), cB + kstep); PG8_STAGE_A(PG8_SA(1, 0), cA + kstep, 0, false); PG8_STAGE_B(PG8_SB(1, 1), cB + hstepB + kstep);
    PG8_WAIT_V(6); PG8_BAR;
    for (;;) {
        const bool has_next = S.next(ui + 1, nxt);
        const char* nA = has_next ? S.a_ptr(nxt) : cA; const char* nB = has_next ? S.b_ptr(nxt) : cB;
#pragma clang loop unroll(disable)
        for (int t = 0; t < nt; t += 2) {
            const bool last = (t == nt - 2);
            const bool lastn = last && has_next;
            const char* a1 = cA + (size_t)(t + 1) * kstep;
            const char* a2 = last ? nA : cA + (size_t)(t + 2) * kstep; const char* b2 = last ? nB : cB + (size_t)(t + 2) * kstep;
            const char* a3 = a2 + kstep; const char* b3 = b2 + kstep;
            if constexpr (Geo::GATHER) { if (t == 2 && ui > 0) { Unit u2; if (S.next(ui + 1, u2)) S.fill_table(tbl + (((ui + 1) & 1) * 2048), u2, tid); } }
            PG8_LDB(B0, 0, 0); PG8_LDB(B1, 0, 1); PG8_SCHED; PG8_LDA(At, 0, 0); PG8_STAGE_A(PG8_SA(1, 1), a1, 1, false);
            PG8_WAIT_V(8); PG8_WAIT_L(0); PG8_BAR; PG8_MMA(0, 0, At, B0); PG8_MMA(0, 1, At, B1); PG8_BAR; PG8_SCHED;
            PG8_LDA(At, 0, 1); PG8_STAGE_B(PG8_SB(0, 0), b2); PG8_STAGE_B(PG8_SB(0, 1), b2 + hstepB); PG8_STAGE_A(PG8_SA(0, 0), a2, 0, lastn);
            PG8_WAIT_V(8); PG8_WAIT_L(0); PG8_BAR; PG8_MMA(1, 0, At, B0); PG8_MMA(1, 1, At, B1); PG8_BAR; PG8_SCHED;
            PG8_LDB(B0, 1, 0); PG8_LDB(B1, 1, 1); PG8_SCHED; PG8_LDA(At, 1, 0); PG8_STAGE_A(PG8_SA(0, 1), a2, 1, lastn);
            PG8_WAIT_V(8); PG8_WAIT_L(0); PG8_BAR; PG8_MMA(0, 0, At, B0); PG8_MMA(0, 1, At, B1); PG8_BAR; PG8_SCHED;
            PG8_LDA(At, 1, 1); PG8_STAGE_B(PG8_SB(1, 0), b3); PG8_STAGE_B(PG8_SB(1, 1), b3 + hstepB); PG8_STAGE_A(PG8_SA(1, 0), a3, 0, lastn);
            PG8_WAIT_V(8); PG8_WAIT_L(0); PG8_BAR; PG8_MMA(1, 0, At, B0); PG8_MMA(1, 1, At, B1); PG8_BAR; PG8_SCHED;
        }
        if (wr == 0) PG8_BAR;
        { const int l_e = lane_id_v();
          E(acc, cur, wr, wc, l_e & 15, l_e >> 4); }
        if (!has_next) break;
#pragma unroll
        for (int a = 0; a < 2; ++a)
#pragma unroll
            for (int b = 0; b < 2; ++b)
#pragma unroll
                for (int m = 0; m < 4; ++m)
#pragma unroll
                    for (int n = 0; n < 2; ++n) acc[a][b][m][n] = (f32x4){0.f, 0.f, 0.f, 0.f};
        cur = nxt; cA = nA; cB = nB; ++ui;
        if (wr == 1) PG8_BAR;
    }
    PG8_WAIT_V(0);
    PG8_BAR;
#undef PG8_SA
#undef PG8_SB
#undef PG8_GLDS
#undef PG8_STAGE_B
#undef PG8_STAGE_A
#undef PG8_LDA
#undef PG8_LDB
#undef PG8_LD16
#undef PG8_LO
#undef PG8_HI
#undef PG8_MMA
#undef PG8_WAIT_V
#undef PG8_WAIT_L
#undef PG8_BAR
#undef PG8_SCHED
}
}

namespace att {
constexpr int KVBLK = 64, LDQKV = ACOLS;
constexpr int SHM_V = KVBLK * 128 * 2, SHM_K = KVBLK * 64 * 2, OFF_V = 0, OFF_K = 2 * SHM_V, OFF_WS = OFF_K + 2 * SHM_K, LDS_TOTAL = OFF_WS + 8 * 64 * 4;
constexpr float THR = 8.f;
#define KSWZ64(row, colB) ((row) * 128 + ((colB) ^ ((((row) >> 1) & 7) << 4)))
#define SBAR() __builtin_amdgcn_sched_barrier(0)
__device__ __forceinline__ int crow(int r, int hi) { return (r & 3) + 8 * (r >> 2) + 4 * hi; }
__device__ __forceinline__ unsigned cvtpk(float lo, float hi) { unsigned r; asm volatile("v_cvt_pk_bf16_f32 %0, %1, %2" : "=v"(r) : "v"(lo), "v"(hi)); return r; }
__device__ __forceinline__ int v_st(int k, int c) { const int kk = (k & ~0xC) | ((k & 4) << 1) | ((k & 8) >> 1); return ((kk >> 3) * 4 + (c >> 5)) * 512 + ((kk & 7) * 32 + (c & 31)) * 2; }
__device__ __forceinline__ int v_rd_base(int lane) { return ((lane & 3) << 3) | (((lane >> 2) & 3) << 6) | (((lane >> 4) & 1) << 5) | (((lane >> 5) & 1) << 8); }
constexpr int v_rd_off(int d0, int ks, int half) { return d0 * 512 + ks * 4096 + half * 2048; }
template <int OFF> __device__ __forceinline__ v4i16_t tr_read(int vb) { v4i16_t r; asm volatile("ds_read_b64_tr_b16 %0, %1 offset:%2" : "=&v"(r) : "v"(vb), "i"(OFF) : "memory"); return r; }
template <int D0> __device__ __forceinline__ void pv_one(f32x16& od, int vb, bf16x8 pa0, bf16x8 pa1, bf16x8 pa2, bf16x8 pa3) {
    const v4i16_t l0 = tr_read<v_rd_off(D0, 0, 0)>(vb), h0 = tr_read<v_rd_off(D0, 0, 1)>(vb), l1 = tr_read<v_rd_off(D0, 1, 0)>(vb), h1 = tr_read<v_rd_off(D0, 1, 1)>(vb);
    const v4i16_t l2 = tr_read<v_rd_off(D0, 2, 0)>(vb), h2 = tr_read<v_rd_off(D0, 2, 1)>(vb), l3 = tr_read<v_rd_off(D0, 3, 0)>(vb), h3 = tr_read<v_rd_off(D0, 3, 1)>(vb);
    asm volatile("s_waitcnt lgkmcnt(0)" ::: "memory"); SBAR();
#define PK(L, H) (bf16x8){L[0], L[1], L[2], L[3], H[0], H[1], H[2], H[3]}
    od = __builtin_amdgcn_mfma_f32_32x32x16_bf16(pa0, PK(l0, h0), od, 0, 0, 0);
    od = __builtin_amdgcn_mfma_f32_32x32x16_bf16(pa1, PK(l1, h1), od, 0, 0, 0);
    od = __builtin_amdgcn_mfma_f32_32x32x16_bf16(pa2, PK(l2, h2), od, 0, 0, 0);
    od = __builtin_amdgcn_mfma_f32_32x32x16_bf16(pa3, PK(l3, h3), od, 0, 0, 0);
#undef PK
}
__device__ __forceinline__ void pv_d0(f32x16* o, int vb, bf16x8 pa0, bf16x8 pa1, bf16x8 pa2, bf16x8 pa3) {
    pv_one<0>(o[0], vb, pa0, pa1, pa2, pa3); pv_one<1>(o[1], vb, pa0, pa1, pa2, pa3); pv_one<2>(o[2], vb, pa0, pa1, pa2, pa3); pv_one<3>(o[3], vb, pa0, pa1, pa2, pa3);
}
__device__ __forceinline__ void qkt(f32x16& p0, f32x16& p1, const char* Ks, const bf16x8* qr, const f32x16& negm, int r32, int hi, float dq, float slope2) {
#pragma unroll
    for (int d0 = 0; d0 < 4; ++d0) { const int cb = (d0 * 16 + hi * 8) * 2;
        const bf16x8 b0 = *reinterpret_cast<const bf16x8*>(Ks + KSWZ64(r32, cb));
        const bf16x8 b1 = *reinterpret_cast<const bf16x8*>(Ks + KSWZ64(32 + r32, cb));
        if (d0 == 0) { p0 = __builtin_amdgcn_mfma_f32_32x32x16_bf16(b0, qr[0], negm, 0, 0, 0); p1 = __builtin_amdgcn_mfma_f32_32x32x16_bf16(b1, qr[0], negm, 0, 0, 0); }
        else { p0 = __builtin_amdgcn_mfma_f32_32x32x16_bf16(b0, qr[d0], p0, 0, 0, 0); p1 = __builtin_amdgcn_mfma_f32_32x32x16_bf16(b1, qr[d0], p1, 0, 0, 0); } }
    asm volatile("" : "+v"(dq), "+v"(p0), "+v"(p1));
#pragma unroll
    for (int r = 0; r < 16; ++r) { const float cr = (float)((r & 3) + 8 * (r >> 2)); p0[r] = fmaf(-slope2, fabsf(dq - cr), p0[r]); p1[r] = fmaf(-slope2, fabsf(dq - 32.f - cr), p1[r]); }
}
__device__ __forceinline__ void partialSM(f32x16& p0, f32x16& p1, f32x16& negm, float& alpha) {
    float pmax = p0[0];
#pragma unroll
    for (int r = 1; r < 16; ++r) pmax = fmaxf(pmax, p0[r]);
#pragma unroll
    for (int r = 0; r < 16; ++r) pmax = fmaxf(pmax, p1[r]);
    { auto rr = __builtin_amdgcn_permlane32_swap(__float_as_uint(pmax), __float_as_uint(pmax), false, false); pmax = fmaxf(__uint_as_float(rr[0]), __uint_as_float(rr[1])); }
    if (__builtin_expect(!__any(pmax > THR), 1)) { alpha = 1.f; }
    else { const float dl = fmaxf(pmax, 0.f); alpha = __builtin_amdgcn_exp2f(-dl);
#pragma unroll
        for (int r = 0; r < 16; ++r) { p0[r] -= dl; p1[r] -= dl; negm[r] -= dl; } }
#pragma unroll
    for (int r = 0; r < 16; ++r) p0[r] = __builtin_amdgcn_exp2f(p0[r]);
}
__device__ __forceinline__ void finishSM(f32x16& p0, f32x16& p1, float alpha, float& l_reg, bf16x8& pa0, bf16x8& pa1, bf16x8& pa2, bf16x8& pa3) {
#pragma unroll
    for (int r = 0; r < 16; ++r) p1[r] = __builtin_amdgcn_exp2f(p1[r]);
    float ps = 0.f;
#pragma unroll
    for (int r = 0; r < 16; ++r) ps += p0[r];
#pragma unroll
    for (int r = 0; r < 16; ++r) ps += p1[r];
    { auto rr = __builtin_amdgcn_permlane32_swap(__float_as_uint(ps), __float_as_uint(ps), false, false); ps = __uint_as_float(rr[0]) + __uint_as_float(rr[1]); }
    l_reg = l_reg * alpha + ps;
#define PK4(P, BASE, OUT) do { const unsigned a0 = cvtpk(P[BASE + 0], P[BASE + 1]), a1 = cvtpk(P[BASE + 2], P[BASE + 3]), b0 = cvtpk(P[BASE + 4], P[BASE + 5]), b1 = cvtpk(P[BASE + 6], P[BASE + 7]); \
        auto r0 = __builtin_amdgcn_permlane32_swap(a0, b0, false, false); auto r1 = __builtin_amdgcn_permlane32_swap(a1, b1, false, false); \
        u32x4 w = {r0[0], r1[0], r0[1], r1[1]}; OUT = __builtin_bit_cast(bf16x8, w); } while (0)
    PK4(p0, 0, pa0); PK4(p0, 8, pa1); PK4(p1, 0, pa2); PK4(p1, 8, pa3);
#undef PK4
}
__device__ __forceinline__ void pass(f32x16 (&o)[4], const bf16_t* Qw, const bf16_t* Kh, const bf16_t* Vh, int qpos, int qb, float slope2, char* lds, int tid, int nL, int NT) {
    const int wid = tid >> 6, lane = tid & 63, r32 = lane & 31, hi = lane >> 5;
    char* V_lds = lds + OFF_V; char* K_lds = lds + OFF_K;
    float* ws = (float*)(lds + OFF_WS) + wid * 64; float* li_l = ws; float* al_l = ws + 32;
    float l_reg = 0.f; bf16x8 qr[4];
#pragma unroll
    for (int d = 0; d < 4; ++d)
#pragma unroll
        for (int r = 0; r < 16; ++r) o[d][r] = 0.f;
    f32x16 negm;
#pragma unroll
    for (int r = 0; r < 16; ++r) negm[r] = 0.f;
#pragma unroll
    for (int d0 = 0; d0 < 4; ++d0) qr[d0] = *reinterpret_cast<const bf16x8*>(Qw + d0 * 16);
    const int kr = tid >> 3, kc = (tid & 7) * 8, kst = KSWZ64(kr, kc * 2);
    const int sr = tid >> 4, sc = (tid & 15) * 8, vst0 = v_st(sr, sc), vst1 = v_st(32 + sr, sc);
    const int vb0 = (int)(uintptr_t)V_lds + v_rd_base(lane);
    const unsigned voff0 = (unsigned)(sr * LDQKV + sc), koff0 = (unsigned)(kr * LDQKV + kc);
    struct { bf16x8 vs0, vs1, ks; } st_[2];
    const int nd = 4 * qb;
#define KT(i) ((i) < 4 ? nd + (i) : ((i) < 4 + nL ? nd + 3 - (i) : nd + (i) - nL))
#define SLOAD(i, tile) do { const unsigned k0_ = (unsigned)((tile) * KVBLK * LDQKV); st_[i].vs0 = *reinterpret_cast<const bf16x8*>(Vh + (k0_ + voff0)); st_[i].vs1 = *reinterpret_cast<const bf16x8*>(Vh + (k0_ + voff0 + 32u * LDQKV)); \
        st_[i].ks = *reinterpret_cast<const bf16x8*>(Kh + (k0_ + koff0)); } while (0)
#define SWRITE(b, i) do { *(bf16x8*)(V_lds + (b) * SHM_V + vst0) = st_[i].vs0; *(bf16x8*)(V_lds + (b) * SHM_V + vst1) = st_[i].vs1; *(bf16x8*)(K_lds + (b) * SHM_K + kst) = st_[i].ks; } while (0)
#define SWAIT() asm volatile("s_waitcnt vmcnt(3)" ::: "memory")
#define RESC(a) do { if (__any((a) < 1.f)) { if (hi == 0) al_l[r32] = (a); asm volatile("s_waitcnt lgkmcnt(0)" ::: "memory"); \
        _Pragma("unroll") for (int d = 0; d < 4; ++d) _Pragma("unroll") for (int r = 0; r < 16; ++r) o[d][r] *= al_l[crow(r, hi)]; } } while (0)
#define DQ(tile) ((float)(qpos - (tile) * KVBLK - 4 * hi))
    f32x16 pA0, pA1, pB0, pB1; float alA, alB; bf16x8 pa0, pa1, pa2, pa3;
    SLOAD(0, KT(0)); asm volatile("s_waitcnt vmcnt(0)" ::: "memory"); SWRITE(0, 0); __syncthreads();
    qkt(pA0, pA1, K_lds, qr, negm, r32, hi, DQ(KT(0)), slope2); partialSM(pA0, pA1, negm, alA);
    SLOAD(1, KT(1)); SLOAD(0, KT(2));
    SWAIT(); SWRITE(1, 1); __syncthreads();
    for (int j = 1; j + 1 < NT; j += 2) {
        SBAR(); qkt(pB0, pB1, K_lds + SHM_K, qr, negm, r32, hi, DQ(KT(j)), slope2);
        finishSM(pA0, pA1, alA, l_reg, pa0, pa1, pa2, pa3); SBAR();
        SLOAD(1, KT(j + 2)); SBAR();
        pv_d0(o, vb0, pa0, pa1, pa2, pa3); partialSM(pB0, pB1, negm, alB);
        __syncthreads(); SWAIT(); SWRITE(0, 0);
        RESC(alB); __syncthreads();
        SBAR(); qkt(pA0, pA1, K_lds, qr, negm, r32, hi, DQ(KT(j + 1)), slope2);
        finishSM(pB0, pB1, alB, l_reg, pa0, pa1, pa2, pa3); SBAR();
        if (j + 3 < NT) SLOAD(0, KT(j + 3)); SBAR();
        pv_d0(o, vb0 + SHM_V, pa0, pa1, pa2, pa3); partialSM(pA0, pA1, negm, alA);
        __syncthreads(); SWAIT(); SWRITE(1, 1);
        RESC(alA); __syncthreads();
    }
    SBAR(); qkt(pB0, pB1, K_lds + SHM_K, qr, negm, r32, hi, DQ(KT(NT - 1)), slope2);
    finishSM(pA0, pA1, alA, l_reg, pa0, pa1, pa2, pa3); SBAR();
    pv_d0(o, vb0, pa0, pa1, pa2, pa3); partialSM(pB0, pB1, negm, alB);
    __syncthreads(); RESC(alB);
    finishSM(pB0, pB1, alB, l_reg, pa0, pa1, pa2, pa3); SBAR();
    pv_d0(o, vb0 + SHM_V, pa0, pa1, pa2, pa3);
    if (hi == 0) li_l[r32] = l_reg; asm volatile("s_waitcnt lgkmcnt(0)" ::: "memory");
#pragma unroll
    for (int r = 0; r < 16; ++r) { const float rl = __builtin_amdgcn_rcpf(li_l[crow(r, hi)]);
#pragma unroll
        for (int d = 0; d < 4; ++d) o[d][r] *= rl; }
    __syncthreads();
#undef KT
#undef SLOAD
#undef SWRITE
#undef SWAIT
#undef RESC
#undef DQ
}
#undef SBAR
}

typedef GAS unsigned gu32;
#define XB_TMO      128
#define XB_XCNT(j)  (256  + 64 * (j))
#define XB_XSUB(j)  (1280 + 64 * (j))
#define XB_XGEN(j)  (2304 + 64 * (j))
#define XB_TOP      3328
#define XB_TOPGEN   3392
#define XCD_BAR_WORDS 3456
#define XB_SPIN_CAP (1u << 23)
__device__ __forceinline__ unsigned xb_ld(unsigned* p)              { return __hip_atomic_load(p, __ATOMIC_RELAXED, __HIP_MEMORY_SCOPE_AGENT); }
__device__ __forceinline__ unsigned xb_add(unsigned* p, unsigned v) { return __hip_atomic_fetch_add(p, v, __ATOMIC_RELAXED, __HIP_MEMORY_SCOPE_AGENT); }
__device__ __forceinline__ unsigned xb_xcc_id() { return (unsigned)__builtin_amdgcn_s_getreg((3 << 11) | 20) & 0xFu; }
#define XB_SPIN(cond, bar) do { unsigned _sp = 0; while (cond) { __builtin_amdgcn_s_sleep(1); \
    if ((++_sp & 255u) == 0u) { if (xb_ld(&(bar)[XB_TMO])) break; if (_sp > XB_SPIN_CAP) { atomicAdd(&(bar)[XB_TMO], 1u); break; } } } } while (0)
struct XcdBarrier { unsigned* bar; unsigned x; volatile LAS unsigned* st; int wave; };
__device__ __forceinline__ XcdBarrier xcd_barrier_post(unsigned* bar, volatile LAS unsigned* st, int wave) {
    XcdBarrier b; b.bar = bar; b.x = xb_xcc_id(); b.st = st; b.wave = wave;
    if (wave == 0 && lane_id_v() == 0) (void)xb_add(&bar[XB_XCNT(b.x)], 1u);
    return b;
}
__device__ __forceinline__ void xcd_barrier_complete(unsigned* bar, unsigned x, unsigned& nloc, unsigned& nx) {
    const unsigned G = gridDim.x * gridDim.y * gridDim.z;
    unsigned sum, cnt, mine, sp = 0u;
    for (;;) {
        sum = 0u; cnt = 0u; mine = 0u;
#pragma unroll
        for (unsigned j = 0; j < 16; ++j) { const unsigned c = xb_ld(&bar[XB_XCNT(j)]); sum += c; cnt += (c > 0u) ? 1u : 0u; mine = (j == x) ? c : mine; }
        if (sum == G) break;
        __builtin_amdgcn_s_sleep(1);
        if ((++sp & 255u) == 0u) { if (xb_ld(&bar[XB_TMO])) break; if (sp > XB_SPIN_CAP) { atomicAdd(&bar[XB_TMO], 1u); break; } }
    }
    nloc = mine > 0u ? mine : 1u; nx = cnt > 0u ? cnt : 1u;
}
__device__ __forceinline__ void xcd_barrier(const XcdBarrier& b) {
    asm volatile("s_waitcnt vmcnt(0)" ::: "memory");
    __syncthreads();
    if (b.wave == 0 && lane_id_v() == 0) {
        unsigned* bar = b.bar;
        __builtin_amdgcn_s_waitcnt(0);
        unsigned nloc = b.st[0], nx = b.st[1];
        if (nloc == 0u) { xcd_barrier_complete(bar, b.x, nloc, nx); b.st[0] = nloc; b.st[1] = nx; }
        const unsigned old = xb_add(&bar[XB_XSUB(b.x)], 1u);
        const unsigned gen = old / nloc;
        if (old + 1u == (gen + 1u) * nloc) {
            __builtin_amdgcn_fence(__ATOMIC_RELEASE, "agent");
            asm volatile("s_waitcnt vmcnt(0)" ::: "memory");
            const unsigned og = xb_add(&bar[XB_TOP], 1u);
            const unsigned tg = og / nx;
            if (og + 1u == (tg + 1u) * nx) xb_add(&bar[XB_TOPGEN], 1u);
            else XB_SPIN(xb_ld(&bar[XB_TOPGEN]) == tg, bar);
            __builtin_amdgcn_fence(__ATOMIC_ACQUIRE, "agent");
            xb_add(&bar[XB_XGEN(b.x)], 1u);
            asm volatile("s_waitcnt vmcnt(0)" ::: "memory");
        } else {
            XB_SPIN(xb_ld(&bar[XB_XGEN(b.x)]) == gen, bar);
            __builtin_amdgcn_fence(__ATOMIC_ACQUIRE, "agent");
            asm volatile("s_waitcnt vmcnt(0)" ::: "memory");
        }
    }
    __syncthreads();
}

struct P0Item { const float* W; void* WT; int K, N, k0, n0, orow0, f8; };
__device__ __forceinline__ void p0_load(const P0Item& t, f32x4 (&v)[8], int lane) {
#pragma unroll
    for (int i = 0; i < 8; ++i) { const int kk = 8 * i + (lane >> 3), n4 = (lane & 7) * 4; v[i] = *(const GAS f32x4*)(t.W + (size_t)(t.k0 + kk) * t.N + t.n0 + n4); }
}
__device__ __forceinline__ void p0_store(const P0Item& t, const f32x4 (&v)[8], LAS float* scr, int lane) {
#pragma unroll
    for (int i = 0; i < 8; ++i) { const int kk = 8 * i + (lane >> 3), n4 = (lane & 7) * 4; LAS float* d = scr + kk * 33 + n4; d[0] = v[i].x; d[1] = v[i].y; d[2] = v[i].z; d[3] = v[i].w; }
    LDS_WAIT(); asm volatile("" ::: "memory");
    const int c = lane & 7;
#pragma unroll
    for (int j = 0; j < 4; ++j) { const int n = (lane >> 3) + 8 * j; const LAS float* s = scr + (8 * c) * 33 + n;
        if (t.f8) {
            int t0 = __builtin_amdgcn_cvt_pk_fp8_f32(s[0 * 33] * 32.f, s[1 * 33] * 32.f, 0, false); t0 = __builtin_amdgcn_cvt_pk_fp8_f32(s[2 * 33] * 32.f, s[3 * 33] * 32.f, t0, true);
            int t1 = __builtin_amdgcn_cvt_pk_fp8_f32(s[4 * 33] * 32.f, s[5 * 33] * 32.f, 0, false); t1 = __builtin_amdgcn_cvt_pk_fp8_f32(s[6 * 33] * 32.f, s[7 * 33] * 32.f, t1, true);
            *(GAS u32x2*)((unsigned char*)t.WT + (size_t)(t.orow0 + n) * t.K + t.k0 + 8 * c) = (u32x2){(unsigned)t0, (unsigned)t1};
        } else {
            u32x4 o; o.x = pk2(s[0 * 33], s[1 * 33]); o.y = pk2(s[2 * 33], s[3 * 33]); o.z = pk2(s[4 * 33], s[5 * 33]); o.w = pk2(s[6 * 33], s[7 * 33]);
            *(GAS u32x4*)((bf16_t*)t.WT + (size_t)(t.orow0 + n) * t.K + t.k0 + 8 * c) = o; } }
    LDS_WAIT(); asm volatile("" ::: "memory");
}

struct Args { const float* in[25]; float* out; unsigned char* ws; };

__global__ void __launch_bounds__(512, 2) mega_fwd(Args args) {
    extern __shared__ __attribute__((aligned(16))) unsigned char lds_raw[];
    LAS unsigned char* lds = (LAS unsigned char*)lds_raw;
    volatile LAS unsigned* MISC = (volatile LAS unsigned*)(lds + MISC_OFF);
    const int G = gridDim.x, bx = blockIdx.x, NGW = G * 8;
    const int wave_s = __builtin_amdgcn_readfirstlane(threadIdx.x >> 6);
    unsigned char* ws = args.ws;
    gu32* ctl = (gu32*)(ws + WS_CTL);
    const float* x = args.in[0];
    float* out = args.out;
    unsigned char* WGU = ws + WS_WGU; unsigned char* WD = ws + WS_WD; bf16_t* WIN = (bf16_t*)(ws + WS_WIN); bf16_t* WOUT = (bf16_t*)(ws + WS_WOUT);
    bf16_t* XN = (bf16_t*)(ws + WS_XN); unsigned char* H2 = ws + WS_H2; bf16_t* GF = (bf16_t*)(ws + WS_GF);
    bf16_t* HP = (bf16_t*)(ws + WS_HP); bf16_t* QKV = (bf16_t*)(ws + WS_QKV); bf16_t* HZ = (bf16_t*)(ws + WS_HZ); bf16_t* MIX = (bf16_t*)(ws + WS_MIX);
    unsigned char* ACT = ws + WS_ACT; bf16_t* Y = (bf16_t*)(ws + WS_Y);
    float* AFF = (float*)(ws + WS_AFF); int* TOK = (int*)(ws + WS_TOK); float* GSEL = (float*)(ws + WS_GSEL); unsigned short* INV = (unsigned short*)(ws + WS_INV);
    float* NSUM = (float*)(ws + WS_CTL) + CW_NSUM;

    if (wave_s == 0) ((LAS unsigned*)(lds + MISC_OFF))[lane_id_v()] = 0u;
    __syncthreads();
    XcdBarrier bar = xcd_barrier_post((unsigned*)(ctl + CW_BAR), MISC + 8, wave_s);

    {
        PHASE_IDS();
        LAS float* scr = (LAS float*)(lds + wave * 16384);
        constexpr int I_IN = (DM / 64) * (INC / 32), I_OUT = (DM / 64) * (DM / 32), I_GU = (DM / 64) * (FF / 32), I_DN = (FF / 64) * (DM / 32);
        constexpr int NITEMS = I_IN + I_OUT + NE * (2 * I_GU + I_DN);
#define P0_DECODE(T, it_) do { int r = (it_); \
            if (r < I_IN) { const int nblk = INC / 32, kb = r / nblk, nb = r % nblk; T.W = args.in[2]; T.WT = WIN; T.K = DM; T.N = INC; T.k0 = 64 * kb; T.n0 = 32 * nb; T.orow0 = 32 * nb; T.f8 = 0; break; } r -= I_IN; \
            if (r < I_OUT) { const int nblk = DM / 32, kb = r / nblk, nb = r % nblk; T.W = args.in[18]; T.WT = WOUT; T.K = DM; T.N = DM; T.k0 = 64 * kb; T.n0 = 32 * nb; T.orow0 = 32 * nb; T.f8 = 0; break; } r -= I_OUT; \
            const int e = r / (2 * I_GU + I_DN); r -= e * (2 * I_GU + I_DN); \
            if (r < 2 * I_GU) { const int up = r >= I_GU; if (up) r -= I_GU; const int nblk = FF / 32, kb = r / nblk, nb = r % nblk, f0 = 32 * nb; \
                T.W = args.in[up ? 22 : 21] + (size_t)e * DM * FF; T.WT = WGU + (size_t)e * 2 * FF * DM; T.K = DM; T.N = FF; T.k0 = 64 * kb; T.n0 = f0; T.orow0 = (f0 >> 7) * 256 + up * 128 + (f0 & 127); T.f8 = 1; break; } \
            r -= 2 * I_GU; \
            { const int nblk = DM / 32, kb = r / nblk, nb = r % nblk; T.W = args.in[23] + (size_t)e * FF * DM; T.WT = WD + (size_t)e * DM * FF; T.K = FF; T.N = DM; T.k0 = 64 * kb; T.n0 = 32 * nb; T.orow0 = 32 * nb; T.f8 = 1; } } while (0)
        for (int rep_ = 0; rep_ < REP_P0W; ++rep_) {
            P0Item ta, tb; f32x4 va[8], vb[8];
            int it = gw;
            if (it < NITEMS) { P0_DECODE(ta, it); p0_load(ta, va, lane); }
            while (it < NITEMS) {
                const bool hb = it + NGW < NITEMS;
                if (hb) { P0_DECODE(tb, it + NGW); p0_load(tb, vb, lane); }
                p0_store(ta, va, scr, lane);
                if (!hb) break;
                const bool ha = it + 2 * NGW < NITEMS;
                if (ha) { P0_DECODE(ta, it + 2 * NGW); p0_load(ta, va, lane); }
                p0_store(tb, vb, scr, lane);
                it += 2 * NGW;
            }
        }
#undef P0_DECODE
        const float* g = args.in[1];
        int rep_xn = REP_XN; asm volatile("" : "+s"(rep_xn));
        for (int rep_ = 0; rep_ < rep_xn; ++rep_)
        for (int m = gw; m < NTOK; m += NGW) {
            const GAS f32x4* xr = (const GAS f32x4*)(x + (size_t)m * DM) + lane;
            f32x4 v[4]; float s = 0.f;
#pragma unroll
            for (int j = 0; j < 4; ++j) { v[j] = xr[64 * j]; s += (v[j].x * v[j].x + v[j].y * v[j].y) + (v[j].z * v[j].z + v[j].w * v[j].w); }
            const float rstd = rsqrtf(wave_sum(s) * (1.f / DM) + EPS);
            GAS u32x2* o8 = (GAS u32x2*)(XN + (size_t)m * DM) + lane;
#pragma unroll
            for (int j = 0; j < 4; ++j) { const f32x4 gg = ((const GAS f32x4*)g)[lane + 64 * j]; u32x2 w; w.x = pk2(v[j].x * rstd * gg.x, v[j].y * rstd * gg.y); w.y = pk2(v[j].z * rstd * gg.z, v[j].w * rstd * gg.w); o8[64 * j] = w; }
        }
        __syncthreads();
        LAS float* w1s = (LAS float*)(lds + 118784);
        LAS float* w2s = (LAS float*)(lds + 127232);
        if (bx < 256) { for (int q = tid; q < 33 * 64; q += 512) w1s[q] = args.in[5][q]; for (int q = tid; q < 64 * 64; q += 512) w2s[q] = args.in[7][q]; }
        __syncthreads();
        for (int it = bx; it < 256; it += G) {
            const int ib = it >> 2, dn = it & 3, dir = dn >> 1, n = dn & 1, i0 = ib * 64, ibase = i0 + (dir == 0 ? 1 : 0);
            LAS float* zz = (LAS float*)lds;
            LAS float* h1 = zz + 64 * 33;
            LAS float* h2 = h1 + 64 * 64;
            const float* b1 = args.in[6]; const float* b2 = args.in[8]; const float* w3 = args.in[9]; const float* fr = args.in[10];
            for (int q = tid; q < 64 * 33; q += 512) { const int p = q / 33, j = q % 33, i = ibase + p;
                const float t = (float)i / (float)(SEQ - 1), w = 6.283185307179586f * (float)i / (float)SEQ; float v;
                if (j == 0) v = t; else { const float band = 1e-4f + (float)((j - 1) & 15) * ((15.f - 1e-4f) / 15.f); v = (j <= 16) ? __cosf(band * w) : -__sinf(band * w); }
                zz[q] = v; }
            __syncthreads();
            {
                const int j = tid & 63; float a[8];
#pragma unroll
                for (int m = 0; m < 8; ++m) a[m] = b1[j];
#pragma unroll 3
                for (int k = 0; k < 33; ++k) { const float w = w1s[k * 64 + j];
#pragma unroll
                    for (int m = 0; m < 8; ++m) a[m] += zz[(wave + 8 * m) * 33 + k] * w; }
                const float f = fr[j];
#pragma unroll
                for (int m = 0; m < 8; ++m) h1[(wave + 8 * m) * 64 + j] = __sinf(f * a[m]);
            }
            __syncthreads();
            {
                const int j = tid & 63; float a[8];
#pragma unroll
                for (int m = 0; m < 8; ++m) a[m] = b2[j];
#pragma unroll 2
                for (int k = 0; k < 64; k += 4) { const float w0 = w2s[(k + 0) * 64 + j], w1_ = w2s[(k + 1) * 64 + j], w2_ = w2s[(k + 2) * 64 + j], w3_ = w2s[(k + 3) * 64 + j];
#pragma unroll
                    for (int m = 0; m < 8; ++m) { const f32x4 hh = *(const LAS f32x4*)&h1[(wave + 8 * m) * 64 + k]; a[m] += (hh.x * w0 + hh.y * w1_) + (hh.z * w2_ + hh.w * w3_); } }
                const float f = fr[j];
#pragma unroll
                for (int m = 0; m < 8; ++m) h2[(wave + 8 * m) * 64 + j] = __sinf(f * a[m]);
            }
            __syncthreads();
            const int c = tid, col = dn * 512 + c;
            const float mind = logf(1e-2f) / 1.5f, maxd = logf(1e-2f) / 0.3f;
            const float delta = fabsf(mind + (float)c * ((maxd - mind) / 511.f));
            float asum = 0.f;
            LAS unsigned short* ftile = (LAS unsigned short*)(lds + 45056) + wave * (64 * 72);
            {
                float hv[64];
#pragma unroll
                for (int p = 0; p < 64; ++p) hv[p] = 0.f;
                float f0 = 0.f;
                for (int k = 0; k < 64; k += 4) { const float w0 = w3[(k + 0) * 2048 + col], w1_ = w3[(k + 1) * 2048 + col], w2_ = w3[(k + 2) * 2048 + col], w3_ = w3[(k + 3) * 2048 + col];
                    if (dir == 1 && ib == 0) { const f32x4 hh = *(const LAS f32x4*)&h2[k]; f0 += (hh.x * w3[(k + 0) * 2048 + col - 1024] + hh.y * w3[(k + 1) * 2048 + col - 1024]) + (hh.z * w3[(k + 2) * 2048 + col - 1024] + hh.w * w3[(k + 3) * 2048 + col - 1024]); }
#pragma unroll
                    for (int p0 = 0; p0 < 64; p0 += 16) {
                        f32x4 hh[16];
#pragma unroll
                        for (int p = 0; p < 16; ++p) hh[p] = *(const LAS f32x4*)&h2[(p0 + p) * 64 + k];
                        asm volatile("" ::: "memory");
#pragma unroll
                        for (int p = 0; p < 16; ++p) hv[p0 + p] += (hh[p].x * w0 + hh[p].y * w1_) + (hh[p].z * w2_ + hh[p].w * w3_); } }
                LAS unsigned short* frow = ftile + lane * 72;
#pragma unroll
                for (int p = 0; p < 64; ++p) { const int i = ibase + p; const float t = (float)i / (float)(SEQ - 1); float h = hv[p] * __expf(-t * delta);
                    bool valid = dir == 0 ? (i <= SEQ - 1) : (i >= 1);
                    if (dir == 1 && i == 0) { h = f0; valid = true; }
                    const unsigned hb = valid ? f2bf(h) : 0u; const float hr = __builtin_bit_cast(float, hb << 16);
                    asum += fabsf(hr); frow[dir == 0 ? 63 - p : p] = (unsigned short)hb; }
            }
            LDS_WAIT(); asm volatile("" ::: "memory");
            {
                const int gbase = dir == 0 ? GOFF - i0 - 64 : GOFF + i0;
#pragma unroll
                for (int j = 0; j < 8; ++j) { const int ch = 8 * j + (lane >> 3), chunk = lane & 7;
                    const u32x4 v = *(const LAS u32x4*)(ftile + ch * 72 + chunk * 8);
                    *(GAS u32x4*)(GF + (size_t)(n * 512 + wave * 64 + ch) * GLEN + gbase + chunk * 8) = v; }
            }
            if (ib == 63) { bf16_t* gf = GF + (size_t)(n * 512 + c) * GLEN + (dir == 0 ? 0 : GOFF + 4096);
                for (int q = 0; q < 32; ++q) *(GAS u32x4*)(gf + q * 8) = (u32x4){0u, 0u, 0u, 0u}; }
            atomicAdd(&NSUM[n * 512 + c], asum);
            __syncthreads();
        }
    }
    xcd_barrier(bar);

    int rep_p1 = REP_P1; asm volatile("" : "+s"(rep_p1));
    for (int rep_ = 0; rep_ < rep_p1; ++rep_) {
    {
        pg8::GeoTokPerm S; S.A = WIN; S.X = XN; S.KB = DM * 2; S.ord.init(HCOLS / 256, NTOK / 256, G, bx);
        pg8::EpiBf16 E{HP, NTOK, 0, 1.f};
        pg8::gemm_phase<false>(lds, (LAS unsigned*)(lds + TBL_OFF), S, E, wave_s);
    }
    {
        pg8::GeoPlain S; S.A = XN; S.Bt = WIN + (size_t)HCOLS * DM; S.KB = DM * 2; S.ord.init(NTOK / 256, ACOLS / 256, G, bx);
        pg8::EpiBf16 E{QKV, ACOLS, 512, QSCALE};
        pg8::gemm_phase<false>(lds, (LAS unsigned*)(lds + TBL_OFF), S, E, wave_s);
    }
    }
    xcd_barrier(bar);

    {
        PHASE_IDS();
        LAS unsigned* red = (LAS unsigned*)lds;
        float* QN2 = (float*)(ws + WS_AFF); float* KN2 = QN2 + 4096;
        for (int it = bx; it < NB * 64; it += G) {
            const int b = it >> 6, tile = it & 63, row = tid >> 3, g = tid & 7;
            const bf16_t* rp = QKV + ((size_t)b * SEQ + tile * 64 + row) * ACOLS + g * 64;
            float sq = 0.f, sk = 0.f;
#pragma unroll
            for (int j = 0; j < 8; ++j) { const u32x4 v = *(const GAS u32x4*)(rp + j * 8), w = *(const GAS u32x4*)(rp + 512 + j * 8);
#pragma unroll
                for (int k = 0; k < 4; ++k) { sq += bflo(v[k]) * bflo(v[k]) + bfhi(v[k]) * bfhi(v[k]); sk += bflo(w[k]) * bflo(w[k]) + bfhi(w[k]) * bfhi(w[k]); } }
            if (tid < 16) red[tid] = 0u;
            __syncthreads();
            atomicMax((unsigned*)&red[g], __float_as_uint(sq)); atomicMax((unsigned*)&red[8 + g], __float_as_uint(sk));
            __syncthreads();
            if (tid < 8) QN2[(size_t)(b * 8 + tid) * 64 + tile] = __uint_as_float(red[tid]); else if (tid < 16) KN2[(size_t)(b * 8 + tid - 8) * 64 + tile] = __uint_as_float(red[tid]);
            __syncthreads();
        }
    }
    xcd_barrier(bar);

    {
        PHASE_IDS();
        {
            const float* conv_w = args.in[3]; const float* conv_b = args.in[4]; const float* skip = args.in[11];
            if (tid < 64) { const int bufi = tid >> 5, row = tid & 31, rr = row < 16 ? row : SEQ + row; *(LAS u32x4*)(lds + bufi * HY_ZBYTES + rr * 16) = (u32x4){0u, 0u, 0u, 0u}; }
            const int r32 = lane & 31, hi = lane >> 5;
            const int tr_lane = (2 * ((lane >> 4) & 1) + ((lane & 3) >> 1) + 8 * hi + ((lane & 15) >> 2)) * 16 + 8 * (lane & 1);
            int rep_hy = REP_HY; asm volatile("" : "+s"(rep_hy));
            const bool split13 = (G == 256);
            const int hy_n = split13 ? (bx < 128 ? 1 : 3) : (HW - bx + G - 1) / G, hy_0 = split13 ? (bx < 128 ? bx : 128 + (bx - 128) * 3) : bx, hy_s = split13 ? 1 : G;
            for (int rep_ = 0; rep_ < rep_hy; ++rep_)
            for (int ui_ = 0; ui_ < hy_n; ++ui_) {
                const int c = hy_0 + ui_ * hy_s;
                __syncthreads();
                {
                    const int col = 1024 + c; const float w0 = conv_w[col], w1 = conv_w[HCOLS + col], w2 = conv_w[2 * HCOLS + col], cb = conv_b[col];
                    const bf16_t* hp = HP + (size_t)col * SEQ * 8;
#pragma unroll 2
                    for (int i = 0; i < 8; ++i) { const int t = tid + 512 * i;
                        const u32x4 z4 = (u32x4){0u, 0u, 0u, 0u};
                        const u32x4 pm = t > 0 ? *(const GAS u32x4*)(hp + (size_t)(t - 1) * 8) : z4, p0 = *(const GAS u32x4*)(hp + (size_t)t * 8), pp = t < SEQ - 1 ? *(const GAS u32x4*)(hp + (size_t)(t + 1) * 8) : z4;
                        u32x4 o;
#pragma unroll
                        for (int k = 0; k < 4; ++k) { const float lo = cb + w0 * bflo(pm[k]) + w1 * bflo(p0[k]) + w2 * bflo(pp[k]), hh = cb + w0 * bfhi(pm[k]) + w1 * bfhi(p0[k]) + w2 * bfhi(pp[k]); o[k] = pk2(lo, hh); }
                        *(LAS u32x4*)(lds + HY_ZA + (t + 16) * 16) = o; }
                }
                for (int n = 0; n < 2; ++n) {
                    {
                        const GAS u32x4* gsrc = (const GAS u32x4*)(GF + (size_t)(n * 512 + c) * GLEN);
                        for (int q = tid; q < GLEN * 2 / 16; q += 512) *(LAS u32x4*)(lds + HY_FB + q * 16) = gsrc[q];
                    }
                    __syncthreads();
                    f32x16 acc[2][2];
#pragma unroll
                    for (int a = 0; a < 2; ++a)
#pragma unroll
                        for (int b = 0; b < 2; ++b)
#pragma unroll
                            for (int k = 0; k < 16; ++k) acc[a][b][k] = 0.f;
                    const LAS unsigned char* za = lds + (n == 0 ? HY_ZA : HY_ZB) + tr_lane;
                    const LAS unsigned char* fbp = lds + HY_FB + 2 * GOFF - 32 + 16 * (hi - r32) - 512 * (2 * wave);
#define HY_STEP(OFFA, OFFB) do { \
                        const v4i16_t x0 = __builtin_amdgcn_ds_read_tr16_b64_v4i16((LAS v4i16_t*)(za + (OFFA))); \
                        const v4i16_t x1 = __builtin_amdgcn_ds_read_tr16_b64_v4i16((LAS v4i16_t*)(za + (OFFA) + 64)); \
                        const v4i16_t x2 = __builtin_amdgcn_ds_read_tr16_b64_v4i16((LAS v4i16_t*)(za + (OFFA) + 128)); \
                        const bf16x8 b0 = *(const LAS bf16x8*)(fbp + (OFFB)), b1 = *(const LAS bf16x8*)(fbp + (OFFB) - 512); \
                        const bf16x8 a0 = (bf16x8){x0[0], x0[1], x0[2], x0[3], x1[0], x1[1], x1[2], x1[3]}, a1 = (bf16x8){x1[0], x1[1], x1[2], x1[3], x2[0], x2[1], x2[2], x2[3]}; \
                        acc[0][0] = __builtin_amdgcn_mfma_f32_32x32x16_bf16(a0, b0, acc[0][0], 0, 0, 0); \
                        acc[0][1] = __builtin_amdgcn_mfma_f32_32x32x16_bf16(a1, b0, acc[0][1], 0, 0, 0); \
                        acc[1][0] = __builtin_amdgcn_mfma_f32_32x32x16_bf16(a0, b1, acc[1][0], 0, 0, 0); \
                        acc[1][1] = __builtin_amdgcn_mfma_f32_32x32x16_bf16(a1, b1, acc[1][1], 0, 0, 0); } while (0)
#pragma clang loop unroll(disable)
                    for (int c4 = 0; c4 < 64; ++c4) {
                        HY_STEP(0, 0); HY_STEP(256, 32); HY_STEP(512, 64); HY_STEP(768, 96);
                        za += 1024; fbp += 128;
                    }
                    HY_STEP(0, 0);
#undef HY_STEP
                    const int gcol = n * 512 + c; const float w0 = conv_w[gcol], w1 = conv_w[HCOLS + gcol], w2 = conv_w[2 * HCOLS + gcol], cb = conv_b[gcol];
                    const float inv = 1.f / NSUM[n * 512 + c], sk = skip[n * 512 + c];
                    const bf16_t* hp = HP + (size_t)gcol * SEQ * 8 + 4 * hi;
                    const LAS unsigned char* zin = lds + (n == 0 ? HY_ZA : HY_ZB) + 8 * hi;
#pragma unroll
                    for (int sp = 0; sp < 2; ++sp) {
                        const int tb = 256 * (2 * wave + sp) + 8 * r32;
                        u32x2 P[10];
#pragma unroll
                        for (int k = 0; k < 10; ++k) { const int tq = tb - 1 + k; P[k] = (tq >= 0 && tq < SEQ) ? *(const GAS u32x2*)(hp + (size_t)tq * 8) : (u32x2){0u, 0u}; }
#pragma unroll
                        for (int tt = 0; tt < 8; ++tt) {
                            const int t = tb + tt; const u32x2 zi = *(const LAS u32x2*)(zin + (t + 16) * 16);
                            const float zv[4] = {bflo(zi.x), bfhi(zi.x), bflo(zi.y), bfhi(zi.y)};
                            const float pm[4] = {bflo(P[tt].x), bfhi(P[tt].x), bflo(P[tt].y), bfhi(P[tt].y)};
                            const float pc[4] = {bflo(P[tt + 1].x), bfhi(P[tt + 1].x), bflo(P[tt + 1].y), bfhi(P[tt + 1].y)};
                            const float pp[4] = {bflo(P[tt + 2].x), bfhi(P[tt + 2].x), bflo(P[tt + 2].y), bfhi(P[tt + 2].y)};
                            float zo[4];
#pragma unroll
                            for (int bb = 0; bb < 4; ++bb) { const float gate = cb + w0 * pm[bb] + w1 * pc[bb] + w2 * pp[bb]; zo[bb] = gate * (acc[sp][tt >> 2][(tt & 3) * 4 + bb] * inv + sk * zv[bb]); }
                            u32x2 w; w.x = pk2(zo[0], zo[1]); w.y = pk2(zo[2], zo[3]);
                            if (n == 0) *(LAS u32x2*)(lds + HY_ZB + (t + 16) * 16 + 8 * hi) = w;
                            else *(GAS u32x2*)(HZ + ((size_t)c * SEQ + t) * 8 + 4 * hi) = w;
                        }
                    }
                    __syncthreads();
                }
            }
        }
        __syncthreads();
        {
            const int wid = wave, r32 = lane & 31, hi = lane >> 5;
            const float* QN2 = (const float*)(ws + WS_AFF); const float* KN2 = QN2 + 4096;
            for (int rep_ = 0; rep_ < REP_AT; ++rep_)
            for (int unit = bx; unit < NB * 4 * 16; unit += G) {
                const int v_ = unit & 127, qb = v_ & 15, b = v_ >> 4, h = unit < 256 ? 2 + (unit >> 7) : ((unit - 256) >> 7 ? 0 : 1), q0 = qb * 256;
                const bf16_t* pb = QKV + (size_t)b * SEQ * ACOLS;
                const float slope2 = exp2f(-2.f * (float)(h + 1)) * LOG2E;
                const int l_u = lane_id_v(), r32u = l_u & 31, hiu = l_u >> 5;
                const int qpos = q0 + wid * 32 + r32u;
                f32x16 o[4];
#pragma clang loop unroll(disable)
                for (int mp = 0; mp < 2; ++mp) {
                    int nL, NT;
                    { const float* qn = QN2 + ((size_t)(b * 8 + h * 2 + mp)) * 64; const float* kn = KN2 + ((size_t)(b * 8 + h * 2 + mp)) * 64;
                      float km = kn[lane_id_v()];
                      km = wave_max(km);
                      const float qm = fmaxf(fmaxf(qn[4 * qb], qn[4 * qb + 1]), fmaxf(qn[4 * qb + 2], qn[4 * qb + 3]));
                      const float rthr = (150.f + 2.f * sqrtf(qm * km)) / slope2;
                      const int side = __builtin_amdgcn_readfirstlane((int)fminf(rthr * (1.f / 64.f), 64.f)) + 2;
                      nL = min(4 * qb, side); int nR = min(60 - 4 * qb, side); NT = 4 + nL + nR;
                      if (NT & 1) { if (nL < 4 * qb) ++nL; else ++nR; ++NT; } }
                    att::pass(o, pb + (size_t)qpos * ACOLS + h * 128 + mp * 64 + hiu * 8, pb + 512 + h * 128 + mp * 64, pb + 1024 + h * 128, qpos, qb, slope2, (char*)lds_raw, tid, nL, NT);
                    if (mp == 0) {
                        int z2 = 0; asm volatile("" : "+s"(z2));
                        GAS f32x4* pk = (GAS f32x4*)((float*)(ws + WS_PARK) + (size_t)(bx * 8 + wid) * 4096 + lane * 64 + z2);
#pragma unroll
                        for (int d = 0; d < 4; ++d)
#pragma unroll
                            for (int k = 0; k < 4; ++k) pk[d * 4 + k] = (f32x4){o[d][4 * k], o[d][4 * k + 1], o[d][4 * k + 2], o[d][4 * k + 3]};
                    }
                    __builtin_amdgcn_sched_barrier(0);
                }
                asm volatile("s_waitcnt vmcnt(0)" ::: "memory");
                int zz = 0; asm volatile("" : "+s"(zz));
                float lam;
                { float s1 = 0.f, s2 = 0.f; for (int i = 0; i < 64; ++i) { s1 += args.in[13][i + zz] * args.in[14][i + zz]; s2 += args.in[15][i + zz] * args.in[16][i + zz]; } lam = expf(s1) - expf(s2) + 0.2f; }
                const float* subg = args.in[17] + zz;
                int lane_c = lane; asm volatile("" : "+v"(lane_c)); const int r32c = lane_c & 31, hic = lane_c >> 5;
                {
                    const GAS f32x4* pk = (const GAS f32x4*)((float*)(ws + WS_PARK) + (size_t)(bx * 8 + wid) * 4096 + lane_c * 64 + zz);
#pragma unroll
                    for (int d = 0; d < 4; ++d)
#pragma unroll
                        for (int k = 0; k < 4; ++k) { const f32x4 pv = pk[d * 4 + k];
#pragma unroll
                            for (int q = 0; q < 4; ++q) o[d][4 * k + q] = pv[q] - lam * o[d][4 * k + q]; }
                }
#pragma unroll
                for (int r = 0; r < 16; ++r) {
                    float ss = 0.f;
#pragma unroll
                    for (int d = 0; d < 4; ++d) ss += o[d][r] * o[d][r];
                    ss += sx<1>(ss); ss += sx<2>(ss); ss += sx<4>(ss); ss += sx<8>(ss); ss += sx<16>(ss);
                    const float rs = rsqrtf(ss * (1.f / 128.f) + EPS) * 0.8f;
                    bf16_t* op = MIX + ((size_t)b * SEQ + q0 + wid * 32 + att::crow(r, hic)) * DM + 512 + h * 128 + r32c;
#pragma unroll
                    for (int d = 0; d < 4; ++d) op[d * 32] = (bf16_t)f2bf(o[d][r] * rs * subg[d * 32 + r32c]);
                }
            }
        }
    }
    xcd_barrier(bar);

    {
        PHASE_IDS();
        const float* hg = args.in[12];
        LAS unsigned short* tile = (LAS unsigned short*)lds;
        LAS float* rs = (LAS float*)(lds + 32768);
        int rep_3a = REP_P3A; asm volatile("" : "+s"(rep_3a));
        for (int rep_ = 0; rep_ < rep_3a; ++rep_)
        for (int it = bx; it < 8 * 128; it += G) {
            const int g = it & 7, tb = it >> 3, t0 = tb * 32;
            __syncthreads();
            for (int q = tid; q < 64 * 32; q += 512) { const int ch = q >> 5, seg = q & 31;
                const u32x4 v = *(const GAS u32x4*)(HZ + ((size_t)(g * 64 + ch) * SEQ + t0 + seg) * 8);
                *(LAS u32x4*)(tile + ch * 256 + seg * 8) = v; }
            __syncthreads();
            if (tid < 256) { float s = 0.f; for (int ch = 0; ch < 64; ++ch) { const float v = bf2f(tile[ch * 256 + tid]); s += v * v; } rs[tid] = rsqrtf(s * (1.f / 64.f) + EPS); }
            __syncthreads();
            for (int q = tid; q < 256 * 8; q += 512) { const int tk = q >> 3, c8 = (q & 7) * 8;
                const float r = rs[tk]; const int t = t0 + (tk >> 3), b = tk & 7;
                float v[8];
#pragma unroll
                for (int j = 0; j < 8; ++j) v[j] = bf2f(tile[(c8 + j) * 256 + tk]) * r * hg[g * 64 + c8 + j];
                u32x4 w; w.x = pk2(v[0], v[1]); w.y = pk2(v[2], v[3]); w.z = pk2(v[4], v[5]); w.w = pk2(v[6], v[7]);
                *(GAS u32x4*)(MIX + ((size_t)b * SEQ + t) * DM + g * 64 + c8) = w; }
        }
        __syncthreads();
    }
    xcd_barrier(bar);

    {
        pg8::GeoPlain S; S.A = MIX; S.Bt = WOUT; S.KB = DM * 2; S.ord.init(NTOK / 256, DM / 256, G, bx);
        pg8::EpiResF32 E{x, out, DM};
        for (int rep_ = 0; rep_ < REP_P3B; ++rep_) pg8::gemm_phase<false>(lds, (LAS unsigned*)(lds + TBL_OFF), S, E, wave_s);
    }
    xcd_barrier(bar);

    {
        PHASE_IDS();
        const float* g = args.in[19]; const float* wr = args.in[20];
        LAS float* gwl = (LAS float*)lds;
        for (int q = tid; q < DM * 4; q += 512) { const f32x4 w4 = ((const GAS f32x4*)wr)[q]; const float gd = g[q >> 2]; *(LAS f32x4*)(gwl + (q >> 2) * 20 + (q & 3) * 4) = w4 * gd; }
        __syncthreads();
        const int i16 = lane & 15, q4 = lane >> 4;
        int rep_4a = REP_P4A; asm volatile("" : "+s"(rep_4a));
        for (int rep_ = 0; rep_ < rep_4a; ++rep_)
        for (int grp = gw; grp < NTOK / 16; grp += NGW) {
            const int tok0 = grp * 16;
            const float* xrow = out + (size_t)(tok0 + i16) * DM + 4 * q4;
            const LAS float* bp = gwl + (4 * q4) * 20 + i16;
            f32x4 acc = (f32x4){0.f, 0.f, 0.f, 0.f}; float ss = 0.f;
#pragma unroll 8
            for (int kk = 0; kk < 64; ++kk) {
                const f32x4 a = *(const GAS f32x4*)(xrow + 16 * kk);
                ss += (a.x * a.x + a.y * a.y) + (a.z * a.z + a.w * a.w);
                const LAS float* b = bp + kk * 320;
                acc = __builtin_amdgcn_mfma_f32_16x16x4f32(a.x, b[0], acc, 0, 0, 0);
                acc = __builtin_amdgcn_mfma_f32_16x16x4f32(a.y, b[20], acc, 0, 0, 0);
                acc = __builtin_amdgcn_mfma_f32_16x16x4f32(a.z, b[40], acc, 0, 0, 0);
                acc = __builtin_amdgcn_mfma_f32_16x16x4f32(a.w, b[60], acc, 0, 0, 0);
            }
            ss += sx<16>(ss); ss = sum32x(ss);
            const float r = rsqrtf(ss * (1.f / DM) + EPS);
            f32x4 af;
#pragma unroll
            for (int reg = 0; reg < 4; ++reg) {
                const float lg = acc[reg] * lane_read(r, 4 * q4 + reg);
                float mx = lg; mx = fmaxf(mx, sx<1>(mx)); mx = fmaxf(mx, sx<2>(mx)); mx = fmaxf(mx, sx<4>(mx)); mx = fmaxf(mx, sx<8>(mx));
                const float ex = expf(lg - mx); float den = ex; den += sx<1>(den); den += sx<2>(den); den += sx<4>(den); den += sx<8>(den);
                af[reg] = ex / den;
            }
            const int b = tok0 >> 12, t0 = tok0 & 4095;
            *(GAS f32x4*)(AFF + ((size_t)i16 * NB + b) * SEQ + t0 + 4 * q4) = af;
            *(GAS u32x2*)(INV + (size_t)tok0 * 16 + lane * 4) = (u32x2){0xffffffffu, 0xffffffffu};
            for (int i = 0; i < 16; ++i) {
                const float ri = lane_read(r, i);
                const GAS f32x4* xr = (const GAS f32x4*)(out + (size_t)(tok0 + i) * DM) + lane;
                GAS unsigned* o4 = (GAS unsigned*)(H2 + (size_t)(tok0 + i) * DM) + lane;
#pragma unroll
                for (int j = 0; j < 4; ++j) { const f32x4 v = xr[64 * j]; const f32x4 gg = ((const GAS f32x4*)g)[lane + 64 * j];
                    int t = __builtin_amdgcn_cvt_pk_fp8_f32(v.x * ri * gg.x, v.y * ri * gg.y, 0, false); t = __builtin_amdgcn_cvt_pk_fp8_f32(v.z * ri * gg.z, v.w * ri * gg.w, t, true); o4[64 * j] = (unsigned)t; }
            }
        }
        __syncthreads();
    }
    xcd_barrier(bar);

    {
        PHASE_IDS();
        LAS unsigned* hist = (LAS unsigned*)lds; LAS unsigned* scan = hist + 256; LAS unsigned* selw = scan + 512;
        int rep_4b = REP_P4B; asm volatile("" : "+s"(rep_4b));
        for (int rep_ = 0; rep_ < rep_4b; ++rep_)
        for (int eb = bx; eb < NE * NB; eb += G) {
            const int b = eb & 7, e = eb >> 3;
            const float* a = AFF + (size_t)eb * SEQ;
            unsigned v[8];
#pragma unroll
            for (int j = 0; j < 8; ++j) v[j] = __float_as_uint(a[tid * 8 + j]);
            unsigned prefix = 0, mask = 0, need = CAP;
            __syncthreads();
            for (int pass = 0; pass < 4; ++pass) {
                const int shift = 24 - 8 * pass;
                if (tid < 256) hist[tid] = 0;
                __syncthreads();
#pragma unroll
                for (int j = 0; j < 8; ++j) if ((v[j] & mask) == prefix) atomicAdd((unsigned*)&hist[(v[j] >> shift) & 255u], 1u);
                __syncthreads();
                if (tid < 256) scan[tid] = hist[tid];
                __syncthreads();
                for (int off = 1; off < 256; off <<= 1) { const unsigned xx = (tid < 256 && tid + off < 256) ? scan[tid + off] : 0u; __syncthreads(); if (tid < 256) scan[tid] += xx; __syncthreads(); }
                if (tid < 256) { const unsigned above = tid < 255 ? scan[tid + 1] : 0u; if (above < need && need <= scan[tid]) { selw[0] = (unsigned)tid; selw[1] = need - above; } }
                __syncthreads();
                prefix |= selw[0] << shift; mask |= 255u << shift; need = selw[1];
                __syncthreads();
            }
            unsigned cg = 0, ce = 0;
#pragma unroll
            for (int j = 0; j < 8; ++j) { cg += v[j] > prefix; ce += v[j] == prefix; }
            scan[tid] = (cg << 16) | ce;
            __syncthreads();
            for (int off = 1; off < 512; off <<= 1) { const unsigned xx = tid >= off ? scan[tid - off] : 0u; __syncthreads(); scan[tid] += xx; __syncthreads(); }
            const unsigned incl = scan[tid]; unsigned pg = (incl >> 16) - cg, pe = (incl & 0xffffu) - ce;
#pragma unroll
            for (int j = 0; j < 8; ++j) {
                const bool isg = v[j] > prefix, ise = v[j] == prefix;
                if (isg || (ise && pe < need)) {
                    const unsigned pos = pg + (pe < need ? pe : need); const int token = b * SEQ + tid * 8 + j;
                    TOK[(size_t)eb * CAP + pos] = token; GSEL[(size_t)eb * CAP + pos] = __uint_as_float(v[j]); INV[(size_t)token * 16 + e] = (unsigned short)pos;
                }
                pg += isg; pe += ise;
            }
            __syncthreads();
        }
    }
    xcd_barrier(bar);

    {
        pg8::GeoExpert<true> S; S.A = H2; S.Bt = WGU; S.KB = DM; S.bexp = (size_t)2 * FF * DM; S.tok = TOK; S.ord.init(NSLOT / 256, 2 * FF / 256, G, bx);
        pg8::EpiSwiGLU E{ACT, FF};
        for (int rep_ = 0; rep_ < REP_P5; ++rep_) pg8::gemm_phase<true>(lds, (LAS unsigned*)(lds + TBL_OFF), S, E, wave_s);
    }
    xcd_barrier(bar);

    {
        pg8::GeoExpert<false> S; S.A = ACT; S.Bt = WD; S.KB = FF; S.bexp = (size_t)DM * FF; S.tok = nullptr; S.ord.init(NSLOT / 256, DM / 256, G, bx);
        pg8::EpiBf16 E{Y, DM, 0, 1.f};
        for (int rep_ = 0; rep_ < REP_P6; ++rep_) pg8::gemm_phase<true>(lds, (LAS unsigned*)(lds + TBL_OFF), S, E, wave_s);
    }
    xcd_barrier(bar);

    {
        PHASE_IDS();
        const float* g = args.in[24];
        for (int m = gw; m < NTOK; m += NGW) {
            const GAS f32x4* xr = (const GAS f32x4*)(out + (size_t)m * DM) + lane;
            f32x4 v[4];
#pragma unroll
            for (int j = 0; j < 4; ++j) v[j] = xr[64 * j];
            const int b = m >> 12;
            const unsigned short myinv = INV[(size_t)m * 16 + (lane & 15)];
            for (int e = 0; e < 16; ++e) {
                const unsigned s = (unsigned)lane_read_i((int)myinv, e);
                if (s != 0xffffu) {
                    const size_t slot = ((size_t)e * NB + b) * CAP + s;
                    const float gv = GSEL[slot];
                    const GAS u32x2* yr = (const GAS u32x2*)(Y + slot * DM) + lane;
#pragma unroll
                    for (int j = 0; j < 4; ++j) { const u32x2 w = yr[64 * j]; v[j].x += gv * bflo(w.x); v[j].y += gv * bfhi(w.x); v[j].z += gv * bflo(w.y); v[j].w += gv * bfhi(w.y); }
                }
            }
            float s = 0.f;
#pragma unroll
            for (int j = 0; j < 4; ++j) s += (v[j].x * v[j].x + v[j].y * v[j].y) + (v[j].z * v[j].z + v[j].w * v[j].w);
            const float r = rsqrtf(wave_sum(s) * (1.f / DM) + EPS);
            GAS f32x4* o = (GAS f32x4*)(out + (size_t)m * DM) + lane;
#pragma unroll
            for (int j = 0; j < 4; ++j) { const f32x4 gg = ((const GAS f32x4*)g)[lane + 64 * j]; o[64 * j] = (f32x4){v[j].x * r * gg.x, v[j].y * r * gg.y, v[j].z * r * gg.z, v[j].w * r * gg.w}; }
        }
    }
}

extern "C" void kernel_launch(void* const* d_in, const int* in_sizes, int n_in, void* d_out, int out_size, void* d_ws, size_t ws_size, hipStream_t stream) {
    static int grid = 0;
    if (grid == 0) {
        if (n_in != 25 || ws_size < WS_END) { fprintf(stderr, "kernel_launch: unexpected n_in %d / ws %zu\n", n_in, ws_size); grid = -1; return; }
        int dev = 0, cus = 0;
        if (hipGetDevice(&dev) != hipSuccess || hipDeviceGetAttribute(&cus, hipDeviceAttributeMultiprocessorCount, dev) != hipSuccess) { grid = -1; return; }
        if (hipFuncSetAttribute((const void*)mega_fwd, hipFuncAttributeMaxDynamicSharedMemorySize, LDS_BYTES) != hipSuccess) { fprintf(stderr, "kernel_launch: hipFuncSetAttribute failed\n"); grid = -1; return; }
        int per_cu = 0;
        if (hipOccupancyMaxActiveBlocksPerMultiprocessor(&per_cu, (const void*)mega_fwd, 512, LDS_BYTES) != hipSuccess || per_cu < 1) fprintf(stderr, "kernel_launch: occupancy query says %d\n", per_cu);
        (void)hipGetLastError();
        grid = cus;
    }
    if (grid < 0) return;
    (void)hipMemsetAsync((char*)d_ws + WS_CTL, 0, CTL_BYTES, stream);
    Args a; memset(&a, 0, sizeof a);
    for (int i = 0; i < 25; ++i) a.in[i] = (const float*)d_in[i];
    a.out = (float*)d_out; a.ws = (unsigned char*)d_ws;
    hipLaunchKernelGGL(mega_fwd, dim3(grid), dim3(512), LDS_BYTES, stream, a);
}
```

```cpp
#include <hip/hip_runtime.h>
#include <cstdio>
#include <cstdint>
#include <cstring>

#define GAS __attribute__((address_space(1)))
#define LAS __attribute__((address_space(3)))
typedef unsigned short bf16_t;
typedef short bf16x8 __attribute__((ext_vector_type(8)));
typedef float f32x4 __attribute__((ext_vector_type(4)));
typedef float f32x2 __attribute__((ext_vector_type(2)));
typedef unsigned u32x4 __attribute__((ext_vector_type(4)));
typedef unsigned u32x2 __attribute__((ext_vector_type(2)));
typedef short v4i16_t __attribute__((ext_vector_type(4)));
typedef int i32x4 __attribute__((ext_vector_type(4)));
typedef int i32x8 __attribute__((ext_vector_type(8)));
constexpr int F8_SCALES = 127 | (122 << 8);
typedef float f32x16 __attribute__((ext_vector_type(16)));

constexpr int DM = 1024, NB = 8, SEQ = 4096, NTOK = NB * SEQ;
constexpr int HW = 512, HCOLS = 1536, INC = 3072, ACOLS = 1536;
constexpr int NE = 16, CAP = 512, FF = 2816, NSLOT = NE * NB * CAP;
constexpr float EPS = 1e-6f;
constexpr float LOG2E = 1.4426950408889634f;
constexpr float QSCALE = 0.125f * LOG2E;
constexpr int GOFF = 4352, GLEN = 8704;

constexpr size_t MiB = 1u << 20;
constexpr size_t WS_CTL = 0, CTL_BYTES = 1 * MiB;
constexpr size_t WS_WGU = 2 * MiB;
constexpr size_t WS_WD = 90 * MiB;
constexpr size_t WS_AFF = 134 * MiB;
constexpr size_t WS_TOK = 136 * MiB;
constexpr size_t WS_GSEL = WS_TOK + 256 * 1024;
constexpr size_t WS_INV = 137 * MiB;
constexpr size_t WS_XN = 138 * MiB;
constexpr size_t WS_H2 = WS_XN;
constexpr size_t WS_WIN = 202 * MiB;
constexpr size_t WS_WOUT = 208 * MiB;
constexpr size_t WS_GF = 210 * MiB;
constexpr size_t WS_HP = 228 * MiB;
constexpr size_t WS_QKV = 324 * MiB;
constexpr size_t WS_ACT = 228 * MiB;
constexpr size_t WS_HZ = 420 * MiB;
constexpr size_t WS_MIX = 452 * MiB;
constexpr size_t WS_PARK = 516 * MiB;
constexpr size_t WS_Y = 420 * MiB;
constexpr size_t WS_END = 548 * MiB;
constexpr int CW_BAR = 4096;
constexpr int CW_NSUM = 16384;

constexpr int REP_XN = 1, REP_P3A = 1, REP_P4A = 1, REP_P4B = 1;
constexpr int REP_P0W = 1, REP_P1 = 1, REP_HY = 1, REP_AT = 1, REP_P3B = 1, REP_P5 = 1, REP_P6 = 1;
constexpr int LDS_BYTES = 160 * 1024;
constexpr int MISC_OFF = LDS_BYTES - 256;
constexpr int HY_ZBYTES = (SEQ + 32) * 16, HY_ZA = 0, HY_ZB = HY_ZBYTES, HY_FB = 2 * HY_ZBYTES;
constexpr int TBL_OFF = 131072;

__device__ __forceinline__ unsigned f2bf(float f) { unsigned u = __builtin_bit_cast(unsigned, f); return (u + 0x7fffu + ((u >> 16) & 1u)) >> 16; }
__device__ __forceinline__ unsigned pk2(float lo, float hi) { return f2bf(lo) | (f2bf(hi) << 16); }
__device__ __forceinline__ float bf2f(unsigned short h) { return __builtin_bit_cast(float, (unsigned)h << 16); }
__device__ __forceinline__ float bflo(unsigned w) { return __builtin_bit_cast(float, w << 16); }
__device__ __forceinline__ float bfhi(unsigned w) { return __builtin_bit_cast(float, w & 0xffff0000u); }
template <int M> __device__ __forceinline__ float sx(float v) { static_assert(M >= 1 && M <= 16, "sx: xor mask 1..16"); return __int_as_float(__builtin_amdgcn_ds_swizzle(__float_as_int(v), (M << 10) | 0x1f)); }
__device__ __forceinline__ float sum32x(float v) { auto r = __builtin_amdgcn_permlane32_swap(__float_as_uint(v), __float_as_uint(v), false, false); return __uint_as_float(r[0]) + __uint_as_float(r[1]); }
__device__ __forceinline__ float max32x(float v) { auto r = __builtin_amdgcn_permlane32_swap(__float_as_uint(v), __float_as_uint(v), false, false); return fmaxf(__uint_as_float(r[0]), __uint_as_float(r[1])); }
__device__ __forceinline__ float lane_read(float v, int src) { return __int_as_float(__builtin_amdgcn_ds_bpermute(src << 2, __float_as_int(v))); }
__device__ __forceinline__ int lane_read_i(int v, int src) { return __builtin_amdgcn_ds_bpermute(src << 2, v); }
__device__ __forceinline__ float wave_sum(float v) { v += sx<1>(v); v += sx<2>(v); v += sx<4>(v); v += sx<8>(v); v += sx<16>(v); return sum32x(v); }
__device__ __forceinline__ float wave_max(float v) { v = fmaxf(v, sx<1>(v)); v = fmaxf(v, sx<2>(v)); v = fmaxf(v, sx<4>(v)); v = fmaxf(v, sx<8>(v)); v = fmaxf(v, sx<16>(v)); return max32x(v); }
#define LDS_WAIT() asm volatile("s_waitcnt lgkmcnt(0)" ::: "memory")
__device__ __forceinline__ int lane_id_v() { int l; asm volatile("v_mbcnt_lo_u32_b32 %0, -1, 0\n\tv_mbcnt_hi_u32_b32 %0, -1, %0" : "=v"(l)); return l; }
#define PHASE_IDS() const int wave = wave_s; int tid_o = wave_s * 64 + lane_id_v(); asm volatile("" : "+v"(tid_o)); const int tid = tid_o, lane = tid & 63, gw = blockIdx.x * 8 + wave; (void)lane; (void)gw

namespace pg8 {
constexpr int BM = 256, BK = 64, HALF = 128, HTB = HALF * BK * 2, STAGE_BYTES = 8 * HTB, NXCD = 8, WGM = 8;
__host__ __device__ __forceinline__ int lds_byte(int r, int c) { const int st = (r >> 4) * 2 + (c >> 5), rr = r & 15, cc = c & 31, ob = rr * 64 + cc * 2; return st * 1024 + (ob ^ (((ob >> 9) & 1) << 5)); }
__host__ __device__ __forceinline__ void stage_rc(int b, int& R, int& C) { const int st = b / 1024, sb = b % 1024, swz = sb ^ (((sb >> 9) & 1) << 5); R = (st >> 1) * 16 + swz / 64; C = (st & 1) * 32 + (swz % 64) / 2; }
__host__ __device__ __forceinline__ int perm32(int rho) { const int n = rho >> 4, i = rho & 15; return 8 * (i >> 2) + 4 * n + (i & 3); }
struct Unit { int pm, pn; };

struct TileOrder {
    int nM, nN, nwg, G, c;
    __device__ void init(int nM_, int nN_, int G_, int c_) { nM = nM_; nN = nN_; nwg = nM * nN; G = G_; c = c_; }
    __device__ bool next(int i, Unit& u) const {
        const long L = (long)i * G + c; if (L >= nwg) return false;
        int wgid = (int)L; { const int q = nwg / NXCD, r = nwg % NXCD, xcd = wgid % NXCD, off = wgid / NXCD; wgid = (xcd < r ? xcd * (q + 1) : r * (q + 1) + (xcd - r) * q) + off; }
        const int nig = WGM * nN, gid = wgid / nig, fm = gid * WGM, gsz = (nM - fm) < WGM ? (nM - fm) : WGM;
        u.pm = fm + ((wgid % nig) % gsz); u.pn = (wgid % nig) / gsz; return true;
    }
};
__device__ __forceinline__ unsigned cvt_pk_bf16(float lo, float hi) { unsigned r; asm volatile("v_cvt_pk_bf16_f32 %0, %1, %2" : "=v"(r) : "v"(lo), "v"(hi)); return r; }

struct EpiBf16 {
    static constexpr bool PERM = true;
    bf16_t* O; int ldc; int scols; float sc;
    __device__ __forceinline__ void operator()(const f32x4 (&acc)[2][2][4][2], const Unit& u, int wr, int wc, int fr, int fq) const {
        const int row0 = u.pm * BM + wr * 64 + fr, col0 = u.pn * BM + wc * 32 + 8 * fq;
        const float s = (u.pn * BM < scols) ? sc : 1.f;
#pragma unroll
        for (int ai = 0; ai < 2; ++ai)
#pragma unroll
            for (int m = 0; m < 4; ++m) { bf16_t* rowp = O + (size_t)(row0 + ai * HALF + m * 16) * ldc + col0;
#pragma unroll
                for (int bj = 0; bj < 2; ++bj) { const f32x4 v0 = acc[ai][bj][m][0] * s, v1 = acc[ai][bj][m][1] * s;
                    u32x4 w; w.x = cvt_pk_bf16(v0[0], v0[1]); w.y = cvt_pk_bf16(v0[2], v0[3]); w.z = cvt_pk_bf16(v1[0], v1[1]); w.w = cvt_pk_bf16(v1[2], v1[3]);
                    *(u32x4*)(rowp + bj * HALF) = w; } }
    }
};
struct EpiResF32 {
    static constexpr bool PERM = false;
    const float* R; float* C; int ldc;
    __device__ __forceinline__ void operator()(const f32x4 (&acc)[2][2][4][2], const Unit& u, int wr, int wc, int fr, int fq) const {
        const int row0 = u.pm * BM + wr * 64 + fr, col0 = u.pn * BM + wc * 32 + 4 * fq;
#pragma unroll
        for (int ai = 0; ai < 2; ++ai)
#pragma unroll
            for (int m = 0; m < 4; ++m) { const size_t off = (size_t)(row0 + ai * HALF + m * 16) * ldc + col0;
#pragma unroll
                for (int bj = 0; bj < 2; ++bj)
#pragma unroll
                    for (int n = 0; n < 2; ++n) { const f32x4 r = *(const f32x4*)(R + off + bj * HALF + n * 16); *(f32x4*)(C + off + bj * HALF + n * 16) = r + acc[ai][bj][m][n]; } }
    }
};
struct EpiSwiGLU {
    static constexpr bool PERM = true;
    unsigned char* O; int ldc;
    __device__ __forceinline__ void operator()(const f32x4 (&acc)[2][2][4][2], const Unit& u, int wr, int wc, int fr, int fq) const {
        const int row0 = u.pm * BM + wr * 64 + fr, col0 = u.pn * HALF + wc * 32 + 8 * fq;
#pragma unroll
        for (int ai = 0; ai < 2; ++ai)
#pragma unroll
            for (int m = 0; m < 4; ++m) { unsigned char* rowp = O + (size_t)(row0 + ai * HALF + m * 16) * ldc + col0;
                float o[8];
#pragma unroll
                for (int n = 0; n < 2; ++n)
#pragma unroll
                    for (int j = 0; j < 4; ++j) { const float g = acc[ai][0][m][n][j], up = acc[ai][1][m][n][j];
                        o[n * 4 + j] = g * __builtin_amdgcn_rcpf(1.f + __builtin_amdgcn_exp2f(-g * LOG2E)) * up; }
                u32x2 w; int t0 = __builtin_amdgcn_cvt_pk_fp8_f32(o[0], o[1], 0, false); t0 = __builtin_amdgcn_cvt_pk_fp8_f32(o[2], o[3], t0, true);
                int t1 = __builtin_amdgcn_cvt_pk_fp8_f32(o[4], o[5], 0, false); t1 = __builtin_amdgcn_cvt_pk_fp8_f32(o[6], o[7], t1, true);
                w.x = (unsigned)t0; w.y = (unsigned)t1; *(u32x2*)rowp = w; }
    }
};

struct GeoPlain {
    static constexpr bool GATHER = false;
    const bf16_t* A; const bf16_t* Bt; int KB; TileOrder ord;
    __device__ __forceinline__ bool next(int i, Unit& u) const { return ord.next(i, u); }
    __device__ __forceinline__ const char* a_ptr(const Unit& u) const { return (const char*)A + (size_t)u.pm * BM * KB; }
    __device__ __forceinline__ const char* b_ptr(const Unit& u) const { return (const char*)Bt + (size_t)u.pn * BM * KB; }
    __device__ __forceinline__ size_t hstepA() const { return (size_t)HALF * KB; }
    __device__ __forceinline__ size_t hstepB() const { return (size_t)HALF * KB; }
    __device__ __forceinline__ size_t istepA() const { return (size_t)64 * KB; }
    __device__ __forceinline__ size_t istepB() const { return (size_t)64 * KB; }
    __device__ __forceinline__ unsigned a_voff(int R, int C) const { return (unsigned)(R * KB + C * 2); }
    __device__ __forceinline__ unsigned b_voff(int R, int C) const { return (unsigned)(R * KB + C * 2); }
    __device__ __forceinline__ void fill_table(LAS unsigned*, const Unit&, int) const {}
};
struct GeoTokPerm {
    static constexpr bool GATHER = false;
    const bf16_t* A; const bf16_t* X; int KB; TileOrder ord;
    __device__ __forceinline__ bool next(int i, Unit& u) const { return ord.next(i, u); }
    __device__ __forceinline__ const char* a_ptr(const Unit& u) const { return (const char*)A + (size_t)u.pm * BM * KB; }
    __device__ __forceinline__ const char* b_ptr(const Unit& u) const { return (const char*)X + (size_t)u.pn * 32 * KB; }
    __device__ __forceinline__ size_t hstepA() const { return (size_t)HALF * KB; }
    __device__ __forceinline__ size_t hstepB() const { return (size_t)16 * KB; }
    __device__ __forceinline__ size_t istepA() const { return (size_t)64 * KB; }
    __device__ __forceinline__ size_t istepB() const { return (size_t)8 * KB; }
    __device__ __forceinline__ unsigned a_voff(int R, int C) const { return (unsigned)(R * KB + C * 2); }
    __device__ __forceinline__ unsigned b_voff(int R, int C) const { return (unsigned)(((R & 7) * SEQ + (R >> 3)) * KB + C * 2); }
    __device__ __forceinline__ void fill_table(LAS unsigned*, const Unit&, int) const {}
};
template <bool G> struct GeoExpert {
    static constexpr bool GATHER = G;
    const void* A; const void* Bt; int KB; size_t bexp;    const int* tok; TileOrder ord;
    __device__ __forceinline__ bool next(int i, Unit& u) const { return ord.next(i, u); }
    __device__ __forceinline__ const char* a_ptr(const Unit& u) const { return G ? (const char*)A : (const char*)A + (size_t)u.pm * BM * KB; }
    __device__ __forceinline__ const char* b_ptr(const Unit& u) const { return (const char*)Bt + (size_t)(u.pm >> 4) * bexp + (size_t)u.pn * BM * KB; }
    __device__ __forceinline__ size_t hstepA() const { return (size_t)HALF * KB; }
    __device__ __forceinline__ size_t hstepB() const { return (size_t)HALF * KB; }
    __device__ __forceinline__ size_t istepA() const { return (size_t)64 * KB; }
    __device__ __forceinline__ size_t istepB() const { return (size_t)64 * KB; }
    __device__ __forceinline__ unsigned a_voff(int R, int C) const { return (unsigned)(R * KB + C * 2); }
    __device__ __forceinline__ unsigned b_voff(int R, int C) const { return (unsigned)(R * KB + C * 2); }
    __device__ __forceinline__ void fill_table(LAS unsigned* tb, const Unit& u, int tid) const { if (G) { int t_ = tid; asm volatile("" : "+v"(t_));
#pragma unroll
        for (int i = 0; i < 2; ++i) { int R, C; stage_rc(t_ * 16 + i * 8192, R, C);
#pragma unroll
            for (int h = 0; h < 2; ++h) tb[h * 1024 + i * 512 + tid] = (unsigned)tok[u.pm * 256 + h * 128 + R] * (unsigned)KB + (unsigned)C * 2u; } } }
};

template <bool F8, class Epi, class Geo>
__device__ __forceinline__ void gemm_phase(LAS unsigned char* lds, LAS unsigned* tbl, const Geo& S, const Epi& E, int wave_s) {
    int tid_ = wave_s * 64 + lane_id_v(); asm volatile("" : "+v"(tid_));
    const int tid = tid_, wid = wave_s, lane = tid & 63, wr = wid >> 2, wc = wid & 3, fr = lane & 15, fq = lane >> 4;
    const int nt = S.KB / (BK * 2);
    unsigned voffA, voffB;
    { int R, C; stage_rc(tid * 16, R, C); const int Rb = Epi::PERM ? ((R & ~31) + perm32(R & 31)) : R; voffA = S.a_voff(R, C); voffB = S.b_voff(Rb, C); }
    const size_t istepA = S.istepA(), istepB = S.istepB();
    const size_t kstep = (size_t)(BK * 2);
    const size_t hstepA = S.hstepA(), hstepB = S.hstepB();
    const unsigned ldsw = (unsigned)wid * 1024u;
    const int aoff = lds_byte(wr * 64 + fr, fq * 8), boff = lds_byte(wc * 32 + fr, fq * 8);
    const LAS unsigned char* ldsB = lds + 4 * HTB + boff;
#define PG8_SA(b, h) (((b) * 2 + (h)) * HTB)
#define PG8_SB(b, h) ((4 + (b) * 2 + (h)) * HTB)
#define PG8_GLDS(bufoff, gptr, i_) __builtin_amdgcn_global_load_lds((const unsigned*)(gptr), (LAS unsigned*)(lds + (bufoff) + ldsw + (i_) * 8192), 16, 0, 0)
#define PG8_STAGE_B(bufoff, gbase) do { PG8_GLDS(bufoff, (const char*)(gbase) + voffB, 0); PG8_GLDS(bufoff, (const char*)(gbase) + istepB + voffB, 1); } while (0)
#define PG8_STAGE_A(bufoff, gbase, h, nx) do { if constexpr (Geo::GATHER) { const LAS unsigned* _tb = tbl + (((ui + ((nx) ? 1 : 0)) & 1) * 2048) + (h) * 1024 + tid; \
        const unsigned _v0 = _tb[0], _v1 = _tb[512]; PG8_GLDS(bufoff, (const char*)(gbase) + _v0, 0); PG8_GLDS(bufoff, (const char*)(gbase) + _v1, 1); } \
        else { PG8_GLDS(bufoff, (const char*)(gbase) + (h) * hstepA + voffA, 0); PG8_GLDS(bufoff, (const char*)(gbase) + (h) * hstepA + istepA + voffA, 1); } } while (0)
#define PG8_LD16(off) (*(const LAS i32x4*)(lds + (off)))
#define PG8_LDA(dst, b, h) do { _Pragma("unroll") for (int m = 0; m < 4; ++m) dst[m] = __builtin_shufflevector(PG8_LD16(PG8_SA(b, h) + aoff + m * 2048), PG8_LD16(PG8_SA(b, h) + aoff + m * 2048 + 1024), 0, 1, 2, 3, 4, 5, 6, 7); } while (0)
#define PG8_LDB(dst, b, h) do { _Pragma("unroll") for (int n = 0; n < 2; ++n) dst[n] = __builtin_shufflevector(*(const LAS i32x4*)(ldsB + ((b) * 2 + (h)) * HTB + n * 2048), *(const LAS i32x4*)(ldsB + ((b) * 2 + (h)) * HTB + n * 2048 + 1024), 0, 1, 2, 3, 4, 5, 6, 7); } while (0)
#define PG8_LO(v) __builtin_bit_cast(bf16x8, __builtin_shufflevector(v, v, 0, 1, 2, 3))
#define PG8_HI(v) __builtin_bit_cast(bf16x8, __builtin_shufflevector(v, v, 4, 5, 6, 7))
#define PG8_MMA(ai, bj, At, Bt) do { __builtin_amdgcn_s_setprio(1); _Pragma("unroll") for (int m = 0; m < 4; ++m) _Pragma("unroll") for (int n = 0; n < 2; ++n) { \
        if constexpr (F8) { acc[ai][bj][m][n] = __builtin_amdgcn_mfma_scale_f32_16x16x128_f8f6f4(Bt[n], At[m], acc[ai][bj][m][n], 0, 0, 1, F8_SCALES, 0, F8_SCALES); } \
        else { acc[ai][bj][m][n] = __builtin_amdgcn_mfma_f32_16x16x32_bf16(PG8_LO(Bt[n]), PG8_LO(At[m]), acc[ai][bj][m][n], 0, 0, 0); \
               acc[ai][bj][m][n] = __builtin_amdgcn_mfma_f32_16x16x32_bf16(PG8_HI(Bt[n]), PG8_HI(At[m]), acc[ai][bj][m][n], 0, 0, 0); } } \
        __builtin_amdgcn_s_setprio(0); } while (0)
#define PG8_WAIT_V(n) asm volatile("s_waitcnt vmcnt(" #n ")" ::: "memory")
#define PG8_WAIT_L(n) asm volatile("s_waitcnt lgkmcnt(" #n ")" ::: "memory")
#define PG8_BAR __builtin_amdgcn_s_barrier()
#define PG8_SCHED __builtin_amdgcn_sched_barrier(0)
    Unit cur, nxt; int ui = 0;
    if (!S.next(0, cur)) return;
    f32x4 acc[2][2][4][2];
#pragma unroll
    for (int a = 0; a < 2; ++a)
#pragma unroll
        for (int b = 0; b < 2; ++b)
#pragma unroll
            for (int m = 0; m < 4; ++m)
#pragma unroll
                for (int n = 0; n < 2; ++n) acc[a][b][m][n] = (f32x4){0.f, 0.f, 0.f, 0.f};
    i32x8 At[4], B0[2], B1[2];
    const char* cA = S.a_ptr(cur); const char* cB = S.b_ptr(cur);
    if constexpr (Geo::GATHER) {
        S.fill_table(tbl, cur, tid);
        Unit u1; if (S.next(1, u1)) S.fill_table(tbl + 2048, u1, tid);
        asm volatile("s_waitcnt vmcnt(0) lgkmcnt(0)" ::: "memory"); PG8_BAR; asm volatile("" ::: "memory");
    }
    PG8_STAGE_B(PG8_SB(0, 0), cB); PG8_STAGE_B(PG8_SB(0, 1), cB + hstepB); PG8_STAGE_A(PG8_SA(0, 0), cA, 0, false); PG8_STAGE_A(PG8_SA(0, 1), cA, 1, false);
    if (wr == 1) PG8_BAR;
    PG8_WAIT_V(2); PG8_BAR;
    PG8_STAGE_B(PG8_SB(1, 0), cB + kstep); PG8_STAGE_A(PG8_SA(1, 0), cA + kstep, 0, false); PG8_STAGE_B(PG8_SB(1, 1), cB + hstepB + kstep);
    PG8_WAIT_V(6); PG8_BAR;
    for (;;) {
        const bool has_next = S.next(ui + 1, nxt);
        const char* nA = has_next ? S.a_ptr(nxt) : cA; const char* nB = has_next ? S.b_ptr(nxt) : cB;
#pragma clang loop unroll(disable)
        for (int t = 0; t < nt; t += 2) {
            const bool last = (t == nt - 2);
            const bool lastn = last && has_next;
            const char* a1 = cA + (size_t)(t + 1) * kstep;
            const char* a2 = last ? nA : cA + (size_t)(t + 2) * kstep; const char* b2 = last ? nB : cB + (size_t)(t + 2) * kstep;
            const char* a3 = a2 + kstep; const char* b3 = b2 + kstep;
            if constexpr (Geo::GATHER) { if (t == 2 && ui > 0) { Unit u2; if (S.next(ui + 1, u2)) S.fill_table(tbl + (((ui + 1) & 1) * 2048), u2, tid); } }
            PG8_LDB(B0, 0, 0); PG8_LDB(B1, 0, 1); PG8_SCHED; PG8_LDA(At, 0, 0); PG8_STAGE_A(PG8_SA(1, 1), a1, 1, false);
            PG8_WAIT_V(8); PG8_WAIT_L(0); PG8_BAR; PG8_MMA(0, 0, At, B0); PG8_MMA(0, 1, At, B1); PG8_BAR; PG8_SCHED;
            PG8_LDA(At, 0, 1); PG8_STAGE_B(PG8_SB(0, 0), b2); PG8_STAGE_B(PG8_SB(0, 1), b2 + hstepB); PG8_STAGE_A(PG8_SA(0, 0), a2, 0, lastn);
            PG8_WAIT_V(8); PG8_WAIT_L(0); PG8_BAR; PG8_MMA(1, 0, At, B0); PG8_MMA(1, 1, At, B1); PG8_BAR; PG8_SCHED;
            PG8_LDB(B0, 1, 0); PG8_LDB(B1, 1, 1); PG8_SCHED; PG8_LDA(At, 1, 0); PG8_STAGE_A(PG8_SA(0, 1), a2, 1, lastn);
            PG8_WAIT_V(8); PG8_WAIT_L(0); PG8_BAR; PG8_MMA(0, 0, At, B0); PG8_MMA(0, 1, At, B1); PG8_BAR; PG8_SCHED;
            PG8_LDA(At, 1, 1); PG8_STAGE_B(PG8_SB(1, 0), b3); PG8_STAGE_B(PG8_SB(1, 1), b3 + hstepB); PG8_STAGE_A(PG8_SA(1, 0), a3, 0, lastn);
            PG8_WAIT_V(8); PG8_WAIT_L(0); PG8_BAR; PG8_MMA(1, 0, At, B0); PG8_MMA(1, 1, At, B1); PG8_BAR; PG8_SCHED;
        }
        if (wr == 0) PG8_BAR;
        { const int l_e = lane_id_v();
          E(acc, cur, wr, wc, l_e & 15, l_e >> 4); }
        if (!has_next) break;
#pragma unroll
        for (int a = 0; a < 2; ++a)
#pragma unroll
            for (int b = 0; b < 2; ++b)
#pragma unroll
                for (int m = 0; m < 4; ++m)
#pragma unroll
                    for (int n = 0; n < 2; ++n) acc[a][b][m][n] = (f32x4){0.f, 0.f, 0.f, 0.f};
        cur = nxt; cA = nA; cB = nB; ++ui;
        if (wr == 1) PG8_BAR;
    }
    PG8_WAIT_V(0);
    PG8_BAR;
#undef PG8_SA
#undef PG8_SB
#undef PG8_GLDS
#undef PG8_STAGE_B
#undef PG8_STAGE_A
#undef PG8_LDA
#undef PG8_LDB
#undef PG8_LD16
#undef PG8_LO
#undef PG8_HI
#undef PG8_MMA
#undef PG8_WAIT_V
#undef PG8_WAIT_L
#undef PG8_BAR
#undef PG8_SCHED
}
}

namespace att {
constexpr int KVBLK = 64, LDQKV = ACOLS;
constexpr int SHM_V = KVBLK * 128 * 2, SHM_K = KVBLK * 64 * 2, OFF_V = 0, OFF_K = 2 * SHM_V, OFF_WS = OFF_K + 2 * SHM_K, LDS_TOTAL = OFF_WS + 8 * 64 * 4;
constexpr float THR = 8.f;
#define KSWZ64(row, colB) ((row) * 128 + ((colB) ^ ((((row) >> 1) & 7) << 4)))
#define SBAR() __builtin_amdgcn_sched_barrier(0)
__device__ __forceinline__ int crow(int r, int hi) { return (r & 3) + 8 * (r >> 2) + 4 * hi; }
__device__ __forceinline__ unsigned cvtpk(float lo, float hi) { unsigned r; asm volatile("v_cvt_pk_bf16_f32 %0, %1, %2" : "=v"(r) : "v"(lo), "v"(hi)); return r; }
__device__ __forceinline__ int v_st(int k, int c) { const int kk = (k & ~0xC) | ((k & 4) << 1) | ((k & 8) >> 1); return ((kk >> 3) * 4 + (c >> 5)) * 512 + ((kk & 7) * 32 + (c & 31)) * 2; }
__device__ __forceinline__ int v_rd_base(int lane) { return ((lane & 3) << 3) | (((lane >> 2) & 3) << 6) | (((lane >> 4) & 1) << 5) | (((lane >> 5) & 1) << 8); }
constexpr int v_rd_off(int d0, int ks, int half) { return d0 * 512 + ks * 4096 + half * 2048; }
template <int OFF> __device__ __forceinline__ v4i16_t tr_read(int vb) { v4i16_t r; asm volatile("ds_read_b64_tr_b16 %0, %1 offset:%2" : "=&v"(r) : "v"(vb), "i"(OFF) : "memory"); return r; }
template <int D0> __device__ __forceinline__ void pv_one(f32x16& od, int vb, bf16x8 pa0, bf16x8 pa1, bf16x8 pa2, bf16x8 pa3) {
    const v4i16_t l0 = tr_read<v_rd_off(D0, 0, 0)>(vb), h0 = tr_read<v_rd_off(D0, 0, 1)>(vb), l1 = tr_read<v_rd_off(D0, 1, 0)>(vb), h1 = tr_read<v_rd_off(D0, 1, 1)>(vb);
    const v4i16_t l2 = tr_read<v_rd_off(D0, 2, 0)>(vb), h2 = tr_read<v_rd_off(D0, 2, 1)>(vb), l3 = tr_read<v_rd_off(D0, 3, 0)>(vb), h3 = tr_read<v_rd_off(D0, 3, 1)>(vb);
    asm volatile("s_waitcnt lgkmcnt(0)" ::: "memory"); SBAR();
#define PK(L, H) (bf16x8){L[0], L[1], L[2], L[3], H[0], H[1], H[2], H[3]}
    od = __builtin_amdgcn_mfma_f32_32x32x16_bf16(pa0, PK(l0, h0), od, 0, 0, 0);
    od = __builtin_amdgcn_mfma_f32_32x32x16_bf16(pa1, PK(l1, h1), od, 0, 0, 0);
    od = __builtin_amdgcn_mfma_f32_32x32x16_bf16(pa2, PK(l2, h2), od, 0, 0, 0);
    od = __builtin_amdgcn_mfma_f32_32x32x16_bf16(pa3, PK(l3, h3), od, 0, 0, 0);
#undef PK
}
__device__ __forceinline__ void pv_d0(f32x16* o, int vb, bf16x8 pa0, bf16x8 pa1, bf16x8 pa2, bf16x8 pa3) {
    pv_one<0>(o[0], vb, pa0, pa1, pa2, pa3); pv_one<1>(o[1], vb, pa0, pa1, pa2, pa3); pv_one<2>(o[2], vb, pa0, pa1, pa2, pa3); pv_one<3>(o[3], vb, pa0, pa1, pa2, pa3);
}
__device__ __forceinline__ void qkt(f32x16& p0, f32x16& p1, const char* Ks, const bf16x8* qr, const f32x16& negm, int r32, int hi, float dq, float slope2) {
#pragma unroll
    for (int d0 = 0; d0 < 4; ++d0) { const int cb = (d0 * 16 + hi * 8) * 2;
        const bf16x8 b0 = *reinterpret_cast<const bf16x8*>(Ks + KSWZ64(r32, cb));
        const bf16x8 b1 = *reinterpret_cast<const bf16x8*>(Ks + KSWZ64(32 + r32, cb));
        if (d0 == 0) { p0 = __builtin_amdgcn_mfma_f32_32x32x16_bf16(b0, qr[0], negm, 0, 0, 0); p1 = __builtin_amdgcn_mfma_f32_32x32x16_bf16(b1, qr[0], negm, 0, 0, 0); }
        else { p0 = __builtin_amdgcn_mfma_f32_32x32x16_bf16(b0, qr[d0], p0, 0, 0, 0); p1 = __builtin_amdgcn_mfma_f32_32x32x16_bf16(b1, qr[d0], p1, 0, 0, 0); } }
    asm volatile("" : "+v"(dq), "+v"(p0), "+v"(p1));
#pragma unroll
    for (int r = 0; r < 16; ++r) { const float cr = (float)((r & 3) + 8 * (r >> 2)); p0[r] = fmaf(-slope2, fabsf(dq - cr), p0[r]); p1[r] = fmaf(-slope2, fabsf(dq - 32.f - cr), p1[r]); }
}
__device__ __forceinline__ void partialSM(f32x16& p0, f32x16& p1, f32x16& negm, float& alpha) {
    float pmax = p0[0];
#pragma unroll
    for (int r = 1; r < 16; ++r) pmax = fmaxf(pmax, p0[r]);
#pragma unroll
    for (int r = 0; r < 16; ++r) pmax = fmaxf(pmax, p1[r]);
    { auto rr = __builtin_amdgcn_permlane32_swap(__float_as_uint(pmax), __float_as_uint(pmax), false, false); pmax = fmaxf(__uint_as_float(rr[0]), __uint_as_float(rr[1])); }
    if (__builtin_expect(!__any(pmax > THR), 1)) { alpha = 1.f; }
    else { const float dl = fmaxf(pmax, 0.f); alpha = __builtin_amdgcn_exp2f(-dl);
#pragma unroll
        for (int r = 0; r < 16; ++r) { p0[r] -= dl; p1[r] -= dl; negm[r] -= dl; } }
#pragma unroll
    for (int r = 0; r < 16; ++r) p0[r] = __builtin_amdgcn_exp2f(p0[r]);
}
__device__ __forceinline__ void finishSM(f32x16& p0, f32x16& p1, float alpha, float& l_reg, bf16x8& pa0, bf16x8& pa1, bf16x8& pa2, bf16x8& pa3) {
#pragma unroll
    for (int r = 0; r < 16; ++r) p1[r] = __builtin_amdgcn_exp2f(p1[r]);
    float ps = 0.f;
#pragma unroll
    for (int r = 0; r < 16; ++r) ps += p0[r];
#pragma unroll
    for (int r = 0; r < 16; ++r) ps += p1[r];
    { auto rr = __builtin_amdgcn_permlane32_swap(__float_as_uint(ps), __float_as_uint(ps), false, false); ps = __uint_as_float(rr[0]) + __uint_as_float(rr[1]); }
    l_reg = l_reg * alpha + ps;
#define PK4(P, BASE, OUT) do { const unsigned a0 = cvtpk(P[BASE + 0], P[BASE + 1]), a1 = cvtpk(P[BASE + 2], P[BASE + 3]), b0 = cvtpk(P[BASE + 4], P[BASE + 5]), b1 = cvtpk(P[BASE + 6], P[BASE + 7]); \
        auto r0 = __builtin_amdgcn_permlane32_swap(a0, b0, false, false); auto r1 = __builtin_amdgcn_permlane32_swap(a1, b1, false, false); \
        u32x4 w = {r0[0], r1[0], r0[1], r1[1]}; OUT = __builtin_bit_cast(bf16x8, w); } while (0)
    PK4(p0, 0, pa0); PK4(p0, 8, pa1); PK4(p1, 0, pa2); PK4(p1, 8, pa3);
#undef PK4
}
__device__ __forceinline__ void pass(f32x16 (&o)[4], const bf16_t* Qw, const bf16_t* Kh, const bf16_t* Vh, int qpos, int qb, float slope2, char* lds, int tid, int nL, int NT) {
    const int wid = tid >> 6, lane = tid & 63, r32 = lane & 31, hi = lane >> 5;
    char* V_lds = lds + OFF_V; char* K_lds = lds + OFF_K;
    float* ws = (float*)(lds + OFF_WS) + wid * 64; float* li_l = ws; float* al_l = ws + 32;
    float l_reg = 0.f; bf16x8 qr[4];
#pragma unroll
    for (int d = 0; d < 4; ++d)
#pragma unroll
        for (int r = 0; r < 16; ++r) o[d][r] = 0.f;
    f32x16 negm;
#pragma unroll
    for (int r = 0; r < 16; ++r) negm[r] = 0.f;
#pragma unroll
    for (int d0 = 0; d0 < 4; ++d0) qr[d0] = *reinterpret_cast<const bf16x8*>(Qw + d0 * 16);
    const int kr = tid >> 3, kc = (tid & 7) * 8, kst = KSWZ64(kr, kc * 2);
    const int sr = tid >> 4, sc = (tid & 15) * 8, vst0 = v_st(sr, sc), vst1 = v_st(32 + sr, sc);
    const int vb0 = (int)(uintptr_t)V_lds + v_rd_base(lane);
    const unsigned voff0 = (unsigned)(sr * LDQKV + sc), koff0 = (unsigned)(kr * LDQKV + kc);
    struct { bf16x8 vs0, vs1, ks; } st_[2];
    const int nd = 4 * qb;
#define KT(i) ((i) < 4 ? nd + (i) : ((i) < 4 + nL ? nd + 3 - (i) : nd + (i) - nL))
#define SLOAD(i, tile) do { const unsigned k0_ = (unsigned)((tile) * KVBLK * LDQKV); st_[i].vs0 = *reinterpret_cast<const bf16x8*>(Vh + (k0_ + voff0)); st_[i].vs1 = *reinterpret_cast<const bf16x8*>(Vh + (k0_ + voff0 + 32u * LDQKV)); \
        st_[i].ks = *reinterpret_cast<const bf16x8*>(Kh + (k0_ + koff0)); } while (0)
#define SWRITE(b, i) do { *(bf16x8*)(V_lds + (b) * SHM_V + vst0) = st_[i].vs0; *(bf16x8*)(V_lds + (b) * SHM_V + vst1) = st_[i].vs1; *(bf16x8*)(K_lds + (b) * SHM_K + kst) = st_[i].ks; } while (0)
#define SWAIT() asm volatile("s_waitcnt vmcnt(3)" ::: "memory")
#define RESC(a) do { if (__any((a) < 1.f)) { if (hi == 0) al_l[r32] = (a); asm volatile("s_waitcnt lgkmcnt(0)" ::: "memory"); \
        _Pragma("unroll") for (int d = 0; d < 4; ++d) _Pragma("unroll") for (int r = 0; r < 16; ++r) o[d][r] *= al_l[crow(r, hi)]; } } while (0)
#define DQ(tile) ((float)(qpos - (tile) * KVBLK - 4 * hi))
    f32x16 pA0, pA1, pB0, pB1; float alA, alB; bf16x8 pa0, pa1, pa2, pa3;
    SLOAD(0, KT(0)); asm volatile("s_waitcnt vmcnt(0)" ::: "memory"); SWRITE(0, 0); __syncthreads();
    qkt(pA0, pA1, K_lds, qr, negm, r32, hi, DQ(KT(0)), slope2); partialSM(pA0, pA1, negm, alA);
    SLOAD(1, KT(1)); SLOAD(0, KT(2));
    SWAIT(); SWRITE(1, 1); __syncthreads();
    for (int j = 1; j + 1 < NT; j += 2) {
        SBAR(); qkt(pB0, pB1, K_lds + SHM_K, qr, negm, r32, hi, DQ(KT(j)), slope2);
        finishSM(pA0, pA1, alA, l_reg, pa0, pa1, pa2, pa3); SBAR();
        SLOAD(1, KT(j + 2)); SBAR();
        pv_d0(o, vb0, pa0, pa1, pa2, pa3); partialSM(pB0, pB1, negm, alB);
        __syncthreads(); SWAIT(); SWRITE(0, 0);
        RESC(alB); __syncthreads();
        SBAR(); qkt(pA0, pA1, K_lds, qr, negm, r32, hi, DQ(KT(j + 1)), slope2);
        finishSM(pB0, pB1, alB, l_reg, pa0, pa1, pa2, pa3); SBAR();
        if (j + 3 < NT) SLOAD(0, KT(j + 3)); SBAR();
        pv_d0(o, vb0 + SHM_V, pa0, pa1, pa2, pa3); partialSM(pA0, pA1, negm, alA);
        __syncthreads(); SWAIT(); SWRITE(1, 1);
        RESC(alA); __syncthreads();
    }
    SBAR(); qkt(pB0, pB1, K_lds + SHM_K, qr, negm, r32, hi, DQ(KT(NT - 1)), slope2);
    finishSM(pA0, pA1, alA, l_reg, pa0, pa1, pa2, pa3); SBAR();
    pv_d0(o, vb0, pa0, pa1, pa2, pa3); partialSM(pB0, pB1, negm, alB);
    __syncthreads(); RESC(alB);
    finishSM(pB0, pB1, alB, l_reg, pa0, pa1, pa2, pa3); SBAR();
    pv_d0(o, vb0 + SHM_V, pa0, pa1, pa2, pa3);
    if (hi == 0) li_l[r32] = l_reg; asm volatile("s_waitcnt lgkmcnt(0)" ::: "memory");
#pragma unroll
    for (int r = 0; r < 16; ++r) { const float rl = __builtin_amdgcn_rcpf(li_l[crow(r, hi)]);
#pragma unroll
        for (int d = 0; d < 4; ++d) o[d][r] *= rl; }
    __syncthreads();
#undef KT
#undef SLOAD
#undef SWRITE
#undef SWAIT
#undef RESC
#undef DQ
}
#undef SBAR
}

typedef GAS unsigned gu32;
#define XB_TMO      128
#define XB_XCNT(j)  (256  + 64 * (j))
#define XB_XSUB(j)  (1280 + 64 * (j))
#define XB_XGEN(j)  (2304 + 64 * (j))
#define XB_TOP      3328
#define XB_TOPGEN   3392
#define XCD_BAR_WORDS 3456
#define XB_SPIN_CAP (1u << 23)
__device__ __forceinline__ unsigned xb_ld(unsigned* p)              { return __hip_atomic_load(p, __ATOMIC_RELAXED, __HIP_MEMORY_SCOPE_AGENT); }
__device__ __forceinline__ unsigned xb_add(unsigned* p, unsigned v) { return __hip_atomic_fetch_add(p, v, __ATOMIC_RELAXED, __HIP_MEMORY_SCOPE_AGENT); }
__device__ __forceinline__ unsigned xb_xcc_id() { return (unsigned)__builtin_amdgcn_s_getreg((3 << 11) | 20) & 0xFu; }
#define XB_SPIN(cond, bar) do { unsigned _sp = 0; while (cond) { __builtin_amdgcn_s_sleep(1); \
    if ((++_sp & 255u) == 0u) { if (xb_ld(&(bar)[XB_TMO])) break; if (_sp > XB_SPIN_CAP) { atomicAdd(&(bar)[XB_TMO], 1u); break; } } } } while (0)
struct XcdBarrier { unsigned* bar; unsigned x; volatile LAS unsigned* st; int wave; };
__device__ __forceinline__ XcdBarrier xcd_barrier_post(unsigned* bar, volatile LAS unsigned* st, int wave) {
    XcdBarrier b; b.bar = bar; b.x = xb_xcc_id(); b.st = st; b.wave = wave;
    if (wave == 0 && lane_id_v() == 0) (void)xb_add(&bar[XB_XCNT(b.x)], 1u);
    return b;
}
__device__ __forceinline__ void xcd_barrier_complete(unsigned* bar, unsigned x, unsigned& nloc, unsigned& nx) {
    const unsigned G = gridDim.x * gridDim.y * gridDim.z;
    unsigned sum, cnt, mine, sp = 0u;
    for (;;) {
        sum = 0u; cnt = 0u; mine = 0u;
#pragma unroll
        for (unsigned j = 0; j < 16; ++j) { const unsigned c = xb_ld(&bar[XB_XCNT(j)]); sum += c; cnt += (c > 0u) ? 1u : 0u; mine = (j == x) ? c : mine; }
        if (sum == G) break;
        __builtin_amdgcn_s_sleep(1);
        if ((++sp & 255u) == 0u) { if (xb_ld(&bar[XB_TMO])) break; if (sp > XB_SPIN_CAP) { atomicAdd(&bar[XB_TMO], 1u); break; } }
    }
    nloc = mine > 0u ? mine : 1u; nx = cnt > 0u ? cnt : 1u;
}
__device__ __forceinline__ void xcd_barrier(const XcdBarrier& b) {
    asm volatile("s_waitcnt vmcnt(0)" ::: "memory");
    __syncthreads();
    if (b.wave == 0 && lane_id_v() == 0) {
        unsigned* bar = b.bar;
        __builtin_amdgcn_s_waitcnt(0);
        unsigned nloc = b.st[0], nx = b.st[1];
        if (nloc == 0u) { xcd_barrier_complete(bar, b.x, nloc, nx); b.st[0] = nloc; b.st[1] = nx; }
        const unsigned old = xb_add(&bar[XB_XSUB(b.x)], 1u);
        const unsigned gen = old / nloc;
        if (old + 1u == (gen + 1u) * nloc) {
            __builtin_amdgcn_fence(__ATOMIC_RELEASE, "agent");
            asm volatile("s_waitcnt vmcnt(0)" ::: "memory");
            const unsigned og = xb_add(&bar[XB_TOP], 1u);
            const unsigned tg = og / nx;
            if (og + 1u == (tg + 1u) * nx) xb_add(&bar[XB_TOPGEN], 1u);
            else XB_SPIN(xb_ld(&bar[XB_TOPGEN]) == tg, bar);
            __builtin_amdgcn_fence(__ATOMIC_ACQUIRE, "agent");
            xb_add(&bar[XB_XGEN(b.x)], 1u);
            asm volatile("s_waitcnt vmcnt(0)" ::: "memory");
        } else {
            XB_SPIN(xb_ld(&bar[XB_XGEN(b.x)]) == gen, bar);
            __builtin_amdgcn_fence(__ATOMIC_ACQUIRE, "agent");
            asm volatile("s_waitcnt vmcnt(0)" ::: "memory");
        }
    }
    __syncthreads();
}

template <bool F8>
__device__ __forceinline__ void p0_transpose_item(const float* W, int K, int N, void* WTv, int k0, int n0, int orow0, LAS float* scr, int lane) {
#pragma unroll
    for (int i = 0; i < 8; ++i) { const int kk = 8 * i + (lane >> 3), n4 = (lane & 7) * 4; const f32x4 v = *(const GAS f32x4*)(W + (size_t)(k0 + kk) * N + n0 + n4);
        LAS float* d = scr + kk * 33 + n4; d[0] = v.x; d[1] = v.y; d[2] = v.z; d[3] = v.w; }
    LDS_WAIT(); asm volatile("" ::: "memory");
    const int c = lane & 7;
#pragma unroll
    for (int j = 0; j < 4; ++j) { const int n = (lane >> 3) + 8 * j; const LAS float* s = scr + (8 * c) * 33 + n;
        if constexpr (F8) {
            int t0 = __builtin_amdgcn_cvt_pk_fp8_f32(s[0 * 33] * 32.f, s[1 * 33] * 32.f, 0, false); t0 = __builtin_amdgcn_cvt_pk_fp8_f32(s[2 * 33] * 32.f, s[3 * 33] * 32.f, t0, true);
            int t1 = __builtin_amdgcn_cvt_pk_fp8_f32(s[4 * 33] * 32.f, s[5 * 33] * 32.f, 0, false); t1 = __builtin_amdgcn_cvt_pk_fp8_f32(s[6 * 33] * 32.f, s[7 * 33] * 32.f, t1, true);
            *(GAS u32x2*)((unsigned char*)WTv + (size_t)(orow0 + n) * K + k0 + 8 * c) = (u32x2){(unsigned)t0, (unsigned)t1};
        } else {
            u32x4 o; o.x = pk2(s[0 * 33], s[1 * 33]); o.y = pk2(s[2 * 33], s[3 * 33]); o.z = pk2(s[4 * 33], s[5 * 33]); o.w = pk2(s[6 * 33], s[7 * 33]);
            *(GAS u32x4*)((bf16_t*)WTv + (size_t)(orow0 + n) * K + k0 + 8 * c) = o; } }
    LDS_WAIT(); asm volatile("" ::: "memory");
}

struct Args { const float* in[25]; float* out; unsigned char* ws; };

__global__ void __launch_bounds__(512, 2) mega_fwd(Args args) {
    extern __shared__ __attribute__((aligned(16))) unsigned char lds_raw[];
    LAS unsigned char* lds = (LAS unsigned char*)lds_raw;
    volatile LAS unsigned* MISC = (volatile LAS unsigned*)(lds + MISC_OFF);
    const int G = gridDim.x, bx = blockIdx.x, NGW = G * 8;
    const int wave_s = __builtin_amdgcn_readfirstlane(threadIdx.x >> 6);
    unsigned char* ws = args.ws;
    gu32* ctl = (gu32*)(ws + WS_CTL);
    const float* x = args.in[0];
    float* out = args.out;
    unsigned char* WGU = ws + WS_WGU; unsigned char* WD = ws + WS_WD; bf16_t* WIN = (bf16_t*)(ws + WS_WIN); bf16_t* WOUT = (bf16_t*)(ws + WS_WOUT);
    bf16_t* XN = (bf16_t*)(ws + WS_XN); unsigned char* H2 = ws + WS_H2; bf16_t* GF = (bf16_t*)(ws + WS_GF);
    bf16_t* HP = (bf16_t*)(ws + WS_HP); bf16_t* QKV = (bf16_t*)(ws + WS_QKV); bf16_t* HZ = (bf16_t*)(ws + WS_HZ); bf16_t* MIX = (bf16_t*)(ws + WS_MIX);
    unsigned char* ACT = ws + WS_ACT; bf16_t* Y = (bf16_t*)(ws + WS_Y);
    float* AFF = (float*)(ws + WS_AFF); int* TOK = (int*)(ws + WS_TOK); float* GSEL = (float*)(ws + WS_GSEL); unsigned short* INV = (unsigned short*)(ws + WS_INV);
    float* NSUM = (float*)(ws + WS_CTL) + CW_NSUM;

    if (wave_s == 0) ((LAS unsigned*)(lds + MISC_OFF))[lane_id_v()] = 0u;
    __syncthreads();
    XcdBarrier bar = xcd_barrier_post((unsigned*)(ctl + CW_BAR), MISC + 8, wave_s);

    {
        PHASE_IDS();
        LAS float* scr = (LAS float*)(lds + wave * 16384);
        constexpr int I_IN = (DM / 64) * (INC / 32), I_OUT = (DM / 64) * (DM / 32), I_GU = (DM / 64) * (FF / 32), I_DN = (FF / 64) * (DM / 32);
        constexpr int NITEMS = I_IN + I_OUT + NE * (2 * I_GU + I_DN);
        for (int rep_ = 0; rep_ < REP_P0W; ++rep_)
        for (int it = gw; it < NITEMS; it += NGW) {
            int r = it;
            if (r < I_IN) { const int nblk = INC / 32, kb = r / nblk, nb = r % nblk; p0_transpose_item<false>(args.in[2], DM, INC, WIN, 64 * kb, 32 * nb, 32 * nb, scr, lane); continue; } r -= I_IN;
            if (r < I_OUT) { const int nblk = DM / 32, kb = r / nblk, nb = r % nblk; p0_transpose_item<false>(args.in[18], DM, DM, WOUT, 64 * kb, 32 * nb, 32 * nb, scr, lane); continue; } r -= I_OUT;
            const int e = r / (2 * I_GU + I_DN); r -= e * (2 * I_GU + I_DN);
            if (r < 2 * I_GU) { const int up = r >= I_GU; if (up) r -= I_GU; const int nblk = FF / 32, kb = r / nblk, nb = r % nblk, f0 = 32 * nb;
                const int orow = (f0 >> 7) * 256 + up * 128 + (f0 & 127);
                p0_transpose_item<true>(args.in[up ? 22 : 21] + (size_t)e * DM * FF, DM, FF, WGU + (size_t)e * 2 * FF * DM, 64 * kb, f0, orow, scr, lane); continue; }
            r -= 2 * I_GU;
            { const int nblk = DM / 32, kb = r / nblk, nb = r % nblk; p0_transpose_item<true>(args.in[23] + (size_t)e * FF * DM, FF, DM, WD + (size_t)e * DM * FF, 64 * kb, 32 * nb, 32 * nb, scr, lane); }
        }
        const float* g = args.in[1];
        int rep_xn = REP_XN; asm volatile("" : "+s"(rep_xn));
        for (int rep_ = 0; rep_ < rep_xn; ++rep_)
        for (int m = gw; m < NTOK; m += NGW) {
            const GAS f32x4* xr = (const GAS f32x4*)(x + (size_t)m * DM) + lane;
            f32x4 v[4]; float s = 0.f;
#pragma unroll
            for (int j = 0; j < 4; ++j) { v[j] = xr[64 * j]; s += (v[j].x * v[j].x + v[j].y * v[j].y) + (v[j].z * v[j].z + v[j].w * v[j].w); }
            const float rstd = rsqrtf(wave_sum(s) * (1.f / DM) + EPS);
            GAS u32x2* o8 = (GAS u32x2*)(XN + (size_t)m * DM) + lane;
#pragma unroll
            for (int j = 0; j < 4; ++j) { const f32x4 gg = ((const GAS f32x4*)g)[lane + 64 * j]; u32x2 w; w.x = pk2(v[j].x * rstd * gg.x, v[j].y * rstd * gg.y); w.y = pk2(v[j].z * rstd * gg.z, v[j].w * rstd * gg.w); o8[64 * j] = w; }
        }
        __syncthreads();
        LAS float* w1s = (LAS float*)(lds + 118784);
        LAS float* w2s = (LAS float*)(lds + 127232);
        if (bx < 256) { for (int q = tid; q < 33 * 64; q += 512) w1s[q] = args.in[5][q]; for (int q = tid; q < 64 * 64; q += 512) w2s[q] = args.in[7][q]; }
        __syncthreads();
        for (int it = bx; it < 256; it += G) {
            const int ib = it >> 2, dn = it & 3, dir = dn >> 1, n = dn & 1, i0 = ib * 64, ibase = i0 + (dir == 0 ? 1 : 0);
            LAS float* zz = (LAS float*)lds;
            LAS float* h1 = zz + 64 * 33;
            LAS float* h2 = h1 + 64 * 64;
            const float* b1 = args.in[6]; const float* b2 = args.in[8]; const float* w3 = args.in[9]; const float* fr = args.in[10];
            for (int q = tid; q < 64 * 33; q += 512) { const int p = q / 33, j = q % 33, i = ibase + p;
                const float t = (float)i / (float)(SEQ - 1), w = 6.283185307179586f * (float)i / (float)SEQ; float v;
                if (j == 0) v = t; else { const float band = 1e-4f + (float)((j - 1) & 15) * ((15.f - 1e-4f) / 15.f); v = (j <= 16) ? __cosf(band * w) : -__sinf(band * w); }
                zz[q] = v; }
            __syncthreads();
            {
                const int j = tid & 63; float a[8];
#pragma unroll
                for (int m = 0; m < 8; ++m) a[m] = b1[j];
#pragma unroll 3
                for (int k = 0; k < 33; ++k) { const float w = w1s[k * 64 + j];
#pragma unroll
                    for (int m = 0; m < 8; ++m) a[m] += zz[(wave + 8 * m) * 33 + k] * w; }
                const float f = fr[j];
#pragma unroll
                for (int m = 0; m < 8; ++m) h1[(wave + 8 * m) * 64 + j] = __sinf(f * a[m]);
            }
            __syncthreads();
            {
                const int j = tid & 63; float a[8];
#pragma unroll
                for (int m = 0; m < 8; ++m) a[m] = b2[j];
#pragma unroll 2
                for (int k = 0; k < 64; k += 4) { const float w0 = w2s[(k + 0) * 64 + j], w1_ = w2s[(k + 1) * 64 + j], w2_ = w2s[(k + 2) * 64 + j], w3_ = w2s[(k + 3) * 64 + j];
#pragma unroll
                    for (int m = 0; m < 8; ++m) { const f32x4 hh = *(const LAS f32x4*)&h1[(wave + 8 * m) * 64 + k]; a[m] += (hh.x * w0 + hh.y * w1_) + (hh.z * w2_ + hh.w * w3_); } }
                const float f = fr[j];
#pragma unroll
                for (int m = 0; m < 8; ++m) h2[(wave + 8 * m) * 64 + j] = __sinf(f * a[m]);
            }
            __syncthreads();
            const int c = tid, col = dn * 512 + c;
            const float mind = logf(1e-2f) / 1.5f, maxd = logf(1e-2f) / 0.3f;
            const float delta = fabsf(mind + (float)c * ((maxd - mind) / 511.f));
            float asum = 0.f;
            LAS unsigned short* ftile = (LAS unsigned short*)(lds + 45056) + wave * (64 * 72);
            {
                float hv[64];
#pragma unroll
                for (int p = 0; p < 64; ++p) hv[p] = 0.f;
                float f0 = 0.f;
                for (int k = 0; k < 64; k += 4) { const float w0 = w3[(k + 0) * 2048 + col], w1_ = w3[(k + 1) * 2048 + col], w2_ = w3[(k + 2) * 2048 + col], w3_ = w3[(k + 3) * 2048 + col];
                    if (dir == 1 && ib == 0) { const f32x4 hh = *(const LAS f32x4*)&h2[k]; f0 += (hh.x * w3[(k + 0) * 2048 + col - 1024] + hh.y * w3[(k + 1) * 2048 + col - 1024]) + (hh.z * w3[(k + 2) * 2048 + col - 1024] + hh.w * w3[(k + 3) * 2048 + col - 1024]); }
#pragma unroll
                    for (int p0 = 0; p0 < 64; p0 += 16) {
                        f32x4 hh[16];
#pragma unroll
                        for (int p = 0; p < 16; ++p) hh[p] = *(const LAS f32x4*)&h2[(p0 + p) * 64 + k];
                        asm volatile("" ::: "memory");
#pragma unroll
                        for (int p = 0; p < 16; ++p) hv[p0 + p] += (hh[p].x * w0 + hh[p].y * w1_) + (hh[p].z * w2_ + hh[p].w * w3_); } }
                LAS unsigned short* frow = ftile + lane * 72;
#pragma unroll
                for (int p = 0; p < 64; ++p) { const int i = ibase + p; const float t = (float)i / (float)(SEQ - 1); float h = hv[p] * __expf(-t * delta);
                    bool valid = dir == 0 ? (i <= SEQ - 1) : (i >= 1);
                    if (dir == 1 && i == 0) { h = f0; valid = true; }
                    const unsigned hb = valid ? f2bf(h) : 0u; const float hr = __builtin_bit_cast(float, hb << 16);
                    asum += fabsf(hr); frow[dir == 0 ? 63 - p : p] = (unsigned short)hb; }
            }
            LDS_WAIT(); asm volatile("" ::: "memory");
            {
                const int gbase = dir == 0 ? GOFF - i0 - 64 : GOFF + i0;
#pragma unroll
                for (int j = 0; j < 8; ++j) { const int ch = 8 * j + (lane >> 3), chunk = lane & 7;
                    const u32x4 v = *(const LAS u32x4*)(ftile + ch * 72 + chunk * 8);
                    *(GAS u32x4*)(GF + (size_t)(n * 512 + wave * 64 + ch) * GLEN + gbase + chunk * 8) = v; }
            }
            if (ib == 63) { bf16_t* gf = GF + (size_t)(n * 512 + c) * GLEN + (dir == 0 ? 0 : GOFF + 4096);
                for (int q = 0; q < 32; ++q) *(GAS u32x4*)(gf + q * 8) = (u32x4){0u, 0u, 0u, 0u}; }
            atomicAdd(&NSUM[n * 512 + c], asum);
            __syncthreads();
        }
    }
    xcd_barrier(bar);

    int rep_p1 = REP_P1; asm volatile("" : "+s"(rep_p1));
    for (int rep_ = 0; rep_ < rep_p1; ++rep_) {
    {
        pg8::GeoTokPerm S; S.A = WIN; S.X = XN; S.KB = DM * 2; S.ord.init(HCOLS / 256, NTOK / 256, G, bx);
        pg8::EpiBf16 E{HP, NTOK, 0, 1.f};
        pg8::gemm_phase<false>(lds, (LAS unsigned*)(lds + TBL_OFF), S, E, wave_s);
    }
    {
        pg8::GeoPlain S; S.A = XN; S.Bt = WIN + (size_t)HCOLS * DM; S.KB = DM * 2; S.ord.init(NTOK / 256, ACOLS / 256, G, bx);
        pg8::EpiBf16 E{QKV, ACOLS, 512, QSCALE};
        pg8::gemm_phase<false>(lds, (LAS unsigned*)(lds + TBL_OFF), S, E, wave_s);
    }
    }
    xcd_barrier(bar);

    {
        PHASE_IDS();
        LAS unsigned* red = (LAS unsigned*)lds;
        float* QN2 = (float*)(ws + WS_AFF); float* KN2 = QN2 + 4096;
        for (int it = bx; it < NB * 64; it += G) {
            const int b = it >> 6, tile = it & 63, row = tid >> 3, g = tid & 7;
            const bf16_t* rp = QKV + ((size_t)b * SEQ + tile * 64 + row) * ACOLS + g * 64;
            float sq = 0.f, sk = 0.f;
#pragma unroll
            for (int j = 0; j < 8; ++j) { const u32x4 v = *(const GAS u32x4*)(rp + j * 8), w = *(const GAS u32x4*)(rp + 512 + j * 8);
#pragma unroll
                for (int k = 0; k < 4; ++k) { sq += bflo(v[k]) * bflo(v[k]) + bfhi(v[k]) * bfhi(v[k]); sk += bflo(w[k]) * bflo(w[k]) + bfhi(w[k]) * bfhi(w[k]); } }
            if (tid < 16) red[tid] = 0u;
            __syncthreads();
            atomicMax((unsigned*)&red[g], __float_as_uint(sq)); atomicMax((unsigned*)&red[8 + g], __float_as_uint(sk));
            __syncthreads();
            if (tid < 8) QN2[(size_t)(b * 8 + tid) * 64 + tile] = __uint_as_float(red[tid]); else if (tid < 16) KN2[(size_t)(b * 8 + tid - 8) * 64 + tile] = __uint_as_float(red[tid]);
            __syncthreads();
        }
    }
    xcd_barrier(bar);

    {
        PHASE_IDS();
        {
            const float* conv_w = args.in[3]; const float* conv_b = args.in[4]; const float* skip = args.in[11];
            if (tid < 64) { const int bufi = tid >> 5, row = tid & 31, rr = row < 16 ? row : SEQ + row; *(LAS u32x4*)(lds + bufi * HY_ZBYTES + rr * 16) = (u32x4){0u, 0u, 0u, 0u}; }
            const int r32 = lane & 31, hi = lane >> 5;
            const int tr_lane = (2 * ((lane >> 4) & 1) + ((lane & 3) >> 1) + 8 * hi + ((lane & 15) >> 2)) * 16 + 8 * (lane & 1);
            int rep_hy = REP_HY; asm volatile("" : "+s"(rep_hy));
            const bool split13 = (G == 256);
            const int hy_n = split13 ? (bx < 128 ? 1 : 3) : (HW - bx + G - 1) / G, hy_0 = split13 ? (bx < 128 ? bx : 128 + (bx - 128) * 3) : bx, hy_s = split13 ? 1 : G;
            for (int rep_ = 0; rep_ < rep_hy; ++rep_)
            for (int ui_ = 0; ui_ < hy_n; ++ui_) {
                const int c = hy_0 + ui_ * hy_s;
                __syncthreads();
                {
                    const int col = 1024 + c; const float w0 = conv_w[col], w1 = conv_w[HCOLS + col], w2 = conv_w[2 * HCOLS + col], cb = conv_b[col];
                    const bf16_t* hp = HP + (size_t)col * SEQ * 8;
#pragma unroll 2
                    for (int i = 0; i < 8; ++i) { const int t = tid + 512 * i;
                        const u32x4 z4 = (u32x4){0u, 0u, 0u, 0u};
                        const u32x4 pm = t > 0 ? *(const GAS u32x4*)(hp + (size_t)(t - 1) * 8) : z4, p0 = *(const GAS u32x4*)(hp + (size_t)t * 8), pp = t < SEQ - 1 ? *(const GAS u32x4*)(hp + (size_t)(t + 1) * 8) : z4;
                        u32x4 o;
#pragma unroll
                        for (int k = 0; k < 4; ++k) { const float lo = cb + w0 * bflo(pm[k]) + w1 * bflo(p0[k]) + w2 * bflo(pp[k]), hh = cb + w0 * bfhi(pm[k]) + w1 * bfhi(p0[k]) + w2 * bfhi(pp[k]); o[k] = pk2(lo, hh); }
                        *(LAS u32x4*)(lds + HY_ZA + (t + 16) * 16) = o; }
                }
                for (int n = 0; n < 2; ++n) {
                    {
                        const GAS u32x4* gsrc = (const GAS u32x4*)(GF + (size_t)(n * 512 + c) * GLEN);
                        for (int q = tid; q < GLEN * 2 / 16; q += 512) *(LAS u32x4*)(lds + HY_FB + q * 16) = gsrc[q];
                    }
                    __syncthreads();
                    f32x16 acc[2][2];
#pragma unroll
                    for (int a = 0; a < 2; ++a)
#pragma unroll
                        for (int b = 0; b < 2; ++b)
#pragma unroll
                            for (int k = 0; k < 16; ++k) acc[a][b][k] = 0.f;
                    const LAS unsigned char* za = lds + (n == 0 ? HY_ZA : HY_ZB) + tr_lane;
                    const LAS unsigned char* fbp = lds + HY_FB + 2 * GOFF - 32 + 16 * (hi - r32) - 512 * (2 * wave);
#define HY_STEP(OFFA, OFFB) do { \
                        const v4i16_t x0 = __builtin_amdgcn_ds_read_tr16_b64_v4i16((LAS v4i16_t*)(za + (OFFA))); \
                        const v4i16_t x1 = __builtin_amdgcn_ds_read_tr16_b64_v4i16((LAS v4i16_t*)(za + (OFFA) + 64)); \
                        const v4i16_t x2 = __builtin_amdgcn_ds_read_tr16_b64_v4i16((LAS v4i16_t*)(za + (OFFA) + 128)); \
                        const bf16x8 b0 = *(const LAS bf16x8*)(fbp + (OFFB)), b1 = *(const LAS bf16x8*)(fbp + (OFFB) - 512); \
                        const bf16x8 a0 = (bf16x8){x0[0], x0[1], x0[2], x0[3], x1[0], x1[1], x1[2], x1[3]}, a1 = (bf16x8){x1[0], x1[1], x1[2], x1[3], x2[0], x2[1], x2[2], x2[3]}; \
                        acc[0][0] = __builtin_amdgcn_mfma_f32_32x32x16_bf16(a0, b0, acc[0][0], 0, 0, 0); \
                        acc[0][1] = __builtin_amdgcn_mfma_f32_32x32x16_bf16(a1, b0, acc[0][1], 0, 0, 0); \
                        acc[1][0] = __builtin_amdgcn_mfma_f32_32x32x16_bf16(a0, b1, acc[1][0], 0, 0, 0); \
                        acc[1][1] = __builtin_amdgcn_mfma_f32_32x32x16_bf16(a1, b1, acc[1][1], 0, 0, 0); } while (0)
#pragma clang loop unroll(disable)
                    for (int c4 = 0; c4 < 64; ++c4) {
                        HY_STEP(0, 0); HY_STEP(256, 32); HY_STEP(512, 64); HY_STEP(768, 96);
                        za += 1024; fbp += 128;
                    }
                    HY_STEP(0, 0);
#undef HY_STEP
                    const int gcol = n * 512 + c; const float w0 = conv_w[gcol], w1 = conv_w[HCOLS + gcol], w2 = conv_w[2 * HCOLS + gcol], cb = conv_b[gcol];
                    const float inv = 1.f / NSUM[n * 512 + c], sk = skip[n * 512 + c];
                    const bf16_t* hp = HP + (size_t)gcol * SEQ * 8 + 4 * hi;
                    const LAS unsigned char* zin = lds + (n == 0 ? HY_ZA : HY_ZB) + 8 * hi;
#pragma unroll
                    for (int sp = 0; sp < 2; ++sp) {
                        const int tb = 256 * (2 * wave + sp) + 8 * r32;
                        u32x2 P[10];
#pragma unroll
                        for (int k = 0; k < 10; ++k) { const int tq = tb - 1 + k; P[k] = (tq >= 0 && tq < SEQ) ? *(const GAS u32x2*)(hp + (size_t)tq * 8) : (u32x2){0u, 0u}; }
#pragma unroll
                        for (int tt = 0; tt < 8; ++tt) {
                            const int t = tb + tt; const u32x2 zi = *(const LAS u32x2*)(zin + (t + 16) * 16);
                            const float zv[4] = {bflo(zi.x), bfhi(zi.x), bflo(zi.y), bfhi(zi.y)};
                            const float pm[4] = {bflo(P[tt].x), bfhi(P[tt].x), bflo(P[tt].y), bfhi(P[tt].y)};
                            const float pc[4] = {bflo(P[tt + 1].x), bfhi(P[tt + 1].x), bflo(P[tt + 1].y), bfhi(P[tt + 1].y)};
                            const float pp[4] = {bflo(P[tt + 2].x), bfhi(P[tt + 2].x), bflo(P[tt + 2].y), bfhi(P[tt + 2].y)};
                            float zo[4];
#pragma unroll
                            for (int bb = 0; bb < 4; ++bb) { const float gate = cb + w0 * pm[bb] + w1 * pc[bb] + w2 * pp[bb]; zo[bb] = gate * (acc[sp][tt >> 2][(tt & 3) * 4 + bb] * inv + sk * zv[bb]); }
                            u32x2 w; w.x = pk2(zo[0], zo[1]); w.y = pk2(zo[2], zo[3]);
                            if (n == 0) *(LAS u32x2*)(lds + HY_ZB + (t + 16) * 16 + 8 * hi) = w;
                            else *(GAS u32x2*)(HZ + ((size_t)c * SEQ + t) * 8 + 4 * hi) = w;
                        }
                    }
                    __syncthreads();
                }
            }
        }
        __syncthreads();
        {
            const int wid = wave, r32 = lane & 31, hi = lane >> 5;
            const float* QN2 = (const float*)(ws + WS_AFF); const float* KN2 = QN2 + 4096;
            for (int rep_ = 0; rep_ < REP_AT; ++rep_)
            for (int unit = bx; unit < NB * 4 * 16; unit += G) {
                const int v_ = unit & 127, qb = v_ & 15, b = v_ >> 4, h = unit < 256 ? 2 + (unit >> 7) : ((unit - 256) >> 7 ? 0 : 1), q0 = qb * 256;
                const bf16_t* pb = QKV + (size_t)b * SEQ * ACOLS;
                const float slope2 = exp2f(-2.f * (float)(h + 1)) * LOG2E;
                const int l_u = lane_id_v(), r32u = l_u & 31, hiu = l_u >> 5;
                const int qpos = q0 + wid * 32 + r32u;
                f32x16 o[4];
#pragma clang loop unroll(disable)
                for (int mp = 0; mp < 2; ++mp) {
                    int nL, NT;
                    { const float* qn = QN2 + ((size_t)(b * 8 + h * 2 + mp)) * 64; const float* kn = KN2 + ((size_t)(b * 8 + h * 2 + mp)) * 64;
                      float km = kn[lane_id_v()];
                      km = wave_max(km);
                      const float qm = fmaxf(fmaxf(qn[4 * qb], qn[4 * qb + 1]), fmaxf(qn[4 * qb + 2], qn[4 * qb + 3]));
                      const float rthr = (150.f + 2.f * sqrtf(qm * km)) / slope2;
                      const int side = __builtin_amdgcn_readfirstlane((int)fminf(rthr * (1.f / 64.f), 64.f)) + 2;
                      nL = min(4 * qb, side); int nR = min(60 - 4 * qb, side); NT = 4 + nL + nR;
                      if (NT & 1) { if (nL < 4 * qb) ++nL; else ++nR; ++NT; } }
                    att::pass(o, pb + (size_t)qpos * ACOLS + h * 128 + mp * 64 + hiu * 8, pb + 512 + h * 128 + mp * 64, pb + 1024 + h * 128, qpos, qb, slope2, (char*)lds_raw, tid, nL, NT);
                    if (mp == 0) {
                        int z2 = 0; asm volatile("" : "+s"(z2));
                        GAS f32x4* pk = (GAS f32x4*)((float*)(ws + WS_PARK) + (size_t)(bx * 8 + wid) * 4096 + lane * 64 + z2);
#pragma unroll
                        for (int d = 0; d < 4; ++d)
#pragma unroll
                            for (int k = 0; k < 4; ++k) pk[d * 4 + k] = (f32x4){o[d][4 * k], o[d][4 * k + 1], o[d][4 * k + 2], o[d][4 * k + 3]};
                    }
                    __builtin_amdgcn_sched_barrier(0);
                }
                asm volatile("s_waitcnt vmcnt(0)" ::: "memory");
                int zz = 0; asm volatile("" : "+s"(zz));
                float lam;
                { float s1 = 0.f, s2 = 0.f; for (int i = 0; i < 64; ++i) { s1 += args.in[13][i + zz] * args.in[14][i + zz]; s2 += args.in[15][i + zz] * args.in[16][i + zz]; } lam = expf(s1) - expf(s2) + 0.2f; }
                const float* subg = args.in[17] + zz;
                int lane_c = lane; asm volatile("" : "+v"(lane_c)); const int r32c = lane_c & 31, hic = lane_c >> 5;
                {
                    const GAS f32x4* pk = (const GAS f32x4*)((float*)(ws + WS_PARK) + (size_t)(bx * 8 + wid) * 4096 + lane_c * 64 + zz);
#pragma unroll
                    for (int d = 0; d < 4; ++d)
#pragma unroll
                        for (int k = 0; k < 4; ++k) { const f32x4 pv = pk[d * 4 + k];
#pragma unroll
                            for (int q = 0; q < 4; ++q) o[d][4 * k + q] = pv[q] - lam * o[d][4 * k + q]; }
                }
#pragma unroll
                for (int r = 0; r < 16; ++r) {
                    float ss = 0.f;
#pragma unroll
                    for (int d = 0; d < 4; ++d) ss += o[d][r] * o[d][r];
                    ss += sx<1>(ss); ss += sx<2>(ss); ss += sx<4>(ss); ss += sx<8>(ss); ss += sx<16>(ss);
                    const float rs = rsqrtf(ss * (1.f / 128.f) + EPS) * 0.8f;
                    bf16_t* op = MIX + ((size_t)b * SEQ + q0 + wid * 32 + att::crow(r, hic)) * DM + 512 + h * 128 + r32c;
#pragma unroll
                    for (int d = 0; d < 4; ++d) op[d * 32] = (bf16_t)f2bf(o[d][r] * rs * subg[d * 32 + r32c]);
                }
            }
        }
    }
    xcd_barrier(bar);

    {
        PHASE_IDS();
        const float* hg = args.in[12];
        LAS unsigned short* tile = (LAS unsigned short*)lds;
        LAS float* rs = (LAS float*)(lds + 32768);
        int rep_3a = REP_P3A; asm volatile("" : "+s"(rep_3a));
        for (int rep_ = 0; rep_ < rep_3a; ++rep_)
        for (int it = bx; it < 8 * 128; it += G) {
            const int g = it & 7, tb = it >> 3, t0 = tb * 32;
            __syncthreads();
            for (int q = tid; q < 64 * 32; q += 512) { const int ch = q >> 5, seg = q & 31;
                const u32x4 v = *(const GAS u32x4*)(HZ + ((size_t)(g * 64 + ch) * SEQ + t0 + seg) * 8);
                *(LAS u32x4*)(tile + ch * 256 + seg * 8) = v; }
            __syncthreads();
            if (tid < 256) { float s = 0.f; for (int ch = 0; ch < 64; ++ch) { const float v = bf2f(tile[ch * 256 + tid]); s += v * v; } rs[tid] = rsqrtf(s * (1.f / 64.f) + EPS); }
            __syncthreads();
            for (int q = tid; q < 256 * 8; q += 512) { const int tk = q >> 3, c8 = (q & 7) * 8;
                const float r = rs[tk]; const int t = t0 + (tk >> 3), b = tk & 7;
                float v[8];
#pragma unroll
                for (int j = 0; j < 8; ++j) v[j] = bf2f(tile[(c8 + j) * 256 + tk]) * r * hg[g * 64 + c8 + j];
                u32x4 w; w.x = pk2(v[0], v[1]); w.y = pk2(v[2], v[3]); w.z = pk2(v[4], v[5]); w.w = pk2(v[6], v[7]);
                *(GAS u32x4*)(MIX + ((size_t)b * SEQ + t) * DM + g * 64 + c8) = w; }
        }
        __syncthreads();
    }
    xcd_barrier(bar);

    {
        pg8::GeoPlain S; S.A = MIX; S.Bt = WOUT; S.KB = DM * 2; S.ord.init(NTOK / 256, DM / 256, G, bx);
        pg8::EpiResF32 E{x, out, DM};
        for (int rep_ = 0; rep_ < REP_P3B; ++rep_) pg8::gemm_phase<false>(lds, (LAS unsigned*)(lds + TBL_OFF), S, E, wave_s);
    }
    xcd_barrier(bar);

    {
        PHASE_IDS();
        const float* g = args.in[19]; const float* wr = args.in[20];
        LAS float* gwl = (LAS float*)lds;
        for (int q = tid; q < DM * 4; q += 512) { const f32x4 w4 = ((const GAS f32x4*)wr)[q]; const float gd = g[q >> 2]; *(LAS f32x4*)(gwl + (q >> 2) * 20 + (q & 3) * 4) = w4 * gd; }
        __syncthreads();
        const int i16 = lane & 15, q4 = lane >> 4;
        int rep_4a = REP_P4A; asm volatile("" : "+s"(rep_4a));
        for (int rep_ = 0; rep_ < rep_4a; ++rep_)
        for (int grp = gw; grp < NTOK / 16; grp += NGW) {
            const int tok0 = grp * 16;
            const float* xrow = out + (size_t)(tok0 + i16) * DM + 4 * q4;
            const LAS float* bp = gwl + (4 * q4) * 20 + i16;
            f32x4 acc = (f32x4){0.f, 0.f, 0.f, 0.f}; float ss = 0.f;
#pragma unroll 8
            for (int kk = 0; kk < 64; ++kk) {
                const f32x4 a = *(const GAS f32x4*)(xrow + 16 * kk);
                ss += (a.x * a.x + a.y * a.y) + (a.z * a.z + a.w * a.w);
                const LAS float* b = bp + kk * 320;
                acc = __builtin_amdgcn_mfma_f32_16x16x4f32(a.x, b[0], acc, 0, 0, 0);
                acc = __builtin_amdgcn_mfma_f32_16x16x4f32(a.y, b[20], acc, 0, 0, 0);
                acc = __builtin_amdgcn_mfma_f32_16x16x4f32(a.z, b[40], acc, 0, 0, 0);
                acc = __builtin_amdgcn_mfma_f32_16x16x4f32(a.w, b[60], acc, 0, 0, 0);
            }
            ss += sx<16>(ss); ss = sum32x(ss);
            const float r = rsqrtf(ss * (1.f / DM) + EPS);
            f32x4 af;
#pragma unroll
            for (int reg = 0; reg < 4; ++reg) {
                const float lg = acc[reg] * lane_read(r, 4 * q4 + reg);
                float mx = lg; mx = fmaxf(mx, sx<1>(mx)); mx = fmaxf(mx, sx<2>(mx)); mx = fmaxf(mx, sx<4>(mx)); mx = fmaxf(mx, sx<8>(mx));
                const float ex = expf(lg - mx); float den = ex; den += sx<1>(den); den += sx<2>(den); den += sx<4>(den); den += sx<8>(den);
                af[reg] = ex / den;
            }
            const int b = tok0 >> 12, t0 = tok0 & 4095;
            *(GAS f32x4*)(AFF + ((size_t)i16 * NB + b) * SEQ + t0 + 4 * q4) = af;
            *(GAS u32x2*)(INV + (size_t)tok0 * 16 + lane * 4) = (u32x2){0xffffffffu, 0xffffffffu};
            for (int i = 0; i < 16; ++i) {
                const float ri = lane_read(r, i);
                const GAS f32x4* xr = (const GAS f32x4*)(out + (size_t)(tok0 + i) * DM) + lane;
                GAS unsigned* o4 = (GAS unsigned*)(H2 + (size_t)(tok0 + i) * DM) + lane;
#pragma unroll
                for (int j = 0; j < 4; ++j) { const f32x4 v = xr[64 * j]; const f32x4 gg = ((const GAS f32x4*)g)[lane + 64 * j];
                    int t = __builtin_amdgcn_cvt_pk_fp8_f32(v.x * ri * gg.x, v.y * ri * gg.y, 0, false); t = __builtin_amdgcn_cvt_pk_fp8_f32(v.z * ri * gg.z, v.w * ri * gg.w, t, true); o4[64 * j] = (unsigned)t; }
            }
        }
        __syncthreads();
    }
    xcd_barrier(bar);

    {
        PHASE_IDS();
        LAS unsigned* hist = (LAS unsigned*)lds; LAS unsigned* scan = hist + 256; LAS unsigned* selw = scan + 512;
        int rep_4b = REP_P4B; asm volatile("" : "+s"(rep_4b));
        for (int rep_ = 0; rep_ < rep_4b; ++rep_)
        for (int eb = bx; eb < NE * NB; eb += G) {
            const int b = eb & 7, e = eb >> 3;
            const float* a = AFF + (size_t)eb * SEQ;
            unsigned v[8];
#pragma unroll
            for (int j = 0; j < 8; ++j) v[j] = __float_as_uint(a[tid * 8 + j]);
            unsigned prefix = 0, mask = 0, need = CAP;
            __syncthreads();
            for (int pass = 0; pass < 4; ++pass) {
                const int shift = 24 - 8 * pass;
                if (tid < 256) hist[tid] = 0;
                __syncthreads();
#pragma unroll
                for (int j = 0; j < 8; ++j) if ((v[j] & mask) == prefix) atomicAdd((unsigned*)&hist[(v[j] >> shift) & 255u], 1u);
                __syncthreads();
                if (tid < 256) scan[tid] = hist[tid];
                __syncthreads();
                for (int off = 1; off < 256; off <<= 1) { const unsigned xx = (tid < 256 && tid + off < 256) ? scan[tid + off] : 0u; __syncthreads(); if (tid < 256) scan[tid] += xx; __syncthreads(); }
                if (tid < 256) { const unsigned above = tid < 255 ? scan[tid + 1] : 0u; if (above < need && need <= scan[tid]) { selw[0] = (unsigned)tid; selw[1] = need - above; } }
                __syncthreads();
                prefix |= selw[0] << shift; mask |= 255u << shift; need = selw[1];
                __syncthreads();
            }
            unsigned cg = 0, ce = 0;
#pragma unroll
            for (int j = 0; j < 8; ++j) { cg += v[j] > prefix; ce += v[j] == prefix; }
            scan[tid] = (cg << 16) | ce;
            __syncthreads();
            for (int off = 1; off < 512; off <<= 1) { const unsigned xx = tid >= off ? scan[tid - off] : 0u; __syncthreads(); scan[tid] += xx; __syncthreads(); }
            const unsigned incl = scan[tid]; unsigned pg = (incl >> 16) - cg, pe = (incl & 0xffffu) - ce;
#pragma unroll
            for (int j = 0; j < 8; ++j) {
                const bool isg = v[j] > prefix, ise = v[j] == prefix;
                if (isg || (ise && pe < need)) {
                    const unsigned pos = pg + (pe < need ? pe : need); const int token = b * SEQ + tid * 8 + j;
                    TOK[(size_t)eb * CAP + pos] = token; GSEL[(size_t)eb * CAP + pos] = __uint_as_float(v[j]); INV[(size_t)token * 16 + e] = (unsigned short)pos;
                }
                pg += isg; pe += ise;
            }
            __syncthreads();
        }
    }
    xcd_barrier(bar);

    {
        pg8::GeoExpert<true> S; S.A = H2; S.Bt = WGU; S.KB = DM; S.bexp = (size_t)2 * FF * DM; S.tok = TOK; S.ord.init(NSLOT / 256, 2 * FF / 256, G, bx);
        pg8::EpiSwiGLU E{ACT, FF};
        for (int rep_ = 0; rep_ < REP_P5; ++rep_) pg8::gemm_phase<true>(lds, (LAS unsigned*)(lds + TBL_OFF), S, E, wave_s);
    }
    xcd_barrier(bar);

    {
        pg8::GeoExpert<false> S; S.A = ACT; S.Bt = WD; S.KB = FF; S.bexp = (size_t)DM * FF; S.tok = nullptr; S.ord.init(NSLOT / 256, DM / 256, G, bx);
        pg8::EpiBf16 E{Y, DM, 0, 1.f};
        for (int rep_ = 0; rep_ < REP_P6; ++rep_) pg8::gemm_phase<true>(lds, (LAS unsigned*)(lds + TBL_OFF), S, E, wave_s);
    }
    xcd_barrier(bar);

    {
        PHASE_IDS();
        const float* g = args.in[24];
        for (int m = gw; m < NTOK; m += NGW) {
            const GAS f32x4* xr = (const GAS f32x4*)(out + (size_t)m * DM) + lane;
            f32x4 v[4];
#pragma unroll
            for (int j = 0; j < 4; ++j) v[j] = xr[64 * j];
            const int b = m >> 12;
            const unsigned short myinv = INV[(size_t)m * 16 + (lane & 15)];
            for (int e = 0; e < 16; ++e) {
                const unsigned s = (unsigned)lane_read_i((int)myinv, e);
                if (s != 0xffffu) {
                    const size_t slot = ((size_t)e * NB + b) * CAP + s;
                    const float gv = GSEL[slot];
                    const GAS u32x2* yr = (const GAS u32x2*)(Y + slot * DM) + lane;
#pragma unroll
                    for (int j = 0; j < 4; ++j) { const u32x2 w = yr[64 * j]; v[j].x += gv * bflo(w.x); v[j].y += gv * bfhi(w.x); v[j].z += gv * bflo(w.y); v[j].w += gv * bfhi(w.y); }
                }
            }
            float s = 0.f;
#pragma unroll
            for (int j = 0; j < 4; ++j) s += (v[j].x * v[j].x + v[j].y * v[j].y) + (v[j].z * v[j].z + v[j].w * v[j].w);
            const float r = rsqrtf(wave_sum(s) * (1.f / DM) + EPS);
            GAS f32x4* o = (GAS f32x4*)(out + (size_t)m * DM) + lane;
#pragma unroll
            for (int j = 0; j < 4; ++j) { const f32x4 gg = ((const GAS f32x4*)g)[lane + 64 * j]; o[64 * j] = (f32x4){v[j].x * r * gg.x, v[j].y * r * gg.y, v[j].z * r * gg.z, v[j].w * r * gg.w}; }
        }
    }
}

extern "C" void kernel_launch(void* const* d_in, const int* in_sizes, int n_in, void* d_out, int out_size, void* d_ws, size_t ws_size, hipStream_t stream) {
    static int grid = 0;
    if (grid == 0) {
        if (n_in != 25 || ws_size < WS_END) { fprintf(stderr, "kernel_launch: unexpected n_in %d / ws %zu\n", n_in, ws_size); grid = -1; return; }
        int dev = 0, cus = 0;
        if (hipGetDevice(&dev) != hipSuccess || hipDeviceGetAttribute(&cus, hipDeviceAttributeMultiprocessorCount, dev) != hipSuccess) { grid = -1; return; }
        if (hipFuncSetAttribute((const void*)mega_fwd, hipFuncAttributeMaxDynamicSharedMemorySize, LDS_BYTES) != hipSuccess) { fprintf(stderr, "kernel_launch: hipFuncSetAttribute failed\n"); grid = -1; return; }
        int per_cu = 0;
        if (hipOccupancyMaxActiveBlocksPerMultiprocessor(&per_cu, (const void*)mega_fwd, 512, LDS_BYTES) != hipSuccess || per_cu < 1) fprintf(stderr, "kernel_launch: occupancy query says %d\n", per_cu);
        (void)hipGetLastError();
        grid = cus;
    }
    if (grid < 0) return;
    (void)hipMemsetAsync((char*)d_ws + WS_CTL, 0, CTL_BYTES, stream);
    Args a; memset(&a, 0, sizeof a);
    for (int i = 0; i < 25; ++i) a.in[i] = (const float*)d_in[i];
    a.out = (float*)d_out; a.ws = (unsigned char*)d_ws;
    hipLaunchKernelGGL(mega_fwd, dim3(grid), dim3(512), LDS_BYTES, stream, a);
}
```

```cpp
#include <hip/hip_runtime.h>
#include <cstdio>
#include <cstdint>
#include <cstring>

#define GAS __attribute__((address_space(1)))
#define LAS __attribute__((address_space(3)))
typedef unsigned short bf16_t;
typedef short bf16x8 __attribute__((ext_vector_type(8)));
typedef float f32x4 __attribute__((ext_vector_type(4)));
typedef float f32x2 __attribute__((ext_vector_type(2)));
typedef unsigned u32x4 __attribute__((ext_vector_type(4)));
typedef unsigned u32x2 __attribute__((ext_vector_type(2)));
typedef short v4i16_t __attribute__((ext_vector_type(4)));
typedef int i32x4 __attribute__((ext_vector_type(4)));
typedef int i32x8 __attribute__((ext_vector_type(8)));
constexpr int F8_SCALES = 127 | (122 << 8);
typedef float f32x16 __attribute__((ext_vector_type(16)));

constexpr int DM = 1024, NB = 8, SEQ = 4096, NTOK = NB * SEQ;
constexpr int HW = 512, HCOLS = 1536, INC = 3072, ACOLS = 1536;
constexpr int NE = 16, CAP = 512, FF = 2816, NSLOT = NE * NB * CAP;
constexpr float EPS = 1e-6f;
constexpr float LOG2E = 1.4426950408889634f;
constexpr float QSCALE = 0.125f * LOG2E;
constexpr int GOFF = 4352, GLEN = 8704;

constexpr size_t MiB = 1u << 20;
constexpr size_t WS_CTL = 0, CTL_BYTES = 1 * MiB;
constexpr size_t WS_WGU = 2 * MiB;
constexpr size_t WS_WD = 90 * MiB;
constexpr size_t WS_AFF = 134 * MiB;
constexpr size_t WS_TOK = 136 * MiB;
constexpr size_t WS_GSEL = WS_TOK + 256 * 1024;
constexpr size_t WS_INV = 137 * MiB;
constexpr size_t WS_XN = 138 * MiB;
constexpr size_t WS_H2 = WS_XN;
constexpr size_t WS_WIN = 202 * MiB;
constexpr size_t WS_WOUT = 208 * MiB;
constexpr size_t WS_GF = 210 * MiB;
constexpr size_t WS_HP = 228 * MiB;
constexpr size_t WS_QKV = 324 * MiB;
constexpr size_t WS_ACT = 228 * MiB;
constexpr size_t WS_HZ = 420 * MiB;
constexpr size_t WS_MIX = 452 * MiB;
constexpr size_t WS_PARK = 516 * MiB;
constexpr size_t WS_Y = 420 * MiB;
constexpr size_t WS_END = 548 * MiB;
constexpr int CW_BAR = 4096;
constexpr int CW_NSUM = 16384;
constexpr int CW_NPART = 65536;
constexpr int CW_WQ = 32768;

constexpr int REP_XN = 1, REP_P3A = 1, REP_P4A = 1, REP_P4B = 1;
constexpr int REP_P0W = 1, REP_P1 = 1, REP_HY = 1, REP_AT = 1, REP_P3B = 1, REP_P5 = 1, REP_P6 = 1;
constexpr int LDS_BYTES = 160 * 1024;
constexpr int MISC_OFF = LDS_BYTES - 256;
constexpr int HY_ZBYTES = (SEQ + 32) * 16, HY_ZA = 0, HY_ZB = HY_ZBYTES, HY_FB = 2 * HY_ZBYTES;
constexpr int TBL_OFF = 131072;

__device__ __forceinline__ unsigned f2bf(float f) { unsigned u = __builtin_bit_cast(unsigned, f); return (u + 0x7fffu + ((u >> 16) & 1u)) >> 16; }
__device__ __forceinline__ unsigned pk2(float lo, float hi) { return f2bf(lo) | (f2bf(hi) << 16); }
__device__ __forceinline__ float bf2f(unsigned short h) { return __builtin_bit_cast(float, (unsigned)h << 16); }
__device__ __forceinline__ float bflo(unsigned w) { return __builtin_bit_cast(float, w << 16); }
__device__ __forceinline__ float bfhi(unsigned w) { return __builtin_bit_cast(float, w & 0xffff0000u); }
template <int M> __device__ __forceinline__ float sx(float v) { static_assert(M >= 1 && M <= 16, "sx: xor mask 1..16"); return __int_as_float(__builtin_amdgcn_ds_swizzle(__float_as_int(v), (M << 10) | 0x1f)); }
__device__ __forceinline__ float sum32x(float v) { auto r = __builtin_amdgcn_permlane32_swap(__float_as_uint(v), __float_as_uint(v), false, false); return __uint_as_float(r[0]) + __uint_as_float(r[1]); }
__device__ __forceinline__ float max32x(float v) { auto r = __builtin_amdgcn_permlane32_swap(__float_as_uint(v), __float_as_uint(v), false, false); return fmaxf(__uint_as_float(r[0]), __uint_as_float(r[1])); }
__device__ __forceinline__ float lane_read(float v, int src) { return __int_as_float(__builtin_amdgcn_ds_bpermute(src << 2, __float_as_int(v))); }
__device__ __forceinline__ int lane_read_i(int v, int src) { return __builtin_amdgcn_ds_bpermute(src << 2, v); }
__device__ __forceinline__ float wave_sum(float v) { v += sx<1>(v); v += sx<2>(v); v += sx<4>(v); v += sx<8>(v); v += sx<16>(v); return sum32x(v); }
__device__ __forceinline__ float wave_max(float v) { v = fmaxf(v, sx<1>(v)); v = fmaxf(v, sx<2>(v)); v = fmaxf(v, sx<4>(v)); v = fmaxf(v, sx<8>(v)); v = fmaxf(v, sx<16>(v)); return max32x(v); }
#define LDS_WAIT() asm volatile("s_waitcnt lgkmcnt(0)" ::: "memory")
__device__ __forceinline__ int lane_id_v() { int l; asm volatile("v_mbcnt_lo_u32_b32 %0, -1, 0\n\tv_mbcnt_hi_u32_b32 %0, -1, %0" : "=v"(l)); return l; }
#define PHASE_IDS() const int wave = wave_s; int tid_o = wave_s * 64 + lane_id_v(); asm volatile("" : "+v"(tid_o)); const int tid = tid_o, lane = tid & 63, gw = blockIdx.x * 8 + wave; (void)lane; (void)gw

namespace pg8 {
constexpr int BM = 256, BK = 64, HALF = 128, HTB = HALF * BK * 2, STAGE_BYTES = 8 * HTB, NXCD = 8, WGM = 8;
__host__ __device__ __forceinline__ int lds_byte(int r, int c) { const int st = (r >> 4) * 2 + (c >> 5), rr = r & 15, cc = c & 31, ob = rr * 64 + cc * 2; return st * 1024 + (ob ^ (((ob >> 9) & 1) << 5)); }
__host__ __device__ __forceinline__ void stage_rc(int b, int& R, int& C) { const int st = b / 1024, sb = b % 1024, swz = sb ^ (((sb >> 9) & 1) << 5); R = (st >> 1) * 16 + swz / 64; C = (st & 1) * 32 + (swz % 64) / 2; }
__host__ __device__ __forceinline__ int perm32(int rho) { const int n = rho >> 4, i = rho & 15; return 8 * (i >> 2) + 4 * n + (i & 3); }
struct Unit { int pm, pn; };

struct TileOrder {
    int nM, nN, nwg, G, c;
    __device__ void init(int nM_, int nN_, int G_, int c_) { nM = nM_; nN = nN_; nwg = nM * nN; G = G_; c = c_; }
    __device__ bool next(int i, Unit& u) const {
        const long L = (long)i * G + c; if (L >= nwg) return false;
        int wgid = (int)L; { const int q = nwg / NXCD, r = nwg % NXCD, xcd = wgid % NXCD, off = wgid / NXCD; wgid = (xcd < r ? xcd * (q + 1) : r * (q + 1) + (xcd - r) * q) + off; }
        const int nig = WGM * nN, gid = wgid / nig, fm = gid * WGM, gsz = (nM - fm) < WGM ? (nM - fm) : WGM;
        u.pm = fm + ((wgid % nig) % gsz); u.pn = (wgid % nig) / gsz; return true;
    }
};
__device__ __forceinline__ unsigned cvt_pk_bf16(float lo, float hi) { unsigned r; asm volatile("v_cvt_pk_bf16_f32 %0, %1, %2" : "=v"(r) : "v"(lo), "v"(hi)); return r; }

struct EpiBf16 {
    static constexpr bool PERM = true;
    bf16_t* O; int ldc; int scols; float sc;
    __device__ __forceinline__ void operator()(const f32x4 (&acc)[2][2][4][2], const Unit& u, int wr, int wc, int fr, int fq) const {
        const int row0 = u.pm * BM + wr * 64 + fr, col0 = u.pn * BM + wc * 32 + 8 * fq;
        const float s = (u.pn * BM < scols) ? sc : 1.f;
#pragma unroll
        for (int ai = 0; ai < 2; ++ai)
#pragma unroll
            for (int m = 0; m < 4; ++m) { bf16_t* rowp = O + (size_t)(row0 + ai * HALF + m * 16) * ldc + col0;
#pragma unroll
                for (int bj = 0; bj < 2; ++bj) { const f32x4 v0 = acc[ai][bj][m][0] * s, v1 = acc[ai][bj][m][1] * s;
                    u32x4 w; w.x = cvt_pk_bf16(v0[0], v0[1]); w.y = cvt_pk_bf16(v0[2], v0[3]); w.z = cvt_pk_bf16(v1[0], v1[1]); w.w = cvt_pk_bf16(v1[2], v1[3]);
                    *(u32x4*)(rowp + bj * HALF) = w; } }
    }
};
struct EpiFp8 {
    static constexpr bool PERM = true;
    unsigned char* O; int ldc;
    __device__ __forceinline__ void operator()(const f32x4 (&acc)[2][2][4][2], const Unit& u, int wr, int wc, int fr, int fq) const {
        const int row0 = u.pm * BM + wr * 64 + fr, col0 = u.pn * BM + wc * 32 + 8 * fq;
#pragma unroll
        for (int ai = 0; ai < 2; ++ai)
#pragma unroll
            for (int m = 0; m < 4; ++m) { unsigned char* rowp = O + (size_t)(row0 + ai * HALF + m * 16) * ldc + col0;
#pragma unroll
                for (int bj = 0; bj < 2; ++bj) { const f32x4 v0 = acc[ai][bj][m][0], v1 = acc[ai][bj][m][1];
                    int t0 = __builtin_amdgcn_cvt_pk_fp8_f32(v0[0], v0[1], 0, false); t0 = __builtin_amdgcn_cvt_pk_fp8_f32(v0[2], v0[3], t0, true);
                    int t1 = __builtin_amdgcn_cvt_pk_fp8_f32(v1[0], v1[1], 0, false); t1 = __builtin_amdgcn_cvt_pk_fp8_f32(v1[2], v1[3], t1, true);
                    *(u32x2*)(rowp + bj * HALF) = (u32x2){(unsigned)t0, (unsigned)t1}; } }
    }
};
struct EpiResF32 {
    static constexpr bool PERM = false;
    const float* R; float* C; int ldc;
    __device__ __forceinline__ void operator()(const f32x4 (&acc)[2][2][4][2], const Unit& u, int wr, int wc, int fr, int fq) const {
        const int row0 = u.pm * BM + wr * 64 + fr, col0 = u.pn * BM + wc * 32 + 4 * fq;
#pragma unroll
        for (int ai = 0; ai < 2; ++ai)
#pragma unroll
            for (int m = 0; m < 4; ++m) { const size_t off = (size_t)(row0 + ai * HALF + m * 16) * ldc + col0;
#pragma unroll
                for (int bj = 0; bj < 2; ++bj)
#pragma unroll
                    for (int n = 0; n < 2; ++n) { const f32x4 r = *(const f32x4*)(R + off + bj * HALF + n * 16); *(f32x4*)(C + off + bj * HALF + n * 16) = r + acc[ai][bj][m][n]; } }
    }
};
struct EpiSwiGLU {
    static constexpr bool PERM = true;
    unsigned char* O; int ldc;
    __device__ __forceinline__ void operator()(const f32x4 (&acc)[2][2][4][2], const Unit& u, int wr, int wc, int fr, int fq) const {
        const int row0 = u.pm * BM + wr * 64 + fr, col0 = u.pn * HALF + wc * 32 + 8 * fq;
#pragma unroll
        for (int ai = 0; ai < 2; ++ai)
#pragma unroll
            for (int m = 0; m < 4; ++m) { unsigned char* rowp = O + (size_t)(row0 + ai * HALF + m * 16) * ldc + col0;
                float o[8];
#pragma unroll
                for (int n = 0; n < 2; ++n)
#pragma unroll
                    for (int j = 0; j < 4; ++j) { const float g = acc[ai][0][m][n][j], up = acc[ai][1][m][n][j];
                        o[n * 4 + j] = g * __builtin_amdgcn_rcpf(1.f + __builtin_amdgcn_exp2f(-g * LOG2E)) * up; }
                u32x2 w; int t0 = __builtin_amdgcn_cvt_pk_fp8_f32(o[0], o[1], 0, false); t0 = __builtin_amdgcn_cvt_pk_fp8_f32(o[2], o[3], t0, true);
                int t1 = __builtin_amdgcn_cvt_pk_fp8_f32(o[4], o[5], 0, false); t1 = __builtin_amdgcn_cvt_pk_fp8_f32(o[6], o[7], t1, true);
                w.x = (unsigned)t0; w.y = (unsigned)t1; *(u32x2*)rowp = w; }
    }
};

struct GeoPlain {
    static constexpr bool GATHER = false;
    const bf16_t* A; const bf16_t* Bt; int KB; TileOrder ord;
    __device__ __forceinline__ bool next(int i, Unit& u) const { return ord.next(i, u); }
    __device__ __forceinline__ const char* a_ptr(const Unit& u) const { return (const char*)A + (size_t)u.pm * BM * KB; }
    __device__ __forceinline__ const char* b_ptr(const Unit& u) const { return (const char*)Bt + (size_t)u.pn * BM * KB; }
    __device__ __forceinline__ size_t hstepA() const { return (size_t)HALF * KB; }
    __device__ __forceinline__ size_t hstepB() const { return (size_t)HALF * KB; }
    __device__ __forceinline__ size_t istepA() const { return (size_t)64 * KB; }
    __device__ __forceinline__ size_t istepB() const { return (size_t)64 * KB; }
    __device__ __forceinline__ unsigned a_voff(int R, int C) const { return (unsigned)(R * KB + C * 2); }
    __device__ __forceinline__ unsigned b_voff(int R, int C) const { return (unsigned)(R * KB + C * 2); }
    __device__ __forceinline__ void fill_table(LAS unsigned*, const Unit&, int) const {}
};
struct GeoTokPerm {
    static constexpr bool GATHER = false;
    const bf16_t* A; const bf16_t* X; int KB; TileOrder ord;
    __device__ __forceinline__ bool next(int i, Unit& u) const { return ord.next(i, u); }
    __device__ __forceinline__ const char* a_ptr(const Unit& u) const { return (const char*)A + (size_t)u.pm * BM * KB; }
    __device__ __forceinline__ const char* b_ptr(const Unit& u) const { return (const char*)X + (size_t)u.pn * 32 * KB; }
    __device__ __forceinline__ size_t hstepA() const { return (size_t)HALF * KB; }
    __device__ __forceinline__ size_t hstepB() const { return (size_t)16 * KB; }
    __device__ __forceinline__ size_t istepA() const { return (size_t)64 * KB; }
    __device__ __forceinline__ size_t istepB() const { return (size_t)8 * KB; }
    __device__ __forceinline__ unsigned a_voff(int R, int C) const { return (unsigned)(R * KB + C * 2); }
    __device__ __forceinline__ unsigned b_voff(int R, int C) const { return (unsigned)(((R & 7) * SEQ + (R >> 3)) * KB + C * 2); }
    __device__ __forceinline__ void fill_table(LAS unsigned*, const Unit&, int) const {}
};
template <bool G> struct GeoExpert {
    static constexpr bool GATHER = G;
    const void* A; const void* Bt; int KB; size_t bexp;    const int* tok; TileOrder ord;
    __device__ __forceinline__ bool next(int i, Unit& u) const { return ord.next(i, u); }
    __device__ __forceinline__ const char* a_ptr(const Unit& u) const { return G ? (const char*)A : (const char*)A + (size_t)u.pm * BM * KB; }
    __device__ __forceinline__ const char* b_ptr(const Unit& u) const { return (const char*)Bt + (size_t)(u.pm >> 4) * bexp + (size_t)u.pn * BM * KB; }
    __device__ __forceinline__ size_t hstepA() const { return (size_t)HALF * KB; }
    __device__ __forceinline__ size_t hstepB() const { return (size_t)HALF * KB; }
    __device__ __forceinline__ size_t istepA() const { return (size_t)64 * KB; }
    __device__ __forceinline__ size_t istepB() const { return (size_t)64 * KB; }
    __device__ __forceinline__ unsigned a_voff(int R, int C) const { return (unsigned)(R * KB + C * 2); }
    __device__ __forceinline__ unsigned b_voff(int R, int C) const { return (unsigned)(R * KB + C * 2); }
    __device__ __forceinline__ void fill_table(LAS unsigned* tb, const Unit& u, int tid) const { if (G) { int t_ = tid; asm volatile("" : "+v"(t_));
#pragma unroll
        for (int i = 0; i < 2; ++i) { int R, C; stage_rc(t_ * 16 + i * 8192, R, C);
#pragma unroll
            for (int h = 0; h < 2; ++h) tb[h * 1024 + i * 512 + tid] = (unsigned)tok[u.pm * 256 + h * 128 + R] * (unsigned)KB + (unsigned)C * 2u; } } }
};

template <bool F8, class Epi, class Geo>
__device__ __forceinline__ void gemm_phase(LAS unsigned char* lds, LAS unsigned* tbl, const Geo& S, const Epi& E, int wave_s) {
    int tid_ = wave_s * 64 + lane_id_v(); asm volatile("" : "+v"(tid_));
    const int tid = tid_, wid = wave_s, lane = tid & 63, wr = wid >> 2, wc = wid & 3, fr = lane & 15, fq = lane >> 4;
    const int nt = S.KB / (BK * 2);
    unsigned voffA, voffB;
    { int R, C; stage_rc(tid * 16, R, C); const int Rb = Epi::PERM ? ((R & ~31) + perm32(R & 31)) : R; voffA = S.a_voff(R, C); voffB = S.b_voff(Rb, C); }
    const size_t istepA = S.istepA(), istepB = S.istepB();
    const size_t kstep = (size_t)(BK * 2);
    const size_t hstepA = S.hstepA(), hstepB = S.hstepB();
    const unsigned ldsw = (unsigned)wid * 1024u;
    const int aoff = lds_byte(wr * 64 + fr, fq * 8), boff = lds_byte(wc * 32 + fr, fq * 8);
    const LAS unsigned char* ldsB = lds + 4 * HTB + boff;
#define PG8_SA(b, h) (((b) * 2 + (h)) * HTB)
#define PG8_SB(b, h) ((4 + (b) * 2 + (h)) * HTB)
#define PG8_GLDS(bufoff, gptr, i_) __builtin_amdgcn_global_load_lds((const unsigned*)(gptr), (LAS unsigned*)(lds + (bufoff) + ldsw + (i_) * 8192), 16, 0, 0)
#define PG8_STAGE_B(bufoff, gbase) do { PG8_GLDS(bufoff, (const char*)(gbase) + voffB, 0); PG8_GLDS(bufoff, (const char*)(gbase) + istepB + voffB, 1); } while (0)
#define PG8_STAGE_A(bufoff, gbase, h, nx) do { if constexpr (Geo::GATHER) { const LAS unsigned* _tb = tbl + (((ui + ((nx) ? 1 : 0)) & 1) * 2048) + (h) * 1024 + tid; \
        const unsigned _v0 = _tb[0], _v1 = _tb[512]; PG8_GLDS(bufoff, (const char*)(gbase) + _v0, 0); PG8_GLDS(bufoff, (const char*)(gbase) + _v1, 1); } \
        else { PG8_GLDS(bufoff, (const char*)(gbase) + (h) * hstepA + voffA, 0); PG8_GLDS(bufoff, (const char*)(gbase) + (h) * hstepA + istepA + voffA, 1); } } while (0)
#define PG8_LD16(off) (*(const LAS i32x4*)(lds + (off)))
#define PG8_LDA(dst, b, h) do { _Pragma("unroll") for (int m = 0; m < 4; ++m) dst[m] = __builtin_shufflevector(PG8_LD16(PG8_SA(b, h) + aoff + m * 2048), PG8_LD16(PG8_SA(b, h) + aoff + m * 2048 + 1024), 0, 1, 2, 3, 4, 5, 6, 7); } while (0)
#define PG8_LDB(dst, b, h) do { _Pragma("unroll") for (int n = 0; n < 2; ++n) dst[n] = __builtin_shufflevector(*(const LAS i32x4*)(ldsB + ((b) * 2 + (h)) * HTB + n * 2048), *(const LAS i32x4*)(ldsB + ((b) * 2 + (h)) * HTB + n * 2048 + 1024), 0, 1, 2, 3, 4, 5, 6, 7); } while (0)
#define PG8_LO(v) __builtin_bit_cast(bf16x8, __builtin_shufflevector(v, v, 0, 1, 2, 3))
#define PG8_HI(v) __builtin_bit_cast(bf16x8, __builtin_shufflevector(v, v, 4, 5, 6, 7))
#define PG8_MMA(ai, bj, At, Bt) do { __builtin_amdgcn_s_setprio(1); _Pragma("unroll") for (int m = 0; m < 4; ++m) _Pragma("unroll") for (int n = 0; n < 2; ++n) { \
        if constexpr (F8) { acc[ai][bj][m][n] = __builtin_amdgcn_mfma_scale_f32_16x16x128_f8f6f4(Bt[n], At[m], acc[ai][bj][m][n], 0, 0, 1, F8_SCALES, 0, F8_SCALES); } \
        else { acc[ai][bj][m][n] = __builtin_amdgcn_mfma_f32_16x16x32_bf16(PG8_LO(Bt[n]), PG8_LO(At[m]), acc[ai][bj][m][n], 0, 0, 0); \
               acc[ai][bj][m][n] = __builtin_amdgcn_mfma_f32_16x16x32_bf16(PG8_HI(Bt[n]), PG8_HI(At[m]), acc[ai][bj][m][n], 0, 0, 0); } } \
        __builtin_amdgcn_s_setprio(0); } while (0)
#define PG8_WAIT_V(n) asm volatile("s_waitcnt vmcnt(" #n ")" ::: "memory")
#define PG8_WAIT_L(n) asm volatile("s_waitcnt lgkmcnt(" #n ")" ::: "memory")
#define PG8_BAR __builtin_amdgcn_s_barrier()
#define PG8_SCHED __builtin_amdgcn_sched_barrier(0)
    Unit cur, nxt; int ui = 0;
    if (!S.next(0, cur)) return;
    f32x4 acc[2][2][4][2];
#pragma unroll
    for (int a = 0; a < 2; ++a)
#pragma unroll
        for (int b = 0; b < 2; ++b)
#pragma unroll
            for (int m = 0; m < 4; ++m)
#pragma unroll
                for (int n = 0; n < 2; ++n) acc[a][b][m][n] = (f32x4){0.f, 0.f, 0.f, 0.f};
    i32x8 At[4], B0[2], B1[2];
    const char* cA = S.a_ptr(cur); const char* cB = S.b_ptr(cur);
    if constexpr (Geo::GATHER) {
        S.fill_table(tbl, cur, tid);
        Unit u1; if (S.next(1, u1)) S.fill_table(tbl + 2048, u1, tid);
        asm volatile("s_waitcnt vmcnt(0) lgkmcnt(0)" ::: "memory"); PG8_BAR; asm volatile("" ::: "memory");
    }
    PG8_STAGE_B(PG8_SB(0, 0), cB); PG8_STAGE_B(PG8_SB(0, 1), cB + hstepB); PG8_STAGE_A(PG8_SA(0, 0), cA, 0, false); PG8_STAGE_A(PG8_SA(0, 1), cA, 1, false);
    if (wr == 1) PG8_BAR;
    PG8_WAIT_V(2); PG8_BAR;
    PG8_STAGE_B(PG8_SB(1, 0), cB + kstep); PG8_STAGE_A(PG8_SA(1, 0), cA + kstep, 0, false); PG8_STAGE_B(PG8_SB(1, 1), cB + hstepB + kstep);
    PG8_WAIT_V(6); PG8_BAR;
    for (;;) {
        const bool has_next = S.next(ui + 1, nxt);
        const char* nA = has_next ? S.a_ptr(nxt) : cA; const char* nB = has_next ? S.b_ptr(nxt) : cB;
#pragma clang loop unroll(disable)
        for (int t = 0; t < nt; t += 2) {
            const bool last = (t == nt - 2);
            const bool lastn = last && has_next;
            const char* a1 = cA + (size_t)(t + 1) * kstep;
            const char* a2 = last ? nA : cA + (size_t)(t + 2) * kstep; const char* b2 = last ? nB : cB + (size_t)(t + 2) * kstep;
            const char* a3 = a2 + kstep; const char* b3 = b2 + kstep;
            if constexpr (Geo::GATHER) { if (t == 2 && ui > 0) { Unit u2; if (S.next(ui + 1, u2)) S.fill_table(tbl + (((ui + 1) & 1) * 2048), u2, tid); } }
            PG8_LDB(B0, 0, 0); PG8_LDB(B1, 0, 1); PG8_SCHED; PG8_LDA(At, 0, 0); PG8_STAGE_A(PG8_SA(1, 1), a1, 1, false);
            PG8_WAIT_V(8); PG8_WAIT_L(0); PG8_BAR; PG8_MMA(0, 0, At, B0); PG8_MMA(0, 1, At, B1); PG8_BAR; PG8_SCHED;
            PG8_LDA(At, 0, 1); PG8_STAGE_B(PG8_SB(0, 0), b2); PG8_STAGE_B(PG8_SB(0, 1), b2 + hstepB); PG8_STAGE_A(PG8_SA(0, 0), a2, 0, lastn);
            PG8_WAIT_V(8); PG8_WAIT_L(0); PG8_BAR; PG8_MMA(1, 0, At, B0); PG8_MMA(1, 1, At, B1); PG8_BAR; PG8_SCHED;
            PG8_LDB(B0, 1, 0); PG8_LDB(B1, 1, 1); PG8_SCHED; PG8_LDA(At, 1, 0); PG8_STAGE_A(PG8_SA(0, 1), a2, 1, lastn);
            PG8_WAIT_V(8); PG8_WAIT_L(0); PG8_BAR; PG8_MMA(0, 0, At, B0); PG8_MMA(0, 1, At, B1); PG8_BAR; PG8_SCHED;
            PG8_LDA(At, 1, 1); PG8_STAGE_B(PG8_SB(1, 0), b3); PG8_STAGE_B(PG8_SB(1, 1), b3 + hstepB); PG8_STAGE_A(PG8_SA(1, 0), a3, 0, lastn);
            PG8_WAIT_V(8); PG8_WAIT_L(0); PG8_BAR; PG8_MMA(1, 0, At, B0); PG8_MMA(1, 1, At, B1); PG8_BAR; PG8_SCHED;
        }
        if (wr == 0) PG8_BAR;
        { const int l_e = lane_id_v();
          E(acc, cur, wr, wc, l_e & 15, l_e >> 4); }
        if (!has_next) break;
#pragma unroll
        for (int a = 0; a < 2; ++a)
#pragma unroll
            for (int b = 0; b < 2; ++b)
#pragma unroll
                for (int m = 0; m < 4; ++m)
#pragma unroll
                    for (int n = 0; n < 2; ++n) acc[a][b][m][n] = (f32x4){0.f, 0.f, 0.f, 0.f};
        cur = nxt; cA = nA; cB = nB; ++ui;
        if (wr == 1) PG8_BAR;
    }
    PG8_WAIT_V(0);
    PG8_BAR;
#undef PG8_SA
#undef PG8_SB
#undef PG8_GLDS
#undef PG8_STAGE_B
#undef PG8_STAGE_A
#undef PG8_LDA
#undef PG8_LDB
#undef PG8_LD16
#undef PG8_LO
#undef PG8_HI
#undef PG8_MMA
#undef PG8_WAIT_V
#undef PG8_WAIT_L
#undef PG8_BAR
#undef PG8_SCHED
}
}

namespace att {
constexpr int KVBLK = 64, LDQKV = ACOLS;
constexpr int SHM_V = KVBLK * 128 * 2, SHM_K = KVBLK * 64 * 2, OFF_V = 0, OFF_K = 2 * SHM_V, OFF_WS = OFF_K + 2 * SHM_K, LDS_TOTAL = OFF_WS + 8 * 64 * 4;
constexpr float THR = 8.f;
#define KSWZ64(row, colB) ((row) * 128 + ((colB) ^ ((((row) >> 1) & 7) << 4)))
#define SBAR() __builtin_amdgcn_sched_barrier(0)
__device__ __forceinline__ int crow(int r, int hi) { return (r & 3) + 8 * (r >> 2) + 4 * hi; }
__device__ __forceinline__ unsigned cvtpk(float lo, float hi) { unsigned r; asm volatile("v_cvt_pk_bf16_f32 %0, %1, %2" : "=v"(r) : "v"(lo), "v"(hi)); return r; }
__device__ __forceinline__ int v_st(int k, int c) { const int kk = k;     return ((kk >> 3) * 4 + (c >> 5)) * 512 + ((kk & 7) * 32 + (c & 31)) * 2; }
__device__ __forceinline__ int v_rd_base(int lane) { return ((lane & 3) << 3) | (((lane >> 2) & 3) << 6) | (((lane >> 4) & 1) << 5) | (((lane >> 5) & 1) << 8); }
constexpr int v_rd_off(int d0, int ks, int half) { return d0 * 512 + ks * 4096 + half * 2048; }
__device__ __forceinline__ float fadd_s(float a, float b) { float r; asm("v_add_f32 %0, %1, %2" : "=v"(r) : "v"(a), "v"(b)); return r; }
template <int OFF> __device__ __forceinline__ v4i16_t tr_read(int vb) { v4i16_t r; asm volatile("ds_read_b64_tr_b16 %0, %1 offset:%2" : "=&v"(r) : "v"(vb), "i"(OFF) : "memory"); return r; }
template <int D0> __device__ __forceinline__ void pv_one(f32x16& od, int vb, bf16x8 pa0, bf16x8 pa1, bf16x8 pa2, bf16x8 pa3) {
    const v4i16_t l0 = tr_read<v_rd_off(D0, 0, 0)>(vb), h0 = tr_read<v_rd_off(D0, 0, 1)>(vb), l1 = tr_read<v_rd_off(D0, 1, 0)>(vb), h1 = tr_read<v_rd_off(D0, 1, 1)>(vb);
    const v4i16_t l2 = tr_read<v_rd_off(D0, 2, 0)>(vb), h2 = tr_read<v_rd_off(D0, 2, 1)>(vb), l3 = tr_read<v_rd_off(D0, 3, 0)>(vb), h3 = tr_read<v_rd_off(D0, 3, 1)>(vb);
    asm volatile("s_waitcnt lgkmcnt(0)" ::: "memory"); SBAR();
#define PK(L, H) (bf16x8){L[0], L[1], L[2], L[3], H[0], H[1], H[2], H[3]}
    od = __builtin_amdgcn_mfma_f32_32x32x16_bf16(pa0, PK(l0, h0), od, 0, 0, 0);
    od = __builtin_amdgcn_mfma_f32_32x32x16_bf16(pa1, PK(l1, h1), od, 0, 0, 0);
    od = __builtin_amdgcn_mfma_f32_32x32x16_bf16(pa2, PK(l2, h2), od, 0, 0, 0);
    od = __builtin_amdgcn_mfma_f32_32x32x16_bf16(pa3, PK(l3, h3), od, 0, 0, 0);
#undef PK
}
__device__ __forceinline__ void pv_d0(f32x16* o, int vb, bf16x8 pa0, bf16x8 pa1, bf16x8 pa2, bf16x8 pa3) {
    pv_one<0>(o[0], vb, pa0, pa1, pa2, pa3); pv_one<1>(o[1], vb, pa0, pa1, pa2, pa3); pv_one<2>(o[2], vb, pa0, pa1, pa2, pa3); pv_one<3>(o[3], vb, pa0, pa1, pa2, pa3);
}
__device__ __forceinline__ void qk_mfma(f32x16& p0, f32x16& p1, const char* Ks, const bf16x8* qr, const f32x16& negm, int kb) {
#pragma unroll
    for (int d0 = 0; d0 < 4; ++d0) { int x_ = d0 * 32; asm volatile("" : "+s"(x_));
        const bf16x8 b0 = *reinterpret_cast<const bf16x8*>(Ks + (kb ^ x_));
        const bf16x8 b1 = *reinterpret_cast<const bf16x8*>(Ks + (kb ^ x_) + 32 * 128);
        if (d0 == 0) { p0 = __builtin_amdgcn_mfma_f32_32x32x16_bf16(b0, qr[0], negm, 0, 0, 0); p1 = __builtin_amdgcn_mfma_f32_32x32x16_bf16(b1, qr[0], negm, 0, 0, 0); }
        else { p0 = __builtin_amdgcn_mfma_f32_32x32x16_bf16(b0, qr[d0], p0, 0, 0, 0); p1 = __builtin_amdgcn_mfma_f32_32x32x16_bf16(b1, qr[d0], p1, 0, 0, 0); } }
}
__device__ __forceinline__ void rowmaxSM(f32x16& p0, f32x16& p1, f32x16& cl, float& alpha, bool diag, float a0, float a1, int dd, float slope2) {
    asm volatile("" : "+v"(a0), "+v"(a1), "+v"(dd), "+v"(p0), "+v"(p1));
    if (diag) {
        const int h8 = (lane_id_v() >> 5) * 8, y = dd - 32, w0 = dd - h8, w1 = y - h8;
#pragma unroll
        for (int r = 0; r < 16; ++r) { const int c2 = 2 * ((r & 3) + 8 * (r >> 2)); p0[r] = fmaf(-slope2, (float)max(dd, c2 - w0), p0[r]); p1[r] = fmaf(-slope2, (float)max(y, c2 - w1), p1[r]); }
    } else {
#pragma unroll
        for (int r = 0; r < 16; ++r) { p0[r] = fadd_s(p0[r], a0); p1[r] = fadd_s(p1[r], a1); }
    }
    float pmax = p0[0];
#pragma unroll
    for (int r = 1; r < 16; ++r) pmax = fmaxf(pmax, p0[r]);
#pragma unroll
    for (int r = 0; r < 16; ++r) pmax = fmaxf(pmax, p1[r]);
    { auto rr = __builtin_amdgcn_permlane32_swap(__float_as_uint(pmax), __float_as_uint(pmax), false, false); pmax = fmaxf(__uint_as_float(rr[0]), __uint_as_float(rr[1])); }
    if (__builtin_expect(!__any(pmax > THR), 1)) { alpha = 1.f; }
    else { const float dl = fmaxf(pmax, 0.f); alpha = __builtin_amdgcn_exp2f(-dl);
#pragma unroll
        for (int r = 0; r < 16; ++r) { p0[r] -= dl; p1[r] -= dl; cl[r] -= dl; } }
}
__device__ __forceinline__ float rowsumSM(f32x16& p0, f32x16& p1) {
    asm volatile("s_nop 0" : "+v"(p0), "+v"(p1));
    float s0 = fadd_s(p0[0], p1[0]), s1 = fadd_s(p0[1], p1[1]), s2 = fadd_s(p0[2], p1[2]), s3 = fadd_s(p0[3], p1[3]);
#pragma unroll
    for (int r = 4; r < 16; r += 4) { s0 = fadd_s(s0, p0[r]); s1 = fadd_s(s1, p0[r + 1]); s2 = fadd_s(s2, p0[r + 2]); s3 = fadd_s(s3, p0[r + 3]);
                                      s0 = fadd_s(s0, p1[r]); s1 = fadd_s(s1, p1[r + 1]); s2 = fadd_s(s2, p1[r + 2]); s3 = fadd_s(s3, p1[r + 3]); }
    float ps = fadd_s(fadd_s(s0, s1), fadd_s(s2, s3));
    { auto rr = __builtin_amdgcn_permlane32_swap(__float_as_uint(ps), __float_as_uint(ps), false, false); ps = __uint_as_float(rr[0]) + __uint_as_float(rr[1]); }
    return ps;
}
__device__ __forceinline__ float specSM(f32x16& p0, f32x16& p1, f32x16& cl, float& alpha, float a0, float a1) {
    asm volatile("" : "+v"(a0), "+v"(a1), "+v"(p0), "+v"(p1));
#pragma unroll
    for (int r = 0; r < 16; ++r) { p0[r] = __builtin_amdgcn_exp2f(fadd_s(p0[r], a0)); p1[r] = __builtin_amdgcn_exp2f(fadd_s(p1[r], a1)); }
    float ps = rowsumSM(p0, p1);
    if (__builtin_expect(!__any(ps > 256.f), 1)) { alpha = 1.f; }
    else { float em = p0[0];
#pragma unroll
        for (int r = 1; r < 16; ++r) em = fmaxf(em, p0[r]);
#pragma unroll
        for (int r = 0; r < 16; ++r) em = fmaxf(em, p1[r]);
        { auto rr = __builtin_amdgcn_permlane32_swap(__float_as_uint(em), __float_as_uint(em), false, false); em = fmaxf(__uint_as_float(rr[0]), __uint_as_float(rr[1])); }
        const float dl = fmaxf(__builtin_amdgcn_logf(em), 0.f); alpha = __builtin_amdgcn_exp2f(-dl);
#pragma unroll
        for (int r = 0; r < 16; ++r) { p0[r] *= alpha; p1[r] *= alpha; cl[r] -= dl; }
        ps *= alpha; }
    return ps;
}
__device__ __forceinline__ void packSM(f32x16& p0, f32x16& p1, bf16x8& pa0, bf16x8& pa1, bf16x8& pa2, bf16x8& pa3) {
#define PK4(P, BASE, OUT) do { const u32x4 w = {cvtpk(P[BASE + 0], P[BASE + 1]), cvtpk(P[BASE + 2], P[BASE + 3]), cvtpk(P[BASE + 4], P[BASE + 5]), cvtpk(P[BASE + 6], P[BASE + 7])}; \
        OUT = __builtin_bit_cast(bf16x8, w); } while (0)
    PK4(p0, 0, pa0); PK4(p0, 8, pa1); PK4(p1, 0, pa2); PK4(p1, 8, pa3);
#undef PK4
}
__device__ __forceinline__ void pass(f32x16 (&o)[4], const bf16_t* Qw, const bf16_t* Kh, const bf16_t* Vh, int qpos, int qb, float slope2, char* lds, int tid, int nL, int NT, bool spec) {
    const int wid = tid >> 6, lane = tid & 63, r32 = lane & 31, hi = lane >> 5;
    const int g = __builtin_amdgcn_readfirstlane(wid >> 2);
    const GAS bf16_t* Kg = (const GAS bf16_t*)(((uintptr_t)(unsigned)__builtin_amdgcn_readfirstlane((int)((uintptr_t)Kh >> 32)) << 32) | (unsigned)__builtin_amdgcn_readfirstlane((int)(uintptr_t)Kh));
    const GAS bf16_t* Vg = (const GAS bf16_t*)(((uintptr_t)(unsigned)__builtin_amdgcn_readfirstlane((int)((uintptr_t)Vh >> 32)) << 32) | (unsigned)__builtin_amdgcn_readfirstlane((int)(uintptr_t)Vh));
    char* V_lds = lds + OFF_V; char* K_lds = lds + OFF_K;
    float* ws = (float*)(lds + OFF_WS) + wid * 64; float* li_l = ws; float* al_l = ws + 32;
    float l_reg = 0.f; bf16x8 qr[4];
#pragma unroll
    for (int d = 0; d < 4; ++d)
#pragma unroll
        for (int r = 0; r < 16; ++r) o[d][r] = 0.f;
    f32x16 cl;
    { const float h4s = slope2 * (float)((lane_id_v() >> 5) * 4);
#pragma unroll
      for (int r = 0; r < 16; ++r) cl[r] = fmaf(slope2, (float)((r & 3) + 8 * (r >> 2)), h4s); }
#pragma unroll
    for (int d0 = 0; d0 < 4; ++d0) qr[d0] = *reinterpret_cast<const bf16x8*>(Qw + d0 * 16);
    const int kr = tid >> 3, kc = (tid & 7) * 8, kst = KSWZ64(kr, kc * 2);
    const int sr = tid >> 4, sc = (tid & 15) * 8, vst0 = v_st(sr, sc), vst1 = v_st(32 + sr, sc);
    const int vb0 = (int)(uintptr_t)V_lds + v_rd_base(lane);
    const int kb = KSWZ64(r32, hi * 16);
    const unsigned voff0 = (unsigned)(sr * LDQKV + sc), koff0 = (unsigned)(kr * LDQKV + kc);
    const unsigned voffU = (unsigned)((63 - sr) * LDQKV + sc), koffU = (unsigned)((63 - kr) * LDQKV + kc);
    struct { bf16x8 vs0, vs1, ks; } st_[2];
    const int nd = 4 * qb;
#define KTF(i) ((i) < 4 ? nd + (i) : ((i) < 4 + nL ? nd + 3 - (i) : nd + (i) - nL))
    int ktv; { const int i_ = min(lane, NT - 1); ktv = KTF(i_); }
#define KT(i) __builtin_amdgcn_readlane(ktv, (i))
#define KTC(i) KT(min((i), NT - 1))
#define SLOAD(i, kt, vt) do { const int kt_ = (kt), vt_ = (vt); const bool ku_ = kt_ > nd + 3, vu_ = vt_ > nd + 3; \
        const unsigned k0_ = (unsigned)(kt_ * KVBLK * LDQKV) + (ku_ ? koffU : koff0), v0_ = (unsigned)(vt_ * KVBLK * LDQKV) + (vu_ ? voffU : voff0), v1_ = vu_ ? v0_ - 32u * LDQKV : v0_ + 32u * LDQKV; \
        st_[i].vs0 = *(const GAS bf16x8*)(Vg + v0_); st_[i].vs1 = *(const GAS bf16x8*)(Vg + v1_); st_[i].ks = *(const GAS bf16x8*)(Kg + k0_); } while (0)
#define SWRITE(i, kbo, vbo) do { *(bf16x8*)(V_lds + (vbo) + vst0) = st_[i].vs0; *(bf16x8*)(V_lds + (vbo) + vst1) = st_[i].vs1; *(bf16x8*)(K_lds + (kbo) + kst) = st_[i].ks; } while (0)
#define SWAIT() asm volatile("s_waitcnt vmcnt(3)" ::: "memory")
#define RESC(a) do { if (__any((a) < 1.f)) { if (hi == 0) al_l[r32] = (a); asm volatile("s_waitcnt lgkmcnt(0)" ::: "memory"); \
        _Pragma("unroll") for (int d = 0; d < 4; ++d) _Pragma("unroll") for (int r = 0; r < 16; ++r) o[d][r] *= al_l[crow(r, hi)]; } } while (0)
#define BAR() do { SBAR(); __syncthreads(); SBAR(); } while (0)
#define SSLOT(PAR, t) do { const int u_ = (t) + g; SWAIT(); SWRITE(PAR, ((PAR + 1 + g) & 1) * SHM_K, ((PAR + g) & 1) * SHM_V); SLOAD(PAR, KTC(u_ + 3), KTC(u_ + 2)); SBAR(); \
        const int tl_ = KT(t); const int dd_ = qpos - tl_ * KVBLK; const float a0_ = slope2 * (float)(tl_ > nd ? dd_ - 63 : -dd_); \
        float al_, ps_; \
        if ((t) < 4 || !spec) { rowmaxSM(p0, p1, cl, al_, (t) < 4, a0_, a0_ + 32.f * slope2, dd_, slope2); \
            _Pragma("unroll") for (int r = 0; r < 16; ++r) { p0[r] = __builtin_amdgcn_exp2f(p0[r]); p1[r] = __builtin_amdgcn_exp2f(p1[r]); } ps_ = rowsumSM(p0, p1); } \
        else ps_ = specSM(p0, p1, cl, al_, a0_, a0_ + 32.f * slope2); \
        RESC(al_); l_reg = l_reg * al_ + ps_; packSM(p0, p1, pa0, pa1, pa2, pa3); } while (0)
    f32x16 p0, p1; bf16x8 pa0, pa1, pa2, pa3;
    {
        const bf16x8 k0r = *(const GAS bf16x8*)(Kg + ((unsigned)(nd * KVBLK * LDQKV) + koff0));
        SLOAD(0, KTC(g + 1), KTC(g)); SLOAD(1, KTC(2 - g), KTC(1 - g));
        asm volatile("s_waitcnt vmcnt(6)" ::: "memory");
        *(bf16x8*)(K_lds + kst) = k0r;
        __syncthreads();
    }
    if (g) { asm volatile("s_waitcnt vmcnt(0)" ::: "memory"); SWRITE(1, SHM_K, 0); SLOAD(1, KTC(3), KTC(2)); BAR(); }
    qk_mfma(p0, p1, K_lds, qr, cl, kb);
    for (int t = 0; t < NT; t += 2) {
        BAR(); SSLOT(0, t); BAR();
        qk_mfma(p0, p1, K_lds + SHM_K, qr, cl, kb); SBAR(); pv_d0(o, vb0, pa0, pa1, pa2, pa3);
        BAR(); SSLOT(1, t + 1); BAR();
        if (t + 2 < NT) { qk_mfma(p0, p1, K_lds, qr, cl, kb); SBAR(); }
        pv_d0(o, vb0 + SHM_V, pa0, pa1, pa2, pa3);
    }
    if (!g) BAR();
    if (hi == 0) li_l[r32] = l_reg; asm volatile("s_waitcnt lgkmcnt(0)" ::: "memory");
#pragma unroll
    for (int r = 0; r < 16; ++r) { const float rl = __builtin_amdgcn_rcpf(li_l[crow(r, hi)]);
#pragma unroll
        for (int d = 0; d < 4; ++d) o[d][r] *= rl; }
    __syncthreads();
#undef KT
#undef KTF
#undef KTC
#undef SLOAD
#undef SWRITE
#undef SWAIT
#undef RESC
#undef BAR
#undef SSLOT
}
#undef SBAR
}

typedef GAS unsigned gu32;
#define XB_TMO      128
#define XB_XCNT(j)  (256  + 64 * (j))
#define XB_XSUB(j)  (1280 + 64 * (j))
#define XB_XGEN(j)  (2304 + 64 * (j))
#define XB_TOP      3328
#define XB_TOPGEN   3392
#define XCD_BAR_WORDS 3456
#define XB_SPIN_CAP (1u << 23)
__device__ __forceinline__ unsigned xb_ld(unsigned* p)              { return __hip_atomic_load(p, __ATOMIC_RELAXED, __HIP_MEMORY_SCOPE_AGENT); }
__device__ __forceinline__ unsigned xb_add(unsigned* p, unsigned v) { return __hip_atomic_fetch_add(p, v, __ATOMIC_RELAXED, __HIP_MEMORY_SCOPE_AGENT); }
__device__ __forceinline__ unsigned xb_xcc_id() { return (unsigned)__builtin_amdgcn_s_getreg((3 << 11) | 20) & 0xFu; }
#define XB_SPIN(cond, bar) do { unsigned _sp = 0; while (cond) { __builtin_amdgcn_s_sleep(1); \
    if ((++_sp & 255u) == 0u) { if (xb_ld(&(bar)[XB_TMO])) break; if (_sp > XB_SPIN_CAP) { atomicAdd(&(bar)[XB_TMO], 1u); break; } } } } while (0)
struct XcdBarrier { unsigned* bar; unsigned x; volatile LAS unsigned* st; int wave; };
__device__ __forceinline__ XcdBarrier xcd_barrier_post(unsigned* bar, volatile LAS unsigned* st, int wave) {
    XcdBarrier b; b.bar = bar; b.x = xb_xcc_id(); b.st = st; b.wave = wave;
    if (wave == 0 && lane_id_v() == 0) (void)xb_add(&bar[XB_XCNT(b.x)], 1u);
    return b;
}
__device__ __forceinline__ void xcd_barrier_complete(unsigned* bar, unsigned x, unsigned& nloc, unsigned& nx) {
    const unsigned G = gridDim.x * gridDim.y * gridDim.z;
    unsigned sum, cnt, mine, sp = 0u;
    for (;;) {
        sum = 0u; cnt = 0u; mine = 0u;
#pragma unroll
        for (unsigned j = 0; j < 16; ++j) { const unsigned c = xb_ld(&bar[XB_XCNT(j)]); sum += c; cnt += (c > 0u) ? 1u : 0u; mine = (j == x) ? c : mine; }
        if (sum == G) break;
        __builtin_amdgcn_s_sleep(1);
        if ((++sp & 255u) == 0u) { if (xb_ld(&bar[XB_TMO])) break; if (sp > XB_SPIN_CAP) { atomicAdd(&bar[XB_TMO], 1u); break; } }
    }
    nloc = mine > 0u ? mine : 1u; nx = cnt > 0u ? cnt : 1u;
}
__device__ __forceinline__ void xcd_barrier(const XcdBarrier& b) {
    asm volatile("s_waitcnt vmcnt(0)" ::: "memory");
    __syncthreads();
    if (b.wave == 0 && lane_id_v() == 0) {
        unsigned* bar = b.bar;
        __builtin_amdgcn_s_waitcnt(0);
        unsigned nloc = b.st[0], nx = b.st[1];
        if (nloc == 0u) { xcd_barrier_complete(bar, b.x, nloc, nx); b.st[0] = nloc; b.st[1] = nx; }
        const unsigned old = xb_add(&bar[XB_XSUB(b.x)], 1u);
        const unsigned gen = old / nloc;
        if (old + 1u == (gen + 1u) * nloc) {
            __builtin_amdgcn_fence(__ATOMIC_RELEASE, "agent");
            asm volatile("s_waitcnt vmcnt(0)" ::: "memory");
            const unsigned og = xb_add(&bar[XB_TOP], 1u);
            const unsigned tg = og / nx;
            if (og + 1u == (tg + 1u) * nx) xb_add(&bar[XB_TOPGEN], 1u);
            else XB_SPIN(xb_ld(&bar[XB_TOPGEN]) == tg, bar);
            __builtin_amdgcn_fence(__ATOMIC_ACQUIRE, "agent");
            xb_add(&bar[XB_XGEN(b.x)], 1u);
            asm volatile("s_waitcnt vmcnt(0)" ::: "memory");
        } else {
            XB_SPIN(xb_ld(&bar[XB_XGEN(b.x)]) == gen, bar);
            __builtin_amdgcn_fence(__ATOMIC_ACQUIRE, "agent");
            asm volatile("s_waitcnt vmcnt(0)" ::: "memory");
        }
    }
    __syncthreads();
}

template <bool F8>
__device__ __forceinline__ void p0_transpose_item(const float* W, int K, int N, void* WTv, int k0, int n0, int orow0, LAS float* scr, int lane) {
#pragma unroll
    for (int i = 0; i < 8; ++i) { const int kk = 8 * i + (lane >> 3), n4 = (lane & 7) * 4; const f32x4 v = *(const GAS f32x4*)(W + (size_t)(k0 + kk) * N + n0 + n4);
        LAS float* d = scr + kk * 33 + n4; d[0] = v.x; d[1] = v.y; d[2] = v.z; d[3] = v.w; }
    LDS_WAIT(); asm volatile("" ::: "memory");
    const int c = lane & 7;
#pragma unroll
    for (int j = 0; j < 4; ++j) { const int n = (lane >> 3) + 8 * j; const LAS float* s = scr + (8 * c) * 33 + n;
        if constexpr (F8) {
            int t0 = __builtin_amdgcn_cvt_pk_fp8_f32(s[0 * 33] * 32.f, s[1 * 33] * 32.f, 0, false); t0 = __builtin_amdgcn_cvt_pk_fp8_f32(s[2 * 33] * 32.f, s[3 * 33] * 32.f, t0, true);
            int t1 = __builtin_amdgcn_cvt_pk_fp8_f32(s[4 * 33] * 32.f, s[5 * 33] * 32.f, 0, false); t1 = __builtin_amdgcn_cvt_pk_fp8_f32(s[6 * 33] * 32.f, s[7 * 33] * 32.f, t1, true);
            *(GAS u32x2*)((unsigned char*)WTv + (size_t)(orow0 + n) * K + k0 + 8 * c) = (u32x2){(unsigned)t0, (unsigned)t1};
        } else {
            u32x4 o; o.x = pk2(s[0 * 33], s[1 * 33]); o.y = pk2(s[2 * 33], s[3 * 33]); o.z = pk2(s[4 * 33], s[5 * 33]); o.w = pk2(s[6 * 33], s[7 * 33]);
            *(GAS u32x4*)((bf16_t*)WTv + (size_t)(orow0 + n) * K + k0 + 8 * c) = o; } }
    LDS_WAIT(); asm volatile("" ::: "memory");
}

struct Args { const float* in[25]; float* out; unsigned char* ws; };
constexpr int P0_I_IN = (DM / 64) * (INC / 32), P0_I_OUT = (DM / 64) * (DM / 32), P0_I_GU = (DM / 64) * (FF / 32), P0_I_DN = (FF / 64) * (DM / 32);
constexpr int P0_NITEMS = P0_I_IN + P0_I_OUT + NE * (2 * P0_I_GU + P0_I_DN), P0_NDEF = 10 * (2 * P0_I_GU + P0_I_DN), P0_CHUNK = 4;
__device__ __forceinline__ void p0_weight_item(const Args& args, int it, bf16_t* WIN, bf16_t* WOUT, unsigned char* WGU, unsigned char* WD, LAS float* scr, int lane) {
    int r = it;
    if (r < P0_I_IN) { const int nblk = INC / 32, kb = r / nblk, nb = r % nblk; p0_transpose_item<false>(args.in[2], DM, INC, WIN, 64 * kb, 32 * nb, 32 * nb, scr, lane); return; } r -= P0_I_IN;
    if (r < P0_I_OUT) { const int nblk = DM / 32, kb = r / nblk, nb = r % nblk; p0_transpose_item<false>(args.in[18], DM, DM, WOUT, 64 * kb, 32 * nb, 32 * nb, scr, lane); return; } r -= P0_I_OUT;
    const int e = r / (2 * P0_I_GU + P0_I_DN); r -= e * (2 * P0_I_GU + P0_I_DN);
    if (r < 2 * P0_I_GU) { const int up = r >= P0_I_GU; if (up) r -= P0_I_GU; const int nblk = FF / 32, kb = r / nblk, nb = r % nblk, f0 = 32 * nb;
        const int orow = (f0 >> 7) * 256 + up * 128 + (f0 & 127);
        p0_transpose_item<true>(args.in[up ? 22 : 21] + (size_t)e * DM * FF, DM, FF, WGU + (size_t)e * 2 * FF * DM, 64 * kb, f0, orow, scr, lane); return; }
    r -= 2 * P0_I_GU;
    { const int nblk = DM / 32, kb = r / nblk, nb = r % nblk; p0_transpose_item<true>(args.in[23] + (size_t)e * FF * DM, FF, DM, WD + (size_t)e * DM * FF, 64 * kb, 32 * nb, 32 * nb, scr, lane); }
}

__global__ void __launch_bounds__(512, 2) mega_fwd(Args args) {
    extern __shared__ __attribute__((aligned(16))) unsigned char lds_raw[];
    LAS unsigned char* lds = (LAS unsigned char*)lds_raw;
    volatile LAS unsigned* MISC = (volatile LAS unsigned*)(lds + MISC_OFF);
    const int G = gridDim.x, bx = blockIdx.x, NGW = G * 8;
    const int wave_s = __builtin_amdgcn_readfirstlane(threadIdx.x >> 6);
    unsigned char* ws = args.ws;
    gu32* ctl = (gu32*)(ws + WS_CTL);
    const float* x = args.in[0];
    float* out = args.out;
    unsigned char* WGU = ws + WS_WGU; unsigned char* WD = ws + WS_WD; bf16_t* WIN = (bf16_t*)(ws + WS_WIN); bf16_t* WOUT = (bf16_t*)(ws + WS_WOUT);
    bf16_t* XN = (bf16_t*)(ws + WS_XN); unsigned char* H2 = ws + WS_H2; bf16_t* GF = (bf16_t*)(ws + WS_GF);
    bf16_t* HP = (bf16_t*)(ws + WS_HP); bf16_t* QKV = (bf16_t*)(ws + WS_QKV); bf16_t* HZ = (bf16_t*)(ws + WS_HZ); bf16_t* MIX = (bf16_t*)(ws + WS_MIX);
    unsigned char* ACT = ws + WS_ACT; unsigned char* Y = ws + WS_Y;
    float* AFF = (float*)(ws + WS_AFF); int* TOK = (int*)(ws + WS_TOK); float* GSEL = (float*)(ws + WS_GSEL); unsigned short* INV = (unsigned short*)(ws + WS_INV);
    float* NSUM = (float*)(ws + WS_CTL) + CW_NSUM;

    if (wave_s == 0) ((LAS unsigned*)(lds + MISC_OFF))[lane_id_v()] = 0u;
    __syncthreads();
    XcdBarrier bar = xcd_barrier_post((unsigned*)(ctl + CW_BAR), MISC + 8, wave_s);

    {
        PHASE_IDS();
        LAS float* scr = (LAS float*)(lds + wave * 16384);
        const int n_p0 = (G == 256) ? P0_NITEMS - P0_NDEF : P0_NITEMS;
        for (int rep_ = 0; rep_ < REP_P0W; ++rep_)
        for (int it = gw; it < n_p0; it += NGW) p0_weight_item(args, it, WIN, WOUT, WGU, WD, scr, lane);
        const float* g = args.in[1];
        int rep_xn = REP_XN; asm volatile("" : "+s"(rep_xn));
        for (int rep_ = 0; rep_ < rep_xn; ++rep_)
        for (int m = gw; m < NTOK; m += NGW) {
            const GAS f32x4* xr = (const GAS f32x4*)(x + (size_t)m * DM) + lane;
            f32x4 v[4]; float s = 0.f;
#pragma unroll
            for (int j = 0; j < 4; ++j) { v[j] = xr[64 * j]; s += (v[j].x * v[j].x + v[j].y * v[j].y) + (v[j].z * v[j].z + v[j].w * v[j].w); }
            const float rstd = rsqrtf(wave_sum(s) * (1.f / DM) + EPS);
            GAS u32x2* o8 = (GAS u32x2*)(XN + (size_t)m * DM) + lane;
#pragma unroll
            for (int j = 0; j < 4; ++j) { const f32x4 gg = ((const GAS f32x4*)g)[lane + 64 * j]; u32x2 w; w.x = pk2(v[j].x * rstd * gg.x, v[j].y * rstd * gg.y); w.y = pk2(v[j].z * rstd * gg.z, v[j].w * rstd * gg.w); o8[64 * j] = w; }
        }
        __syncthreads();
        LAS float* w1s = (LAS float*)(lds + 118784);
        LAS float* w2s = (LAS float*)(lds + 127232);
        if (bx < 256) { for (int q = tid; q < 33 * 64; q += 512) w1s[q] = args.in[5][q]; for (int q = tid; q < 64 * 64; q += 512) w2s[q] = args.in[7][q]; }
        __syncthreads();
        for (int it = bx; it < 256; it += G) {
            const int ib = it >> 2, dn = it & 3, dir = dn >> 1, n = dn & 1, i0 = ib * 64, ibase = i0 + (dir == 0 ? 1 : 0);
            LAS float* zz = (LAS float*)lds;
            LAS float* h1 = zz + 64 * 33;
            LAS float* h2 = h1 + 64 * 64;
            const float* b1 = args.in[6]; const float* b2 = args.in[8]; const float* w3 = args.in[9]; const float* fr = args.in[10];
            for (int q = tid; q < 64 * 33; q += 512) { const int p = q / 33, j = q % 33, i = ibase + p;
                const float t = (float)i / (float)(SEQ - 1), w = 6.283185307179586f * (float)i / (float)SEQ; float v;
                if (j == 0) v = t; else { const float band = 1e-4f + (float)((j - 1) & 15) * ((15.f - 1e-4f) / 15.f); v = (j <= 16) ? __cosf(band * w) : -__sinf(band * w); }
                zz[q] = v; }
            __syncthreads();
            {
                const int j = tid & 63; float a[8];
#pragma unroll
                for (int m = 0; m < 8; ++m) a[m] = b1[j];
#pragma unroll 3
                for (int k = 0; k < 33; ++k) { const float w = w1s[k * 64 + j];
#pragma unroll
                    for (int m = 0; m < 8; ++m) a[m] += zz[(wave + 8 * m) * 33 + k] * w; }
                const float f = fr[j];
#pragma unroll
                for (int m = 0; m < 8; ++m) h1[(wave + 8 * m) * 64 + j] = __sinf(f * a[m]);
            }
            __syncthreads();
            {
                const int j = tid & 63; float a[8];
#pragma unroll
                for (int m = 0; m < 8; ++m) a[m] = b2[j];
#pragma unroll 2
                for (int k = 0; k < 64; k += 4) { const float w0 = w2s[(k + 0) * 64 + j], w1_ = w2s[(k + 1) * 64 + j], w2_ = w2s[(k + 2) * 64 + j], w3_ = w2s[(k + 3) * 64 + j];
#pragma unroll
                    for (int m = 0; m < 8; ++m) { const f32x4 hh = *(const LAS f32x4*)&h1[(wave + 8 * m) * 64 + k]; a[m] += (hh.x * w0 + hh.y * w1_) + (hh.z * w2_ + hh.w * w3_); } }
                const float f = fr[j];
#pragma unroll
                for (int m = 0; m < 8; ++m) h2[(wave + 8 * m) * 64 + j] = __sinf(f * a[m]);
            }
            __syncthreads();
            const int c = tid, col = dn * 512 + c;
            const float mind = logf(1e-2f) / 1.5f, maxd = logf(1e-2f) / 0.3f;
            const float delta = fabsf(mind + (float)c * ((maxd - mind) / 511.f));
            float asum = 0.f;
            LAS unsigned short* ftile = (LAS unsigned short*)(lds + 45056) + wave * (64 * 72);
            {
                float hv[64];
#pragma unroll
                for (int p = 0; p < 64; ++p) hv[p] = 0.f;
                float f0 = 0.f;
                float nw0 = w3[0 * 2048 + col], nw1 = w3[1 * 2048 + col], nw2 = w3[2 * 2048 + col], nw3 = w3[3 * 2048 + col];
#pragma clang loop unroll(disable)
                for (int k = 0; k < 64; k += 4) { const float w0 = nw0, w1_ = nw1, w2_ = nw2, w3_ = nw3;
                    { const int kn = k + 4 < 64 ? k + 4 : k; nw0 = w3[(kn + 0) * 2048 + col]; nw1 = w3[(kn + 1) * 2048 + col]; nw2 = w3[(kn + 2) * 2048 + col]; nw3 = w3[(kn + 3) * 2048 + col]; }
                    if (dir == 1 && ib == 0) { const f32x4 hh = *(const LAS f32x4*)&h2[k]; f0 += (hh.x * w3[(k + 0) * 2048 + col - 1024] + hh.y * w3[(k + 1) * 2048 + col - 1024]) + (hh.z * w3[(k + 2) * 2048 + col - 1024] + hh.w * w3[(k + 3) * 2048 + col - 1024]); }
#pragma unroll
                    for (int p0 = 0; p0 < 64; p0 += 16) {
                        f32x4 hh[16];
#pragma unroll
                        for (int p = 0; p < 16; ++p) hh[p] = *(const LAS f32x4*)&h2[(p0 + p) * 64 + k];
                        asm volatile("" ::: "memory");
#pragma unroll
                        for (int p = 0; p < 16; ++p) hv[p0 + p] += (hh[p].x * w0 + hh[p].y * w1_) + (hh[p].z * w2_ + hh[p].w * w3_); } }
                LAS unsigned short* frow = ftile + lane * 72;
#pragma unroll
                for (int p = 0; p < 64; ++p) { const int i = ibase + p; const float t = (float)i / (float)(SEQ - 1); float h = hv[p] * __expf(-t * delta);
                    bool valid = dir == 0 ? (i <= SEQ - 1) : (i >= 1);
                    if (dir == 1 && i == 0) { h = f0; valid = true; }
                    const unsigned hb = valid ? f2bf(h) : 0u; const float hr = __builtin_bit_cast(float, hb << 16);
                    asum += fabsf(hr); frow[dir == 0 ? 63 - p : p] = (unsigned short)hb; }
            }
            LDS_WAIT(); asm volatile("" ::: "memory");
            {
                const int gbase = dir == 0 ? GOFF - i0 - 64 : GOFF + i0;
#pragma unroll
                for (int j = 0; j < 8; ++j) { const int ch = 8 * j + (lane >> 3), chunk = lane & 7;
                    const u32x4 v = *(const LAS u32x4*)(ftile + ch * 72 + chunk * 8);
                    *(GAS u32x4*)(GF + (size_t)(n * 512 + wave * 64 + ch) * GLEN + gbase + chunk * 8) = v; }
            }
            if (ib == 63) { bf16_t* gf = GF + (size_t)(n * 512 + c) * GLEN + (dir == 0 ? 0 : GOFF + 4096);
                for (int q = 0; q < 32; ++q) *(GAS u32x4*)(gf + q * 8) = (u32x4){0u, 0u, 0u, 0u}; }
            ((float*)(ws + WS_CTL) + CW_NPART)[(size_t)((n * 2 + dir) * 64 + ib) * 512 + c] = asum;
            __syncthreads();
        }
    }
    xcd_barrier(bar);

    int rep_p1 = REP_P1; asm volatile("" : "+s"(rep_p1));
    for (int rep_ = 0; rep_ < rep_p1; ++rep_) {
    {
        pg8::GeoTokPerm S; S.A = WIN; S.X = XN; S.KB = DM * 2; S.ord.init(HCOLS / 256, NTOK / 256, G, bx);
        pg8::EpiBf16 E{HP, NTOK, 0, 1.f};
        pg8::gemm_phase<false>(lds, (LAS unsigned*)(lds + TBL_OFF), S, E, wave_s);
    }
    {
        pg8::GeoPlain S; S.A = XN; S.Bt = WIN + (size_t)HCOLS * DM; S.KB = DM * 2; S.ord.init(NTOK / 256, ACOLS / 256, G, bx);
        pg8::EpiBf16 E{QKV, ACOLS, 512, QSCALE};
        pg8::gemm_phase<false>(lds, (LAS unsigned*)(lds + TBL_OFF), S, E, wave_s);
    }
    }
    xcd_barrier(bar);

    {
        PHASE_IDS();
        LAS unsigned* red = (LAS unsigned*)lds;
        float* QN2 = (float*)(ws + WS_AFF); float* KN2 = QN2 + 4096;
        for (int it = bx; it < NB * 64; it += G) {
            const int b = it >> 6, tile = it & 63, row = tid >> 3, g = tid & 7;
            const bf16_t* rp = QKV + ((size_t)b * SEQ + tile * 64 + row) * ACOLS + g * 64;
            float sq = 0.f, sk = 0.f;
#pragma unroll
            for (int j = 0; j < 8; ++j) { const u32x4 v = *(const GAS u32x4*)(rp + j * 8), w = *(const GAS u32x4*)(rp + 512 + j * 8);
#pragma unroll
                for (int k = 0; k < 4; ++k) { sq += bflo(v[k]) * bflo(v[k]) + bfhi(v[k]) * bfhi(v[k]); sk += bflo(w[k]) * bflo(w[k]) + bfhi(w[k]) * bfhi(w[k]); } }
            if (tid < 16) red[tid] = 0u;
            __syncthreads();
            atomicMax((unsigned*)&red[g], __float_as_uint(sq)); atomicMax((unsigned*)&red[8 + g], __float_as_uint(sk));
            __syncthreads();
            if (tid < 8) QN2[(size_t)(b * 8 + tid) * 64 + tile] = __uint_as_float(red[tid]); else if (tid < 16) KN2[(size_t)(b * 8 + tid - 8) * 64 + tile] = __uint_as_float(red[tid]);
            __syncthreads();
        }
        for (int k = gw; k < 2 * 512; k += NGW) {
            const float* np = (const float*)(ws + WS_CTL) + CW_NPART + (size_t)(k >> 9) * 128 * 512 + (k & 511);
            const float v = np[(size_t)lane * 512] + np[(size_t)(lane + 64) * 512];
            const float tot = wave_sum(v);
            if (lane == 0) NSUM[k] = tot;
        }
    }
    xcd_barrier(bar);

    {
        PHASE_IDS();
        {
            const float* conv_w = args.in[3]; const float* conv_b = args.in[4]; const float* skip = args.in[11];
            if (tid < 64) { const int bufi = tid >> 5, row = tid & 31, rr = row < 16 ? row : SEQ + row; *(LAS u32x4*)(lds + bufi * HY_ZBYTES + rr * 16) = (u32x4){0u, 0u, 0u, 0u}; }
            const int r32 = lane & 31, hi = lane >> 5;
            const int tr_lane = (2 * ((lane >> 4) & 1) + ((lane & 3) >> 1) + 8 * hi + ((lane & 15) >> 2)) * 16 + 8 * (lane & 1);
            int rep_hy = REP_HY; asm volatile("" : "+s"(rep_hy));
            const bool split13 = (G == 256);
            const int hy_n = split13 ? (bx < 128 ? 1 : 3) : (HW - bx + G - 1) / G, hy_0 = split13 ? (bx < 128 ? bx : 128 + (bx - 128) * 3) : bx, hy_s = split13 ? 1 : G;
            for (int rep_ = 0; rep_ < rep_hy; ++rep_)
            for (int ui_ = 0; ui_ < hy_n; ++ui_) {
                const int c = hy_0 + ui_ * hy_s;
                __syncthreads();
                {
                    const int col = 1024 + c; const float w0 = conv_w[col], w1 = conv_w[HCOLS + col], w2 = conv_w[2 * HCOLS + col], cb = conv_b[col];
                    const bf16_t* hp = HP + (size_t)col * SEQ * 8;
#pragma unroll 2
                    for (int i = 0; i < 8; ++i) { const int t = tid + 512 * i;
                        const u32x4 z4 = (u32x4){0u, 0u, 0u, 0u};
                        const u32x4 pm = t > 0 ? *(const GAS u32x4*)(hp + (size_t)(t - 1) * 8) : z4, p0 = *(const GAS u32x4*)(hp + (size_t)t * 8), pp = t < SEQ - 1 ? *(const GAS u32x4*)(hp + (size_t)(t + 1) * 8) : z4;
                        u32x4 o;
#pragma unroll
                        for (int k = 0; k < 4; ++k) { const float lo = cb + w0 * bflo(pm[k]) + w1 * bflo(p0[k]) + w2 * bflo(pp[k]), hh = cb + w0 * bfhi(pm[k]) + w1 * bfhi(p0[k]) + w2 * bfhi(pp[k]); o[k] = pk2(lo, hh); }
                        *(LAS u32x4*)(lds + HY_ZA + (t + 16) * 16) = o; }
                }
                for (int n = 0; n < 2; ++n) {
                    {
                        const GAS u32x4* gsrc = (const GAS u32x4*)(GF + (size_t)(n * 512 + c) * GLEN);
                        static_assert(GLEN * 2 / 16 == 2 * 512 + 64, "filter row = 1088 16-byte pieces");
                        const u32x4 f0 = gsrc[tid], f1 = gsrc[tid + 512]; u32x4 f2 = (u32x4){0u, 0u, 0u, 0u}; if (tid < 64) f2 = gsrc[tid + 1024];
                        *(LAS u32x4*)(lds + HY_FB + tid * 16) = f0; *(LAS u32x4*)(lds + HY_FB + (tid + 512) * 16) = f1; if (tid < 64) *(LAS u32x4*)(lds + HY_FB + (tid + 1024) * 16) = f2;
                    }
                    __syncthreads();
                    f32x16 acc[2][2];
#pragma unroll
                    for (int a = 0; a < 2; ++a)
#pragma unroll
                        for (int b = 0; b < 2; ++b)
#pragma unroll
                            for (int k = 0; k < 16; ++k) acc[a][b][k] = 0.f;
                    const LAS unsigned char* za = lds + (n == 0 ? HY_ZA : HY_ZB) + tr_lane;
                    const LAS unsigned char* fbp = lds + HY_FB + 2 * GOFF - 32 + 16 * (hi - r32) - 512 * (2 * wave);
#define HY_STEP(OFFA, OFFB) do { \
                        const v4i16_t x0 = __builtin_amdgcn_ds_read_tr16_b64_v4i16((LAS v4i16_t*)(za + (OFFA))); \
                        const v4i16_t x1 = __builtin_amdgcn_ds_read_tr16_b64_v4i16((LAS v4i16_t*)(za + (OFFA) + 64)); \
                        const v4i16_t x2 = __builtin_amdgcn_ds_read_tr16_b64_v4i16((LAS v4i16_t*)(za + (OFFA) + 128)); \
                        const bf16x8 b0 = *(const LAS bf16x8*)(fbp + (OFFB)), b1 = *(const LAS bf16x8*)(fbp + (OFFB) - 512); \
                        const bf16x8 a0 = (bf16x8){x0[0], x0[1], x0[2], x0[3], x1[0], x1[1], x1[2], x1[3]}, a1 = (bf16x8){x1[0], x1[1], x1[2], x1[3], x2[0], x2[1], x2[2], x2[3]}; \
                        acc[0][0] = __builtin_amdgcn_mfma_f32_32x32x16_bf16(a0, b0, acc[0][0], 0, 0, 0); \
                        acc[0][1] = __builtin_amdgcn_mfma_f32_32x32x16_bf16(a1, b0, acc[0][1], 0, 0, 0); \
                        acc[1][0] = __builtin_amdgcn_mfma_f32_32x32x16_bf16(a0, b1, acc[1][0], 0, 0, 0); \
                        acc[1][1] = __builtin_amdgcn_mfma_f32_32x32x16_bf16(a1, b1, acc[1][1], 0, 0, 0); } while (0)
#pragma clang loop unroll(disable)
                    for (int c4 = 0; c4 < 64; ++c4) {
                        HY_STEP(0, 0); HY_STEP(256, 32); HY_STEP(512, 64); HY_STEP(768, 96);
                        za += 1024; fbp += 128;
                    }
                    HY_STEP(0, 0);
#undef HY_STEP
                    const int gcol = n * 512 + c; const float w0 = conv_w[gcol], w1 = conv_w[HCOLS + gcol], w2 = conv_w[2 * HCOLS + gcol], cb = conv_b[gcol];
                    const float inv = 1.f / NSUM[n * 512 + c], sk = skip[n * 512 + c];
                    const bf16_t* hp = HP + (size_t)gcol * SEQ * 8 + 4 * hi;
                    const LAS unsigned char* zin = lds + (n == 0 ? HY_ZA : HY_ZB) + 8 * hi;
#pragma unroll
                    for (int sp = 0; sp < 2; ++sp) {
                        const int tb = 256 * (2 * wave + sp) + 8 * r32;
                        u32x2 P[10];
#pragma unroll
                        for (int k = 0; k < 10; ++k) { const int tq = tb - 1 + k; P[k] = (tq >= 0 && tq < SEQ) ? *(const GAS u32x2*)(hp + (size_t)tq * 8) : (u32x2){0u, 0u}; }
#pragma unroll
                        for (int tt = 0; tt < 8; ++tt) {
                            const int t = tb + tt; const u32x2 zi = *(const LAS u32x2*)(zin + (t + 16) * 16);
                            const float zv[4] = {bflo(zi.x), bfhi(zi.x), bflo(zi.y), bfhi(zi.y)};
                            const float pm[4] = {bflo(P[tt].x), bfhi(P[tt].x), bflo(P[tt].y), bfhi(P[tt].y)};
                            const float pc[4] = {bflo(P[tt + 1].x), bfhi(P[tt + 1].x), bflo(P[tt + 1].y), bfhi(P[tt + 1].y)};
                            const float pp[4] = {bflo(P[tt + 2].x), bfhi(P[tt + 2].x), bflo(P[tt + 2].y), bfhi(P[tt + 2].y)};
                            float zo[4];
#pragma unroll
                            for (int bb = 0; bb < 4; ++bb) { const float gate = cb + w0 * pm[bb] + w1 * pc[bb] + w2 * pp[bb]; zo[bb] = gate * (acc[sp][tt >> 2][(tt & 3) * 4 + bb] * inv + sk * zv[bb]); }
                            u32x2 w; w.x = pk2(zo[0], zo[1]); w.y = pk2(zo[2], zo[3]);
                            if (n == 0) *(LAS u32x2*)(lds + HY_ZB + (t + 16) * 16 + 8 * hi) = w;
                            else *(GAS u32x2*)(HZ + ((size_t)c * SEQ + t) * 8 + 4 * hi) = w;
                        }
                    }
                    __syncthreads();
                }
            }
        }
        __syncthreads();
        {
            const int wid = wave, r32 = lane & 31, hi = lane >> 5;
            const float* QN2 = (const float*)(ws + WS_AFF); const float* KN2 = QN2 + 4096;
            for (int rep_ = 0; rep_ < REP_AT; ++rep_)
            for (int unit = bx; unit < NB * 4 * 16; unit += G) {
                const int v_ = unit & 127, qb = v_ & 15, b = v_ >> 4, h = unit < 256 ? 2 + (unit >> 7) : ((unit - 256) >> 7 ? 0 : 1), q0 = qb * 256;
                const bf16_t* pb = QKV + (size_t)b * SEQ * ACOLS;
                const float slope2 = exp2f(-2.f * (float)(h + 1)) * LOG2E;
                f32x16 o[4];
#pragma clang loop unroll(disable)
                for (int mp = 0; mp < 2; ++mp) {
                    const int l_u = lane_id_v(), r32u = l_u & 31, hiu = l_u >> 5;
                    const int qpos = q0 + wid * 32 + r32u;
                    int nL, NT; bool spec;
                    { const float* qn = QN2 + ((size_t)(b * 8 + h * 2 + mp)) * 64; const float* kn = KN2 + ((size_t)(b * 8 + h * 2 + mp)) * 64;
                      float km = kn[lane_id_v()];
                      km = wave_max(km);
                      const float qm = fmaxf(fmaxf(qn[4 * qb], qn[4 * qb + 1]), fmaxf(qn[4 * qb + 2], qn[4 * qb + 3]));
                      const float qk2 = 2.f * sqrtf(qm * km);
                      spec = __builtin_amdgcn_readfirstlane((int)(qk2 < 120.f)) != 0;
                      const float rthr = (150.f + qk2) / slope2;
                      const int side = __builtin_amdgcn_readfirstlane((int)fminf(rthr * (1.f / 64.f), 64.f)) + 1;
                      nL = min(4 * qb, side); int nR = min(60 - 4 * qb, side); NT = 4 + nL + nR;
                      if (NT & 1) { if (nL < 4 * qb) ++nL; else ++nR; ++NT; } }
                    att::pass(o, pb + (size_t)qpos * ACOLS + h * 128 + mp * 64 + hiu * 8, pb + 512 + h * 128 + mp * 64, pb + 1024 + h * 128, qpos, qb, slope2, (char*)lds_raw, tid, nL, NT, spec);
                    if (mp == 0) {
                        int z2 = 0; asm volatile("" : "+s"(z2));
                        GAS f32x4* pk = (GAS f32x4*)((float*)(ws + WS_PARK) + (size_t)(bx * 8 + wid) * 4096 + lane_id_v() * 64 + z2);
#pragma unroll
                        for (int d = 0; d < 4; ++d)
#pragma unroll
                            for (int k = 0; k < 4; ++k) pk[d * 4 + k] = (f32x4){o[d][4 * k], o[d][4 * k + 1], o[d][4 * k + 2], o[d][4 * k + 3]};
                    }
                    __builtin_amdgcn_sched_barrier(0);
                }
                asm volatile("s_waitcnt vmcnt(0)" ::: "memory");
                int zz = 0; asm volatile("" : "+s"(zz));
                float lam;
                { float s1 = 0.f, s2 = 0.f; for (int i = 0; i < 64; ++i) { s1 += args.in[13][i + zz] * args.in[14][i + zz]; s2 += args.in[15][i + zz] * args.in[16][i + zz]; } lam = expf(s1) - expf(s2) + 0.2f; }
                const float* subg = args.in[17] + zz;
                int lane_c = lane; asm volatile("" : "+v"(lane_c)); const int r32c = lane_c & 31, hic = lane_c >> 5;
                {
                    const GAS f32x4* pk = (const GAS f32x4*)((float*)(ws + WS_PARK) + (size_t)(bx * 8 + wid) * 4096 + lane_c * 64 + zz);
#pragma unroll
                    for (int d = 0; d < 4; ++d)
#pragma unroll
                        for (int k = 0; k < 4; ++k) { const f32x4 pv = pk[d * 4 + k];
#pragma unroll
                            for (int q = 0; q < 4; ++q) o[d][4 * k + q] = pv[q] - lam * o[d][4 * k + q]; }
                }
#pragma unroll
                for (int r = 0; r < 16; ++r) {
                    float ss = 0.f;
#pragma unroll
                    for (int d = 0; d < 4; ++d) ss += o[d][r] * o[d][r];
                    ss += sx<1>(ss); ss += sx<2>(ss); ss += sx<4>(ss); ss += sx<8>(ss); ss += sx<16>(ss);
                    const float rs = rsqrtf(ss * (1.f / 128.f) + EPS) * 0.8f;
                    bf16_t* op = MIX + ((size_t)b * SEQ + q0 + wid * 32 + att::crow(r, hic)) * DM + 512 + h * 128 + r32c;
#pragma unroll
                    for (int d = 0; d < 4; ++d) op[d * 32] = (bf16_t)f2bf(o[d][r] * rs * subg[d * 32 + r32c]);
                }
            }
        }
    }
    if (G == 256) {
        __syncthreads();
        int lane_d = lane_id_v(); asm volatile("" : "+v"(lane_d));
        LAS float* scr = (LAS float*)(lds + wave_s * 16384);
        for (;;) {
            int it0 = 0; if (lane_d == 0) it0 = (int)atomicAdd((unsigned*)(ctl + CW_WQ), (unsigned)P0_CHUNK);
            it0 = __builtin_amdgcn_readfirstlane(it0) + P0_NITEMS - P0_NDEF;
            if (it0 >= P0_NITEMS) break;
            for (int it = it0; it < min(it0 + P0_CHUNK, P0_NITEMS); ++it) p0_weight_item(args, it, WIN, WOUT, WGU, WD, scr, lane_d);
        }
    }
    xcd_barrier(bar);

    {
        PHASE_IDS();
        const float* hg = args.in[12];
        LAS unsigned short* tile = (LAS unsigned short*)lds;
        LAS float* rs = (LAS float*)(lds + 32768);
        int rep_3a = REP_P3A; asm volatile("" : "+s"(rep_3a));
        for (int rep_ = 0; rep_ < rep_3a; ++rep_)
        for (int it = bx; it < 8 * 128; it += G) {
            const int g = it & 7, tb = it >> 3, t0 = tb * 32;
            __syncthreads();
            for (int q = tid; q < 64 * 32; q += 512) { const int ch = q >> 5, seg = q & 31;
                const u32x4 v = *(const GAS u32x4*)(HZ + ((size_t)(g * 64 + ch) * SEQ + t0 + seg) * 8);
                *(LAS u32x4*)(tile + ch * 256 + seg * 8) = v; }
            __syncthreads();
            if (tid < 256) { float s = 0.f; for (int ch = 0; ch < 64; ++ch) { const float v = bf2f(tile[ch * 256 + tid]); s += v * v; } rs[tid] = rsqrtf(s * (1.f / 64.f) + EPS); }
            __syncthreads();
            for (int q = tid; q < 256 * 8; q += 512) { const int tk = q >> 3, c8 = (q & 7) * 8;
                const float r = rs[tk]; const int t = t0 + (tk >> 3), b = tk & 7;
                float v[8];
#pragma unroll
                for (int j = 0; j < 8; ++j) v[j] = bf2f(tile[(c8 + j) * 256 + tk]) * r * hg[g * 64 + c8 + j];
                u32x4 w; w.x = pk2(v[0], v[1]); w.y = pk2(v[2], v[3]); w.z = pk2(v[4], v[5]); w.w = pk2(v[6], v[7]);
                *(GAS u32x4*)(MIX + ((size_t)b * SEQ + t) * DM + g * 64 + c8) = w; }
        }
        __syncthreads();
    }
    xcd_barrier(bar);

    {
        pg8::GeoPlain S; S.A = MIX; S.Bt = WOUT; S.KB = DM * 2; S.ord.init(NTOK / 256, DM / 256, G, bx);
        pg8::EpiResF32 E{x, out, DM};
        for (int rep_ = 0; rep_ < REP_P3B; ++rep_) pg8::gemm_phase<false>(lds, (LAS unsigned*)(lds + TBL_OFF), S, E, wave_s);
    }
    xcd_barrier(bar);

    {
        PHASE_IDS();
        const float* g = args.in[19]; const float* wr = args.in[20];
        LAS float* gwl = (LAS float*)lds;
        for (int q = tid; q < DM * 4; q += 512) { const f32x4 w4 = ((const GAS f32x4*)wr)[q]; const float gd = g[q >> 2]; *(LAS f32x4*)(gwl + (q >> 2) * 20 + (q & 3) * 4) = w4 * gd; }
        __syncthreads();
        const int i16 = lane & 15, q4 = lane >> 4;
        int rep_4a = REP_P4A; asm volatile("" : "+s"(rep_4a));
        for (int rep_ = 0; rep_ < rep_4a; ++rep_)
        for (int grp = gw; grp < NTOK / 16; grp += NGW) {
            const int tok0 = grp * 16;
            const float* xrow = out + (size_t)(tok0 + i16) * DM + 4 * q4;
            const LAS float* bp = gwl + (4 * q4) * 20 + i16;
            f32x4 acc = (f32x4){0.f, 0.f, 0.f, 0.f}; float ss = 0.f;
#pragma unroll 8
            for (int kk = 0; kk < 64; ++kk) {
                const f32x4 a = *(const GAS f32x4*)(xrow + 16 * kk);
                ss += (a.x * a.x + a.y * a.y) + (a.z * a.z + a.w * a.w);
                const LAS float* b = bp + kk * 320;
                acc = __builtin_amdgcn_mfma_f32_16x16x4f32(a.x, b[0], acc, 0, 0, 0);
                acc = __builtin_amdgcn_mfma_f32_16x16x4f32(a.y, b[20], acc, 0, 0, 0);
                acc = __builtin_amdgcn_mfma_f32_16x16x4f32(a.z, b[40], acc, 0, 0, 0);
                acc = __builtin_amdgcn_mfma_f32_16x16x4f32(a.w, b[60], acc, 0, 0, 0);
            }
            ss += sx<16>(ss); ss = sum32x(ss);
            const float r = rsqrtf(ss * (1.f / DM) + EPS);
            f32x4 af;
#pragma unroll
            for (int reg = 0; reg < 4; ++reg) {
                const float lg = acc[reg] * lane_read(r, 4 * q4 + reg);
                float mx = lg; mx = fmaxf(mx, sx<1>(mx)); mx = fmaxf(mx, sx<2>(mx)); mx = fmaxf(mx, sx<4>(mx)); mx = fmaxf(mx, sx<8>(mx));
                const float ex = expf(lg - mx); float den = ex; den += sx<1>(den); den += sx<2>(den); den += sx<4>(den); den += sx<8>(den);
                af[reg] = ex / den;
            }
            const int b = tok0 >> 12, t0 = tok0 & 4095;
            *(GAS f32x4*)(AFF + ((size_t)i16 * NB + b) * SEQ + t0 + 4 * q4) = af;
            *(GAS u32x2*)(INV + (size_t)tok0 * 16 + lane * 4) = (u32x2){0xffffffffu, 0xffffffffu};
            for (int i = 0; i < 16; ++i) {
                const float ri = lane_read(r, i);
                const GAS f32x4* xr = (const GAS f32x4*)(out + (size_t)(tok0 + i) * DM) + lane;
                GAS unsigned* o4 = (GAS unsigned*)(H2 + (size_t)(tok0 + i) * DM) + lane;
#pragma unroll
                for (int j = 0; j < 4; ++j) { const f32x4 v = xr[64 * j]; const f32x4 gg = ((const GAS f32x4*)g)[lane + 64 * j];
                    int t = __builtin_amdgcn_cvt_pk_fp8_f32(v.x * ri * gg.x, v.y * ri * gg.y, 0, false); t = __builtin_amdgcn_cvt_pk_fp8_f32(v.z * ri * gg.z, v.w * ri * gg.w, t, true); o4[64 * j] = (unsigned)t; }
            }
        }
        __syncthreads();
    }
    xcd_barrier(bar);

    {
        PHASE_IDS();
        LAS unsigned* hist = (LAS unsigned*)lds; LAS unsigned* scan = hist + 256; LAS unsigned* selw = scan + 512;
        int rep_4b = REP_P4B; asm volatile("" : "+s"(rep_4b));
        for (int rep_ = 0; rep_ < rep_4b; ++rep_)
        for (int eb = bx; eb < NE * NB; eb += G) {
            const int b = eb & 7, e = eb >> 3;
            const float* a = AFF + (size_t)eb * SEQ;
            unsigned v[8];
#pragma unroll
            for (int j = 0; j < 8; ++j) v[j] = __float_as_uint(a[tid * 8 + j]);
            unsigned prefix = 0, mask = 0, need = CAP;
            __syncthreads();
            for (int pass = 0; pass < 4; ++pass) {
                const int shift = 24 - 8 * pass;
                if (tid < 256) hist[tid] = 0;
                __syncthreads();
#pragma unroll
                for (int j = 0; j < 8; ++j) if ((v[j] & mask) == prefix) atomicAdd((unsigned*)&hist[(v[j] >> shift) & 255u], 1u);
                __syncthreads();
                if (tid < 256) scan[tid] = hist[tid];
                __syncthreads();
                for (int off = 1; off < 256; off <<= 1) { const unsigned xx = (tid < 256 && tid + off < 256) ? scan[tid + off] : 0u; __syncthreads(); if (tid < 256) scan[tid] += xx; __syncthreads(); }
                if (tid < 256) { const unsigned above = tid < 255 ? scan[tid + 1] : 0u; if (above < need && need <= scan[tid]) { selw[0] = (unsigned)tid; selw[1] = need - above; } }
                __syncthreads();
                prefix |= selw[0] << shift; mask |= 255u << shift; need = selw[1];
                __syncthreads();
            }
            unsigned cg = 0, ce = 0;
#pragma unroll
            for (int j = 0; j < 8; ++j) { cg += v[j] > prefix; ce += v[j] == prefix; }
            scan[tid] = (cg << 16) | ce;
            __syncthreads();
            for (int off = 1; off < 512; off <<= 1) { const unsigned xx = tid >= off ? scan[tid - off] : 0u; __syncthreads(); scan[tid] += xx; __syncthreads(); }
            const unsigned incl = scan[tid]; unsigned pg = (incl >> 16) - cg, pe = (incl & 0xffffu) - ce;
#pragma unroll
            for (int j = 0; j < 8; ++j) {
                const bool isg = v[j] > prefix, ise = v[j] == prefix;
                if (isg || (ise && pe < need)) {
                    const unsigned pos = pg + (pe < need ? pe : need); const int token = b * SEQ + tid * 8 + j;
                    TOK[(size_t)eb * CAP + pos] = token; GSEL[(size_t)eb * CAP + pos] = __uint_as_float(v[j]); INV[(size_t)token * 16 + e] = (unsigned short)pos;
                }
                pg += isg; pe += ise;
            }
            __syncthreads();
        }
    }
    xcd_barrier(bar);

    {
        pg8::GeoExpert<true> S; S.A = H2; S.Bt = WGU; S.KB = DM; S.bexp = (size_t)2 * FF * DM; S.tok = TOK; S.ord.init(NSLOT / 256, 2 * FF / 256, G, bx);
        pg8::EpiSwiGLU E{ACT, FF};
        for (int rep_ = 0; rep_ < REP_P5; ++rep_) pg8::gemm_phase<true>(lds, (LAS unsigned*)(lds + TBL_OFF), S, E, wave_s);
    }
    xcd_barrier(bar);

    {
        pg8::GeoExpert<false> S; S.A = ACT; S.Bt = WD; S.KB = FF; S.bexp = (size_t)DM * FF; S.tok = nullptr; S.ord.init(NSLOT / 256, DM / 256, G, bx);
        pg8::EpiFp8 E{Y, DM};
        for (int rep_ = 0; rep_ < REP_P6; ++rep_) pg8::gemm_phase<true>(lds, (LAS unsigned*)(lds + TBL_OFF), S, E, wave_s);
    }
    xcd_barrier(bar);

    {
        PHASE_IDS();
        const float* g = args.in[24];
        for (int m = gw; m < NTOK; m += NGW) {
            const GAS f32x4* xr = (const GAS f32x4*)(out + (size_t)m * DM) + lane;
            f32x4 v[4];
#pragma unroll
            for (int j = 0; j < 4; ++j) v[j] = xr[64 * j];
            const int b = m >> 12;
            const unsigned short myinv = INV[(size_t)m * 16 + (lane & 15)];
            for (int e = 0; e < 16; ++e) {
                const unsigned s = (unsigned)lane_read_i((int)myinv, e);
                if (s != 0xffffu) {
                    const size_t slot = ((size_t)e * NB + b) * CAP + s;
                    const float gv = GSEL[slot];
                    const GAS unsigned* yr = (const GAS unsigned*)(Y + slot * DM) + lane;
#pragma unroll
                    for (int j = 0; j < 4; ++j) { const unsigned w = yr[64 * j]; const f32x2 lo = __builtin_amdgcn_cvt_pk_f32_fp8((int)w, false), hh = __builtin_amdgcn_cvt_pk_f32_fp8((int)w, true);
                        v[j].x += gv * lo.x; v[j].y += gv * lo.y; v[j].z += gv * hh.x; v[j].w += gv * hh.y; }
                }
            }
            float s = 0.f;
#pragma unroll
            for (int j = 0; j < 4; ++j) s += (v[j].x * v[j].x + v[j].y * v[j].y) + (v[j].z * v[j].z + v[j].w * v[j].w);
            const float r = rsqrtf(wave_sum(s) * (1.f / DM) + EPS);
            GAS f32x4* o = (GAS f32x4*)(out + (size_t)m * DM) + lane;
#pragma unroll
            for (int j = 0; j < 4; ++j) { const f32x4 gg = ((const GAS f32x4*)g)[lane + 64 * j]; o[64 * j] = (f32x4){v[j].x * r * gg.x, v[j].y * r * gg.y, v[j].z * r * gg.z, v[j].w * r * gg.w}; }
        }
    }
}

extern "C" void kernel_launch(void* const* d_in, const int* in_sizes, int n_in, void* d_out, int out_size, void* d_ws, size_t ws_size, hipStream_t stream) {
    static int grid = 0;
    if (grid == 0) {
        if (n_in != 25 || ws_size < WS_END) { fprintf(stderr, "kernel_launch: unexpected n_in %d / ws %zu\n", n_in, ws_size); grid = -1; return; }
        int dev = 0, cus = 0;
        if (hipGetDevice(&dev) != hipSuccess || hipDeviceGetAttribute(&cus, hipDeviceAttributeMultiprocessorCount, dev) != hipSuccess) { grid = -1; return; }
        if (hipFuncSetAttribute((const void*)mega_fwd, hipFuncAttributeMaxDynamicSharedMemorySize, LDS_BYTES) != hipSuccess) { fprintf(stderr, "kernel_launch: hipFuncSetAttribute failed\n"); grid = -1; return; }
        int per_cu = 0;
        if (hipOccupancyMaxActiveBlocksPerMultiprocessor(&per_cu, (const void*)mega_fwd, 512, LDS_BYTES) != hipSuccess || per_cu < 1) fprintf(stderr, "kernel_launch: occupancy query says %d\n", per_cu);
        (void)hipGetLastError();
        grid = cus;
    }
    if (grid < 0) return;
    (void)hipMemsetAsync((char*)d_ws + WS_CTL, 0, CTL_BYTES, stream);
    Args a; memset(&a, 0, sizeof a);
    for (int i = 0; i < 25; ++i) a.in[i] = (const float*)d_in[i];
    a.out = (float*)d_out; a.ws = (unsigned char*)d_ws;
    hipLaunchKernelGGL(mega_fwd, dim3(grid), dim3(512), LDS_BYTES, stream, a);
}
```

```cpp
#include <hip/hip_runtime.h>
#include <cstdio>
#include <cstdint>
#include <cstring>

#define GAS __attribute__((address_space(1)))
#define LAS __attribute__((address_space(3)))
typedef unsigned short bf16_t;
typedef short bf16x8 __attribute__((ext_vector_type(8)));
typedef float f32x4 __attribute__((ext_vector_type(4)));
typedef float f32x2 __attribute__((ext_vector_type(2)));
typedef unsigned u32x4 __attribute__((ext_vector_type(4)));
typedef unsigned u32x2 __attribute__((ext_vector_type(2)));
typedef short v4i16_t __attribute__((ext_vector_type(4)));
typedef int i32x4 __attribute__((ext_vector_type(4)));
typedef int i32x8 __attribute__((ext_vector_type(8)));
constexpr int F8_SCALES = 127 | (122 << 8);
typedef float f32x16 __attribute__((ext_vector_type(16)));

constexpr int DM = 1024, NB = 8, SEQ = 4096, NTOK = NB * SEQ;
constexpr int HW = 512, HCOLS = 1536, INC = 3072, ACOLS = 1536;
constexpr int NE = 16, CAP = 512, FF = 2816, NSLOT = NE * NB * CAP;
constexpr float EPS = 1e-6f;
constexpr float LOG2E = 1.4426950408889634f;
constexpr float QSCALE = 0.125f * LOG2E;
constexpr int GOFF = 4352, GLEN = 8704;

constexpr size_t MiB = 1u << 20;
constexpr size_t WS_CTL = 0, CTL_BYTES = 1 * MiB;
constexpr size_t WS_WGU = 2 * MiB;
constexpr size_t WS_WD = 90 * MiB;
constexpr size_t WS_AFF = 134 * MiB;
constexpr size_t WS_TOK = 136 * MiB;
constexpr size_t WS_GSEL = WS_TOK + 256 * 1024;
constexpr size_t WS_INV = 137 * MiB;
constexpr size_t WS_XN = 138 * MiB;
constexpr size_t WS_H2 = WS_XN;
constexpr size_t WS_WIN = 202 * MiB;
constexpr size_t WS_WOUT = 208 * MiB;
constexpr size_t WS_GF = 210 * MiB;
constexpr size_t WS_HP = 228 * MiB;
constexpr size_t WS_QKV = 324 * MiB;
constexpr size_t WS_ACT = 228 * MiB;
constexpr size_t WS_HZ = 420 * MiB;
constexpr size_t WS_MIX = 452 * MiB;
constexpr size_t WS_PARK = 516 * MiB;
constexpr size_t WS_Y = 420 * MiB;
constexpr size_t WS_END = 548 * MiB;
constexpr int CW_BAR = 4096;
constexpr int CW_NSUM = 16384;
constexpr int CW_NPART = 65536;
constexpr int CW_WQ = 32768;

constexpr int REP_XN = 1, REP_P3A = 1, REP_P4A = 1, REP_P4B = 1;
constexpr int REP_P0W = 1, REP_P1 = 1, REP_HY = 1, REP_AT = 1, REP_P3B = 1, REP_P5 = 1, REP_P6 = 1;
constexpr int LDS_BYTES = 160 * 1024;
constexpr int MISC_OFF = LDS_BYTES - 256;
constexpr int HY_ZBYTES = (SEQ + 32) * 16, HY_ZA = 0, HY_ZB = HY_ZBYTES, HY_FB = 2 * HY_ZBYTES;
constexpr int TBL_OFF = 131072;

__device__ __forceinline__ unsigned f2bf(float f) { unsigned u = __builtin_bit_cast(unsigned, f); return (u + 0x7fffu + ((u >> 16) & 1u)) >> 16; }
__device__ __forceinline__ unsigned pk2(float lo, float hi) { return f2bf(lo) | (f2bf(hi) << 16); }
__device__ __forceinline__ float bf2f(unsigned short h) { return __builtin_bit_cast(float, (unsigned)h << 16); }
__device__ __forceinline__ float bflo(unsigned w) { return __builtin_bit_cast(float, w << 16); }
__device__ __forceinline__ float bfhi(unsigned w) { return __builtin_bit_cast(float, w & 0xffff0000u); }
template <int M> __device__ __forceinline__ float sx(float v) { static_assert(M >= 1 && M <= 16, "sx: xor mask 1..16"); return __int_as_float(__builtin_amdgcn_ds_swizzle(__float_as_int(v), (M << 10) | 0x1f)); }
__device__ __forceinline__ float sum32x(float v) { auto r = __builtin_amdgcn_permlane32_swap(__float_as_uint(v), __float_as_uint(v), false, false); return __uint_as_float(r[0]) + __uint_as_float(r[1]); }
__device__ __forceinline__ float max32x(float v) { auto r = __builtin_amdgcn_permlane32_swap(__float_as_uint(v), __float_as_uint(v), false, false); return fmaxf(__uint_as_float(r[0]), __uint_as_float(r[1])); }
__device__ __forceinline__ float lane_read(float v, int src) { return __int_as_float(__builtin_amdgcn_ds_bpermute(src << 2, __float_as_int(v))); }
__device__ __forceinline__ int lane_read_i(int v, int src) { return __builtin_amdgcn_ds_bpermute(src << 2, v); }
__device__ __forceinline__ float wave_sum(float v) { v += sx<1>(v); v += sx<2>(v); v += sx<4>(v); v += sx<8>(v); v += sx<16>(v); return sum32x(v); }
__device__ __forceinline__ float wave_max(float v) { v = fmaxf(v, sx<1>(v)); v = fmaxf(v, sx<2>(v)); v = fmaxf(v, sx<4>(v)); v = fmaxf(v, sx<8>(v)); v = fmaxf(v, sx<16>(v)); return max32x(v); }
#define LDS_WAIT() asm volatile("s_waitcnt lgkmcnt(0)" ::: "memory")
__device__ __forceinline__ int lane_id_v() { int l; asm volatile("v_mbcnt_lo_u32_b32 %0, -1, 0\n\tv_mbcnt_hi_u32_b32 %0, -1, %0" : "=v"(l)); return l; }
#define PHASE_IDS() const int wave = wave_s; int tid_o = wave_s * 64 + lane_id_v(); asm volatile("" : "+v"(tid_o)); const int tid = tid_o, lane = tid & 63, gw = blockIdx.x * 8 + wave; (void)lane; (void)gw

namespace pg8 {
constexpr int BM = 256, BK = 64, HALF = 128, HTB = HALF * BK * 2, STAGE_BYTES = 8 * HTB, NXCD = 8, WGM = 8;
__host__ __device__ __forceinline__ int lds_byte(int r, int c) { const int st = (r >> 4) * 2 + (c >> 5), rr = r & 15, cc = c & 31, ob = rr * 64 + cc * 2; return st * 1024 + (ob ^ (((ob >> 9) & 1) << 5)); }
__host__ __device__ __forceinline__ void stage_rc(int b, int& R, int& C) { const int st = b / 1024, sb = b % 1024, swz = sb ^ (((sb >> 9) & 1) << 5); R = (st >> 1) * 16 + swz / 64; C = (st & 1) * 32 + (swz % 64) / 2; }
__host__ __device__ __forceinline__ int perm32(int rho) { const int n = rho >> 4, i = rho & 15; return 8 * (i >> 2) + 4 * n + (i & 3); }
struct Unit { int pm, pn; };

struct TileOrder {
    int nM, nN, nwg, G, c;
    __device__ void init(int nM_, int nN_, int G_, int c_) { nM = nM_; nN = nN_; nwg = nM * nN; G = G_; c = c_; }
    __device__ bool next(int i, Unit& u) const {
        const long L = (long)i * G + c; if (L >= nwg) return false;
        int wgid = (int)L; { const int q = nwg / NXCD, r = nwg % NXCD, xcd = wgid % NXCD, off = wgid / NXCD; wgid = (xcd < r ? xcd * (q + 1) : r * (q + 1) + (xcd - r) * q) + off; }
        const int nig = WGM * nN, gid = wgid / nig, fm = gid * WGM, gsz = (nM - fm) < WGM ? (nM - fm) : WGM;
        u.pm = fm + ((wgid % nig) % gsz); u.pn = (wgid % nig) / gsz; return true;
    }
};
__device__ __forceinline__ unsigned cvt_pk_bf16(float lo, float hi) { unsigned r; asm volatile("v_cvt_pk_bf16_f32 %0, %1, %2" : "=v"(r) : "v"(lo), "v"(hi)); return r; }

struct EpiBf16 {
    static constexpr bool PERM = true;
    bf16_t* O; int ldc; int scols; float sc;
    __device__ __forceinline__ void operator()(const f32x4 (&acc)[2][2][4][2], const Unit& u, int wr, int wc, int fr, int fq) const {
        const int row0 = u.pm * BM + wr * 64 + fr, col0 = u.pn * BM + wc * 32 + 8 * fq;
        const float s = (u.pn * BM < scols) ? sc : 1.f;
#pragma unroll
        for (int ai = 0; ai < 2; ++ai)
#pragma unroll
            for (int m = 0; m < 4; ++m) { bf16_t* rowp = O + (size_t)(row0 + ai * HALF + m * 16) * ldc + col0;
#pragma unroll
                for (int bj = 0; bj < 2; ++bj) { const f32x4 v0 = acc[ai][bj][m][0] * s, v1 = acc[ai][bj][m][1] * s;
                    u32x4 w; w.x = cvt_pk_bf16(v0[0], v0[1]); w.y = cvt_pk_bf16(v0[2], v0[3]); w.z = cvt_pk_bf16(v1[0], v1[1]); w.w = cvt_pk_bf16(v1[2], v1[3]);
                    *(u32x4*)(rowp + bj * HALF) = w; } }
    }
};
struct EpiFp8 {
    static constexpr bool PERM = true;
    unsigned char* O; int ldc;
    __device__ __forceinline__ void operator()(const f32x4 (&acc)[2][2][4][2], const Unit& u, int wr, int wc, int fr, int fq) const {
        const int row0 = u.pm * BM + wr * 64 + fr, col0 = u.pn * BM + wc * 32 + 8 * fq;
#pragma unroll
        for (int ai = 0; ai < 2; ++ai)
#pragma unroll
            for (int m = 0; m < 4; ++m) { unsigned char* rowp = O + (size_t)(row0 + ai * HALF + m * 16) * ldc + col0;
#pragma unroll
                for (int bj = 0; bj < 2; ++bj) { const f32x4 v0 = acc[ai][bj][m][0], v1 = acc[ai][bj][m][1];
                    int t0 = __builtin_amdgcn_cvt_pk_fp8_f32(v0[0], v0[1], 0, false); t0 = __builtin_amdgcn_cvt_pk_fp8_f32(v0[2], v0[3], t0, true);
                    int t1 = __builtin_amdgcn_cvt_pk_fp8_f32(v1[0], v1[1], 0, false); t1 = __builtin_amdgcn_cvt_pk_fp8_f32(v1[2], v1[3], t1, true);
                    *(u32x2*)(rowp + bj * HALF) = (u32x2){(unsigned)t0, (unsigned)t1}; } }
    }
};
struct EpiResF32 {
    static constexpr bool PERM = false;
    const float* R; float* C; int ldc;
    __device__ __forceinline__ void operator()(const f32x4 (&acc)[2][2][4][2], const Unit& u, int wr, int wc, int fr, int fq) const {
        const int row0 = u.pm * BM + wr * 64 + fr, col0 = u.pn * BM + wc * 32 + 4 * fq;
#pragma unroll
        for (int ai = 0; ai < 2; ++ai)
#pragma unroll
            for (int m = 0; m < 4; ++m) { const size_t off = (size_t)(row0 + ai * HALF + m * 16) * ldc + col0;
#pragma unroll
                for (int bj = 0; bj < 2; ++bj)
#pragma unroll
                    for (int n = 0; n < 2; ++n) { const f32x4 r = *(const f32x4*)(R + off + bj * HALF + n * 16); *(f32x4*)(C + off + bj * HALF + n * 16) = r + acc[ai][bj][m][n]; } }
    }
};
struct EpiSwiGLU {
    static constexpr bool PERM = true;
    unsigned char* O; int ldc;
    __device__ __forceinline__ void operator()(const f32x4 (&acc)[2][2][4][2], const Unit& u, int wr, int wc, int fr, int fq) const {
        const int row0 = u.pm * BM + wr * 64 + fr, col0 = u.pn * HALF + wc * 32 + 8 * fq;
#pragma unroll
        for (int ai = 0; ai < 2; ++ai)
#pragma unroll
            for (int m = 0; m < 4; ++m) { unsigned char* rowp = O + (size_t)(row0 + ai * HALF + m * 16) * ldc + col0;
                float o[8];
#pragma unroll
                for (int n = 0; n < 2; ++n)
#pragma unroll
                    for (int j = 0; j < 4; ++j) { const float g = acc[ai][0][m][n][j], up = acc[ai][1][m][n][j];
                        o[n * 4 + j] = g * __builtin_amdgcn_rcpf(1.f + __builtin_amdgcn_exp2f(-g * LOG2E)) * up; }
                u32x2 w; int t0 = __builtin_amdgcn_cvt_pk_fp8_f32(o[0], o[1], 0, false); t0 = __builtin_amdgcn_cvt_pk_fp8_f32(o[2], o[3], t0, true);
                int t1 = __builtin_amdgcn_cvt_pk_fp8_f32(o[4], o[5], 0, false); t1 = __builtin_amdgcn_cvt_pk_fp8_f32(o[6], o[7], t1, true);
                w.x = (unsigned)t0; w.y = (unsigned)t1; *(u32x2*)rowp = w; }
    }
};

struct GeoPlain {
    static constexpr bool GATHER = false;
    const bf16_t* A; const bf16_t* Bt; int KB; TileOrder ord;
    __device__ __forceinline__ bool next(int i, Unit& u) const { return ord.next(i, u); }
    __device__ __forceinline__ const char* a_ptr(const Unit& u) const { return (const char*)A + (size_t)u.pm * BM * KB; }
    __device__ __forceinline__ const char* b_ptr(const Unit& u) const { return (const char*)Bt + (size_t)u.pn * BM * KB; }
    __device__ __forceinline__ size_t hstepA() const { return (size_t)HALF * KB; }
    __device__ __forceinline__ size_t hstepB() const { return (size_t)HALF * KB; }
    __device__ __forceinline__ size_t istepA() const { return (size_t)64 * KB; }
    __device__ __forceinline__ size_t istepB() const { return (size_t)64 * KB; }
    __device__ __forceinline__ unsigned a_voff(int R, int C) const { return (unsigned)(R * KB + C * 2); }
    __device__ __forceinline__ unsigned b_voff(int R, int C) const { return (unsigned)(R * KB + C * 2); }
    __device__ __forceinline__ void fill_table(LAS unsigned*, const Unit&, int) const {}
};
struct GeoTokPerm {
    static constexpr bool GATHER = false;
    const bf16_t* A; const bf16_t* X; int KB; TileOrder ord;
    __device__ __forceinline__ bool next(int i, Unit& u) const { return ord.next(i, u); }
    __device__ __forceinline__ const char* a_ptr(const Unit& u) const { return (const char*)A + (size_t)u.pm * BM * KB; }
    __device__ __forceinline__ const char* b_ptr(const Unit& u) const { return (const char*)X + (size_t)u.pn * 32 * KB; }
    __device__ __forceinline__ size_t hstepA() const { return (size_t)HALF * KB; }
    __device__ __forceinline__ size_t hstepB() const { return (size_t)16 * KB; }
    __device__ __forceinline__ size_t istepA() const { return (size_t)64 * KB; }
    __device__ __forceinline__ size_t istepB() const { return (size_t)8 * KB; }
    __device__ __forceinline__ unsigned a_voff(int R, int C) const { return (unsigned)(R * KB + C * 2); }
    __device__ __forceinline__ unsigned b_voff(int R, int C) const { return (unsigned)(((R & 7) * SEQ + (R >> 3)) * KB + C * 2); }
    __device__ __forceinline__ void fill_table(LAS unsigned*, const Unit&, int) const {}
};
template <bool G> struct GeoExpert {
    static constexpr bool GATHER = G;
    const void* A; const void* Bt; int KB; size_t bexp;    const int* tok; TileOrder ord;
    __device__ __forceinline__ bool next(int i, Unit& u) const { return ord.next(i, u); }
    __device__ __forceinline__ const char* a_ptr(const Unit& u) const { return G ? (const char*)A : (const char*)A + (size_t)u.pm * BM * KB; }
    __device__ __forceinline__ const char* b_ptr(const Unit& u) const { return (const char*)Bt + (size_t)(u.pm >> 4) * bexp + (size_t)u.pn * BM * KB; }
    __device__ __forceinline__ size_t hstepA() const { return (size_t)HALF * KB; }
    __device__ __forceinline__ size_t hstepB() const { return (size_t)HALF * KB; }
    __device__ __forceinline__ size_t istepA() const { return (size_t)64 * KB; }
    __device__ __forceinline__ size_t istepB() const { return (size_t)64 * KB; }
    __device__ __forceinline__ unsigned a_voff(int R, int C) const { return (unsigned)(R * KB + C * 2); }
    __device__ __forceinline__ unsigned b_voff(int R, int C) const { return (unsigned)(R * KB + C * 2); }
    __device__ __forceinline__ void fill_table(LAS unsigned* tb, const Unit& u, int tid) const { if (G) { int t_ = tid; asm volatile("" : "+v"(t_));
#pragma unroll
        for (int i = 0; i < 2; ++i) { int R, C; stage_rc(t_ * 16 + i * 8192, R, C);
#pragma unroll
            for (int h = 0; h < 2; ++h) tb[h * 1024 + i * 512 + tid] = (unsigned)tok[u.pm * 256 + h * 128 + R] * (unsigned)KB + (unsigned)C * 2u; } } }
};

template <bool F8, class Epi, class Geo>
__device__ __forceinline__ void gemm_phase(LAS unsigned char* lds, LAS unsigned* tbl, const Geo& S, const Epi& E, int wave_s) {
    int tid_ = wave_s * 64 + lane_id_v(); asm volatile("" : "+v"(tid_));
    const int tid = tid_, wid = wave_s, lane = tid & 63, wr = wid >> 2, wc = wid & 3, fr = lane & 15, fq = lane >> 4;
    const int nt = S.KB / (BK * 2);
    unsigned voffA, voffB;
    { int R, C; stage_rc(tid * 16, R, C); const int Rb = Epi::PERM ? ((R & ~31) + perm32(R & 31)) : R; voffA = S.a_voff(R, C); voffB = S.b_voff(Rb, C); }
    const size_t istepA = S.istepA(), istepB = S.istepB();
    const size_t kstep = (size_t)(BK * 2);
    const size_t hstepA = S.hstepA(), hstepB = S.hstepB();
    const unsigned ldsw = (unsigned)wid * 1024u;
    const int aoff = lds_byte(wr * 64 + fr, fq * 8), boff = lds_byte(wc * 32 + fr, fq * 8);
    const LAS unsigned char* ldsB = lds + 4 * HTB + boff;
#define PG8_SA(b, h) (((b) * 2 + (h)) * HTB)
#define PG8_SB(b, h) ((4 + (b) * 2 + (h)) * HTB)
#define PG8_GLDS(bufoff, gptr, i_) __builtin_amdgcn_global_load_lds((const unsigned*)(gptr), (LAS unsigned*)(lds + (bufoff) + ldsw + (i_) * 8192), 16, 0, 0)
#define PG8_STAGE_B(bufoff, gbase) do { PG8_GLDS(bufoff, (const char*)(gbase) + voffB, 0); PG8_GLDS(bufoff, (const char*)(gbase) + istepB + voffB, 1); } while (0)
#define PG8_STAGE_A(bufoff, gbase, h, nx) do { if constexpr (Geo::GATHER) { const LAS unsigned* _tb = tbl + (((ui + ((nx) ? 1 : 0)) & 1) * 2048) + (h) * 1024 + tid; \
        const unsigned _v0 = _tb[0], _v1 = _tb[512]; PG8_GLDS(bufoff, (const char*)(gbase) + _v0, 0); PG8_GLDS(bufoff, (const char*)(gbase) + _v1, 1); } \
        else { PG8_GLDS(bufoff, (const char*)(gbase) + (h) * hstepA + voffA, 0); PG8_GLDS(bufoff, (const char*)(gbase) + (h) * hstepA + istepA + voffA, 1); } } while (0)
#define PG8_LD16(off) (*(const LAS i32x4*)(lds + (off)))
#define PG8_LDA(dst, b, h) do { _Pragma("unroll") for (int m = 0; m < 4; ++m) dst[m] = __builtin_shufflevector(PG8_LD16(PG8_SA(b, h) + aoff + m * 2048), PG8_LD16(PG8_SA(b, h) + aoff + m * 2048 + 1024), 0, 1, 2, 3, 4, 5, 6, 7); } while (0)
#define PG8_LDB(dst, b, h) do { _Pragma("unroll") for (int n = 0; n < 2; ++n) dst[n] = __builtin_shufflevector(*(const LAS i32x4*)(ldsB + ((b) * 2 + (h)) * HTB + n * 2048), *(const LAS i32x4*)(ldsB + ((b) * 2 + (h)) * HTB + n * 2048 + 1024), 0, 1, 2, 3, 4, 5, 6, 7); } while (0)
#define PG8_LO(v) __builtin_bit_cast(bf16x8, __builtin_shufflevector(v, v, 0, 1, 2, 3))
#define PG8_HI(v) __builtin_bit_cast(bf16x8, __builtin_shufflevector(v, v, 4, 5, 6, 7))
#define PG8_MMA(ai, bj, At, Bt) do { __builtin_amdgcn_s_setprio(1); _Pragma("unroll") for (int m = 0; m < 4; ++m) _Pragma("unroll") for (int n = 0; n < 2; ++n) { \
        if constexpr (F8) { acc[ai][bj][m][n] = __builtin_amdgcn_mfma_scale_f32_16x16x128_f8f6f4(Bt[n], At[m], acc[ai][bj][m][n], 0, 0, 1, F8_SCALES, 0, F8_SCALES); } \
        else { acc[ai][bj][m][n] = __builtin_amdgcn_mfma_f32_16x16x32_bf16(PG8_LO(Bt[n]), PG8_LO(At[m]), acc[ai][bj][m][n], 0, 0, 0); \
               acc[ai][bj][m][n] = __builtin_amdgcn_mfma_f32_16x16x32_bf16(PG8_HI(Bt[n]), PG8_HI(At[m]), acc[ai][bj][m][n], 0, 0, 0); } } \
        __builtin_amdgcn_s_setprio(0); } while (0)
#define PG8_WAIT_V(n) asm volatile("s_waitcnt vmcnt(" #n ")" ::: "memory")
#define PG8_WAIT_L(n) asm volatile("s_waitcnt lgkmcnt(" #n ")" ::: "memory")
#define PG8_BAR __builtin_amdgcn_s_barrier()
#define PG8_SCHED __builtin_amdgcn_sched_barrier(0)
    Unit cur, nxt; int ui = 0;
    if (!S.next(0, cur)) return;
    f32x4 acc[2][2][4][2];
#pragma unroll
    for (int a = 0; a < 2; ++a)
#pragma unroll
        for (int b = 0; b < 2; ++b)
#pragma unroll
            for (int m = 0; m < 4; ++m)
#pragma unroll
                for (int n = 0; n < 2; ++n) acc[a][b][m][n] = (f32x4){0.f, 0.f, 0.f, 0.f};
    i32x8 At[4], B0[2], B1[2];
    const char* cA = S.a_ptr(cur); const char* cB = S.b_ptr(cur);
    if constexpr (Geo::GATHER) {
        S.fill_table(tbl, cur, tid);
        Unit u1; if (S.next(1, u1)) S.fill_table(tbl + 2048, u1, tid);
        asm volatile("s_waitcnt vmcnt(0) lgkmcnt(0)" ::: "memory"); PG8_BAR; asm volatile("" ::: "memory");
    }
    PG8_STAGE_B(PG8_SB(0, 0), cB); PG8_STAGE_B(PG8_SB(0, 1), cB + hstepB); PG8_STAGE_A(PG8_SA(0, 0), cA, 0, false); PG8_STAGE_A(PG8_SA(0, 1), cA, 1, false);
    if (wr == 1) PG8_BAR;
    PG8_WAIT_V(2); PG8_BAR;
    PG8_STAGE_B(PG8_SB(1, 0), cB + kstep); PG8_STAGE_A(PG8_SA(1, 0), cA + kstep, 0, false); PG8_STAGE_B(PG8_SB(1, 1), cB + hstepB + kstep);
    PG8_WAIT_V(6); PG8_BAR;
    for (;;) {
        const bool has_next = S.next(ui + 1, nxt);
        const char* nA = has_next ? S.a_ptr(nxt) : cA; const char* nB = has_next ? S.b_ptr(nxt) : cB;
#pragma clang loop unroll(disable)
        for (int t = 0; t < nt; t += 2) {
            const bool last = (t == nt - 2);
            const bool lastn = last && has_next;
            const char* a1 = cA + (size_t)(t + 1) * kstep;
            const char* a2 = last ? nA : cA + (size_t)(t + 2) * kstep; const char* b2 = last ? nB : cB + (size_t)(t + 2) * kstep;
            const char* a3 = a2 + kstep; const char* b3 = b2 + kstep;
            if constexpr (Geo::GATHER) { if (t == 2 && ui > 0) { Unit u2; if (S.next(ui + 1, u2)) S.fill_table(tbl + (((ui + 1) & 1) * 2048), u2, tid); } }
            PG8_LDB(B0, 0, 0); PG8_LDB(B1, 0, 1); PG8_SCHED; PG8_LDA(At, 0, 0); PG8_STAGE_A(PG8_SA(1, 1), a1, 1, false);
            PG8_WAIT_V(8); PG8_WAIT_L(0); PG8_BAR; PG8_MMA(0, 0, At, B0); PG8_MMA(0, 1, At, B1); PG8_BAR; PG8_SCHED;
            PG8_LDA(At, 0, 1); PG8_STAGE_B(PG8_SB(0, 0), b2); PG8_STAGE_B(PG8_SB(0, 1), b2 + hstepB); PG8_STAGE_A(PG8_SA(0, 0), a2, 0, lastn);
            PG8_WAIT_V(8); PG8_WAIT_L(0); PG8_BAR; PG8_MMA(1, 0, At, B0); PG8_MMA(1, 1, At, B1); PG8_BAR; PG8_SCHED;
            PG8_LDB(B0, 1, 0); PG8_LDB(B1, 1, 1); PG8_SCHED; PG8_LDA(At, 1, 0); PG8_STAGE_A(PG8_SA(0, 1), a2, 1, lastn);
            PG8_WAIT_V(8); PG8_WAIT_L(0); PG8_BAR; PG8_MMA(0, 0, At, B0); PG8_MMA(0, 1, At, B1); PG8_BAR; PG8_SCHED;
            PG8_LDA(At, 1, 1); PG8_STAGE_B(PG8_SB(1, 0), b3); PG8_STAGE_B(PG8_SB(1, 1), b3 + hstepB); PG8_STAGE_A(PG8_SA(1, 0), a3, 0, lastn);
            PG8_WAIT_V(8); PG8_WAIT_L(0); PG8_BAR; PG8_MMA(1, 0, At, B0); PG8_MMA(1, 1, At, B1); PG8_BAR; PG8_SCHED;
        }
        if (wr == 0) PG8_BAR;
        { const int l_e = lane_id_v();
          E(acc, cur, wr, wc, l_e & 15, l_e >> 4); }
        if (!has_next) break;
#pragma unroll
        for (int a = 0; a < 2; ++a)
#pragma unroll
            for (int b = 0; b < 2; ++b)
#pragma unroll
                for (int m = 0; m < 4; ++m)
#pragma unroll
                    for (int n = 0; n < 2; ++n) acc[a][b][m][n] = (f32x4){0.f, 0.f, 0.f, 0.f};
        cur = nxt; cA = nA; cB = nB; ++ui;
        if (wr == 1) PG8_BAR;
    }
    PG8_WAIT_V(0);
    PG8_BAR;
#undef PG8_SA
#undef PG8_SB
#undef PG8_GLDS
#undef PG8_STAGE_B
#undef PG8_STAGE_A
#undef PG8_LDA
#undef PG8_LDB
#undef PG8_LD16
#undef PG8_LO
#undef PG8_HI
#undef PG8_MMA
#undef PG8_WAIT_V
#undef PG8_WAIT_L
#undef PG8_BAR
#undef PG8_SCHED
}
}

namespace att {
constexpr int KVBLK = 64, LDQKV = ACOLS;
constexpr int SHM_V = KVBLK * 128 * 2, SHM_K = KVBLK * 64 * 2, OFF_V = 0, OFF_K = 2 * SHM_V, OFF_WS = OFF_K + 2 * SHM_K, LDS_TOTAL = OFF_WS + 8 * 64 * 4;
constexpr float THR = 8.f;
#define KSWZ64(row, colB) ((row) * 128 + ((colB) ^ ((((row) >> 1) & 7) << 4)))
#define SBAR() __builtin_amdgcn_sched_barrier(0)
__device__ __forceinline__ int crow(int r, int hi) { return (r & 3) + 8 * (r >> 2) + 4 * hi; }
__device__ __forceinline__ unsigned cvtpk(float lo, float hi) { unsigned r; asm volatile("v_cvt_pk_bf16_f32 %0, %1, %2" : "=v"(r) : "v"(lo), "v"(hi)); return r; }
__device__ __forceinline__ int v_st(int k, int c) { const int kk = k;     return ((kk >> 3) * 4 + (c >> 5)) * 512 + ((kk & 7) * 32 + (c & 31)) * 2; }
__device__ __forceinline__ int v_rd_base(int lane) { return ((lane & 3) << 3) | (((lane >> 2) & 3) << 6) | (((lane >> 4) & 1) << 5) | (((lane >> 5) & 1) << 8); }
constexpr int v_rd_off(int d0, int ks, int half) { return d0 * 512 + ks * 4096 + half * 2048; }
__device__ __forceinline__ float fadd_s(float a, float b) { float r; asm("v_add_f32 %0, %1, %2" : "=v"(r) : "v"(a), "v"(b)); return r; }
template <int OFF> __device__ __forceinline__ v4i16_t tr_read(int vb) { v4i16_t r; asm volatile("ds_read_b64_tr_b16 %0, %1 offset:%2" : "=&v"(r) : "v"(vb), "i"(OFF) : "memory"); return r; }
template <int D0> __device__ __forceinline__ void pv_one(f32x16& od, int vb, bf16x8 pa0, bf16x8 pa1, bf16x8 pa2, bf16x8 pa3) {
    const v4i16_t l0 = tr_read<v_rd_off(D0, 0, 0)>(vb), h0 = tr_read<v_rd_off(D0, 0, 1)>(vb), l1 = tr_read<v_rd_off(D0, 1, 0)>(vb), h1 = tr_read<v_rd_off(D0, 1, 1)>(vb);
    const v4i16_t l2 = tr_read<v_rd_off(D0, 2, 0)>(vb), h2 = tr_read<v_rd_off(D0, 2, 1)>(vb), l3 = tr_read<v_rd_off(D0, 3, 0)>(vb), h3 = tr_read<v_rd_off(D0, 3, 1)>(vb);
    asm volatile("s_waitcnt lgkmcnt(0)" ::: "memory"); SBAR();
#define PK(L, H) (bf16x8){L[0], L[1], L[2], L[3], H[0], H[1], H[2], H[3]}
    od = __builtin_amdgcn_mfma_f32_32x32x16_bf16(pa0, PK(l0, h0), od, 0, 0, 0);
    od = __builtin_amdgcn_mfma_f32_32x32x16_bf16(pa1, PK(l1, h1), od, 0, 0, 0);
    od = __builtin_amdgcn_mfma_f32_32x32x16_bf16(pa2, PK(l2, h2), od, 0, 0, 0);
    od = __builtin_amdgcn_mfma_f32_32x32x16_bf16(pa3, PK(l3, h3), od, 0, 0, 0);
#undef PK
}
__device__ __forceinline__ void pv_d0(f32x16* o, int vb, bf16x8 pa0, bf16x8 pa1, bf16x8 pa2, bf16x8 pa3) {
    pv_one<0>(o[0], vb, pa0, pa1, pa2, pa3); pv_one<1>(o[1], vb, pa0, pa1, pa2, pa3); pv_one<2>(o[2], vb, pa0, pa1, pa2, pa3); pv_one<3>(o[3], vb, pa0, pa1, pa2, pa3);
}
__device__ __forceinline__ void qk_mfma(f32x16& p0, f32x16& p1, const char* Ks, const bf16x8* qr, const f32x16& negm, int kb) {
#pragma unroll
    for (int d0 = 0; d0 < 4; ++d0) { int x_ = d0 * 32; asm volatile("" : "+s"(x_));
        const bf16x8 b0 = *reinterpret_cast<const bf16x8*>(Ks + (kb ^ x_));
        const bf16x8 b1 = *reinterpret_cast<const bf16x8*>(Ks + (kb ^ x_) + 32 * 128);
        if (d0 == 0) { p0 = __builtin_amdgcn_mfma_f32_32x32x16_bf16(b0, qr[0], negm, 0, 0, 0); p1 = __builtin_amdgcn_mfma_f32_32x32x16_bf16(b1, qr[0], negm, 0, 0, 0); }
        else { p0 = __builtin_amdgcn_mfma_f32_32x32x16_bf16(b0, qr[d0], p0, 0, 0, 0); p1 = __builtin_amdgcn_mfma_f32_32x32x16_bf16(b1, qr[d0], p1, 0, 0, 0); } }
}
__device__ __forceinline__ void rowmaxSM(f32x16& p0, f32x16& p1, f32x16& cl, float& alpha, bool diag, float a0, float a1, int dd, float slope2) {
    asm volatile("" : "+v"(a0), "+v"(a1), "+v"(dd), "+v"(p0), "+v"(p1));
    if (diag) {
        const int h8 = (lane_id_v() >> 5) * 8, y = dd - 32, w0 = dd - h8, w1 = y - h8;
#pragma unroll
        for (int r = 0; r < 16; ++r) { const int c2 = 2 * ((r & 3) + 8 * (r >> 2)); p0[r] = fmaf(-slope2, (float)max(dd, c2 - w0), p0[r]); p1[r] = fmaf(-slope2, (float)max(y, c2 - w1), p1[r]); }
    } else {
#pragma unroll
        for (int r = 0; r < 16; ++r) { p0[r] = fadd_s(p0[r], a0); p1[r] = fadd_s(p1[r], a1); }
    }
    float pmax = p0[0];
#pragma unroll
    for (int r = 1; r < 16; ++r) pmax = fmaxf(pmax, p0[r]);
#pragma unroll
    for (int r = 0; r < 16; ++r) pmax = fmaxf(pmax, p1[r]);
    { auto rr = __builtin_amdgcn_permlane32_swap(__float_as_uint(pmax), __float_as_uint(pmax), false, false); pmax = fmaxf(__uint_as_float(rr[0]), __uint_as_float(rr[1])); }
    if (__builtin_expect(!__any(pmax > THR), 1)) { alpha = 1.f; }
    else { const float dl = fmaxf(pmax, 0.f); alpha = __builtin_amdgcn_exp2f(-dl);
#pragma unroll
        for (int r = 0; r < 16; ++r) { p0[r] -= dl; p1[r] -= dl; cl[r] -= dl; } }
}
__device__ __forceinline__ float rowsumSM(f32x16& p0, f32x16& p1) {
    asm volatile("s_nop 0" : "+v"(p0), "+v"(p1));
    float s0 = fadd_s(p0[0], p1[0]), s1 = fadd_s(p0[1], p1[1]), s2 = fadd_s(p0[2], p1[2]), s3 = fadd_s(p0[3], p1[3]);
#pragma unroll
    for (int r = 4; r < 16; r += 4) { s0 = fadd_s(s0, p0[r]); s1 = fadd_s(s1, p0[r + 1]); s2 = fadd_s(s2, p0[r + 2]); s3 = fadd_s(s3, p0[r + 3]);
                                      s0 = fadd_s(s0, p1[r]); s1 = fadd_s(s1, p1[r + 1]); s2 = fadd_s(s2, p1[r + 2]); s3 = fadd_s(s3, p1[r + 3]); }
    float ps = fadd_s(fadd_s(s0, s1), fadd_s(s2, s3));
    return ps;
}
__device__ __forceinline__ float specSM(f32x16& p0, f32x16& p1, f32x16& cl, float& alpha, float a0, float a1) {
    asm volatile("" : "+v"(a0), "+v"(a1), "+v"(p0), "+v"(p1));
#pragma unroll
    for (int r = 0; r < 16; ++r) { p0[r] = __builtin_amdgcn_exp2f(fadd_s(p0[r], a0)); p1[r] = __builtin_amdgcn_exp2f(fadd_s(p1[r], a1)); }
    float ps = rowsumSM(p0, p1);
    if (__builtin_expect(!__any(ps > 256.f), 1)) { alpha = 1.f; }
    else { float em = p0[0];
#pragma unroll
        for (int r = 1; r < 16; ++r) em = fmaxf(em, p0[r]);
#pragma unroll
        for (int r = 0; r < 16; ++r) em = fmaxf(em, p1[r]);
        { auto rr = __builtin_amdgcn_permlane32_swap(__float_as_uint(em), __float_as_uint(em), false, false); em = fmaxf(__uint_as_float(rr[0]), __uint_as_float(rr[1])); }
        const float dl = fmaxf(__builtin_amdgcn_logf(em), 0.f); alpha = __builtin_amdgcn_exp2f(-dl);
#pragma unroll
        for (int r = 0; r < 16; ++r) { p0[r] *= alpha; p1[r] *= alpha; cl[r] -= dl; }
        ps *= alpha; }
    return ps;
}
__device__ __forceinline__ void packSM(f32x16& p0, f32x16& p1, bf16x8& pa0, bf16x8& pa1, bf16x8& pa2, bf16x8& pa3) {
#define PK4(P, BASE, OUT) do { const u32x4 w = {cvtpk(P[BASE + 0], P[BASE + 1]), cvtpk(P[BASE + 2], P[BASE + 3]), cvtpk(P[BASE + 4], P[BASE + 5]), cvtpk(P[BASE + 6], P[BASE + 7])}; \
        OUT = __builtin_bit_cast(bf16x8, w); } while (0)
    PK4(p0, 0, pa0); PK4(p0, 8, pa1); PK4(p1, 0, pa2); PK4(p1, 8, pa3);
#undef PK4
}
__device__ __forceinline__ void pass(f32x16 (&o)[4], const bf16_t* Qw, const bf16_t* Kh, const bf16_t* Vh, int qpos, int qb, float slope2, char* lds, int tid, int nL, int NT, bool spec) {
    const int wid = tid >> 6, lane = tid & 63, r32 = lane & 31, hi = lane >> 5;
    const int g = __builtin_amdgcn_readfirstlane(wid >> 2);
    const GAS bf16_t* Kg = (const GAS bf16_t*)(((uintptr_t)(unsigned)__builtin_amdgcn_readfirstlane((int)((uintptr_t)Kh >> 32)) << 32) | (unsigned)__builtin_amdgcn_readfirstlane((int)(uintptr_t)Kh));
    const GAS bf16_t* Vg = (const GAS bf16_t*)(((uintptr_t)(unsigned)__builtin_amdgcn_readfirstlane((int)((uintptr_t)Vh >> 32)) << 32) | (unsigned)__builtin_amdgcn_readfirstlane((int)(uintptr_t)Vh));
    char* V_lds = lds + OFF_V; char* K_lds = lds + OFF_K;
    float* ws = (float*)(lds + OFF_WS) + wid * 64; float* li_l = ws; float* al_l = ws + 32;
    float l_reg = 0.f; bf16x8 qr[4];
#pragma unroll
    for (int d = 0; d < 4; ++d)
#pragma unroll
        for (int r = 0; r < 16; ++r) o[d][r] = 0.f;
    f32x16 cl;
    { const float h4s = slope2 * (float)((lane_id_v() >> 5) * 4);
#pragma unroll
      for (int r = 0; r < 16; ++r) cl[r] = fmaf(slope2, (float)((r & 3) + 8 * (r >> 2)), h4s); }
#pragma unroll
    for (int d0 = 0; d0 < 4; ++d0) qr[d0] = *reinterpret_cast<const bf16x8*>(Qw + d0 * 16);
    const int kr = tid >> 3, kc = (tid & 7) * 8, kst = KSWZ64(kr, kc * 2);
    const int sr = tid >> 4, sc = (tid & 15) * 8, vst0 = v_st(sr, sc), vst1 = v_st(32 + sr, sc);
    const int vb0 = (int)(uintptr_t)V_lds + v_rd_base(lane);
    const int kb = KSWZ64(r32, hi * 16);
    const unsigned voff0 = (unsigned)(sr * LDQKV + sc), koff0 = (unsigned)(kr * LDQKV + kc);
    const unsigned voffU = (unsigned)((63 - sr) * LDQKV + sc), koffU = (unsigned)((63 - kr) * LDQKV + kc);
    struct { bf16x8 vs0, vs1, ks; } st_[2];
    const int nd = 4 * qb;
#define KTF(i) ((i) < 4 ? nd + (i) : ((i) < 4 + nL ? nd + 3 - (i) : nd + (i) - nL))
    int ktv; { const int i_ = min(lane, NT - 1); ktv = KTF(i_); }
#define KT(i) __builtin_amdgcn_readlane(ktv, (i))
#define KTC(i) KT(min((i), NT - 1))
#define SLOAD(i, kt, vt) do { const int kt_ = (kt), vt_ = (vt); const bool ku_ = kt_ > nd + 3, vu_ = vt_ > nd + 3; \
        const unsigned k0_ = (unsigned)(kt_ * KVBLK * LDQKV) + (ku_ ? koffU : koff0), v0_ = (unsigned)(vt_ * KVBLK * LDQKV) + (vu_ ? voffU : voff0), v1_ = vu_ ? v0_ - 32u * LDQKV : v0_ + 32u * LDQKV; \
        st_[i].vs0 = *(const GAS bf16x8*)(Vg + v0_); st_[i].vs1 = *(const GAS bf16x8*)(Vg + v1_); st_[i].ks = *(const GAS bf16x8*)(Kg + k0_); } while (0)
#define SWRITE(i, kbo, vbo) do { *(bf16x8*)(V_lds + (vbo) + vst0) = st_[i].vs0; *(bf16x8*)(V_lds + (vbo) + vst1) = st_[i].vs1; *(bf16x8*)(K_lds + (kbo) + kst) = st_[i].ks; } while (0)
#define SWAIT() asm volatile("s_waitcnt vmcnt(3)" ::: "memory")
#define RESC(a) do { if (__any((a) < 1.f)) { if (hi == 0) al_l[r32] = (a); asm volatile("s_waitcnt lgkmcnt(0)" ::: "memory"); \
        _Pragma("unroll") for (int d = 0; d < 4; ++d) _Pragma("unroll") for (int r = 0; r < 16; ++r) o[d][r] *= al_l[crow(r, hi)]; } } while (0)
#define BAR() do { SBAR(); __syncthreads(); SBAR(); } while (0)
#define SSLOT(PAR, t) do { const int u_ = (t) + g; SWAIT(); SWRITE(PAR, ((PAR + 1 + g) & 1) * SHM_K, ((PAR + g) & 1) * SHM_V); SLOAD(PAR, KTC(u_ + 3), KTC(u_ + 2)); SBAR(); \
        const int tl_ = KT(t); const int dd_ = qpos - tl_ * KVBLK; const float a0_ = slope2 * (float)(tl_ > nd ? dd_ - 63 : -dd_); \
        float al_, ps_; \
        if ((t) < 4 || !spec) { rowmaxSM(p0, p1, cl, al_, (t) < 4, a0_, a0_ + 32.f * slope2, dd_, slope2); \
            _Pragma("unroll") for (int r = 0; r < 16; ++r) { p0[r] = __builtin_amdgcn_exp2f(p0[r]); p1[r] = __builtin_amdgcn_exp2f(p1[r]); } ps_ = rowsumSM(p0, p1); } \
        else ps_ = specSM(p0, p1, cl, al_, a0_, a0_ + 32.f * slope2); \
        RESC(al_); l_reg = l_reg * al_ + ps_; packSM(p0, p1, pa0, pa1, pa2, pa3); } while (0)
    f32x16 p0, p1; bf16x8 pa0, pa1, pa2, pa3;
    {
        const bf16x8 k0r = *(const GAS bf16x8*)(Kg + ((unsigned)(nd * KVBLK * LDQKV) + koff0));
        SLOAD(0, KTC(g + 1), KTC(g)); SLOAD(1, KTC(2 - g), KTC(1 - g));
        asm volatile("s_waitcnt vmcnt(6)" ::: "memory");
        *(bf16x8*)(K_lds + kst) = k0r;
        __syncthreads();
    }
    if (g) { asm volatile("s_waitcnt vmcnt(0)" ::: "memory"); SWRITE(1, SHM_K, 0); SLOAD(1, KTC(3), KTC(2)); BAR(); }
    qk_mfma(p0, p1, K_lds, qr, cl, kb);
    for (int t = 0; t < NT; t += 2) {
        BAR(); SSLOT(0, t); BAR();
        qk_mfma(p0, p1, K_lds + SHM_K, qr, cl, kb); SBAR(); pv_d0(o, vb0, pa0, pa1, pa2, pa3);
        BAR(); SSLOT(1, t + 1); BAR();
        if (t + 2 < NT) { qk_mfma(p0, p1, K_lds, qr, cl, kb); SBAR(); }
        pv_d0(o, vb0 + SHM_V, pa0, pa1, pa2, pa3);
    }
    if (!g) BAR();
    { auto rr = __builtin_amdgcn_permlane32_swap(__float_as_uint(l_reg), __float_as_uint(l_reg), false, false); l_reg = __uint_as_float(rr[0]) + __uint_as_float(rr[1]); }
    if (hi == 0) li_l[r32] = l_reg; asm volatile("s_waitcnt lgkmcnt(0)" ::: "memory");
#pragma unroll
    for (int r = 0; r < 16; ++r) { const float rl = __builtin_amdgcn_rcpf(li_l[crow(r, hi)]);
#pragma unroll
        for (int d = 0; d < 4; ++d) o[d][r] *= rl; }
    __syncthreads();
#undef KT
#undef KTF
#undef KTC
#undef SLOAD
#undef SWRITE
#undef SWAIT
#undef RESC
#undef BAR
#undef SSLOT
}
#undef SBAR
}

typedef GAS unsigned gu32;
#define XB_TMO      128
#define XB_XCNT(j)  (256  + 64 * (j))
#define XB_XSUB(j)  (1280 + 64 * (j))
#define XB_XGEN(j)  (2304 + 64 * (j))
#define XB_TOP      3328
#define XB_TOPGEN   3392
#define XCD_BAR_WORDS 3456
#define XB_SPIN_CAP (1u << 23)
__device__ __forceinline__ unsigned xb_ld(unsigned* p)              { return __hip_atomic_load(p, __ATOMIC_RELAXED, __HIP_MEMORY_SCOPE_AGENT); }
__device__ __forceinline__ unsigned xb_add(unsigned* p, unsigned v) { return __hip_atomic_fetch_add(p, v, __ATOMIC_RELAXED, __HIP_MEMORY_SCOPE_AGENT); }
__device__ __forceinline__ unsigned xb_xcc_id() { return (unsigned)__builtin_amdgcn_s_getreg((3 << 11) | 20) & 0xFu; }
#define XB_SPIN(cond, bar) do { unsigned _sp = 0; while (cond) { __builtin_amdgcn_s_sleep(1); \
    if ((++_sp & 255u) == 0u) { if (xb_ld(&(bar)[XB_TMO])) break; if (_sp > XB_SPIN_CAP) { atomicAdd(&(bar)[XB_TMO], 1u); break; } } } } while (0)
struct XcdBarrier { unsigned* bar; unsigned x; volatile LAS unsigned* st; int wave; };
__device__ __forceinline__ XcdBarrier xcd_barrier_post(unsigned* bar, volatile LAS unsigned* st, int wave) {
    XcdBarrier b; b.bar = bar; b.x = xb_xcc_id(); b.st = st; b.wave = wave;
    if (wave == 0 && lane_id_v() == 0) (void)xb_add(&bar[XB_XCNT(b.x)], 1u);
    return b;
}
__device__ __forceinline__ void xcd_barrier_complete(unsigned* bar, unsigned x, unsigned& nloc, unsigned& nx) {
    const unsigned G = gridDim.x * gridDim.y * gridDim.z;
    unsigned sum, cnt, mine, sp = 0u;
    for (;;) {
        sum = 0u; cnt = 0u; mine = 0u;
#pragma unroll
        for (unsigned j = 0; j < 16; ++j) { const unsigned c = xb_ld(&bar[XB_XCNT(j)]); sum += c; cnt += (c > 0u) ? 1u : 0u; mine = (j == x) ? c : mine; }
        if (sum == G) break;
        __builtin_amdgcn_s_sleep(1);
        if ((++sp & 255u) == 0u) { if (xb_ld(&bar[XB_TMO])) break; if (sp > XB_SPIN_CAP) { atomicAdd(&bar[XB_TMO], 1u); break; } }
    }
    nloc = mine > 0u ? mine : 1u; nx = cnt > 0u ? cnt : 1u;
}
__device__ __forceinline__ void xcd_barrier(const XcdBarrier& b) {
    asm volatile("s_waitcnt vmcnt(0)" ::: "memory");
    __syncthreads();
    if (b.wave == 0 && lane_id_v() == 0) {
        unsigned* bar = b.bar;
        __builtin_amdgcn_s_waitcnt(0);
        unsigned nloc = b.st[0], nx = b.st[1];
        if (nloc == 0u) { xcd_barrier_complete(bar, b.x, nloc, nx); b.st[0] = nloc; b.st[1] = nx; }
        const unsigned old = xb_add(&bar[XB_XSUB(b.x)], 1u);
        const unsigned gen = old / nloc;
        if (old + 1u == (gen + 1u) * nloc) {
            __builtin_amdgcn_fence(__ATOMIC_RELEASE, "agent");
            asm volatile("s_waitcnt vmcnt(0)" ::: "memory");
            const unsigned og = xb_add(&bar[XB_TOP], 1u);
            const unsigned tg = og / nx;
            if (og + 1u == (tg + 1u) * nx) xb_add(&bar[XB_TOPGEN], 1u);
            else XB_SPIN(xb_ld(&bar[XB_TOPGEN]) == tg, bar);
            __builtin_amdgcn_fence(__ATOMIC_ACQUIRE, "agent");
            xb_add(&bar[XB_XGEN(b.x)], 1u);
            asm volatile("s_waitcnt vmcnt(0)" ::: "memory");
        } else {
            XB_SPIN(xb_ld(&bar[XB_XGEN(b.x)]) == gen, bar);
            __builtin_amdgcn_fence(__ATOMIC_ACQUIRE, "agent");
            asm volatile("s_waitcnt vmcnt(0)" ::: "memory");
        }
    }
    __syncthreads();
}

template <bool F8>
__device__ __forceinline__ void p0_transpose_item(const float* W, int K, int N, void* WTv, int k0, int n0, int orow0, LAS float* scr, int lane) {
#pragma unroll
    for (int i = 0; i < 8; ++i) { const int kk = 8 * i + (lane >> 3), n4 = (lane & 7) * 4; const f32x4 v = *(const GAS f32x4*)(W + (size_t)(k0 + kk) * N + n0 + n4);
        LAS float* d = scr + kk * 33 + n4; d[0] = v.x; d[1] = v.y; d[2] = v.z; d[3] = v.w; }
    LDS_WAIT(); asm volatile("" ::: "memory");
    const int c = lane & 7;
#pragma unroll
    for (int j = 0; j < 4; ++j) { const int n = (lane >> 3) + 8 * j; const LAS float* s = scr + (8 * c) * 33 + n;
        if constexpr (F8) {
            int t0 = __builtin_amdgcn_cvt_pk_fp8_f32(s[0 * 33] * 32.f, s[1 * 33] * 32.f, 0, false); t0 = __builtin_amdgcn_cvt_pk_fp8_f32(s[2 * 33] * 32.f, s[3 * 33] * 32.f, t0, true);
            int t1 = __builtin_amdgcn_cvt_pk_fp8_f32(s[4 * 33] * 32.f, s[5 * 33] * 32.f, 0, false); t1 = __builtin_amdgcn_cvt_pk_fp8_f32(s[6 * 33] * 32.f, s[7 * 33] * 32.f, t1, true);
            *(GAS u32x2*)((unsigned char*)WTv + (size_t)(orow0 + n) * K + k0 + 8 * c) = (u32x2){(unsigned)t0, (unsigned)t1};
        } else {
            u32x4 o; o.x = pk2(s[0 * 33], s[1 * 33]); o.y = pk2(s[2 * 33], s[3 * 33]); o.z = pk2(s[4 * 33], s[5 * 33]); o.w = pk2(s[6 * 33], s[7 * 33]);
            *(GAS u32x4*)((bf16_t*)WTv + (size_t)(orow0 + n) * K + k0 + 8 * c) = o; } }
    LDS_WAIT(); asm volatile("" ::: "memory");
}

struct Args { const float* in[25]; float* out; unsigned char* ws; };
constexpr int P0_I_IN = (DM / 64) * (INC / 32), P0_I_OUT = (DM / 64) * (DM / 32), P0_I_GU = (DM / 64) * (FF / 32), P0_I_DN = (FF / 64) * (DM / 32);
constexpr int P0_NITEMS = P0_I_IN + P0_I_OUT + NE * (2 * P0_I_GU + P0_I_DN), P0_NDEF = 10 * (2 * P0_I_GU + P0_I_DN), P0_CHUNK = 4;
__device__ __forceinline__ void p0_weight_item(const Args& args, int it, bf16_t* WIN, bf16_t* WOUT, unsigned char* WGU, unsigned char* WD, LAS float* scr, int lane) {
    int r = it;
    if (r < P0_I_IN) { const int nblk = INC / 32, kb = r / nblk, nb = r % nblk; p0_transpose_item<false>(args.in[2], DM, INC, WIN, 64 * kb, 32 * nb, 32 * nb, scr, lane); return; } r -= P0_I_IN;
    if (r < P0_I_OUT) { const int nblk = DM / 32, kb = r / nblk, nb = r % nblk; p0_transpose_item<false>(args.in[18], DM, DM, WOUT, 64 * kb, 32 * nb, 32 * nb, scr, lane); return; } r -= P0_I_OUT;
    const int e = r / (2 * P0_I_GU + P0_I_DN); r -= e * (2 * P0_I_GU + P0_I_DN);
    if (r < 2 * P0_I_GU) { const int up = r >= P0_I_GU; if (up) r -= P0_I_GU; const int nblk = FF / 32, kb = r / nblk, nb = r % nblk, f0 = 32 * nb;
        const int orow = (f0 >> 7) * 256 + up * 128 + (f0 & 127);
        p0_transpose_item<true>(args.in[up ? 22 : 21] + (size_t)e * DM * FF, DM, FF, WGU + (size_t)e * 2 * FF * DM, 64 * kb, f0, orow, scr, lane); return; }
    r -= 2 * P0_I_GU;
    { const int nblk = DM / 32, kb = r / nblk, nb = r % nblk; p0_transpose_item<true>(args.in[23] + (size_t)e * FF * DM, FF, DM, WD + (size_t)e * DM * FF, 64 * kb, 32 * nb, 32 * nb, scr, lane); }
}

__global__ void __launch_bounds__(512, 2) mega_fwd(Args args) {
    extern __shared__ __attribute__((aligned(16))) unsigned char lds_raw[];
    LAS unsigned char* lds = (LAS unsigned char*)lds_raw;
    volatile LAS unsigned* MISC = (volatile LAS unsigned*)(lds + MISC_OFF);
    const int G = gridDim.x, bx = blockIdx.x, NGW = G * 8;
    const int wave_s = __builtin_amdgcn_readfirstlane(threadIdx.x >> 6);
    unsigned char* ws = args.ws;
    gu32* ctl = (gu32*)(ws + WS_CTL);
    const float* x = args.in[0];
    float* out = args.out;
    unsigned char* WGU = ws + WS_WGU; unsigned char* WD = ws + WS_WD; bf16_t* WIN = (bf16_t*)(ws + WS_WIN); bf16_t* WOUT = (bf16_t*)(ws + WS_WOUT);
    bf16_t* XN = (bf16_t*)(ws + WS_XN); unsigned char* H2 = ws + WS_H2; bf16_t* GF = (bf16_t*)(ws + WS_GF);
    bf16_t* HP = (bf16_t*)(ws + WS_HP); bf16_t* QKV = (bf16_t*)(ws + WS_QKV); bf16_t* HZ = (bf16_t*)(ws + WS_HZ); bf16_t* MIX = (bf16_t*)(ws + WS_MIX);
    unsigned char* ACT = ws + WS_ACT; unsigned char* Y = ws + WS_Y;
    float* AFF = (float*)(ws + WS_AFF); int* TOK = (int*)(ws + WS_TOK); float* GSEL = (float*)(ws + WS_GSEL); unsigned short* INV = (unsigned short*)(ws + WS_INV);
    float* NSUM = (float*)(ws + WS_CTL) + CW_NSUM;

    if (wave_s == 0) ((LAS unsigned*)(lds + MISC_OFF))[lane_id_v()] = 0u;
    __syncthreads();
    XcdBarrier bar = xcd_barrier_post((unsigned*)(ctl + CW_BAR), MISC + 8, wave_s);

    {
        PHASE_IDS();
        LAS float* scr = (LAS float*)(lds + wave * 16384);
        const int n_p0 = (G == 256) ? P0_NITEMS - P0_NDEF : P0_NITEMS;
        for (int rep_ = 0; rep_ < REP_P0W; ++rep_)
        for (int it = gw; it < n_p0; it += NGW) p0_weight_item(args, it, WIN, WOUT, WGU, WD, scr, lane);
        const float* g = args.in[1];
        int rep_xn = REP_XN; asm volatile("" : "+s"(rep_xn));
        for (int rep_ = 0; rep_ < rep_xn; ++rep_)
        for (int m = gw; m < NTOK; m += NGW) {
            const GAS f32x4* xr = (const GAS f32x4*)(x + (size_t)m * DM) + lane;
            f32x4 v[4]; float s = 0.f;
#pragma unroll
            for (int j = 0; j < 4; ++j) { v[j] = xr[64 * j]; s += (v[j].x * v[j].x + v[j].y * v[j].y) + (v[j].z * v[j].z + v[j].w * v[j].w); }
            const float rstd = rsqrtf(wave_sum(s) * (1.f / DM) + EPS);
            GAS u32x2* o8 = (GAS u32x2*)(XN + (size_t)m * DM) + lane;
#pragma unroll
            for (int j = 0; j < 4; ++j) { const f32x4 gg = ((const GAS f32x4*)g)[lane + 64 * j]; u32x2 w; w.x = pk2(v[j].x * rstd * gg.x, v[j].y * rstd * gg.y); w.y = pk2(v[j].z * rstd * gg.z, v[j].w * rstd * gg.w); o8[64 * j] = w; }
        }
        __syncthreads();
        LAS float* w1s = (LAS float*)(lds + 118784);
        LAS float* w2s = (LAS float*)(lds + 127232);
        if (bx < 256) { for (int q = tid; q < 33 * 64; q += 512) w1s[q] = args.in[5][q]; for (int q = tid; q < 64 * 64; q += 512) w2s[q] = args.in[7][q]; }
        __syncthreads();
        for (int it = bx; it < 256; it += G) {
            const int ib = it >> 2, dn = it & 3, dir = dn >> 1, n = dn & 1, i0 = ib * 64, ibase = i0 + (dir == 0 ? 1 : 0);
            LAS float* zz = (LAS float*)lds;
            LAS float* h1 = zz + 64 * 33;
            LAS float* h2 = h1 + 64 * 64;
            const float* b1 = args.in[6]; const float* b2 = args.in[8]; const float* w3 = args.in[9]; const float* fr = args.in[10];
            for (int q = tid; q < 64 * 33; q += 512) { const int p = q / 33, j = q % 33, i = ibase + p;
                const float t = (float)i / (float)(SEQ - 1), w = 6.283185307179586f * (float)i / (float)SEQ; float v;
                if (j == 0) v = t; else { const float band = 1e-4f + (float)((j - 1) & 15) * ((15.f - 1e-4f) / 15.f); v = (j <= 16) ? __cosf(band * w) : -__sinf(band * w); }
                zz[q] = v; }
            __syncthreads();
            {
                const int j = tid & 63; float a[8];
#pragma unroll
                for (int m = 0; m < 8; ++m) a[m] = b1[j];
#pragma unroll 3
                for (int k = 0; k < 33; ++k) { const float w = w1s[k * 64 + j];
#pragma unroll
                    for (int m = 0; m < 8; ++m) a[m] += zz[(wave + 8 * m) * 33 + k] * w; }
                const float f = fr[j];
#pragma unroll
                for (int m = 0; m < 8; ++m) h1[(wave + 8 * m) * 64 + j] = __sinf(f * a[m]);
            }
            __syncthreads();
            {
                const int j = tid & 63; float a[8];
#pragma unroll
                for (int m = 0; m < 8; ++m) a[m] = b2[j];
#pragma unroll 2
                for (int k = 0; k < 64; k += 4) { const float w0 = w2s[(k + 0) * 64 + j], w1_ = w2s[(k + 1) * 64 + j], w2_ = w2s[(k + 2) * 64 + j], w3_ = w2s[(k + 3) * 64 + j];
#pragma unroll
                    for (int m = 0; m < 8; ++m) { const f32x4 hh = *(const LAS f32x4*)&h1[(wave + 8 * m) * 64 + k]; a[m] += (hh.x * w0 + hh.y * w1_) + (hh.z * w2_ + hh.w * w3_); } }
                const float f = fr[j];
#pragma unroll
                for (int m = 0; m < 8; ++m) h2[(wave + 8 * m) * 64 + j] = __sinf(f * a[m]);
            }
            __syncthreads();
            const int c = tid, col = dn * 512 + c;
            const float mind = logf(1e-2f) / 1.5f, maxd = logf(1e-2f) / 0.3f;
            const float delta = fabsf(mind + (float)c * ((maxd - mind) / 511.f));
            float asum = 0.f;
            LAS unsigned short* ftile = (LAS unsigned short*)(lds + 45056) + wave * (64 * 72);
            {
                float hv[64];
#pragma unroll
                for (int p = 0; p < 64; ++p) hv[p] = 0.f;
                float f0 = 0.f;
                float nw0 = w3[0 * 2048 + col], nw1 = w3[1 * 2048 + col], nw2 = w3[2 * 2048 + col], nw3 = w3[3 * 2048 + col];
#pragma clang loop unroll(disable)
                for (int k = 0; k < 64; k += 4) { const float w0 = nw0, w1_ = nw1, w2_ = nw2, w3_ = nw3;
                    { const int kn = k + 4 < 64 ? k + 4 : k; nw0 = w3[(kn + 0) * 2048 + col]; nw1 = w3[(kn + 1) * 2048 + col]; nw2 = w3[(kn + 2) * 2048 + col]; nw3 = w3[(kn + 3) * 2048 + col]; }
                    if (dir == 1 && ib == 0) { const f32x4 hh = *(const LAS f32x4*)&h2[k]; f0 += (hh.x * w3[(k + 0) * 2048 + col - 1024] + hh.y * w3[(k + 1) * 2048 + col - 1024]) + (hh.z * w3[(k + 2) * 2048 + col - 1024] + hh.w * w3[(k + 3) * 2048 + col - 1024]); }
#pragma unroll
                    for (int p0 = 0; p0 < 64; p0 += 16) {
                        f32x4 hh[16];
#pragma unroll
                        for (int p = 0; p < 16; ++p) hh[p] = *(const LAS f32x4*)&h2[(p0 + p) * 64 + k];
                        asm volatile("" ::: "memory");
#pragma unroll
                        for (int p = 0; p < 16; ++p) hv[p0 + p] += (hh[p].x * w0 + hh[p].y * w1_) + (hh[p].z * w2_ + hh[p].w * w3_); } }
                LAS unsigned short* frow = ftile + lane * 72;
#pragma unroll
                for (int p = 0; p < 64; ++p) { const int i = ibase + p; const float t = (float)i / (float)(SEQ - 1); float h = hv[p] * __expf(-t * delta);
                    bool valid = dir == 0 ? (i <= SEQ - 1) : (i >= 1);
                    if (dir == 1 && i == 0) { h = f0; valid = true; }
                    const unsigned hb = valid ? f2bf(h) : 0u; const float hr = __builtin_bit_cast(float, hb << 16);
                    asum += fabsf(hr); frow[dir == 0 ? 63 - p : p] = (unsigned short)hb; }
            }
            LDS_WAIT(); asm volatile("" ::: "memory");
            {
                const int gbase = dir == 0 ? GOFF - i0 - 64 : GOFF + i0;
#pragma unroll
                for (int j = 0; j < 8; ++j) { const int ch = 8 * j + (lane >> 3), chunk = lane & 7;
                    const u32x4 v = *(const LAS u32x4*)(ftile + ch * 72 + chunk * 8);
                    *(GAS u32x4*)(GF + (size_t)(n * 512 + wave * 64 + ch) * GLEN + gbase + chunk * 8) = v; }
            }
            if (ib == 63) { bf16_t* gf = GF + (size_t)(n * 512 + c) * GLEN + (dir == 0 ? 0 : GOFF + 4096);
                for (int q = 0; q < 32; ++q) *(GAS u32x4*)(gf + q * 8) = (u32x4){0u, 0u, 0u, 0u}; }
            ((float*)(ws + WS_CTL) + CW_NPART)[(size_t)((n * 2 + dir) * 64 + ib) * 512 + c] = asum;
            __syncthreads();
        }
    }
    xcd_barrier(bar);

    int rep_p1 = REP_P1; asm volatile("" : "+s"(rep_p1));
    for (int rep_ = 0; rep_ < rep_p1; ++rep_) {
    {
        pg8::GeoTokPerm S; S.A = WIN; S.X = XN; S.KB = DM * 2; S.ord.init(HCOLS / 256, NTOK / 256, G, bx);
        pg8::EpiBf16 E{HP, NTOK, 0, 1.f};
        pg8::gemm_phase<false>(lds, (LAS unsigned*)(lds + TBL_OFF), S, E, wave_s);
    }
    {
        pg8::GeoPlain S; S.A = XN; S.Bt = WIN + (size_t)HCOLS * DM; S.KB = DM * 2; S.ord.init(NTOK / 256, ACOLS / 256, G, bx);
        pg8::EpiBf16 E{QKV, ACOLS, 512, QSCALE};
        pg8::gemm_phase<false>(lds, (LAS unsigned*)(lds + TBL_OFF), S, E, wave_s);
    }
    }
    xcd_barrier(bar);

    {
        PHASE_IDS();
        LAS unsigned* red = (LAS unsigned*)lds;
        float* QN2 = (float*)(ws + WS_AFF); float* KN2 = QN2 + 4096;
        for (int it = bx; it < NB * 64; it += G) {
            const int b = it >> 6, tile = it & 63, row = tid >> 3, g = tid & 7;
            const bf16_t* rp = QKV + ((size_t)b * SEQ + tile * 64 + row) * ACOLS + g * 64;
            float sq = 0.f, sk = 0.f;
#pragma unroll
            for (int j = 0; j < 8; ++j) { const u32x4 v = *(const GAS u32x4*)(rp + j * 8), w = *(const GAS u32x4*)(rp + 512 + j * 8);
#pragma unroll
                for (int k = 0; k < 4; ++k) { sq += bflo(v[k]) * bflo(v[k]) + bfhi(v[k]) * bfhi(v[k]); sk += bflo(w[k]) * bflo(w[k]) + bfhi(w[k]) * bfhi(w[k]); } }
            if (tid < 16) red[tid] = 0u;
            __syncthreads();
            atomicMax((unsigned*)&red[g], __float_as_uint(sq)); atomicMax((unsigned*)&red[8 + g], __float_as_uint(sk));
            __syncthreads();
            if (tid < 8) QN2[(size_t)(b * 8 + tid) * 64 + tile] = __uint_as_float(red[tid]); else if (tid < 16) KN2[(size_t)(b * 8 + tid - 8) * 64 + tile] = __uint_as_float(red[tid]);
            __syncthreads();
        }
        for (int k = gw; k < 2 * 512; k += NGW) {
            const float* np = (const float*)(ws + WS_CTL) + CW_NPART + (size_t)(k >> 9) * 128 * 512 + (k & 511);
            const float v = np[(size_t)lane * 512] + np[(size_t)(lane + 64) * 512];
            const float tot = wave_sum(v);
            if (lane == 0) NSUM[k] = tot;
        }
    }
    xcd_barrier(bar);

    {
        PHASE_IDS();
        {
            const float* conv_w = args.in[3]; const float* conv_b = args.in[4]; const float* skip = args.in[11];
            if (tid < 64) { const int bufi = tid >> 5, row = tid & 31, rr = row < 16 ? row : SEQ + row; *(LAS u32x4*)(lds + bufi * HY_ZBYTES + rr * 16) = (u32x4){0u, 0u, 0u, 0u}; }
            const int r32 = lane & 31, hi = lane >> 5;
            const int tr_lane = (2 * ((lane >> 4) & 1) + ((lane & 3) >> 1) + 8 * hi + ((lane & 15) >> 2)) * 16 + 8 * (lane & 1);
            int rep_hy = REP_HY; asm volatile("" : "+s"(rep_hy));
            const bool split13 = (G == 256);
            const int hy_n = split13 ? (bx < 128 ? 1 : 3) : (HW - bx + G - 1) / G, hy_0 = split13 ? (bx < 128 ? bx : 128 + (bx - 128) * 3) : bx, hy_s = split13 ? 1 : G;
            for (int rep_ = 0; rep_ < rep_hy; ++rep_)
            for (int ui_ = 0; ui_ < hy_n; ++ui_) {
                const int c = hy_0 + ui_ * hy_s;
                __syncthreads();
                {
                    const int col = 1024 + c; const float w0 = conv_w[col], w1 = conv_w[HCOLS + col], w2 = conv_w[2 * HCOLS + col], cb = conv_b[col];
                    const bf16_t* hp = HP + (size_t)col * SEQ * 8;
#pragma unroll 2
                    for (int i = 0; i < 8; ++i) { const int t = tid + 512 * i;
                        const u32x4 z4 = (u32x4){0u, 0u, 0u, 0u};
                        const u32x4 pm = t > 0 ? *(const GAS u32x4*)(hp + (size_t)(t - 1) * 8) : z4, p0 = *(const GAS u32x4*)(hp + (size_t)t * 8), pp = t < SEQ - 1 ? *(const GAS u32x4*)(hp + (size_t)(t + 1) * 8) : z4;
                        u32x4 o;
#pragma unroll
                        for (int k = 0; k < 4; ++k) { const float lo = cb + w0 * bflo(pm[k]) + w1 * bflo(p0[k]) + w2 * bflo(pp[k]), hh = cb + w0 * bfhi(pm[k]) + w1 * bfhi(p0[k]) + w2 * bfhi(pp[k]); o[k] = pk2(lo, hh); }
                        *(LAS u32x4*)(lds + HY_ZA + (t + 16) * 16) = o; }
                }
                for (int n = 0; n < 2; ++n) {
                    {
                        const GAS u32x4* gsrc = (const GAS u32x4*)(GF + (size_t)(n * 512 + c) * GLEN);
                        static_assert(GLEN * 2 / 16 == 2 * 512 + 64, "filter row = 1088 16-byte pieces");
                        const u32x4 f0 = gsrc[tid], f1 = gsrc[tid + 512]; u32x4 f2 = (u32x4){0u, 0u, 0u, 0u}; if (tid < 64) f2 = gsrc[tid + 1024];
                        *(LAS u32x4*)(lds + HY_FB + tid * 16) = f0; *(LAS u32x4*)(lds + HY_FB + (tid + 512) * 16) = f1; if (tid < 64) *(LAS u32x4*)(lds + HY_FB + (tid + 1024) * 16) = f2;
                    }
                    __syncthreads();
                    f32x16 acc[2][2];
#pragma unroll
                    for (int a = 0; a < 2; ++a)
#pragma unroll
                        for (int b = 0; b < 2; ++b)
#pragma unroll
                            for (int k = 0; k < 16; ++k) acc[a][b][k] = 0.f;
                    const LAS unsigned char* za = lds + (n == 0 ? HY_ZA : HY_ZB) + tr_lane;
                    const LAS unsigned char* fbp = lds + HY_FB + 2 * GOFF - 32 + 16 * (hi - r32) - 512 * (2 * wave);
#define HY_STEP(OFFA, OFFB) do { \
                        const v4i16_t x0 = __builtin_amdgcn_ds_read_tr16_b64_v4i16((LAS v4i16_t*)(za + (OFFA))); \
                        const v4i16_t x1 = __builtin_amdgcn_ds_read_tr16_b64_v4i16((LAS v4i16_t*)(za + (OFFA) + 64)); \
                        const v4i16_t x2 = __builtin_amdgcn_ds_read_tr16_b64_v4i16((LAS v4i16_t*)(za + (OFFA) + 128)); \
                        const bf16x8 b0 = *(const LAS bf16x8*)(fbp + (OFFB)), b1 = *(const LAS bf16x8*)(fbp + (OFFB) - 512); \
                        const bf16x8 a0 = (bf16x8){x0[0], x0[1], x0[2], x0[3], x1[0], x1[1], x1[2], x1[3]}, a1 = (bf16x8){x1[0], x1[1], x1[2], x1[3], x2[0], x2[1], x2[2], x2[3]}; \
                        acc[0][0] = __builtin_amdgcn_mfma_f32_32x32x16_bf16(a0, b0, acc[0][0], 0, 0, 0); \
                        acc[0][1] = __builtin_amdgcn_mfma_f32_32x32x16_bf16(a1, b0, acc[0][1], 0, 0, 0); \
                        acc[1][0] = __builtin_amdgcn_mfma_f32_32x32x16_bf16(a0, b1, acc[1][0], 0, 0, 0); \
                        acc[1][1] = __builtin_amdgcn_mfma_f32_32x32x16_bf16(a1, b1, acc[1][1], 0, 0, 0); } while (0)
#pragma clang loop unroll(disable)
                    for (int c4 = 0; c4 < 64; ++c4) {
                        HY_STEP(0, 0); HY_STEP(256, 32); HY_STEP(512, 64); HY_STEP(768, 96);
                        za += 1024; fbp += 128;
                    }
                    HY_STEP(0, 0);
#undef HY_STEP
                    const int gcol = n * 512 + c; const float w0 = conv_w[gcol], w1 = conv_w[HCOLS + gcol], w2 = conv_w[2 * HCOLS + gcol], cb = conv_b[gcol];
                    const float inv = 1.f / NSUM[n * 512 + c], sk = skip[n * 512 + c];
                    const bf16_t* hp = HP + (size_t)gcol * SEQ * 8 + 4 * hi;
                    const LAS unsigned char* zin = lds + (n == 0 ? HY_ZA : HY_ZB) + 8 * hi;
#pragma unroll
                    for (int sp = 0; sp < 2; ++sp) {
                        const int tb = 256 * (2 * wave + sp) + 8 * r32;
                        u32x2 P[10];
#pragma unroll
                        for (int k = 0; k < 10; ++k) { const int tq = tb - 1 + k; P[k] = (tq >= 0 && tq < SEQ) ? *(const GAS u32x2*)(hp + (size_t)tq * 8) : (u32x2){0u, 0u}; }
#pragma unroll
                        for (int tt = 0; tt < 8; ++tt) {
                            const int t = tb + tt; const u32x2 zi = *(const LAS u32x2*)(zin + (t + 16) * 16);
                            const float zv[4] = {bflo(zi.x), bfhi(zi.x), bflo(zi.y), bfhi(zi.y)};
                            const float pm[4] = {bflo(P[tt].x), bfhi(P[tt].x), bflo(P[tt].y), bfhi(P[tt].y)};
                            const float pc[4] = {bflo(P[tt + 1].x), bfhi(P[tt + 1].x), bflo(P[tt + 1].y), bfhi(P[tt + 1].y)};
                            const float pp[4] = {bflo(P[tt + 2].x), bfhi(P[tt + 2].x), bflo(P[tt + 2].y), bfhi(P[tt + 2].y)};
                            float zo[4];
#pragma unroll
                            for (int bb = 0; bb < 4; ++bb) { const float gate = cb + w0 * pm[bb] + w1 * pc[bb] + w2 * pp[bb]; zo[bb] = gate * (acc[sp][tt >> 2][(tt & 3) * 4 + bb] * inv + sk * zv[bb]); }
                            u32x2 w; w.x = pk2(zo[0], zo[1]); w.y = pk2(zo[2], zo[3]);
                            if (n == 0) *(LAS u32x2*)(lds + HY_ZB + (t + 16) * 16 + 8 * hi) = w;
                            else *(GAS u32x2*)(HZ + ((size_t)c * SEQ + t) * 8 + 4 * hi) = w;
                        }
                    }
                    __syncthreads();
                }
            }
        }
        __syncthreads();
        {
            const int wid = wave, r32 = lane & 31, hi = lane >> 5;
            const float* QN2 = (const float*)(ws + WS_AFF); const float* KN2 = QN2 + 4096;
            for (int rep_ = 0; rep_ < REP_AT; ++rep_)
            for (int unit = bx; unit < NB * 4 * 16; unit += G) {
                const int v_ = unit & 127, qb = v_ & 15, b = v_ >> 4, h = unit < 256 ? 2 + (unit >> 7) : ((unit - 256) >> 7 ? 0 : 1), q0 = qb * 256;
                const bf16_t* pb = QKV + (size_t)b * SEQ * ACOLS;
                const float slope2 = exp2f(-2.f * (float)(h + 1)) * LOG2E;
                f32x16 o[4];
#pragma clang loop unroll(disable)
                for (int mp = 0; mp < 2; ++mp) {
                    const int l_u = lane_id_v(), r32u = l_u & 31, hiu = l_u >> 5;
                    const int qpos = q0 + wid * 32 + r32u;
                    int nL, NT; bool spec;
                    { const float* qn = QN2 + ((size_t)(b * 8 + h * 2 + mp)) * 64; const float* kn = KN2 + ((size_t)(b * 8 + h * 2 + mp)) * 64;
                      float km = kn[lane_id_v()];
                      km = wave_max(km);
                      const float qm = fmaxf(fmaxf(qn[4 * qb], qn[4 * qb + 1]), fmaxf(qn[4 * qb + 2], qn[4 * qb + 3]));
                      const float qk2 = 2.f * sqrtf(qm * km);
                      spec = __builtin_amdgcn_readfirstlane((int)(qk2 < 120.f)) != 0;
                      const float rthr = (150.f + qk2) / slope2;
                      const int side = __builtin_amdgcn_readfirstlane((int)fminf(rthr * (1.f / 64.f), 64.f)) + 1;
                      nL = min(4 * qb, side); int nR = min(60 - 4 * qb, side); NT = 4 + nL + nR;
                      if (NT & 1) { if (nL < 4 * qb) ++nL; else ++nR; ++NT; } }
                    att::pass(o, pb + (size_t)qpos * ACOLS + h * 128 + mp * 64 + hiu * 8, pb + 512 + h * 128 + mp * 64, pb + 1024 + h * 128, qpos, qb, slope2, (char*)lds_raw, tid, nL, NT, spec);
                    if (mp == 0) {
                        int z2 = 0; asm volatile("" : "+s"(z2));
                        GAS f32x4* pk = (GAS f32x4*)((float*)(ws + WS_PARK) + (size_t)(bx * 8 + wid) * 4096 + lane_id_v() * 64 + z2);
#pragma unroll
                        for (int d = 0; d < 4; ++d)
#pragma unroll
                            for (int k = 0; k < 4; ++k) pk[d * 4 + k] = (f32x4){o[d][4 * k], o[d][4 * k + 1], o[d][4 * k + 2], o[d][4 * k + 3]};
                    }
                    __builtin_amdgcn_sched_barrier(0);
                }
                asm volatile("s_waitcnt vmcnt(0)" ::: "memory");
                int zz = 0; asm volatile("" : "+s"(zz));
                float lam;
                { float s1 = 0.f, s2 = 0.f; for (int i = 0; i < 64; ++i) { s1 += args.in[13][i + zz] * args.in[14][i + zz]; s2 += args.in[15][i + zz] * args.in[16][i + zz]; } lam = expf(s1) - expf(s2) + 0.2f; }
                const float* subg = args.in[17] + zz;
                int lane_c = lane; asm volatile("" : "+v"(lane_c)); const int r32c = lane_c & 31, hic = lane_c >> 5;
                {
                    const GAS f32x4* pk = (const GAS f32x4*)((float*)(ws + WS_PARK) + (size_t)(bx * 8 + wid) * 4096 + lane_c * 64 + zz);
#pragma unroll
                    for (int d = 0; d < 4; ++d)
#pragma unroll
                        for (int k = 0; k < 4; ++k) { const f32x4 pv = pk[d * 4 + k];
#pragma unroll
                            for (int q = 0; q < 4; ++q) o[d][4 * k + q] = pv[q] - lam * o[d][4 * k + q]; }
                }
#pragma unroll
                for (int r = 0; r < 16; ++r) {
                    float ss = 0.f;
#pragma unroll
                    for (int d = 0; d < 4; ++d) ss += o[d][r] * o[d][r];
                    ss += sx<1>(ss); ss += sx<2>(ss); ss += sx<4>(ss); ss += sx<8>(ss); ss += sx<16>(ss);
                    const float rs = rsqrtf(ss * (1.f / 128.f) + EPS) * 0.8f;
                    bf16_t* op = MIX + ((size_t)b * SEQ + q0 + wid * 32 + att::crow(r, hic)) * DM + 512 + h * 128 + r32c;
#pragma unroll
                    for (int d = 0; d < 4; ++d) op[d * 32] = (bf16_t)f2bf(o[d][r] * rs * subg[d * 32 + r32c]);
                }
            }
        }
    }
    if (G == 256) {
        __syncthreads();
        int lane_d = lane_id_v(); asm volatile("" : "+v"(lane_d));
        LAS float* scr = (LAS float*)(lds + wave_s * 16384);
        for (;;) {
            int it0 = 0; if (lane_d == 0) it0 = (int)atomicAdd((unsigned*)(ctl + CW_WQ), (unsigned)P0_CHUNK);
            it0 = __builtin_amdgcn_readfirstlane(it0) + P0_NITEMS - P0_NDEF;
            if (it0 >= P0_NITEMS) break;
            for (int it = it0; it < min(it0 + P0_CHUNK, P0_NITEMS); ++it) p0_weight_item(args, it, WIN, WOUT, WGU, WD, scr, lane_d);
        }
    }
    xcd_barrier(bar);

    {
        PHASE_IDS();
        const float* hg = args.in[12];
        LAS unsigned short* tile = (LAS unsigned short*)lds;
        LAS float* rs = (LAS float*)(lds + 32768);
        int rep_3a = REP_P3A; asm volatile("" : "+s"(rep_3a));
        for (int rep_ = 0; rep_ < rep_3a; ++rep_)
        for (int it = bx; it < 8 * 128; it += G) {
            const int g = it & 7, tb = it >> 3, t0 = tb * 32;
            __syncthreads();
            for (int q = tid; q < 64 * 32; q += 512) { const int ch = q >> 5, seg = q & 31;
                const u32x4 v = *(const GAS u32x4*)(HZ + ((size_t)(g * 64 + ch) * SEQ + t0 + seg) * 8);
                *(LAS u32x4*)(tile + ch * 256 + seg * 8) = v; }
            __syncthreads();
            if (tid < 256) { float s = 0.f; for (int ch = 0; ch < 64; ++ch) { const float v = bf2f(tile[ch * 256 + tid]); s += v * v; } rs[tid] = rsqrtf(s * (1.f / 64.f) + EPS); }
            __syncthreads();
            for (int q = tid; q < 256 * 8; q += 512) { const int tk = q >> 3, c8 = (q & 7) * 8;
                const float r = rs[tk]; const int t = t0 + (tk >> 3), b = tk & 7;
                float v[8];
#pragma unroll
                for (int j = 0; j < 8; ++j) v[j] = bf2f(tile[(c8 + j) * 256 + tk]) * r * hg[g * 64 + c8 + j];
                u32x4 w; w.x = pk2(v[0], v[1]); w.y = pk2(v[2], v[3]); w.z = pk2(v[4], v[5]); w.w = pk2(v[6], v[7]);
                *(GAS u32x4*)(MIX + ((size_t)b * SEQ + t) * DM + g * 64 + c8) = w; }
        }
        __syncthreads();
    }
    xcd_barrier(bar);

    {
        pg8::GeoPlain S; S.A = MIX; S.Bt = WOUT; S.KB = DM * 2; S.ord.init(NTOK / 256, DM / 256, G, bx);
        pg8::EpiResF32 E{x, out, DM};
        for (int rep_ = 0; rep_ < REP_P3B; ++rep_) pg8::gemm_phase<false>(lds, (LAS unsigned*)(lds + TBL_OFF), S, E, wave_s);
    }
    xcd_barrier(bar);

    {
        PHASE_IDS();
        const float* g = args.in[19]; const float* wr = args.in[20];
        LAS float* gwl = (LAS float*)lds;
        for (int q = tid; q < DM * 4; q += 512) { const f32x4 w4 = ((const GAS f32x4*)wr)[q]; const float gd = g[q >> 2]; *(LAS f32x4*)(gwl + (q >> 2) * 20 + (q & 3) * 4) = w4 * gd; }
        __syncthreads();
        const int i16 = lane & 15, q4 = lane >> 4;
        int rep_4a = REP_P4A; asm volatile("" : "+s"(rep_4a));
        for (int rep_ = 0; rep_ < rep_4a; ++rep_)
        for (int grp = gw; grp < NTOK / 16; grp += NGW) {
            const int tok0 = grp * 16;
            const float* xrow = out + (size_t)(tok0 + i16) * DM + 4 * q4;
            const LAS float* bp = gwl + (4 * q4) * 20 + i16;
            f32x4 acc = (f32x4){0.f, 0.f, 0.f, 0.f}; float ss = 0.f;
#pragma unroll 8
            for (int kk = 0; kk < 64; ++kk) {
                const f32x4 a = *(const GAS f32x4*)(xrow + 16 * kk);
                ss += (a.x * a.x + a.y * a.y) + (a.z * a.z + a.w * a.w);
                const LAS float* b = bp + kk * 320;
                acc = __builtin_amdgcn_mfma_f32_16x16x4f32(a.x, b[0], acc, 0, 0, 0);
                acc = __builtin_amdgcn_mfma_f32_16x16x4f32(a.y, b[20], acc, 0, 0, 0);
                acc = __builtin_amdgcn_mfma_f32_16x16x4f32(a.z, b[40], acc, 0, 0, 0);
                acc = __builtin_amdgcn_mfma_f32_16x16x4f32(a.w, b[60], acc, 0, 0, 0);
            }
            ss += sx<16>(ss); ss = sum32x(ss);
            const float r = rsqrtf(ss * (1.f / DM) + EPS);
            f32x4 af;
#pragma unroll
            for (int reg = 0; reg < 4; ++reg) {
                const float lg = acc[reg] * lane_read(r, 4 * q4 + reg);
                float mx = lg; mx = fmaxf(mx, sx<1>(mx)); mx = fmaxf(mx, sx<2>(mx)); mx = fmaxf(mx, sx<4>(mx)); mx = fmaxf(mx, sx<8>(mx));
                const float ex = expf(lg - mx); float den = ex; den += sx<1>(den); den += sx<2>(den); den += sx<4>(den); den += sx<8>(den);
                af[reg] = ex / den;
            }
            const int b = tok0 >> 12, t0 = tok0 & 4095;
            *(GAS f32x4*)(AFF + ((size_t)i16 * NB + b) * SEQ + t0 + 4 * q4) = af;
            *(GAS u32x2*)(INV + (size_t)tok0 * 16 + lane * 4) = (u32x2){0xffffffffu, 0xffffffffu};
            for (int i = 0; i < 16; ++i) {
                const float ri = lane_read(r, i);
                const GAS f32x4* xr = (const GAS f32x4*)(out + (size_t)(tok0 + i) * DM) + lane;
                GAS unsigned* o4 = (GAS unsigned*)(H2 + (size_t)(tok0 + i) * DM) + lane;
#pragma unroll
                for (int j = 0; j < 4; ++j) { const f32x4 v = xr[64 * j]; const f32x4 gg = ((const GAS f32x4*)g)[lane + 64 * j];
                    int t = __builtin_amdgcn_cvt_pk_fp8_f32(v.x * ri * gg.x, v.y * ri * gg.y, 0, false); t = __builtin_amdgcn_cvt_pk_fp8_f32(v.z * ri * gg.z, v.w * ri * gg.w, t, true); o4[64 * j] = (unsigned)t; }
            }
        }
        __syncthreads();
    }
    xcd_barrier(bar);

    {
        PHASE_IDS();
        LAS unsigned* hist = (LAS unsigned*)lds; LAS unsigned* scan = hist + 256; LAS unsigned* selw = scan + 512;
        int rep_4b = REP_P4B; asm volatile("" : "+s"(rep_4b));
        for (int rep_ = 0; rep_ < rep_4b; ++rep_)
        for (int eb = bx; eb < NE * NB; eb += G) {
            const int b = eb & 7, e = eb >> 3;
            const float* a = AFF + (size_t)eb * SEQ;
            unsigned v[8];
#pragma unroll
            for (int j = 0; j < 8; ++j) v[j] = __float_as_uint(a[tid * 8 + j]);
            unsigned prefix = 0, mask = 0, need = CAP;
            __syncthreads();
            for (int pass = 0; pass < 4; ++pass) {
                const int shift = 24 - 8 * pass;
                if (tid < 256) hist[tid] = 0;
                __syncthreads();
#pragma unroll
                for (int j = 0; j < 8; ++j) if ((v[j] & mask) == prefix) atomicAdd((unsigned*)&hist[(v[j] >> shift) & 255u], 1u);
                __syncthreads();
                if (tid < 256) scan[tid] = hist[tid];
                __syncthreads();
                for (int off = 1; off < 256; off <<= 1) { const unsigned xx = (tid < 256 && tid + off < 256) ? scan[tid + off] : 0u; __syncthreads(); if (tid < 256) scan[tid] += xx; __syncthreads(); }
                if (tid < 256) { const unsigned above = tid < 255 ? scan[tid + 1] : 0u; if (above < need && need <= scan[tid]) { selw[0] = (unsigned)tid; selw[1] = need - above; } }
                __syncthreads();
                prefix |= selw[0] << shift; mask |= 255u << shift; need = selw[1];
                __syncthreads();
            }
            unsigned cg = 0, ce = 0;
#pragma unroll
            for (int j = 0; j < 8; ++j) { cg += v[j] > prefix; ce += v[j] == prefix; }
            scan[tid] = (cg << 16) | ce;
            __syncthreads();
            for (int off = 1; off < 512; off <<= 1) { const unsigned xx = tid >= off ? scan[tid - off] : 0u; __syncthreads(); scan[tid] += xx; __syncthreads(); }
            const unsigned incl = scan[tid]; unsigned pg = (incl >> 16) - cg, pe = (incl & 0xffffu) - ce;
#pragma unroll
            for (int j = 0; j < 8; ++j) {
                const bool isg = v[j] > prefix, ise = v[j] == prefix;
                if (isg || (ise && pe < need)) {
                    const unsigned pos = pg + (pe < need ? pe : need); const int token = b * SEQ + tid * 8 + j;
                    TOK[(size_t)eb * CAP + pos] = token; GSEL[(size_t)eb * CAP + pos] = __uint_as_float(v[j]); INV[(size_t)token * 16 + e] = (unsigned short)pos;
                }
                pg += isg; pe += ise;
            }
            __syncthreads();
        }
    }
    xcd_barrier(bar);

    {
        pg8::GeoExpert<true> S; S.A = H2; S.Bt = WGU; S.KB = DM; S.bexp = (size_t)2 * FF * DM; S.tok = TOK; S.ord.init(NSLOT / 256, 2 * FF / 256, G, bx);
        pg8::EpiSwiGLU E{ACT, FF};
        for (int rep_ = 0; rep_ < REP_P5; ++rep_) pg8::gemm_phase<true>(lds, (LAS unsigned*)(lds + TBL_OFF), S, E, wave_s);
    }
    xcd_barrier(bar);

    {
        pg8::GeoExpert<false> S; S.A = ACT; S.Bt = WD; S.KB = FF; S.bexp = (size_t)DM * FF; S.tok = nullptr; S.ord.init(NSLOT / 256, DM / 256, G, bx);
        pg8::EpiFp8 E{Y, DM};
        for (int rep_ = 0; rep_ < REP_P6; ++rep_) pg8::gemm_phase<true>(lds, (LAS unsigned*)(lds + TBL_OFF), S, E, wave_s);
    }
    xcd_barrier(bar);

    {
        PHASE_IDS();
        const float* g = args.in[24];
        for (int m = gw; m < NTOK; m += NGW) {
            const GAS f32x4* xr = (const GAS f32x4*)(out + (size_t)m * DM) + lane;
            f32x4 v[4];
#pragma unroll
            for (int j = 0; j < 4; ++j) v[j] = xr[64 * j];
            const int b = m >> 12;
            const unsigned short myinv = INV[(size_t)m * 16 + (lane & 15)];
            for (int e = 0; e < 16; ++e) {
                const unsigned s = (unsigned)lane_read_i((int)myinv, e);
                if (s != 0xffffu) {
                    const size_t slot = ((size_t)e * NB + b) * CAP + s;
                    const float gv = GSEL[slot];
                    const GAS unsigned* yr = (const GAS unsigned*)(Y + slot * DM) + lane;
#pragma unroll
                    for (int j = 0; j < 4; ++j) { const unsigned w = yr[64 * j]; const f32x2 lo = __builtin_amdgcn_cvt_pk_f32_fp8((int)w, false), hh = __builtin_amdgcn_cvt_pk_f32_fp8((int)w, true);
                        v[j].x += gv * lo.x; v[j].y += gv * lo.y; v[j].z += gv * hh.x; v[j].w += gv * hh.y; }
                }
            }
            float s = 0.f;
#pragma unroll
            for (int j = 0; j < 4; ++j) s += (v[j].x * v[j].x + v[j].y * v[j].y) + (v[j].z * v[j].z + v[j].w * v[j].w);
            const float r = rsqrtf(wave_sum(s) * (1.f / DM) + EPS);
            GAS f32x4* o = (GAS f32x4*)(out + (size_t)m * DM) + lane;
#pragma unroll
            for (int j = 0; j < 4; ++j) { const f32x4 gg = ((const GAS f32x4*)g)[lane + 64 * j]; o[64 * j] = (f32x4){v[j].x * r * gg.x, v[j].y * r * gg.y, v[j].z * r * gg.z, v[j].w * r * gg.w}; }
        }
    }
}

extern "C" void kernel_launch(void* const* d_in, const int* in_sizes, int n_in, void* d_out, int out_size, void* d_ws, size_t ws_size, hipStream_t stream) {
    static int grid = 0;
    if (grid == 0) {
        if (n_in != 25 || ws_size < WS_END) { fprintf(stderr, "kernel_launch: unexpected n_in %d / ws %zu\n", n_in, ws_size); grid = -1; return; }
        int dev = 0, cus = 0;
        if (hipGetDevice(&dev) != hipSuccess || hipDeviceGetAttribute(&cus, hipDeviceAttributeMultiprocessorCount, dev) != hipSuccess) { grid = -1; return; }
        if (hipFuncSetAttribute((const void*)mega_fwd, hipFuncAttributeMaxDynamicSharedMemorySize, LDS_BYTES) != hipSuccess) { fprintf(stderr, "kernel_launch: hipFuncSetAttribute failed\n"); grid = -1; return; }
        int per_cu = 0;
        if (hipOccupancyMaxActiveBlocksPerMultiprocessor(&per_cu, (const void*)mega_fwd, 512, LDS_BYTES) != hipSuccess || per_cu < 1) fprintf(stderr, "kernel_launch: occupancy query says %d\n", per_cu);
        (void)hipGetLastError();
        grid = cus;
    }
    if (grid < 0) return;
    (void)hipMemsetAsync((char*)d_ws + WS_CTL, 0, CTL_BYTES, stream);
    Args a; memset(&a, 0, sizeof a);
    for (int i = 0; i < 25; ++i) a.in[i] = (const float*)d_in[i];
    a.out = (float*)d_out; a.ws = (unsigned char*)d_ws;
    hipLaunchKernelGGL(mega_fwd, dim3(grid), dim3(512), LDS_BYTES, stream, a);
}
```

```cpp
#include <hip/hip_runtime.h>
#include <cstdio>
#include <cstdint>
#include <cstring>

#define GAS __attribute__((address_space(1)))
#define LAS __attribute__((address_space(3)))
typedef unsigned short bf16_t;
typedef short bf16x8 __attribute__((ext_vector_type(8)));
typedef float f32x4 __attribute__((ext_vector_type(4)));
typedef float f32x2 __attribute__((ext_vector_type(2)));
typedef unsigned u32x4 __attribute__((ext_vector_type(4)));
typedef unsigned u32x2 __attribute__((ext_vector_type(2)));
typedef short v4i16_t __attribute__((ext_vector_type(4)));
typedef int i32x4 __attribute__((ext_vector_type(4)));
typedef int i32x8 __attribute__((ext_vector_type(8)));
constexpr int F8_SCALES = 127 | (122 << 8);
typedef float f32x16 __attribute__((ext_vector_type(16)));

constexpr int DM = 1024, NB = 8, SEQ = 4096, NTOK = NB * SEQ;
constexpr int HW = 512, HCOLS = 1536, INC = 3072, ACOLS = 1536;
constexpr int NE = 16, CAP = 512, FF = 2816, NSLOT = NE * NB * CAP;
constexpr float EPS = 1e-6f;
constexpr float LOG2E = 1.4426950408889634f;
constexpr float QSCALE = 0.125f * LOG2E;
constexpr int GOFF = 4352, GLEN = 8704;

constexpr size_t MiB = 1u << 20;
constexpr size_t WS_CTL = 0, CTL_BYTES = 1 * MiB;
constexpr size_t WS_WGU = 2 * MiB;
constexpr size_t WS_WD = 90 * MiB;
constexpr size_t WS_AFF = 134 * MiB;
constexpr size_t WS_TOK = 136 * MiB;
constexpr size_t WS_GSEL = WS_TOK + 256 * 1024;
constexpr size_t WS_INV = 137 * MiB;
constexpr size_t WS_XN = 138 * MiB;
constexpr size_t WS_H2 = WS_XN;
constexpr size_t WS_WIN = 202 * MiB;
constexpr size_t WS_WOUT = 208 * MiB;
constexpr size_t WS_GF = 210 * MiB;
constexpr size_t WS_HP = 228 * MiB;
constexpr size_t WS_QKV = 324 * MiB;
constexpr size_t WS_ACT = 228 * MiB;
constexpr size_t WS_HZ = 420 * MiB;
constexpr size_t WS_MIX = 452 * MiB;
constexpr size_t WS_PARK = 516 * MiB;
constexpr size_t WS_Y = 420 * MiB;
constexpr size_t WS_END = 548 * MiB;
constexpr int CW_BAR = 4096;
constexpr int CW_NSUM = 16384;
constexpr int CW_NPART = 65536;
constexpr int CW_WQ = 32768;

constexpr int REP_XN = 1, REP_P3A = 1, REP_P4A = 1, REP_P4B = 1;
constexpr int REP_P0W = 1, REP_P1 = 1, REP_HY = 1, REP_AT = 1, REP_P3B = 1, REP_P5 = 1, REP_P6 = 1;
constexpr int LDS_BYTES = 160 * 1024;
constexpr int MISC_OFF = LDS_BYTES - 256;
constexpr int HY_ZBYTES = (SEQ + 32) * 16, HY_ZA = 0, HY_ZB = HY_ZBYTES, HY_FB = 2 * HY_ZBYTES;
constexpr int TBL_OFF = 131072;

__device__ __forceinline__ unsigned f2bf(float f) { unsigned u = __builtin_bit_cast(unsigned, f); return (u + 0x7fffu + ((u >> 16) & 1u)) >> 16; }
__device__ __forceinline__ unsigned pk2(float lo, float hi) { return f2bf(lo) | (f2bf(hi) << 16); }
__device__ __forceinline__ float bf2f(unsigned short h) { return __builtin_bit_cast(float, (unsigned)h << 16); }
__device__ __forceinline__ float bflo(unsigned w) { return __builtin_bit_cast(float, w << 16); }
__device__ __forceinline__ float bfhi(unsigned w) { return __builtin_bit_cast(float, w & 0xffff0000u); }
template <int M> __device__ __forceinline__ float sx(float v) { static_assert(M >= 1 && M <= 16, "sx: xor mask 1..16"); return __int_as_float(__builtin_amdgcn_ds_swizzle(__float_as_int(v), (M << 10) | 0x1f)); }
__device__ __forceinline__ float sum32x(float v) { auto r = __builtin_amdgcn_permlane32_swap(__float_as_uint(v), __float_as_uint(v), false, false); return __uint_as_float(r[0]) + __uint_as_float(r[1]); }
__device__ __forceinline__ float max32x(float v) { auto r = __builtin_amdgcn_permlane32_swap(__float_as_uint(v), __float_as_uint(v), false, false); return fmaxf(__uint_as_float(r[0]), __uint_as_float(r[1])); }
__device__ __forceinline__ float lane_read(float v, int src) { return __int_as_float(__builtin_amdgcn_ds_bpermute(src << 2, __float_as_int(v))); }
__device__ __forceinline__ int lane_read_i(int v, int src) { return __builtin_amdgcn_ds_bpermute(src << 2, v); }
__device__ __forceinline__ float wave_sum(float v) { v += sx<1>(v); v += sx<2>(v); v += sx<4>(v); v += sx<8>(v); v += sx<16>(v); return sum32x(v); }
__device__ __forceinline__ float wave_max(float v) { v = fmaxf(v, sx<1>(v)); v = fmaxf(v, sx<2>(v)); v = fmaxf(v, sx<4>(v)); v = fmaxf(v, sx<8>(v)); v = fmaxf(v, sx<16>(v)); return max32x(v); }
#define LDS_WAIT() asm volatile("s_waitcnt lgkmcnt(0)" ::: "memory")
__device__ __forceinline__ int lane_id_v() { int l; asm volatile("v_mbcnt_lo_u32_b32 %0, -1, 0\n\tv_mbcnt_hi_u32_b32 %0, -1, %0" : "=v"(l)); return l; }
#define PHASE_IDS() const int wave = wave_s; int tid_o = wave_s * 64 + lane_id_v(); asm volatile("" : "+v"(tid_o)); const int tid = tid_o, lane = tid & 63, gw = blockIdx.x * 8 + wave; (void)lane; (void)gw

namespace pg8 {
constexpr int BM = 256, BK = 64, HALF = 128, HTB = HALF * BK * 2, STAGE_BYTES = 8 * HTB, NXCD = 8, WGM = 8;
__host__ __device__ __forceinline__ int lds_byte(int r, int c) { const int st = (r >> 4) * 2 + (c >> 5), rr = r & 15, cc = c & 31, ob = rr * 64 + cc * 2; return st * 1024 + (ob ^ (((ob >> 9) & 1) << 5)); }
__host__ __device__ __forceinline__ void stage_rc(int b, int& R, int& C) { const int st = b / 1024, sb = b % 1024, swz = sb ^ (((sb >> 9) & 1) << 5); R = (st >> 1) * 16 + swz / 64; C = (st & 1) * 32 + (swz % 64) / 2; }
__host__ __device__ __forceinline__ int perm32(int rho) { const int n = rho >> 4, i = rho & 15; return 8 * (i >> 2) + 4 * n + (i & 3); }
struct Unit { int pm, pn; };

struct TileOrder {
    int nM, nN, nwg, G, c;
    __device__ void init(int nM_, int nN_, int G_, int c_) { nM = nM_; nN = nN_; nwg = nM * nN; G = G_; c = c_; }
    __device__ bool next(int i, Unit& u) const {
        const long L = (long)i * G + c; if (L >= nwg) return false;
        int wgid = (int)L; { const int q = nwg / NXCD, r = nwg % NXCD, xcd = wgid % NXCD, off = wgid / NXCD; wgid = (xcd < r ? xcd * (q + 1) : r * (q + 1) + (xcd - r) * q) + off; }
        const int nig = WGM * nN, gid = wgid / nig, fm = gid * WGM, gsz = (nM - fm) < WGM ? (nM - fm) : WGM;
        u.pm = fm + ((wgid % nig) % gsz); u.pn = (wgid % nig) / gsz; return true;
    }
};
__device__ __forceinline__ unsigned cvt_pk_bf16(float lo, float hi) { unsigned r; asm volatile("v_cvt_pk_bf16_f32 %0, %1, %2" : "=v"(r) : "v"(lo), "v"(hi)); return r; }

struct EpiBf16 {
    static constexpr bool PERM = true;
    bf16_t* O; int ldc; int scols; float sc;
    __device__ __forceinline__ void operator()(const f32x4 (&acc)[2][2][4][2], const Unit& u, int wr, int wc, int fr, int fq) const {
        const int row0 = u.pm * BM + wr * 64 + fr, col0 = u.pn * BM + wc * 32 + 8 * fq;
        const float s = (u.pn * BM < scols) ? sc : 1.f;
#pragma unroll
        for (int ai = 0; ai < 2; ++ai)
#pragma unroll
            for (int m = 0; m < 4; ++m) { bf16_t* rowp = O + (size_t)(row0 + ai * HALF + m * 16) * ldc + col0;
#pragma unroll
                for (int bj = 0; bj < 2; ++bj) { const f32x4 v0 = acc[ai][bj][m][0] * s, v1 = acc[ai][bj][m][1] * s;
                    u32x4 w; w.x = cvt_pk_bf16(v0[0], v0[1]); w.y = cvt_pk_bf16(v0[2], v0[3]); w.z = cvt_pk_bf16(v1[0], v1[1]); w.w = cvt_pk_bf16(v1[2], v1[3]);
                    *(u32x4*)(rowp + bj * HALF) = w; } }
    }
};
struct EpiFp8 {
    static constexpr bool PERM = true;
    unsigned char* O; int ldc;
    __device__ __forceinline__ void operator()(const f32x4 (&acc)[2][2][4][2], const Unit& u, int wr, int wc, int fr, int fq) const {
        const int row0 = u.pm * BM + wr * 64 + fr, col0 = u.pn * BM + wc * 32 + 8 * fq;
#pragma unroll
        for (int ai = 0; ai < 2; ++ai)
#pragma unroll
            for (int m = 0; m < 4; ++m) { unsigned char* rowp = O + (size_t)(row0 + ai * HALF + m * 16) * ldc + col0;
#pragma unroll
                for (int bj = 0; bj < 2; ++bj) { const f32x4 v0 = acc[ai][bj][m][0], v1 = acc[ai][bj][m][1];
                    int t0 = __builtin_amdgcn_cvt_pk_fp8_f32(v0[0], v0[1], 0, false); t0 = __builtin_amdgcn_cvt_pk_fp8_f32(v0[2], v0[3], t0, true);
                    int t1 = __builtin_amdgcn_cvt_pk_fp8_f32(v1[0], v1[1], 0, false); t1 = __builtin_amdgcn_cvt_pk_fp8_f32(v1[2], v1[3], t1, true);
                    *(u32x2*)(rowp + bj * HALF) = (u32x2){(unsigned)t0, (unsigned)t1}; } }
    }
};
struct EpiResF32 {
    static constexpr bool PERM = false;
    const float* R; float* C; int ldc;
    __device__ __forceinline__ void operator()(const f32x4 (&acc)[2][2][4][2], const Unit& u, int wr, int wc, int fr, int fq) const {
        const int row0 = u.pm * BM + wr * 64 + fr, col0 = u.pn * BM + wc * 32 + 4 * fq;
#pragma unroll
        for (int ai = 0; ai < 2; ++ai)
#pragma unroll
            for (int m = 0; m < 4; ++m) { const size_t off = (size_t)(row0 + ai * HALF + m * 16) * ldc + col0;
#pragma unroll
                for (int bj = 0; bj < 2; ++bj)
#pragma unroll
                    for (int n = 0; n < 2; ++n) { const f32x4 r = *(const f32x4*)(R + off + bj * HALF + n * 16); *(f32x4*)(C + off + bj * HALF + n * 16) = r + acc[ai][bj][m][n]; } }
    }
};
struct EpiSwiGLU {
    static constexpr bool PERM = true;
    unsigned char* O; int ldc;
    __device__ __forceinline__ void operator()(const f32x4 (&acc)[2][2][4][2], const Unit& u, int wr, int wc, int fr, int fq) const {
        const int row0 = u.pm * BM + wr * 64 + fr, col0 = u.pn * HALF + wc * 32 + 8 * fq;
#pragma unroll
        for (int ai = 0; ai < 2; ++ai)
#pragma unroll
            for (int m = 0; m < 4; ++m) { unsigned char* rowp = O + (size_t)(row0 + ai * HALF + m * 16) * ldc + col0;
                float o[8];
#pragma unroll
                for (int n = 0; n < 2; ++n)
#pragma unroll
                    for (int j = 0; j < 4; ++j) { const float g = acc[ai][0][m][n][j], up = acc[ai][1][m][n][j];
                        o[n * 4 + j] = g * __builtin_amdgcn_rcpf(1.f + __builtin_amdgcn_exp2f(-g * LOG2E)) * up; }
                u32x2 w; int t0 = __builtin_amdgcn_cvt_pk_fp8_f32(o[0], o[1], 0, false); t0 = __builtin_amdgcn_cvt_pk_fp8_f32(o[2], o[3], t0, true);
                int t1 = __builtin_amdgcn_cvt_pk_fp8_f32(o[4], o[5], 0, false); t1 = __builtin_amdgcn_cvt_pk_fp8_f32(o[6], o[7], t1, true);
                w.x = (unsigned)t0; w.y = (unsigned)t1; *(u32x2*)rowp = w; }
    }
};

struct GeoPlain {
    static constexpr bool GATHER = false;
    const bf16_t* A; const bf16_t* Bt; int KB; TileOrder ord;
    __device__ __forceinline__ bool next(int i, Unit& u) const { return ord.next(i, u); }
    __device__ __forceinline__ const char* a_ptr(const Unit& u) const { return (const char*)A + (size_t)u.pm * BM * KB; }
    __device__ __forceinline__ const char* b_ptr(const Unit& u) const { return (const char*)Bt + (size_t)u.pn * BM * KB; }
    __device__ __forceinline__ size_t hstepA() const { return (size_t)HALF * KB; }
    __device__ __forceinline__ size_t hstepB() const { return (size_t)HALF * KB; }
    __device__ __forceinline__ size_t istepA() const { return (size_t)64 * KB; }
    __device__ __forceinline__ size_t istepB() const { return (size_t)64 * KB; }
    __device__ __forceinline__ unsigned a_voff(int R, int C) const { return (unsigned)(R * KB + C * 2); }
    __device__ __forceinline__ unsigned b_voff(int R, int C) const { return (unsigned)(R * KB + C * 2); }
    __device__ __forceinline__ void fill_table(LAS unsigned*, const Unit&, int) const {}
};
struct GeoTokPerm {
    static constexpr bool GATHER = false;
    const bf16_t* A; const bf16_t* X; int KB; TileOrder ord;
    __device__ __forceinline__ bool next(int i, Unit& u) const { return ord.next(i, u); }
    __device__ __forceinline__ const char* a_ptr(const Unit& u) const { return (const char*)A + (size_t)u.pm * BM * KB; }
    __device__ __forceinline__ const char* b_ptr(const Unit& u) const { return (const char*)X + (size_t)u.pn * 32 * KB; }
    __device__ __forceinline__ size_t hstepA() const { return (size_t)HALF * KB; }
    __device__ __forceinline__ size_t hstepB() const { return (size_t)16 * KB; }
    __device__ __forceinline__ size_t istepA() const { return (size_t)64 * KB; }
    __device__ __forceinline__ size_t istepB() const { return (size_t)8 * KB; }
    __device__ __forceinline__ unsigned a_voff(int R, int C) const { return (unsigned)(R * KB + C * 2); }
    __device__ __forceinline__ unsigned b_voff(int R, int C) const { return (unsigned)(((R & 7) * SEQ + (R >> 3)) * KB + C * 2); }
    __device__ __forceinline__ void fill_table(LAS unsigned*, const Unit&, int) const {}
};
template <bool G> struct GeoExpert {
    static constexpr bool GATHER = G;
    const void* A; const void* Bt; int KB; size_t bexp;    const int* tok; TileOrder ord;
    __device__ __forceinline__ bool next(int i, Unit& u) const { return ord.next(i, u); }
    __device__ __forceinline__ const char* a_ptr(const Unit& u) const { return G ? (const char*)A : (const char*)A + (size_t)u.pm * BM * KB; }
    __device__ __forceinline__ const char* b_ptr(const Unit& u) const { return (const char*)Bt + (size_t)(u.pm >> 4) * bexp + (size_t)u.pn * BM * KB; }
    __device__ __forceinline__ size_t hstepA() const { return (size_t)HALF * KB; }
    __device__ __forceinline__ size_t hstepB() const { return (size_t)HALF * KB; }
    __device__ __forceinline__ size_t istepA() const { return (size_t)64 * KB; }
    __device__ __forceinline__ size_t istepB() const { return (size_t)64 * KB; }
    __device__ __forceinline__ unsigned a_voff(int R, int C) const { return (unsigned)(R * KB + C * 2); }
    __device__ __forceinline__ unsigned b_voff(int R, int C) const { return (unsigned)(R * KB + C * 2); }
    __device__ __forceinline__ void fill_table(LAS unsigned* tb, const Unit& u, int tid) const { if (G) { int t_ = tid; asm volatile("" : "+v"(t_));
#pragma unroll
        for (int i = 0; i < 2; ++i) { int R, C; stage_rc(t_ * 16 + i * 8192, R, C);
#pragma unroll
            for (int h = 0; h < 2; ++h) tb[h * 1024 + i * 512 + tid] = (unsigned)tok[u.pm * 256 + h * 128 + R] * (unsigned)KB + (unsigned)C * 2u; } } }
};

template <bool F8, class Epi, class Geo>
__device__ __forceinline__ void gemm_phase(LAS unsigned char* lds, LAS unsigned* tbl, const Geo& S, const Epi& E, int wave_s) {
    int tid_ = wave_s * 64 + lane_id_v(); asm volatile("" : "+v"(tid_));
    const int tid = tid_, wid = wave_s, lane = tid & 63, wr = wid >> 2, wc = wid & 3, fr = lane & 15, fq = lane >> 4;
    const int nt = S.KB / (BK * 2);
    unsigned voffA, voffB;
    { int R, C; stage_rc(tid * 16, R, C); const int Rb = Epi::PERM ? ((R & ~31) + perm32(R & 31)) : R; voffA = S.a_voff(R, C); voffB = S.b_voff(Rb, C); }
    const size_t istepA = S.istepA(), istepB = S.istepB();
    const size_t kstep = (size_t)(BK * 2);
    const size_t hstepA = S.hstepA(), hstepB = S.hstepB();
    const unsigned ldsw = (unsigned)wid * 1024u;
    const int aoff = lds_byte(wr * 64 + fr, fq * 8), boff = lds_byte(wc * 32 + fr, fq * 8);
    const LAS unsigned char* ldsB = lds + 4 * HTB + boff;
#define PG8_SA(b, h) (((b) * 2 + (h)) * HTB)
#define PG8_SB(b, h) ((4 + (b) * 2 + (h)) * HTB)
#define PG8_GLDS(bufoff, gptr, i_) __builtin_amdgcn_global_load_lds((const unsigned*)(gptr), (LAS unsigned*)(lds + (bufoff) + ldsw + (i_) * 8192), 16, 0, 0)
#define PG8_STAGE_B(bufoff, gbase) do { PG8_GLDS(bufoff, (const char*)(gbase) + voffB, 0); PG8_GLDS(bufoff, (const char*)(gbase) + istepB + voffB, 1); } while (0)
#define PG8_STAGE_A(bufoff, gbase, h, nx) do { if constexpr (Geo::GATHER) { const LAS unsigned* _tb = tbl + (((ui + ((nx) ? 1 : 0)) & 1) * 2048) + (h) * 1024 + tid; \
        const unsigned _v0 = _tb[0], _v1 = _tb[512]; PG8_GLDS(bufoff, (const char*)(gbase) + _v0, 0); PG8_GLDS(bufoff, (const char*)(gbase) + _v1, 1); } \
        else { PG8_GLDS(bufoff, (const char*)(gbase) + (h) * hstepA + voffA, 0); PG8_GLDS(bufoff, (const char*)(gbase) + (h) * hstepA + istepA + voffA, 1); } } while (0)
#define PG8_LD16(off) (*(const LAS i32x4*)(lds + (off)))
#define PG8_LDA(dst, b, h) do { _Pragma("unroll") for (int m = 0; m < 4; ++m) dst[m] = __builtin_shufflevector(PG8_LD16(PG8_SA(b, h) + aoff + m * 2048), PG8_LD16(PG8_SA(b, h) + aoff + m * 2048 + 1024), 0, 1, 2, 3, 4, 5, 6, 7); } while (0)
#define PG8_LDB(dst, b, h) do { _Pragma("unroll") for (int n = 0; n < 2; ++n) dst[n] = __builtin_shufflevector(*(const LAS i32x4*)(ldsB + ((b) * 2 + (h)) * HTB + n * 2048), *(const LAS i32x4*)(ldsB + ((b) * 2 + (h)) * HTB + n * 2048 + 1024), 0, 1, 2, 3, 4, 5, 6, 7); } while (0)
#define PG8_LO(v) __builtin_bit_cast(bf16x8, __builtin_shufflevector(v, v, 0, 1, 2, 3))
#define PG8_HI(v) __builtin_bit_cast(bf16x8, __builtin_shufflevector(v, v, 4, 5, 6, 7))
#define PG8_MMA(ai, bj, At, Bt) do { __builtin_amdgcn_s_setprio(1); _Pragma("unroll") for (int m = 0; m < 4; ++m) _Pragma("unroll") for (int n = 0; n < 2; ++n) { \
        if constexpr (F8) { acc[ai][bj][m][n] = __builtin_amdgcn_mfma_scale_f32_16x16x128_f8f6f4(Bt[n], At[m], acc[ai][bj][m][n], 0, 0, 1, F8_SCALES, 0, F8_SCALES); } \
        else { acc[ai][bj][m][n] = __builtin_amdgcn_mfma_f32_16x16x32_bf16(PG8_LO(Bt[n]), PG8_LO(At[m]), acc[ai][bj][m][n], 0, 0, 0); \
               acc[ai][bj][m][n] = __builtin_amdgcn_mfma_f32_16x16x32_bf16(PG8_HI(Bt[n]), PG8_HI(At[m]), acc[ai][bj][m][n], 0, 0, 0); } } \
        __builtin_amdgcn_s_setprio(0); } while (0)
#define PG8_WAIT_V(n) asm volatile("s_waitcnt vmcnt(" #n ")" ::: "memory")
#define PG8_WAIT_L(n) asm volatile("s_waitcnt lgkmcnt(" #n ")" ::: "memory")
#define PG8_BAR __builtin_amdgcn_s_barrier()
#define PG8_SCHED __builtin_amdgcn_sched_barrier(0)
    Unit cur, nxt; int ui = 0;
    if (!S.next(0, cur)) return;
    f32x4 acc[2][2][4][2];
#pragma unroll
    for (int a = 0; a < 2; ++a)
#pragma unroll
        for (int b = 0; b < 2; ++b)
#pragma unroll
            for (int m = 0; m < 4; ++m)
#pragma unroll
                for (int n = 0; n < 2; ++n) acc[a][b][m][n] = (f32x4){0.f, 0.f, 0.f, 0.f};
    i32x8 At[4], B0[2], B1[2];
    const char* cA = S.a_ptr(cur); const char* cB = S.b_ptr(cur);
    if constexpr (Geo::GATHER) {
        S.fill_table(tbl, cur, tid);
        Unit u1; if (S.next(1, u1)) S.fill_table(tbl + 2048, u1, tid);
        asm volatile("s_waitcnt vmcnt(0) lgkmcnt(0)" ::: "memory"); PG8_BAR; asm volatile("" ::: "memory");
    }
    PG8_STAGE_B(PG8_SB(0, 0), cB); PG8_STAGE_B(PG8_SB(0, 1), cB + hstepB); PG8_STAGE_A(PG8_SA(0, 0), cA, 0, false); PG8_STAGE_A(PG8_SA(0, 1), cA, 1, false);
    if (wr == 1) PG8_BAR;
    PG8_WAIT_V(2); PG8_BAR;
    PG8_STAGE_B(PG8_SB(1, 0), cB + kstep); PG8_STAGE_A(PG8_SA(1, 0), cA + kstep, 0, false); PG8_STAGE_B(PG8_SB(1, 1), cB + hstepB + kstep);
    PG8_WAIT_V(6); PG8_BAR;
    for (;;) {
        const bool has_next = S.next(ui + 1, nxt);
        const char* nA = has_next ? S.a_ptr(nxt) : cA; const char* nB = has_next ? S.b_ptr(nxt) : cB;
#pragma clang loop unroll(disable)
        for (int t = 0; t < nt; t += 2) {
            const bool last = (t == nt - 2);
            const bool lastn = last && has_next;
            const char* a1 = cA + (size_t)(t + 1) * kstep;
            const char* a2 = last ? nA : cA + (size_t)(t + 2) * kstep; const char* b2 = last ? nB : cB + (size_t)(t + 2) * kstep;
            const char* a3 = a2 + kstep; const char* b3 = b2 + kstep;
            if constexpr (Geo::GATHER) { if (t == 2 && ui > 0) { Unit u2; if (S.next(ui + 1, u2)) S.fill_table(tbl + (((ui + 1) & 1) * 2048), u2, tid); } }
            PG8_LDB(B0, 0, 0); PG8_LDB(B1, 0, 1); PG8_SCHED; PG8_LDA(At, 0, 0); PG8_STAGE_A(PG8_SA(1, 1), a1, 1, false);
            PG8_WAIT_V(8); PG8_WAIT_L(0); PG8_BAR; PG8_MMA(0, 0, At, B0); PG8_MMA(0, 1, At, B1); PG8_BAR; PG8_SCHED;
            PG8_LDA(At, 0, 1); PG8_STAGE_B(PG8_SB(0, 0), b2); PG8_STAGE_B(PG8_SB(0, 1), b2 + hstepB); PG8_STAGE_A(PG8_SA(0, 0), a2, 0, lastn);
            PG8_WAIT_V(8); PG8_WAIT_L(0); PG8_BAR; PG8_MMA(1, 0, At, B0); PG8_MMA(1, 1, At, B1); PG8_BAR; PG8_SCHED;
            PG8_LDB(B0, 1, 0); PG8_LDB(B1, 1, 1); PG8_SCHED; PG8_LDA(At, 1, 0); PG8_STAGE_A(PG8_SA(0, 1), a2, 1, lastn);
            PG8_WAIT_V(8); PG8_WAIT_L(0); PG8_BAR; PG8_MMA(0, 0, At, B0); PG8_MMA(0, 1, At, B1); PG8_BAR; PG8_SCHED;
            PG8_LDA(At, 1, 1); PG8_STAGE_B(PG8_SB(1, 0), b3); PG8_STAGE_B(PG8_SB(1, 1), b3 + hstepB); PG8_STAGE_A(PG8_SA(1, 0), a3, 0, lastn);
            PG8_WAIT_V(8); PG8_WAIT_L(0); PG8_BAR; PG8_MMA(1, 0, At, B0); PG8_MMA(1, 1, At, B1); PG8_BAR; PG8_SCHED;
        }
        if (wr == 0) PG8_BAR;
        { const int l_e = lane_id_v();
          E(acc, cur, wr, wc, l_e & 15, l_e >> 4); }
        if (!has_next) break;
#pragma unroll
        for (int a = 0; a < 2; ++a)
#pragma unroll
            for (int b = 0; b < 2; ++b)
#pragma unroll
                for (int m = 0; m < 4; ++m)
#pragma unroll
                    for (int n = 0; n < 2; ++n) acc[a][b][m][n] = (f32x4){0.f, 0.f, 0.f, 0.f};
        cur = nxt; cA = nA; cB = nB; ++ui;
        if (wr == 1) PG8_BAR;
    }
    PG8_WAIT_V(0);
    PG8_BAR;
#undef PG8_SA
#undef PG8_SB
#undef PG8_GLDS
#undef PG8_STAGE_B
#undef PG8_STAGE_A
#undef PG8_LDA
#undef PG8_LDB
#undef PG8_LD16
#undef PG8_LO
#undef PG8_HI
#undef PG8_MMA
#undef PG8_WAIT_V
#undef PG8_WAIT_L
#undef PG8_BAR
#undef PG8_SCHED
}
}

namespace att {
constexpr int KVBLK = 64, LDQKV = ACOLS;
constexpr int SHM_V = KVBLK * 128 * 2, SHM_K = KVBLK * 64 * 2, OFF_V = 0, OFF_K = 2 * SHM_V, OFF_WS = OFF_K + 2 * SHM_K, LDS_TOTAL = OFF_WS + 8 * 64 * 4;
constexpr float THR = 8.f;
#define KSWZ64(row, colB) ((row) * 128 + ((colB) ^ ((((row) >> 1) & 7) << 4)))
#define SBAR() __builtin_amdgcn_sched_barrier(0)
__device__ __forceinline__ int crow(int r, int hi) { return (r & 3) + 8 * (r >> 2) + 4 * hi; }
__device__ __forceinline__ unsigned cvtpk(float lo, float hi) { unsigned r; asm volatile("v_cvt_pk_bf16_f32 %0, %1, %2" : "=v"(r) : "v"(lo), "v"(hi)); return r; }
__device__ __forceinline__ int v_st(int k, int c) { const int kk = k;     return ((kk >> 3) * 4 + (c >> 5)) * 512 + ((kk & 7) * 32 + (c & 31)) * 2; }
__device__ __forceinline__ int v_rd_base(int lane) { return ((lane & 3) << 3) | (((lane >> 2) & 3) << 6) | (((lane >> 4) & 1) << 5) | (((lane >> 5) & 1) << 8); }
constexpr int v_rd_off(int d0, int ks, int half) { return d0 * 512 + ks * 4096 + half * 2048; }
__device__ __forceinline__ float fadd_s(float a, float b) { float r; asm("v_add_f32 %0, %1, %2" : "=v"(r) : "v"(a), "v"(b)); return r; }
template <int OFF> __device__ __forceinline__ v4i16_t tr_read(int vb) { v4i16_t r; asm volatile("ds_read_b64_tr_b16 %0, %1 offset:%2" : "=&v"(r) : "v"(vb), "i"(OFF) : "memory"); return r; }
template <int D0> __device__ __forceinline__ void pv_one(f32x16& od, int vb, bf16x8 pa0, bf16x8 pa1, bf16x8 pa2, bf16x8 pa3) {
    const v4i16_t l0 = tr_read<v_rd_off(D0, 0, 0)>(vb), h0 = tr_read<v_rd_off(D0, 0, 1)>(vb), l1 = tr_read<v_rd_off(D0, 1, 0)>(vb), h1 = tr_read<v_rd_off(D0, 1, 1)>(vb);
    const v4i16_t l2 = tr_read<v_rd_off(D0, 2, 0)>(vb), h2 = tr_read<v_rd_off(D0, 2, 1)>(vb), l3 = tr_read<v_rd_off(D0, 3, 0)>(vb), h3 = tr_read<v_rd_off(D0, 3, 1)>(vb);
    asm volatile("s_waitcnt lgkmcnt(0)" ::: "memory"); SBAR();
#define PK(L, H) (bf16x8){L[0], L[1], L[2], L[3], H[0], H[1], H[2], H[3]}
    od = __builtin_amdgcn_mfma_f32_32x32x16_bf16(pa0, PK(l0, h0), od, 0, 0, 0);
    od = __builtin_amdgcn_mfma_f32_32x32x16_bf16(pa1, PK(l1, h1), od, 0, 0, 0);
    od = __builtin_amdgcn_mfma_f32_32x32x16_bf16(pa2, PK(l2, h2), od, 0, 0, 0);
    od = __builtin_amdgcn_mfma_f32_32x32x16_bf16(pa3, PK(l3, h3), od, 0, 0, 0);
#undef PK
}
struct VOps { v4i16_t L0, H0, L1, H1, L2, H2, L3, H3; };
__device__ __forceinline__ void pv_rd0(int vb, VOps& v) {
    v.L0 = tr_read<v_rd_off(0, 0, 0)>(vb); v.H0 = tr_read<v_rd_off(0, 0, 1)>(vb); v.L1 = tr_read<v_rd_off(0, 1, 0)>(vb); v.H1 = tr_read<v_rd_off(0, 1, 1)>(vb);
    v.L2 = tr_read<v_rd_off(0, 2, 0)>(vb); v.H2 = tr_read<v_rd_off(0, 2, 1)>(vb); v.L3 = tr_read<v_rd_off(0, 3, 0)>(vb); v.H3 = tr_read<v_rd_off(0, 3, 1)>(vb);
}
__device__ __forceinline__ void pv_d0(f32x16* o, int vb, bf16x8 pa0, bf16x8 pa1, bf16x8 pa2, bf16x8 pa3, VOps& v) {
    v4i16_t L0 = v.L0, H0 = v.H0, L1 = v.L1, H1 = v.H1, L2 = v.L2, H2 = v.H2, L3 = v.L3, H3 = v.H3;
#define PK(L, H) (bf16x8){L[0], L[1], L[2], L[3], H[0], H[1], H[2], H[3]}
#define LGKMC(n) asm volatile("s_waitcnt lgkmcnt(" #n ")" ::: "memory")
#define PV_RD(G, K, L, H) do { L = tr_read<v_rd_off(G, K, 0)>(vb); H = tr_read<v_rd_off(G, K, 1)>(vb); } while (0)
#define PV_GRP(G, W1, W2, W3) do {   \
        LGKMC(4); SBAR(); o[G] = __builtin_amdgcn_mfma_f32_32x32x16_bf16(pa0, PK(L0, H0), o[G], 0, 0, 0); o[G] = __builtin_amdgcn_mfma_f32_32x32x16_bf16(pa1, PK(L1, H1), o[G], 0, 0, 0); SBAR(); \
        if (G < 3) { PV_RD((G < 3 ? G + 1 : 3), 0, L0, H0); PV_RD((G < 3 ? G + 1 : 3), 1, L1, H1); } \
        W2; SBAR(); o[G] = __builtin_amdgcn_mfma_f32_32x32x16_bf16(pa2, PK(L2, H2), o[G], 0, 0, 0); o[G] = __builtin_amdgcn_mfma_f32_32x32x16_bf16(pa3, PK(L3, H3), o[G], 0, 0, 0); SBAR(); \
        if (G < 3) { PV_RD((G < 3 ? G + 1 : 3), 2, L2, H2); PV_RD((G < 3 ? G + 1 : 3), 3, L3, H3); } } while (0)
    PV_GRP(0, , LGKMC(4), ); PV_GRP(1, , LGKMC(4), ); PV_GRP(2, , LGKMC(4), ); PV_GRP(3, , LGKMC(0), );
#undef PV_GRP
#undef PV_RD
#undef LGKMC
#undef PK
}
__device__ __forceinline__ void qk_mfma(f32x16& p0, f32x16& p1, const char* Ks, const bf16x8* qr, const f32x16& negm, int kb) {
#pragma unroll
    for (int d0 = 0; d0 < 4; ++d0) { int x_ = d0 * 32; asm volatile("" : "+s"(x_));
        const bf16x8 b0 = *reinterpret_cast<const bf16x8*>(Ks + (kb ^ x_));
        const bf16x8 b1 = *reinterpret_cast<const bf16x8*>(Ks + (kb ^ x_) + 32 * 128);
        if (d0 == 0) { p0 = __builtin_amdgcn_mfma_f32_32x32x16_bf16(b0, qr[0], negm, 0, 0, 0); p1 = __builtin_amdgcn_mfma_f32_32x32x16_bf16(b1, qr[0], negm, 0, 0, 0); }
        else { p0 = __builtin_amdgcn_mfma_f32_32x32x16_bf16(b0, qr[d0], p0, 0, 0, 0); p1 = __builtin_amdgcn_mfma_f32_32x32x16_bf16(b1, qr[d0], p1, 0, 0, 0); } }
}
template <int OFF> __device__ __forceinline__ bf16x8 k_read(int ka) { bf16x8 r; asm volatile("ds_read_b128 %0, %1 offset:%2" : "=&v"(r) : "v"(ka), "i"(OFF) : "memory"); return r; }
struct KOps { bf16x8 k0, k1, k2, k3; };
template <int KOFF> __device__ __forceinline__ void qk_issue(int ka, KOps& k) {
    int x1 = 32; asm volatile("" : "+s"(x1)); const int a1 = ka ^ x1;
    k.k0 = k_read<KOFF>(ka); k.k1 = k_read<KOFF + 4096>(ka); k.k2 = k_read<KOFF>(a1); k.k3 = k_read<KOFF + 4096>(a1);
}
template <int KOFF, bool DUTY, bool PRE> __device__ __forceinline__ void qk_rest(f32x16& p0, f32x16& p1, int ka, const bf16x8* qr, const f32x16& negm, KOps& k, int vb, VOps& v) {
    int x2 = 64, x3 = 96; asm volatile("" : "+s"(x2), "+s"(x3));
    const int a2 = ka ^ x2, a3 = ka ^ x3;
#define LGKMC(n) asm volatile("s_waitcnt lgkmcnt(" #n ")" ::: "memory")
    bf16x8 k0 = k.k0, k1 = k.k1, k2 = k.k2, k3 = k.k3;
    if (DUTY) LGKMC(5); else LGKMC(2);
    SBAR(); p0 = __builtin_amdgcn_mfma_f32_32x32x16_bf16(k0, qr[0], negm, 0, 0, 0); p1 = __builtin_amdgcn_mfma_f32_32x32x16_bf16(k1, qr[0], negm, 0, 0, 0); SBAR();
    k0 = k_read<KOFF>(a2); k1 = k_read<KOFF + 4096>(a2);
    if (DUTY) LGKMC(5); else LGKMC(2);
    SBAR(); p0 = __builtin_amdgcn_mfma_f32_32x32x16_bf16(k2, qr[1], p0, 0, 0, 0); p1 = __builtin_amdgcn_mfma_f32_32x32x16_bf16(k3, qr[1], p1, 0, 0, 0); SBAR();
    k2 = k_read<KOFF>(a3); k3 = k_read<KOFF + 4096>(a3);
    LGKMC(2); SBAR(); p0 = __builtin_amdgcn_mfma_f32_32x32x16_bf16(k0, qr[2], p0, 0, 0, 0); p1 = __builtin_amdgcn_mfma_f32_32x32x16_bf16(k1, qr[2], p1, 0, 0, 0); SBAR();
    if (PRE) { pv_rd0(vb, v); LGKMC(8); } else LGKMC(0);
    SBAR(); p0 = __builtin_amdgcn_mfma_f32_32x32x16_bf16(k2, qr[3], p0, 0, 0, 0); p1 = __builtin_amdgcn_mfma_f32_32x32x16_bf16(k3, qr[3], p1, 0, 0, 0); SBAR();
#undef LGKMC
}
__device__ __forceinline__ void rowmaxSM(f32x16& p0, f32x16& p1, f32x16& cl, float& alpha, bool diag, float a0, float a1, int dd, float slope2) {
    asm volatile("" : "+v"(a0), "+v"(a1), "+v"(dd), "+v"(p0), "+v"(p1));
    if (diag) {
        const int h8 = (lane_id_v() >> 5) * 8, y = dd - 32, w0 = dd - h8, w1 = y - h8;
#pragma unroll
        for (int r = 0; r < 16; ++r) { const int c2 = 2 * ((r & 3) + 8 * (r >> 2)); p0[r] = fmaf(-slope2, (float)max(dd, c2 - w0), p0[r]); p1[r] = fmaf(-slope2, (float)max(y, c2 - w1), p1[r]); }
    } else {
#pragma unroll
        for (int r = 0; r < 16; ++r) { p0[r] = fadd_s(p0[r], a0); p1[r] = fadd_s(p1[r], a1); }
    }
    float pmax = p0[0];
#pragma unroll
    for (int r = 1; r < 16; ++r) pmax = fmaxf(pmax, p0[r]);
#pragma unroll
    for (int r = 0; r < 16; ++r) pmax = fmaxf(pmax, p1[r]);
    { auto rr = __builtin_amdgcn_permlane32_swap(__float_as_uint(pmax), __float_as_uint(pmax), false, false); pmax = fmaxf(__uint_as_float(rr[0]), __uint_as_float(rr[1])); }
    if (__builtin_expect(!__any(pmax > THR), 1)) { alpha = 1.f; }
    else { const float dl = fmaxf(pmax, 0.f); alpha = __builtin_amdgcn_exp2f(-dl);
#pragma unroll
        for (int r = 0; r < 16; ++r) { p0[r] -= dl; p1[r] -= dl; cl[r] -= dl; } }
}
__device__ __forceinline__ float rowsumSM(f32x16& p0, f32x16& p1) {
    asm volatile("s_nop 0" : "+v"(p0), "+v"(p1));
    float s0 = fadd_s(p0[0], p1[0]), s1 = fadd_s(p0[1], p1[1]), s2 = fadd_s(p0[2], p1[2]), s3 = fadd_s(p0[3], p1[3]);
#pragma unroll
    for (int r = 4; r < 16; r += 4) { s0 = fadd_s(s0, p0[r]); s1 = fadd_s(s1, p0[r + 1]); s2 = fadd_s(s2, p0[r + 2]); s3 = fadd_s(s3, p0[r + 3]);
                                      s0 = fadd_s(s0, p1[r]); s1 = fadd_s(s1, p1[r + 1]); s2 = fadd_s(s2, p1[r + 2]); s3 = fadd_s(s3, p1[r + 3]); }
    float ps = fadd_s(fadd_s(s0, s1), fadd_s(s2, s3));
    return ps;
}
__device__ __forceinline__ float specSM(f32x16& p0, f32x16& p1, f32x16& cl, float& alpha, float a0, float a1) {
    asm volatile("" : "+v"(a0), "+v"(a1), "+v"(p0), "+v"(p1));
#pragma unroll
    for (int r = 0; r < 16; ++r) p0[r] = __builtin_amdgcn_exp2f(fadd_s(p0[r], a0));
    asm volatile("s_nop 0" : "+v"(p0));
    float s0 = fadd_s(p0[0], p0[4]), s1 = fadd_s(p0[1], p0[5]), s2 = fadd_s(p0[2], p0[6]), s3 = fadd_s(p0[3], p0[7]);
#pragma unroll
    for (int r = 8; r < 16; r += 4) { s0 = fadd_s(s0, p0[r]); s1 = fadd_s(s1, p0[r + 1]); s2 = fadd_s(s2, p0[r + 2]); s3 = fadd_s(s3, p0[r + 3]); }
#pragma unroll
    for (int r = 0; r < 16; ++r) p1[r] = __builtin_amdgcn_exp2f(fadd_s(p1[r], a1));
    asm volatile("s_nop 0" : "+v"(p1));
#pragma unroll
    for (int r = 0; r < 16; r += 4) { s0 = fadd_s(s0, p1[r]); s1 = fadd_s(s1, p1[r + 1]); s2 = fadd_s(s2, p1[r + 2]); s3 = fadd_s(s3, p1[r + 3]); }
    float ps = fadd_s(fadd_s(s0, s1), fadd_s(s2, s3));
    if (__builtin_expect(!__any(ps > 256.f), 1)) { alpha = 1.f; }
    else { float em = p0[0];
#pragma unroll
        for (int r = 1; r < 16; ++r) em = fmaxf(em, p0[r]);
#pragma unroll
        for (int r = 0; r < 16; ++r) em = fmaxf(em, p1[r]);
        { auto rr = __builtin_amdgcn_permlane32_swap(__float_as_uint(em), __float_as_uint(em), false, false); em = fmaxf(__uint_as_float(rr[0]), __uint_as_float(rr[1])); }
        const float dl = fmaxf(__builtin_amdgcn_logf(em), 0.f); alpha = __builtin_amdgcn_exp2f(-dl);
#pragma unroll
        for (int r = 0; r < 16; ++r) { p0[r] *= alpha; p1[r] *= alpha; cl[r] -= dl; }
        ps *= alpha; }
    return ps;
}
__device__ __forceinline__ void packSM(f32x16& p0, f32x16& p1, bf16x8& pa0, bf16x8& pa1, bf16x8& pa2, bf16x8& pa3) {
#define PK4(P, BASE, OUT) do { const u32x4 w = {cvtpk(P[BASE + 0], P[BASE + 1]), cvtpk(P[BASE + 2], P[BASE + 3]), cvtpk(P[BASE + 4], P[BASE + 5]), cvtpk(P[BASE + 6], P[BASE + 7])}; \
        OUT = __builtin_bit_cast(bf16x8, w); } while (0)
    PK4(p0, 0, pa0); PK4(p0, 8, pa1); PK4(p1, 0, pa2); PK4(p1, 8, pa3);
#undef PK4
}
__device__ __forceinline__ void pass(f32x16 (&o)[4], const bf16_t* Qw, const bf16_t* Kh, const bf16_t* Vh, int qpos, int qb, float slope2, char* lds, int tid, int nL, int NT, bool spec) {
    const int wid = tid >> 6, lane = tid & 63, r32 = lane & 31, hi = lane >> 5;
    const int g = __builtin_amdgcn_readfirstlane(wid >> 2);
    const GAS bf16_t* Kg = (const GAS bf16_t*)(((uintptr_t)(unsigned)__builtin_amdgcn_readfirstlane((int)((uintptr_t)Kh >> 32)) << 32) | (unsigned)__builtin_amdgcn_readfirstlane((int)(uintptr_t)Kh));
    const GAS bf16_t* Vg = (const GAS bf16_t*)(((uintptr_t)(unsigned)__builtin_amdgcn_readfirstlane((int)((uintptr_t)Vh >> 32)) << 32) | (unsigned)__builtin_amdgcn_readfirstlane((int)(uintptr_t)Vh));
    char* V_lds = lds + OFF_V; char* K_lds = lds + OFF_K;
    float* ws = (float*)(lds + OFF_WS) + wid * 64; float* li_l = ws; float* al_l = ws + 32;
    float l_reg = 0.f; bf16x8 qr[4];
#pragma unroll
    for (int d = 0; d < 4; ++d)
#pragma unroll
        for (int r = 0; r < 16; ++r) o[d][r] = 0.f;
    f32x16 cl;
    { const float h4s = slope2 * (float)((lane_id_v() >> 5) * 4);
#pragma unroll
      for (int r = 0; r < 16; ++r) cl[r] = fmaf(slope2, (float)((r & 3) + 8 * (r >> 2)), h4s); }
#pragma unroll
    for (int d0 = 0; d0 < 4; ++d0) qr[d0] = *reinterpret_cast<const bf16x8*>(Qw + d0 * 16);
    const int kr = tid >> 3, kc = (tid & 7) * 8, kst = KSWZ64(kr, kc * 2);
    const int sr = tid >> 4, sc = (tid & 15) * 8, vst0 = v_st(sr, sc), vst1 = v_st(32 + sr, sc);
    const int vb0 = (int)(uintptr_t)V_lds + v_rd_base(lane);
    const int kb = KSWZ64(r32, hi * 16); const int ka = (int)(uintptr_t)K_lds + kb;
    const unsigned voff0 = (unsigned)(sr * LDQKV + sc) * 2u, koff0 = (unsigned)(kr * LDQKV + kc) * 2u;
    const unsigned voffU = (unsigned)((63 - sr) * LDQKV + sc) * 2u, koffU = (unsigned)((63 - kr) * LDQKV + kc) * 2u;
    struct { bf16x8 vs0, vs1, ks; } st_[2];
    const int nd = 4 * qb;
#define KTF(i) ((i) < 4 ? nd + (i) : ((i) < 4 + nL ? nd + 3 - (i) : nd + (i) - nL))
    int ktv; { const int i_ = min(lane, NT - 1); ktv = KTF(i_); }
#define KT(i) __builtin_amdgcn_readlane(ktv, (i))
#define KTC(i) KT(min((i), NT - 1))
#define SLOAD(i, kt, vt) do { const int kt_ = (kt), vt_ = (vt); const bool ku_ = kt_ > nd + 3, vu_ = vt_ > nd + 3; \
        const GAS char* kb_ = (const GAS char*)Kg + (size_t)(unsigned)(kt_ * (KVBLK * LDQKV * 2)); const GAS char* vb_ = (const GAS char*)Vg + (size_t)(unsigned)(vt_ * (KVBLK * LDQKV * 2)); \
        const GAS char* vb2_ = vu_ ? vb_ - 32 * LDQKV * 2 : vb_ + 32 * LDQKV * 2; const unsigned ko_ = ku_ ? koffU : koff0, vo_ = vu_ ? voffU : voff0;        \
        st_[i].vs0 = *(const GAS bf16x8*)(vb_ + vo_); st_[i].vs1 = *(const GAS bf16x8*)(vb2_ + vo_); st_[i].ks = *(const GAS bf16x8*)(kb_ + ko_); } while (0)
#define SWRITE(i, kbo, vbo) do { *(bf16x8*)(V_lds + (vbo) + vst0) = st_[i].vs0; *(bf16x8*)(V_lds + (vbo) + vst1) = st_[i].vs1; *(bf16x8*)(K_lds + (kbo) + kst) = st_[i].ks; } while (0)
#define SWAIT() asm volatile("s_waitcnt vmcnt(3)" ::: "memory")
#define RESC(a) do { if (__any((a) < 1.f)) { if (hi == 0) al_l[r32] = (a); asm volatile("s_waitcnt lgkmcnt(0)" ::: "memory"); \
        _Pragma("unroll") for (int d = 0; d < 4; ++d) _Pragma("unroll") for (int r = 0; r < 16; ++r) o[d][r] *= al_l[crow(r, hi)]; } } while (0)
#define BAR() do { SBAR(); __syncthreads(); SBAR(); } while (0)
#define DUTY(PAR, P) do { SWAIT(); SWRITE(PAR, ((PAR + 1) & 1) * SHM_K, PAR * SHM_V); SLOAD(PAR, KTC((P) + 3), KTC((P) + 2)); SBAR(); } while (0)
#define SSLOT(PAR, t) do { \
        const int tl_ = KT(t); const int dd_ = qpos - tl_ * KVBLK; const float a0_ = slope2 * (float)(tl_ > nd ? dd_ - 63 : -dd_); \
        float al_, ps_; \
        if ((t) < 4 || !spec) { rowmaxSM(p0, p1, cl, al_, (t) < 4, a0_, a0_ + 32.f * slope2, dd_, slope2); \
            _Pragma("unroll") for (int r = 0; r < 16; ++r) { p0[r] = __builtin_amdgcn_exp2f(p0[r]); p1[r] = __builtin_amdgcn_exp2f(p1[r]); } ps_ = rowsumSM(p0, p1); } \
        else ps_ = specSM(p0, p1, cl, al_, a0_, a0_ + 32.f * slope2); \
        RESC(al_); l_reg = l_reg * al_ + ps_; packSM(p0, p1, pa0, pa1, pa2, pa3); } while (0)
    f32x16 p0, p1; bf16x8 pa0, pa1, pa2, pa3;
    {
        const bf16x8 k0r = *(const GAS bf16x8*)((const GAS char*)Kg + (size_t)(unsigned)(nd * (KVBLK * LDQKV * 2)) + koff0);
        SLOAD(0, KTC(1), KTC(0)); SLOAD(1, KTC(2), KTC(1));
        asm volatile("s_waitcnt vmcnt(6)" ::: "memory");
        *(bf16x8*)(K_lds + kst) = k0r;
        __syncthreads();
    }
    if (g) BAR();
    KOps ko; VOps vo;
    qk_issue<0>(ka, ko); DUTY(0, 0); qk_rest<0, true, false>(p0, p1, ka, qr, cl, ko, vb0, vo);
    for (int t = 0; t < NT; t += 2) {
        BAR(); SSLOT(0, t); BAR();
        __builtin_amdgcn_s_setprio(1);
        qk_issue<SHM_K>(ka, ko); DUTY(1, t + 1); qk_rest<SHM_K, true, true>(p0, p1, ka, qr, cl, ko, vb0, vo);
        pv_d0(o, vb0, pa0, pa1, pa2, pa3, vo); __builtin_amdgcn_s_setprio(0);
        BAR(); SSLOT(1, t + 1); BAR();
        __builtin_amdgcn_s_setprio(1);
        if (t + 2 < NT) { qk_issue<0>(ka, ko); DUTY(0, t + 2); qk_rest<0, true, true>(p0, p1, ka, qr, cl, ko, vb0 + SHM_V, vo); }
        else pv_rd0(vb0 + SHM_V, vo);
        pv_d0(o, vb0 + SHM_V, pa0, pa1, pa2, pa3, vo); __builtin_amdgcn_s_setprio(0);
    }
    if (!g) BAR();
    { auto rr = __builtin_amdgcn_permlane32_swap(__float_as_uint(l_reg), __float_as_uint(l_reg), false, false); l_reg = __uint_as_float(rr[0]) + __uint_as_float(rr[1]); }
    if (hi == 0) li_l[r32] = l_reg; asm volatile("s_waitcnt lgkmcnt(0)" ::: "memory");
#pragma unroll
    for (int r = 0; r < 16; ++r) { const float rl = __builtin_amdgcn_rcpf(li_l[crow(r, hi)]);
#pragma unroll
        for (int d = 0; d < 4; ++d) o[d][r] *= rl; }
    __syncthreads();
#undef KT
#undef KTF
#undef KTC
#undef SLOAD
#undef SWRITE
#undef SWAIT
#undef RESC
#undef BAR
#undef SSLOT
}
#undef SBAR
}

typedef GAS unsigned gu32;
#define XB_TMO      128
#define XB_XCNT(j)  (256  + 64 * (j))
#define XB_XSUB(j)  (1280 + 64 * (j))
#define XB_XGEN(j)  (2304 + 64 * (j))
#define XB_TOP      3328
#define XB_TOPGEN   3392
#define XCD_BAR_WORDS 3456
#define XB_SPIN_CAP (1u << 23)
__device__ __forceinline__ unsigned xb_ld(unsigned* p)              { return __hip_atomic_load(p, __ATOMIC_RELAXED, __HIP_MEMORY_SCOPE_AGENT); }
__device__ __forceinline__ unsigned xb_add(unsigned* p, unsigned v) { return __hip_atomic_fetch_add(p, v, __ATOMIC_RELAXED, __HIP_MEMORY_SCOPE_AGENT); }
__device__ __forceinline__ unsigned xb_xcc_id() { return (unsigned)__builtin_amdgcn_s_getreg((3 << 11) | 20) & 0xFu; }
#define XB_SPIN(cond, bar) do { unsigned _sp = 0; while (cond) { __builtin_amdgcn_s_sleep(1); \
    if ((++_sp & 255u) == 0u) { if (xb_ld(&(bar)[XB_TMO])) break; if (_sp > XB_SPIN_CAP) { atomicAdd(&(bar)[XB_TMO], 1u); break; } } } } while (0)
struct XcdBarrier { unsigned* bar; unsigned x; volatile LAS unsigned* st; int wave; };
__device__ __forceinline__ XcdBarrier xcd_barrier_post(unsigned* bar, volatile LAS unsigned* st, int wave) {
    XcdBarrier b; b.bar = bar; b.x = xb_xcc_id(); b.st = st; b.wave = wave;
    if (wave == 0 && lane_id_v() == 0) (void)xb_add(&bar[XB_XCNT(b.x)], 1u);
    return b;
}
__device__ __forceinline__ void xcd_barrier_complete(unsigned* bar, unsigned x, unsigned& nloc, unsigned& nx) {
    const unsigned G = gridDim.x * gridDim.y * gridDim.z;
    unsigned sum, cnt, mine, sp = 0u;
    for (;;) {
        sum = 0u; cnt = 0u; mine = 0u;
#pragma unroll
        for (unsigned j = 0; j < 16; ++j) { const unsigned c = xb_ld(&bar[XB_XCNT(j)]); sum += c; cnt += (c > 0u) ? 1u : 0u; mine = (j == x) ? c : mine; }
        if (sum == G) break;
        __builtin_amdgcn_s_sleep(1);
        if ((++sp & 255u) == 0u) { if (xb_ld(&bar[XB_TMO])) break; if (sp > XB_SPIN_CAP) { atomicAdd(&bar[XB_TMO], 1u); break; } }
    }
    nloc = mine > 0u ? mine : 1u; nx = cnt > 0u ? cnt : 1u;
}
__device__ __forceinline__ void xcd_barrier(const XcdBarrier& b) {
    asm volatile("s_waitcnt vmcnt(0)" ::: "memory");
    __syncthreads();
    if (b.wave == 0 && lane_id_v() == 0) {
        unsigned* bar = b.bar;
        __builtin_amdgcn_s_waitcnt(0);
        unsigned nloc = b.st[0], nx = b.st[1];
        if (nloc == 0u) { xcd_barrier_complete(bar, b.x, nloc, nx); b.st[0] = nloc; b.st[1] = nx; }
        const unsigned old = xb_add(&bar[XB_XSUB(b.x)], 1u);
        const unsigned gen = old / nloc;
        if (old + 1u == (gen + 1u) * nloc) {
            __builtin_amdgcn_fence(__ATOMIC_RELEASE, "agent");
            asm volatile("s_waitcnt vmcnt(0)" ::: "memory");
            const unsigned og = xb_add(&bar[XB_TOP], 1u);
            const unsigned tg = og / nx;
            if (og + 1u == (tg + 1u) * nx) xb_add(&bar[XB_TOPGEN], 1u);
            else XB_SPIN(xb_ld(&bar[XB_TOPGEN]) == tg, bar);
            __builtin_amdgcn_fence(__ATOMIC_ACQUIRE, "agent");
            xb_add(&bar[XB_XGEN(b.x)], 1u);
            asm volatile("s_waitcnt vmcnt(0)" ::: "memory");
        } else {
            XB_SPIN(xb_ld(&bar[XB_XGEN(b.x)]) == gen, bar);
            __builtin_amdgcn_fence(__ATOMIC_ACQUIRE, "agent");
            asm volatile("s_waitcnt vmcnt(0)" ::: "memory");
        }
    }
    __syncthreads();
}

template <bool F8>
__device__ __forceinline__ void p0_transpose_item(const float* W, int K, int N, void* WTv, int k0, int n0, int orow0, LAS float* scr, int lane) {
#pragma unroll
    for (int i = 0; i < 8; ++i) { const int kk = 8 * i + (lane >> 3), n4 = (lane & 7) * 4; const f32x4 v = *(const GAS f32x4*)(W + (size_t)(k0 + kk) * N + n0 + n4);
        LAS float* d = scr + kk * 33 + n4; d[0] = v.x; d[1] = v.y; d[2] = v.z; d[3] = v.w; }
    LDS_WAIT(); asm volatile("" ::: "memory");
    const int c = lane & 7;
#pragma unroll
    for (int j = 0; j < 4; ++j) { const int n = (lane >> 3) + 8 * j; const LAS float* s = scr + (8 * c) * 33 + n;
        if constexpr (F8) {
            int t0 = __builtin_amdgcn_cvt_pk_fp8_f32(s[0 * 33] * 32.f, s[1 * 33] * 32.f, 0, false); t0 = __builtin_amdgcn_cvt_pk_fp8_f32(s[2 * 33] * 32.f, s[3 * 33] * 32.f, t0, true);
            int t1 = __builtin_amdgcn_cvt_pk_fp8_f32(s[4 * 33] * 32.f, s[5 * 33] * 32.f, 0, false); t1 = __builtin_amdgcn_cvt_pk_fp8_f32(s[6 * 33] * 32.f, s[7 * 33] * 32.f, t1, true);
            *(GAS u32x2*)((unsigned char*)WTv + (size_t)(orow0 + n) * K + k0 + 8 * c) = (u32x2){(unsigned)t0, (unsigned)t1};
        } else {
            u32x4 o; o.x = pk2(s[0 * 33], s[1 * 33]); o.y = pk2(s[2 * 33], s[3 * 33]); o.z = pk2(s[4 * 33], s[5 * 33]); o.w = pk2(s[6 * 33], s[7 * 33]);
            *(GAS u32x4*)((bf16_t*)WTv + (size_t)(orow0 + n) * K + k0 + 8 * c) = o; } }
    LDS_WAIT(); asm volatile("" ::: "memory");
}

struct Args { const float* in[25]; float* out; unsigned char* ws; };
constexpr int P0_I_IN = (DM / 64) * (INC / 32), P0_I_OUT = (DM / 64) * (DM / 32), P0_I_GU = (DM / 64) * (FF / 32), P0_I_DN = (FF / 64) * (DM / 32);
constexpr int P0_NITEMS = P0_I_IN + P0_I_OUT + NE * (2 * P0_I_GU + P0_I_DN), P0_NDEF = 10 * (2 * P0_I_GU + P0_I_DN), P0_CHUNK = 4;
__device__ __forceinline__ void p0_weight_item(const Args& args, int it, bf16_t* WIN, bf16_t* WOUT, unsigned char* WGU, unsigned char* WD, LAS float* scr, int lane) {
    int r = it;
    if (r < P0_I_IN) { const int nblk = INC / 32, kb = r / nblk, nb = r % nblk; p0_transpose_item<false>(args.in[2], DM, INC, WIN, 64 * kb, 32 * nb, 32 * nb, scr, lane); return; } r -= P0_I_IN;
    if (r < P0_I_OUT) { const int nblk = DM / 32, kb = r / nblk, nb = r % nblk; p0_transpose_item<false>(args.in[18], DM, DM, WOUT, 64 * kb, 32 * nb, 32 * nb, scr, lane); return; } r -= P0_I_OUT;
    const int e = r / (2 * P0_I_GU + P0_I_DN); r -= e * (2 * P0_I_GU + P0_I_DN);
    if (r < 2 * P0_I_GU) { const int up = r >= P0_I_GU; if (up) r -= P0_I_GU; const int nblk = FF / 32, kb = r / nblk, nb = r % nblk, f0 = 32 * nb;
        const int orow = (f0 >> 7) * 256 + up * 128 + (f0 & 127);
        p0_transpose_item<true>(args.in[up ? 22 : 21] + (size_t)e * DM * FF, DM, FF, WGU + (size_t)e * 2 * FF * DM, 64 * kb, f0, orow, scr, lane); return; }
    r -= 2 * P0_I_GU;
    { const int nblk = DM / 32, kb = r / nblk, nb = r % nblk; p0_transpose_item<true>(args.in[23] + (size_t)e * FF * DM, FF, DM, WD + (size_t)e * DM * FF, 64 * kb, 32 * nb, 32 * nb, scr, lane); }
}

struct P0Item { const float* W; void* WT; int K, N, k0, n0, orow0; bool f8; };
__device__ __forceinline__ P0Item p0_decode(const Args& args, int it, bf16_t* WIN, bf16_t* WOUT, unsigned char* WGU, unsigned char* WD) {
    P0Item d; int r = it;
    if (r < P0_I_IN) { const int nblk = INC / 32, kb = r / nblk, nb = r % nblk; d.W = args.in[2]; d.WT = WIN; d.K = DM; d.N = INC; d.k0 = 64 * kb; d.n0 = 32 * nb; d.orow0 = 32 * nb; d.f8 = false; return d; } r -= P0_I_IN;
    if (r < P0_I_OUT) { const int nblk = DM / 32, kb = r / nblk, nb = r % nblk; d.W = args.in[18]; d.WT = WOUT; d.K = DM; d.N = DM; d.k0 = 64 * kb; d.n0 = 32 * nb; d.orow0 = 32 * nb; d.f8 = false; return d; } r -= P0_I_OUT;
    const int e = r / (2 * P0_I_GU + P0_I_DN); r -= e * (2 * P0_I_GU + P0_I_DN);
    if (r < 2 * P0_I_GU) { const int up = r >= P0_I_GU; if (up) r -= P0_I_GU; const int nblk = FF / 32, kb = r / nblk, nb = r % nblk, f0 = 32 * nb;
        d.W = args.in[up ? 22 : 21] + (size_t)e * DM * FF; d.WT = WGU + (size_t)e * 2 * FF * DM; d.K = DM; d.N = FF; d.k0 = 64 * kb; d.n0 = f0; d.orow0 = (f0 >> 7) * 256 + up * 128 + (f0 & 127); d.f8 = true; return d; }
    r -= 2 * P0_I_GU;
    { const int nblk = DM / 32, kb = r / nblk, nb = r % nblk; d.W = args.in[23] + (size_t)e * FF * DM; d.WT = WD + (size_t)e * DM * FF; d.K = FF; d.N = DM; d.k0 = 64 * kb; d.n0 = 32 * nb; d.orow0 = 32 * nb; d.f8 = true; }
    return d;
}
__device__ __forceinline__ void p0_load(const P0Item& d, f32x4 (&v)[8], int lane) {
#pragma unroll
    for (int i = 0; i < 8; ++i) { const int kk = 8 * i + (lane >> 3), n4 = (lane & 7) * 4; v[i] = *(const GAS f32x4*)(d.W + (size_t)(d.k0 + kk) * d.N + d.n0 + n4); }
}
__device__ __forceinline__ void p0_finish(const P0Item& d, const f32x4 (&v)[8], LAS float* scr, int lane) {
#pragma unroll
    for (int i = 0; i < 8; ++i) { const int kk = 8 * i + (lane >> 3), n4 = (lane & 7) * 4; LAS float* q = scr + kk * 33 + n4; q[0] = v[i].x; q[1] = v[i].y; q[2] = v[i].z; q[3] = v[i].w; }
    LDS_WAIT(); asm volatile("" ::: "memory");
    const int c = lane & 7;
#pragma unroll
    for (int j = 0; j < 4; ++j) { const int n = (lane >> 3) + 8 * j; const LAS float* s = scr + (8 * c) * 33 + n;
        if (d.f8) {
            int t0 = __builtin_amdgcn_cvt_pk_fp8_f32(s[0 * 33] * 32.f, s[1 * 33] * 32.f, 0, false); t0 = __builtin_amdgcn_cvt_pk_fp8_f32(s[2 * 33] * 32.f, s[3 * 33] * 32.f, t0, true);
            int t1 = __builtin_amdgcn_cvt_pk_fp8_f32(s[4 * 33] * 32.f, s[5 * 33] * 32.f, 0, false); t1 = __builtin_amdgcn_cvt_pk_fp8_f32(s[6 * 33] * 32.f, s[7 * 33] * 32.f, t1, true);
            *(GAS u32x2*)((unsigned char*)d.WT + (size_t)(d.orow0 + n) * d.K + d.k0 + 8 * c) = (u32x2){(unsigned)t0, (unsigned)t1};
        } else {
            u32x4 o; o.x = pk2(s[0 * 33], s[1 * 33]); o.y = pk2(s[2 * 33], s[3 * 33]); o.z = pk2(s[4 * 33], s[5 * 33]); o.w = pk2(s[6 * 33], s[7 * 33]);
            *(GAS u32x4*)((bf16_t*)d.WT + (size_t)(d.orow0 + n) * d.K + d.k0 + 8 * c) = o; } }
    LDS_WAIT(); asm volatile("" ::: "memory");
}

__global__ void __launch_bounds__(512, 2) mega_fwd(Args args) {
    extern __shared__ __attribute__((aligned(16))) unsigned char lds_raw[];
    LAS unsigned char* lds = (LAS unsigned char*)lds_raw;
    volatile LAS unsigned* MISC = (volatile LAS unsigned*)(lds + MISC_OFF);
    const int G = gridDim.x, bx = blockIdx.x, NGW = G * 8;
    const int wave_s = __builtin_amdgcn_readfirstlane(threadIdx.x >> 6);
    unsigned char* ws = args.ws;
    gu32* ctl = (gu32*)(ws + WS_CTL);
    const float* x = args.in[0];
    float* out = args.out;
    unsigned char* WGU = ws + WS_WGU; unsigned char* WD = ws + WS_WD; bf16_t* WIN = (bf16_t*)(ws + WS_WIN); bf16_t* WOUT = (bf16_t*)(ws + WS_WOUT);
    bf16_t* XN = (bf16_t*)(ws + WS_XN); unsigned char* H2 = ws + WS_H2; bf16_t* GF = (bf16_t*)(ws + WS_GF);
    bf16_t* HP = (bf16_t*)(ws + WS_HP); bf16_t* QKV = (bf16_t*)(ws + WS_QKV); bf16_t* HZ = (bf16_t*)(ws + WS_HZ); bf16_t* MIX = (bf16_t*)(ws + WS_MIX);
    unsigned char* ACT = ws + WS_ACT; unsigned char* Y = ws + WS_Y;
    float* AFF = (float*)(ws + WS_AFF); int* TOK = (int*)(ws + WS_TOK); float* GSEL = (float*)(ws + WS_GSEL); unsigned short* INV = (unsigned short*)(ws + WS_INV);
    float* NSUM = (float*)(ws + WS_CTL) + CW_NSUM;

    if (wave_s == 0) ((LAS unsigned*)(lds + MISC_OFF))[lane_id_v()] = 0u;
    __syncthreads();
    XcdBarrier bar = xcd_barrier_post((unsigned*)(ctl + CW_BAR), MISC + 8, wave_s);

    {
        PHASE_IDS();
        LAS float* scr = (LAS float*)(lds + wave * 16384);
        const int filt_first = (bx >> 3) & 1;
        int nst = 2; asm volatile("" : "+s"(nst));
#pragma clang loop unroll(disable)
        for (int st = 0; st < nst; ++st) {
        int lane_st = lane_id_v(); asm volatile("" : "+v"(lane_st));
        const int lane = lane_st, tid = wave * 64 + lane_st;
        if ((st ^ filt_first) == 0) {
        const int n_p0 = (G == 256) ? P0_NITEMS - P0_NDEF : P0_NITEMS;
        for (int rep_ = 0; rep_ < REP_P0W; ++rep_) {
            f32x4 nw[8];
            if (gw < n_p0) p0_load(p0_decode(args, gw, WIN, WOUT, WGU, WD), nw, lane);
            for (int it = gw; it < n_p0; it += NGW) {
                f32x4 cw[8];
#pragma unroll
                for (int i = 0; i < 8; ++i) cw[i] = nw[i];
                p0_load(p0_decode(args, it + NGW < n_p0 ? it + NGW : it, WIN, WOUT, WGU, WD), nw, lane);
                p0_finish(p0_decode(args, it, WIN, WOUT, WGU, WD), cw, scr, lane);
            }
        }
        const float* g = args.in[1];
        int rep_xn = REP_XN; asm volatile("" : "+s"(rep_xn));
        for (int rep_ = 0; rep_ < rep_xn; ++rep_)
        for (int m = gw; m < NTOK; m += NGW) {
            const GAS f32x4* xr = (const GAS f32x4*)(x + (size_t)m * DM) + lane;
            f32x4 v[4]; float s = 0.f;
#pragma unroll
            for (int j = 0; j < 4; ++j) { v[j] = xr[64 * j]; s += (v[j].x * v[j].x + v[j].y * v[j].y) + (v[j].z * v[j].z + v[j].w * v[j].w); }
            const float rstd = rsqrtf(wave_sum(s) * (1.f / DM) + EPS);
            GAS u32x2* o8 = (GAS u32x2*)(XN + (size_t)m * DM) + lane;
#pragma unroll
            for (int j = 0; j < 4; ++j) { const f32x4 gg = ((const GAS f32x4*)g)[lane + 64 * j]; u32x2 w; w.x = pk2(v[j].x * rstd * gg.x, v[j].y * rstd * gg.y); w.y = pk2(v[j].z * rstd * gg.z, v[j].w * rstd * gg.w); o8[64 * j] = w; }
        }
        } else {
        __syncthreads();
        LAS float* w1s = (LAS float*)(lds + 118784);
        LAS float* w2s = (LAS float*)(lds + 127232);
        if (bx < 256) { for (int q = tid; q < 33 * 64; q += 512) w1s[q] = args.in[5][q]; for (int q = tid; q < 64 * 64; q += 512) w2s[q] = args.in[7][q]; }
        __syncthreads();
        for (int it = bx; it < 256; it += G) {
            const int ib = it >> 2, dn = it & 3, dir = dn >> 1, n = dn & 1, i0 = ib * 64, ibase = i0 + (dir == 0 ? 1 : 0);
            LAS float* zz = (LAS float*)lds;
            LAS float* h1 = zz + 64 * 33;
            LAS float* h2 = h1 + 64 * 64;
            const float* b1 = args.in[6]; const float* b2 = args.in[8]; const float* w3 = args.in[9]; const float* fr = args.in[10];
            for (int q = tid; q < 64 * 33; q += 512) { const int p = q / 33, j = q % 33, i = ibase + p;
                const float t = (float)i / (float)(SEQ - 1), w = 6.283185307179586f * (float)i / (float)SEQ; float v;
                if (j == 0) v = t; else { const float band = 1e-4f + (float)((j - 1) & 15) * ((15.f - 1e-4f) / 15.f); v = (j <= 16) ? __cosf(band * w) : -__sinf(band * w); }
                zz[q] = v; }
            __syncthreads();
            {
                const int j = tid & 63; float a[8];
#pragma unroll
                for (int m = 0; m < 8; ++m) a[m] = b1[j];
#pragma unroll 3
                for (int k = 0; k < 33; ++k) { const float w = w1s[k * 64 + j];
#pragma unroll
                    for (int m = 0; m < 8; ++m) a[m] += zz[(wave + 8 * m) * 33 + k] * w; }
                const float f = fr[j];
#pragma unroll
                for (int m = 0; m < 8; ++m) h1[(wave + 8 * m) * 64 + j] = __sinf(f * a[m]);
            }
            __syncthreads();
            {
                const int j = tid & 63; float a[8];
#pragma unroll
                for (int m = 0; m < 8; ++m) a[m] = b2[j];
#pragma unroll 2
                for (int k = 0; k < 64; k += 4) { const float w0 = w2s[(k + 0) * 64 + j], w1_ = w2s[(k + 1) * 64 + j], w2_ = w2s[(k + 2) * 64 + j], w3_ = w2s[(k + 3) * 64 + j];
#pragma unroll
                    for (int m = 0; m < 8; ++m) { const f32x4 hh = *(const LAS f32x4*)&h1[(wave + 8 * m) * 64 + k]; a[m] += (hh.x * w0 + hh.y * w1_) + (hh.z * w2_ + hh.w * w3_); } }
                const float f = fr[j];
#pragma unroll
                for (int m = 0; m < 8; ++m) h2[(wave + 8 * m) * 64 + j] = __sinf(f * a[m]);
            }
            __syncthreads();
            const int c = tid;
            LAS unsigned short* ftile = (LAS unsigned short*)(lds + 45056);
            LAS float* part = (LAS float*)lds;
            {
                const int cg = tid & 127, pg = tid >> 7, c4 = cg * 4, col4 = dn * 512 + c4;
                const bool lag0 = (dir == 1 && ib == 0 && pg == 0);
                f32x2 a01[16], a23[16];
#pragma unroll
                for (int p = 0; p < 16; ++p) { a01[p] = (f32x2){0.f, 0.f}; a23[p] = (f32x2){0.f, 0.f}; }
                f32x4 f0v = (f32x4){0.f, 0.f, 0.f, 0.f};
                const GAS f32x4* w3v = (const GAS f32x4*)(w3 + col4);
                f32x4 nw[4];
#pragma unroll
                for (int kk = 0; kk < 4; ++kk) nw[kk] = w3v[(size_t)kk * 512];
#pragma clang loop unroll(disable)
                for (int k = 0; k < 64; k += 4) {
                    f32x4 w[4];
#pragma unroll
                    for (int kk = 0; kk < 4; ++kk) w[kk] = nw[kk];
                    { const int kn = k + 4 < 64 ? k + 4 : k;
#pragma unroll
                      for (int kk = 0; kk < 4; ++kk) nw[kk] = w3v[(size_t)(kn + kk) * 512]; }
                    if (lag0) { const f32x4 hh = *(const LAS f32x4*)&h2[k];
#pragma unroll
                        for (int kk = 0; kk < 4; ++kk) { const f32x4 wf = *(const GAS f32x4*)(w3 + (size_t)(k + kk) * 2048 + col4 - 1024); f0v += hh[kk] * wf; } }
                    f32x4 hh[16];
#pragma unroll
                    for (int p = 0; p < 16; ++p) hh[p] = *(const LAS f32x4*)&h2[(pg * 16 + p) * 64 + k];
                    asm volatile("" ::: "memory");
#pragma unroll
                    for (int p = 0; p < 16; ++p) {
#pragma unroll
                        for (int kk = 0; kk < 4; ++kk) { const f32x2 hb2 = (f32x2){hh[p][kk], hh[p][kk]};
                            a01[p] += hb2 * (f32x2){w[kk].x, w[kk].y}; a23[p] += hb2 * (f32x2){w[kk].z, w[kk].w}; } }
                }
                const float mind = logf(1e-2f) / 1.5f, maxd = logf(1e-2f) / 0.3f;
                float as4[4] = {0.f, 0.f, 0.f, 0.f};
#pragma unroll
                for (int p = 0; p < 16; ++p) { const int pp = pg * 16 + p, i = ibase + pp; const float t = (float)i / (float)(SEQ - 1);
                    const bool valid0 = dir == 0 ? (i <= SEQ - 1) : (i >= 1);
                    const float hvj[4] = {a01[p].x, a01[p].y, a23[p].x, a23[p].y};
#pragma unroll
                    for (int j = 0; j < 4; ++j) { const float delta = fabsf(mind + (float)(c4 + j) * ((maxd - mind) / 511.f));
                        float h = hvj[j] * __expf(-t * delta); bool valid = valid0;
                        if (dir == 1 && i == 0) { h = f0v[j]; valid = true; }
                        const unsigned hb = valid ? f2bf(h) : 0u; const float hr = __builtin_bit_cast(float, hb << 16);
                        as4[j] += fabsf(hr); ftile[(c4 + j) * 72 + (dir == 0 ? 63 - pp : pp)] = (unsigned short)hb; } }
#pragma unroll
                for (int j = 0; j < 4; ++j) part[pg * 512 + c4 + j] = as4[j];
            }
            __syncthreads();
            const float asum = (part[c] + part[512 + c]) + (part[1024 + c] + part[1536 + c]);
            {
                const int gbase = dir == 0 ? GOFF - i0 - 64 : GOFF + i0;
#pragma unroll
                for (int j = 0; j < 8; ++j) { const int ch = wave * 64 + 8 * j + (lane >> 3), chunk = lane & 7;
                    const u32x4 v = *(const LAS u32x4*)(ftile + ch * 72 + chunk * 8);
                    *(GAS u32x4*)(GF + (size_t)(n * 512 + ch) * GLEN + gbase + chunk * 8) = v; }
            }
            if (ib == 63) { bf16_t* gf = GF + (size_t)(n * 512 + c) * GLEN + (dir == 0 ? 0 : GOFF + 4096);
                for (int q = 0; q < 32; ++q) *(GAS u32x4*)(gf + q * 8) = (u32x4){0u, 0u, 0u, 0u}; }
            ((float*)(ws + WS_CTL) + CW_NPART)[(size_t)((n * 2 + dir) * 64 + ib) * 512 + c] = asum;
            __syncthreads();
        }
        }
        __syncthreads();
        }
    }
    xcd_barrier(bar);

    int rep_p1 = REP_P1; asm volatile("" : "+s"(rep_p1));
    for (int rep_ = 0; rep_ < rep_p1; ++rep_) {
    {
        pg8::GeoTokPerm S; S.A = WIN; S.X = XN; S.KB = DM * 2; S.ord.init(HCOLS / 256, NTOK / 256, G, bx);
        pg8::EpiBf16 E{HP, NTOK, 0, 1.f};
        pg8::gemm_phase<false>(lds, (LAS unsigned*)(lds + TBL_OFF), S, E, wave_s);
    }
    {
        pg8::GeoPlain S; S.A = XN; S.Bt = WIN + (size_t)HCOLS * DM; S.KB = DM * 2; S.ord.init(NTOK / 256, ACOLS / 256, G, bx);
        pg8::EpiBf16 E{QKV, ACOLS, 512, QSCALE};
        pg8::gemm_phase<false>(lds, (LAS unsigned*)(lds + TBL_OFF), S, E, wave_s);
    }
    }
    xcd_barrier(bar);

    {
        PHASE_IDS();
        LAS unsigned* red = (LAS unsigned*)lds;
        float* QN2 = (float*)(ws + WS_AFF); float* KN2 = QN2 + 4096;
        for (int it = bx; it < NB * 64; it += G) {
            const int b = it >> 6, tile = it & 63, row = tid >> 3, g = tid & 7;
            const bf16_t* rp = QKV + ((size_t)b * SEQ + tile * 64 + row) * ACOLS + g * 64;
            float sq = 0.f, sk = 0.f;
#pragma unroll
            for (int j = 0; j < 8; ++j) { const u32x4 v = *(const GAS u32x4*)(rp + j * 8), w = *(const GAS u32x4*)(rp + 512 + j * 8);
#pragma unroll
                for (int k = 0; k < 4; ++k) { sq += bflo(v[k]) * bflo(v[k]) + bfhi(v[k]) * bfhi(v[k]); sk += bflo(w[k]) * bflo(w[k]) + bfhi(w[k]) * bfhi(w[k]); } }
            if (tid < 16) red[tid] = 0u;
            __syncthreads();
            atomicMax((unsigned*)&red[g], __float_as_uint(sq)); atomicMax((unsigned*)&red[8 + g], __float_as_uint(sk));
            __syncthreads();
            if (tid < 8) QN2[(size_t)(b * 8 + tid) * 64 + tile] = __uint_as_float(red[tid]); else if (tid < 16) KN2[(size_t)(b * 8 + tid - 8) * 64 + tile] = __uint_as_float(red[tid]);
            __syncthreads();
        }
        for (int k = gw; k < 2 * 512; k += NGW) {
            const float* np = (const float*)(ws + WS_CTL) + CW_NPART + (size_t)(k >> 9) * 128 * 512 + (k & 511);
            const float v = np[(size_t)lane * 512] + np[(size_t)(lane + 64) * 512];
            const float tot = wave_sum(v);
            if (lane == 0) NSUM[k] = tot;
        }
    }
    xcd_barrier(bar);

    {
        PHASE_IDS();
        {
            const float* conv_w = args.in[3]; const float* conv_b = args.in[4]; const float* skip = args.in[11];
            if (tid < 64) { const int bufi = tid >> 5, row = tid & 31, rr = row < 16 ? row : SEQ + row; *(LAS u32x4*)(lds + bufi * HY_ZBYTES + rr * 16) = (u32x4){0u, 0u, 0u, 0u}; }
            const int r32 = lane & 31, hi = lane >> 5;
            const int tr_lane = (2 * ((lane >> 4) & 1) + ((lane & 3) >> 1) + 8 * hi + ((lane & 15) >> 2)) * 16 + 8 * (lane & 1);
            int rep_hy = REP_HY; asm volatile("" : "+s"(rep_hy));
            const bool split13 = (G == 256);
            const int hy_n = split13 ? (bx < 128 ? 1 : 3) : (HW - bx + G - 1) / G, hy_0 = split13 ? (bx < 128 ? bx : 128 + (bx - 128) * 3) : bx, hy_s = split13 ? 1 : G;
            for (int rep_ = 0; rep_ < rep_hy; ++rep_)
            for (int ui_ = 0; ui_ < hy_n; ++ui_) {
                const int c = hy_0 + ui_ * hy_s;
                __syncthreads();
                {
                    const int col = 1024 + c; const float w0 = conv_w[col], w1 = conv_w[HCOLS + col], w2 = conv_w[2 * HCOLS + col], cb = conv_b[col];
                    const bf16_t* hp = HP + (size_t)col * SEQ * 8;
#pragma unroll 2
                    for (int i = 0; i < 8; ++i) { const int t = tid + 512 * i;
                        const u32x4 z4 = (u32x4){0u, 0u, 0u, 0u};
                        const u32x4 pm = t > 0 ? *(const GAS u32x4*)(hp + (size_t)(t - 1) * 8) : z4, p0 = *(const GAS u32x4*)(hp + (size_t)t * 8), pp = t < SEQ - 1 ? *(const GAS u32x4*)(hp + (size_t)(t + 1) * 8) : z4;
                        u32x4 o;
#pragma unroll
                        for (int k = 0; k < 4; ++k) { const float lo = cb + w0 * bflo(pm[k]) + w1 * bflo(p0[k]) + w2 * bflo(pp[k]), hh = cb + w0 * bfhi(pm[k]) + w1 * bfhi(p0[k]) + w2 * bfhi(pp[k]); o[k] = pk2(lo, hh); }
                        *(LAS u32x4*)(lds + HY_ZA + (t + 16) * 16) = o; }
                }
                for (int n = 0; n < 2; ++n) {
                    {
                        const GAS u32x4* gsrc = (const GAS u32x4*)(GF + (size_t)(n * 512 + c) * GLEN);
                        static_assert(GLEN * 2 / 16 == 2 * 512 + 64, "filter row = 1088 16-byte pieces");
                        const u32x4 f0 = gsrc[tid], f1 = gsrc[tid + 512]; u32x4 f2 = (u32x4){0u, 0u, 0u, 0u}; if (tid < 64) f2 = gsrc[tid + 1024];
                        *(LAS u32x4*)(lds + HY_FB + tid * 16) = f0; *(LAS u32x4*)(lds + HY_FB + (tid + 512) * 16) = f1; if (tid < 64) *(LAS u32x4*)(lds + HY_FB + (tid + 1024) * 16) = f2;
                    }
                    __syncthreads();
                    f32x16 acc[2][2];
#pragma unroll
                    for (int a = 0; a < 2; ++a)
#pragma unroll
                        for (int b = 0; b < 2; ++b)
#pragma unroll
                            for (int k = 0; k < 16; ++k) acc[a][b][k] = 0.f;
                    const LAS unsigned char* za = lds + (n == 0 ? HY_ZA : HY_ZB) + tr_lane;
                    const LAS unsigned char* fbp = lds + HY_FB + 2 * GOFF - 32 + 16 * (hi - r32) - 512 * (2 * wave);
#define HY_STEP(OFFA, OFFB) do { \
                        const v4i16_t x0 = __builtin_amdgcn_ds_read_tr16_b64_v4i16((LAS v4i16_t*)(za + (OFFA))); \
                        const v4i16_t x1 = __builtin_amdgcn_ds_read_tr16_b64_v4i16((LAS v4i16_t*)(za + (OFFA) + 64)); \
                        const v4i16_t x2 = __builtin_amdgcn_ds_read_tr16_b64_v4i16((LAS v4i16_t*)(za + (OFFA) + 128)); \
                        const bf16x8 b0 = *(const LAS bf16x8*)(fbp + (OFFB)), b1 = *(const LAS bf16x8*)(fbp + (OFFB) - 512); \
                        const bf16x8 a0 = (bf16x8){x0[0], x0[1], x0[2], x0[3], x1[0], x1[1], x1[2], x1[3]}, a1 = (bf16x8){x1[0], x1[1], x1[2], x1[3], x2[0], x2[1], x2[2], x2[3]}; \
                        acc[0][0] = __builtin_amdgcn_mfma_f32_32x32x16_bf16(a0, b0, acc[0][0], 0, 0, 0); \
                        acc[0][1] = __builtin_amdgcn_mfma_f32_32x32x16_bf16(a1, b0, acc[0][1], 0, 0, 0); \
                        acc[1][0] = __builtin_amdgcn_mfma_f32_32x32x16_bf16(a0, b1, acc[1][0], 0, 0, 0); \
                        acc[1][1] = __builtin_amdgcn_mfma_f32_32x32x16_bf16(a1, b1, acc[1][1], 0, 0, 0); } while (0)
#pragma clang loop unroll(disable)
                    for (int c4 = 0; c4 < 64; ++c4) {
                        HY_STEP(0, 0); HY_STEP(256, 32); HY_STEP(512, 64); HY_STEP(768, 96);
                        za += 1024; fbp += 128;
                    }
                    HY_STEP(0, 0);
#undef HY_STEP
                    const int gcol = n * 512 + c; const float w0 = conv_w[gcol], w1 = conv_w[HCOLS + gcol], w2 = conv_w[2 * HCOLS + gcol], cb = conv_b[gcol];
                    const float inv = 1.f / NSUM[n * 512 + c], sk = skip[n * 512 + c];
                    const bf16_t* hp = HP + (size_t)gcol * SEQ * 8 + 4 * hi;
                    const LAS unsigned char* zin = lds + (n == 0 ? HY_ZA : HY_ZB) + 8 * hi;
#pragma unroll
                    for (int sp = 0; sp < 2; ++sp) {
                        const int tb = 256 * (2 * wave + sp) + 8 * r32;
                        u32x2 P[10];
#pragma unroll
                        for (int k = 0; k < 10; ++k) { const int tq = tb - 1 + k; P[k] = (tq >= 0 && tq < SEQ) ? *(const GAS u32x2*)(hp + (size_t)tq * 8) : (u32x2){0u, 0u}; }
#pragma unroll
                        for (int tt = 0; tt < 8; ++tt) {
                            const int t = tb + tt; const u32x2 zi = *(const LAS u32x2*)(zin + (t + 16) * 16);
                            const float zv[4] = {bflo(zi.x), bfhi(zi.x), bflo(zi.y), bfhi(zi.y)};
                            const float pm[4] = {bflo(P[tt].x), bfhi(P[tt].x), bflo(P[tt].y), bfhi(P[tt].y)};
                            const float pc[4] = {bflo(P[tt + 1].x), bfhi(P[tt + 1].x), bflo(P[tt + 1].y), bfhi(P[tt + 1].y)};
                            const float pp[4] = {bflo(P[tt + 2].x), bfhi(P[tt + 2].x), bflo(P[tt + 2].y), bfhi(P[tt + 2].y)};
                            float zo[4];
#pragma unroll
                            for (int bb = 0; bb < 4; ++bb) { const float gate = cb + w0 * pm[bb] + w1 * pc[bb] + w2 * pp[bb]; zo[bb] = gate * (acc[sp][tt >> 2][(tt & 3) * 4 + bb] * inv + sk * zv[bb]); }
                            u32x2 w; w.x = pk2(zo[0], zo[1]); w.y = pk2(zo[2], zo[3]);
                            if (n == 0) *(LAS u32x2*)(lds + HY_ZB + (t + 16) * 16 + 8 * hi) = w;
                            else *(GAS u32x2*)(HZ + ((size_t)c * SEQ + t) * 8 + 4 * hi) = w;
                        }
                    }
                    __syncthreads();
                }
            }
        }
        __syncthreads();
        {
            const int wid = wave, r32 = lane & 31, hi = lane >> 5;
            const float* QN2 = (const float*)(ws + WS_AFF); const float* KN2 = QN2 + 4096;
            float lam_s;
            { const int li = lane_id_v(); const float s1 = wave_sum(args.in[13][li] * args.in[14][li]), s2 = wave_sum(args.in[15][li] * args.in[16][li]);
              lam_s = __int_as_float(__builtin_amdgcn_readfirstlane(__float_as_int(expf(s1) - expf(s2) + 0.2f))); }
            for (int rep_ = 0; rep_ < REP_AT; ++rep_)
            for (int unit = bx; unit < NB * 4 * 16; unit += G) {
                const int v_ = unit & 127, qb = v_ & 15, b = v_ >> 4, h = unit < 256 ? 2 + (unit >> 7) : ((unit - 256) >> 7 ? 0 : 1), q0 = qb * 256;
                const bf16_t* pb = QKV + (size_t)b * SEQ * ACOLS;
                const float slope2 = exp2f(-2.f * (float)(h + 1)) * LOG2E;
                f32x16 o[4];
#pragma clang loop unroll(disable)
                for (int mp = 0; mp < 2; ++mp) {
                    const int l_u = lane_id_v(), r32u = l_u & 31, hiu = l_u >> 5;
                    const int qpos = q0 + wid * 32 + r32u;
                    int nL, NT; bool spec;
                    { const float* qn = QN2 + ((size_t)(b * 8 + h * 2 + mp)) * 64; const float* kn = KN2 + ((size_t)(b * 8 + h * 2 + mp)) * 64;
                      float km = kn[lane_id_v()];
                      km = wave_max(km);
                      const float qm = fmaxf(fmaxf(qn[4 * qb], qn[4 * qb + 1]), fmaxf(qn[4 * qb + 2], qn[4 * qb + 3]));
                      const float qk2 = 2.f * sqrtf(qm * km);
                      spec = __builtin_amdgcn_readfirstlane((int)(qk2 < 120.f)) != 0;
                      const float rthr = (150.f + qk2) / slope2;
                      const int side = __builtin_amdgcn_readfirstlane((int)fminf(rthr * (1.f / 64.f), 64.f)) + 1;
                      nL = min(4 * qb, side); int nR = min(60 - 4 * qb, side); NT = 4 + nL + nR;
                      if (NT & 1) { if (nL < 4 * qb) ++nL; else ++nR; ++NT; } }
                    att::pass(o, pb + (size_t)qpos * ACOLS + h * 128 + mp * 64 + hiu * 8, pb + 512 + h * 128 + mp * 64, pb + 1024 + h * 128, qpos, qb, slope2, (char*)lds_raw, tid, nL, NT, spec);
                    if (mp == 0) {
                        int z2 = 0; asm volatile("" : "+s"(z2));
                        GAS f32x4* pk = (GAS f32x4*)((float*)(ws + WS_PARK) + (size_t)(bx * 8 + wid) * 4096 + lane_id_v() * 64 + z2);
#pragma unroll
                        for (int d = 0; d < 4; ++d)
#pragma unroll
                            for (int k = 0; k < 4; ++k) pk[d * 4 + k] = (f32x4){o[d][4 * k], o[d][4 * k + 1], o[d][4 * k + 2], o[d][4 * k + 3]};
                    }
                    __builtin_amdgcn_sched_barrier(0);
                }
                asm volatile("s_waitcnt vmcnt(0)" ::: "memory");
                int zz = 0; asm volatile("" : "+s"(zz));
                const float lam = lam_s;
                const float* subg = args.in[17] + zz;
                int lane_c = lane; asm volatile("" : "+v"(lane_c)); const int r32c = lane_c & 31, hic = lane_c >> 5;
                {
                    const GAS f32x4* pk = (const GAS f32x4*)((float*)(ws + WS_PARK) + (size_t)(bx * 8 + wid) * 4096 + lane_c * 64 + zz);
#pragma unroll
                    for (int d = 0; d < 4; ++d)
#pragma unroll
                        for (int k = 0; k < 4; ++k) { const f32x4 pv = pk[d * 4 + k];
#pragma unroll
                            for (int q = 0; q < 4; ++q) o[d][4 * k + q] = pv[q] - lam * o[d][4 * k + q]; }
                }
#pragma unroll
                for (int r = 0; r < 16; ++r) {
                    float ss = 0.f;
#pragma unroll
                    for (int d = 0; d < 4; ++d) ss += o[d][r] * o[d][r];
                    ss += sx<1>(ss); ss += sx<2>(ss); ss += sx<4>(ss); ss += sx<8>(ss); ss += sx<16>(ss);
                    const float rs = rsqrtf(ss * (1.f / 128.f) + EPS) * 0.8f;
                    bf16_t* op = MIX + ((size_t)b * SEQ + q0 + wid * 32 + att::crow(r, hic)) * DM + 512 + h * 128 + r32c;
#pragma unroll
                    for (int d = 0; d < 4; ++d) op[d * 32] = (bf16_t)f2bf(o[d][r] * rs * subg[d * 32 + r32c]);
                }
            }
        }
    }
    if (G == 256) {
        __syncthreads();
        int lane_d = lane_id_v(); asm volatile("" : "+v"(lane_d));
        LAS float* scr = (LAS float*)(lds + wave_s * 16384);
        for (;;) {
            int it0 = 0; if (lane_d == 0) it0 = (int)atomicAdd((unsigned*)(ctl + CW_WQ), (unsigned)P0_CHUNK);
            it0 = __builtin_amdgcn_readfirstlane(it0) + P0_NITEMS - P0_NDEF;
            if (it0 >= P0_NITEMS) break;
            for (int it = it0; it < min(it0 + P0_CHUNK, P0_NITEMS); ++it) p0_weight_item(args, it, WIN, WOUT, WGU, WD, scr, lane_d);
        }
    }
    xcd_barrier(bar);

    {
        PHASE_IDS();
        const float* hg = args.in[12];
        LAS unsigned short* tile = (LAS unsigned short*)lds;
        LAS float* rs = (LAS float*)(lds + 32768);
        int rep_3a = REP_P3A; asm volatile("" : "+s"(rep_3a));
        for (int rep_ = 0; rep_ < rep_3a; ++rep_) {
        u32x4 pre[4];
        if (bx < 8 * 128) { const int g = bx & 7, t0 = (bx >> 3) * 32;
#pragma unroll
            for (int k = 0; k < 4; ++k) { const int q = tid + 512 * k, ch = q >> 5, seg = q & 31; pre[k] = *(const GAS u32x4*)(HZ + ((size_t)(g * 64 + ch) * SEQ + t0 + seg) * 8); } }
        for (int it = bx; it < 8 * 128; it += G) {
            const int g = it & 7, tb = it >> 3, t0 = tb * 32;
            __syncthreads();
#pragma unroll
            for (int k = 0; k < 4; ++k) { const int q = tid + 512 * k, ch = q >> 5, seg = q & 31;
                *(LAS u32x4*)(tile + ch * 256 + seg * 8) = pre[k]; }
            if (it + G < 8 * 128) { const int gn = (it + G) & 7, tn = ((it + G) >> 3) * 32;
#pragma unroll
                for (int k = 0; k < 4; ++k) { const int q = tid + 512 * k, ch = q >> 5, seg = q & 31; pre[k] = *(const GAS u32x4*)(HZ + ((size_t)(gn * 64 + ch) * SEQ + tn + seg) * 8); } }
            __syncthreads();
            if (tid < 256) { float s = 0.f; for (int ch = 0; ch < 64; ++ch) { const float v = bf2f(tile[ch * 256 + tid]); s += v * v; } rs[tid] = rsqrtf(s * (1.f / 64.f) + EPS); }
            __syncthreads();
            for (int q = tid; q < 256 * 8; q += 512) { const int tk = q >> 3, c8 = (q & 7) * 8;
                const float r = rs[tk]; const int t = t0 + (tk >> 3), b = tk & 7;
                float v[8];
#pragma unroll
                for (int j = 0; j < 8; ++j) v[j] = bf2f(tile[(c8 + j) * 256 + tk]) * r * hg[g * 64 + c8 + j];
                u32x4 w; w.x = pk2(v[0], v[1]); w.y = pk2(v[2], v[3]); w.z = pk2(v[4], v[5]); w.w = pk2(v[6], v[7]);
                *(GAS u32x4*)(MIX + ((size_t)b * SEQ + t) * DM + g * 64 + c8) = w; }
        }
        }
        __syncthreads();
    }
    xcd_barrier(bar);

    {
        pg8::GeoPlain S; S.A = MIX; S.Bt = WOUT; S.KB = DM * 2; S.ord.init(NTOK / 256, DM / 256, G, bx);
        pg8::EpiResF32 E{x, out, DM};
        for (int rep_ = 0; rep_ < REP_P3B; ++rep_) pg8::gemm_phase<false>(lds, (LAS unsigned*)(lds + TBL_OFF), S, E, wave_s);
    }
    xcd_barrier(bar);

    {
        PHASE_IDS();
        const float* g = args.in[19]; const float* wr = args.in[20];
        LAS float* gwl = (LAS float*)lds;
        for (int q = tid; q < DM * 4; q += 512) { const f32x4 w4 = ((const GAS f32x4*)wr)[q]; const float gd = g[q >> 2]; *(LAS f32x4*)(gwl + (q >> 2) * 20 + (q & 3) * 4) = w4 * gd; }
        __syncthreads();
        const int i16 = lane & 15, q4 = lane >> 4;
        int rep_4a = REP_P4A; asm volatile("" : "+s"(rep_4a));
        for (int rep_ = 0; rep_ < rep_4a; ++rep_)
        for (int grp = gw; grp < NTOK / 16; grp += NGW) {
            const int tok0 = grp * 16;
            const LAS float* bp = gwl + (4 * q4) * 20 + i16;
            f32x4 acc = (f32x4){0.f, 0.f, 0.f, 0.f}; float ss = 0.f;
            u32x2 st[8][8];
            {
                LAS unsigned char* xt = lds + 81920 + wave * 8448;
                const int lr = lane >> 5, lc = lane & 31, wofs = lr * 528 + lc * 16, rofs = i16 * 528 + q4 * 16;
                const float* xg = out + (size_t)(tok0 + lr) * DM + 4 * lc;
                f32x4 nv[8];
#pragma unroll
                for (int j = 0; j < 8; ++j) nv[j] = *(const GAS f32x4*)(xg + (size_t)(2 * j) * DM);
#pragma unroll
                for (int blk = 0; blk < 8; ++blk) {
#pragma unroll
                    for (int j = 0; j < 8; ++j) { *(LAS f32x4*)(xt + wofs + (2 * j) * 528) = nv[j]; st[blk][j] = (u32x2){att::cvtpk(nv[j].x, nv[j].y), att::cvtpk(nv[j].z, nv[j].w)}; }
                    if (blk < 7) {
#pragma unroll
                      for (int j = 0; j < 8; ++j) nv[j] = *(const GAS f32x4*)(xg + (size_t)(2 * j) * DM + 128 * (blk + 1)); }
#pragma unroll
                    for (int s = 0; s < 8; ++s) { const f32x4 a = *(const LAS f32x4*)(xt + rofs + 64 * s);
                        ss += (a.x * a.x + a.y * a.y) + (a.z * a.z + a.w * a.w);
                        const LAS float* b = bp + (8 * blk + s) * 320;
                        acc = __builtin_amdgcn_mfma_f32_16x16x4f32(a.x, b[0], acc, 0, 0, 0);
                        acc = __builtin_amdgcn_mfma_f32_16x16x4f32(a.y, b[20], acc, 0, 0, 0);
                        acc = __builtin_amdgcn_mfma_f32_16x16x4f32(a.z, b[40], acc, 0, 0, 0);
                        acc = __builtin_amdgcn_mfma_f32_16x16x4f32(a.w, b[60], acc, 0, 0, 0); }
                }
            }
            ss += sx<16>(ss); ss = sum32x(ss);
            const float r = rsqrtf(ss * (1.f / DM) + EPS);
            f32x4 af;
#pragma unroll
            for (int reg = 0; reg < 4; ++reg) {
                const float lg = acc[reg] * lane_read(r, 4 * q4 + reg);
                float mx = lg; mx = fmaxf(mx, sx<1>(mx)); mx = fmaxf(mx, sx<2>(mx)); mx = fmaxf(mx, sx<4>(mx)); mx = fmaxf(mx, sx<8>(mx));
                const float ex = expf(lg - mx); float den = ex; den += sx<1>(den); den += sx<2>(den); den += sx<4>(den); den += sx<8>(den);
                af[reg] = ex / den;
            }
            const int b = tok0 >> 12, t0 = tok0 & 4095;
            *(GAS f32x4*)(AFF + ((size_t)i16 * NB + b) * SEQ + t0 + 4 * q4) = af;
            *(GAS u32x2*)(INV + (size_t)tok0 * 16 + lane * 4) = (u32x2){0xffffffffu, 0xffffffffu};
            {
                const int lr = lane >> 5, lc = lane & 31;
                GAS unsigned* o4 = (GAS unsigned*)(H2 + (size_t)(tok0 + lr) * DM) + lc;
                float rj[8];
#pragma unroll
                for (int j = 0; j < 8; ++j) rj[j] = lane_read(r, 2 * j + lr);
#pragma unroll
                for (int blk = 0; blk < 8; ++blk) {
                    const f32x4 gg = ((const GAS f32x4*)g)[32 * blk + lc];
#pragma unroll
                    for (int j = 0; j < 8; ++j) { const u32x2 w = st[blk][j]; const float ri = rj[j];
                        int t = __builtin_amdgcn_cvt_pk_fp8_f32(bflo(w.x) * ri * gg.x, bfhi(w.x) * ri * gg.y, 0, false); t = __builtin_amdgcn_cvt_pk_fp8_f32(bflo(w.y) * ri * gg.z, bfhi(w.y) * ri * gg.w, t, true);
                        o4[(size_t)(2 * j) * (DM / 4) + 32 * blk] = (unsigned)t; }
                }
            }
        }
        __syncthreads();
    }
    xcd_barrier(bar);

    {
        PHASE_IDS();
        LAS unsigned* hist = (LAS unsigned*)lds; LAS unsigned* scan = hist + 256; LAS unsigned* selw = scan + 512;
        int rep_4b = REP_P4B; asm volatile("" : "+s"(rep_4b));
        for (int rep_ = 0; rep_ < rep_4b; ++rep_)
        for (int eb = bx; eb < NE * NB; eb += G) {
            const int b = eb & 7, e = eb >> 3;
            const float* a = AFF + (size_t)eb * SEQ;
            unsigned v[8];
#pragma unroll
            for (int j = 0; j < 8; ++j) v[j] = __float_as_uint(a[tid * 8 + j]);
            unsigned prefix = 0, mask = 0, need = CAP;
            __syncthreads();
            for (int pass = 0; pass < 4; ++pass) {
                const int shift = 24 - 8 * pass;
                if (tid < 256) hist[tid] = 0;
                __syncthreads();
#pragma unroll
                for (int j = 0; j < 8; ++j) if ((v[j] & mask) == prefix) atomicAdd((unsigned*)&hist[(v[j] >> shift) & 255u], 1u);
                __syncthreads();
                if (tid < 256) scan[tid] = hist[tid];
                __syncthreads();
                for (int off = 1; off < 256; off <<= 1) { const unsigned xx = (tid < 256 && tid + off < 256) ? scan[tid + off] : 0u; __syncthreads(); if (tid < 256) scan[tid] += xx; __syncthreads(); }
                if (tid < 256) { const unsigned above = tid < 255 ? scan[tid + 1] : 0u; if (above < need && need <= scan[tid]) { selw[0] = (unsigned)tid; selw[1] = need - above; } }
                __syncthreads();
                prefix |= selw[0] << shift; mask |= 255u << shift; need = selw[1];
                __syncthreads();
            }
            unsigned cg = 0, ce = 0;
#pragma unroll
            for (int j = 0; j < 8; ++j) { cg += v[j] > prefix; ce += v[j] == prefix; }
            scan[tid] = (cg << 16) | ce;
            __syncthreads();
            for (int off = 1; off < 512; off <<= 1) { const unsigned xx = tid >= off ? scan[tid - off] : 0u; __syncthreads(); scan[tid] += xx; __syncthreads(); }
            const unsigned incl = scan[tid]; unsigned pg = (incl >> 16) - cg, pe = (incl & 0xffffu) - ce;
#pragma unroll
            for (int j = 0; j < 8; ++j) {
                const bool isg = v[j] > prefix, ise = v[j] == prefix;
                if (isg || (ise && pe < need)) {
                    const unsigned pos = pg + (pe < need ? pe : need); const int token = b * SEQ + tid * 8 + j;
                    TOK[(size_t)eb * CAP + pos] = token; GSEL[(size_t)eb * CAP + pos] = __uint_as_float(v[j]); INV[(size_t)token * 16 + e] = (unsigned short)pos;
                }
                pg += isg; pe += ise;
            }
            __syncthreads();
        }
    }
    xcd_barrier(bar);

    {
        pg8::GeoExpert<true> S; S.A = H2; S.Bt = WGU; S.KB = DM; S.bexp = (size_t)2 * FF * DM; S.tok = TOK; S.ord.init(NSLOT / 256, 2 * FF / 256, G, bx);
        pg8::EpiSwiGLU E{ACT, FF};
        for (int rep_ = 0; rep_ < REP_P5; ++rep_) pg8::gemm_phase<true>(lds, (LAS unsigned*)(lds + TBL_OFF), S, E, wave_s);
    }
    xcd_barrier(bar);

    {
        pg8::GeoExpert<false> S; S.A = ACT; S.Bt = WD; S.KB = FF; S.bexp = (size_t)DM * FF; S.tok = nullptr; S.ord.init(NSLOT / 256, DM / 256, G, bx);
        pg8::EpiFp8 E{Y, DM};
        for (int rep_ = 0; rep_ < REP_P6; ++rep_) pg8::gemm_phase<true>(lds, (LAS unsigned*)(lds + TBL_OFF), S, E, wave_s);
    }
    xcd_barrier(bar);

    {
        PHASE_IDS();
        const float* g = args.in[24];
        for (int m = gw; m < NTOK; m += NGW) {
            const GAS f32x4* xr = (const GAS f32x4*)(out + (size_t)m * DM) + lane;
            f32x4 v[4];
#pragma unroll
            for (int j = 0; j < 4; ++j) v[j] = xr[64 * j];
            const int b = m >> 12;
            const unsigned short myinv = INV[(size_t)m * 16 + (lane & 15)];
            for (int e = 0; e < 16; ++e) {
                const unsigned s = (unsigned)lane_read_i((int)myinv, e);
                if (s != 0xffffu) {
                    const size_t slot = ((size_t)e * NB + b) * CAP + s;
                    const float gv = GSEL[slot];
                    const GAS unsigned* yr = (const GAS unsigned*)(Y + slot * DM) + lane;
#pragma unroll
                    for (int j = 0; j < 4; ++j) { const unsigned w = yr[64 * j]; const f32x2 lo = __builtin_amdgcn_cvt_pk_f32_fp8((int)w, false), hh = __builtin_amdgcn_cvt_pk_f32_fp8((int)w, true);
                        v[j].x += gv * lo.x; v[j].y += gv * lo.y; v[j].z += gv * hh.x; v[j].w += gv * hh.y; }
                }
            }
            float s = 0.f;
#pragma unroll
            for (int j = 0; j < 4; ++j) s += (v[j].x * v[j].x + v[j].y * v[j].y) + (v[j].z * v[j].z + v[j].w * v[j].w);
            const float r = rsqrtf(wave_sum(s) * (1.f / DM) + EPS);
            GAS f32x4* o = (GAS f32x4*)(out + (size_t)m * DM) + lane;
#pragma unroll
            for (int j = 0; j < 4; ++j) { const f32x4 gg = ((const GAS f32x4*)g)[lane + 64 * j]; o[64 * j] = (f32x4){v[j].x * r * gg.x, v[j].y * r * gg.y, v[j].z * r * gg.z, v[j].w * r * gg.w}; }
        }
    }
}

extern "C" void kernel_launch(void* const* d_in, const int* in_sizes, int n_in, void* d_out, int out_size, void* d_ws, size_t ws_size, hipStream_t stream) {
    static int grid = 0;
    if (grid == 0) {
        if (n_in != 25 || ws_size < WS_END) { fprintf(stderr, "kernel_launch: unexpected n_in %d / ws %zu\n", n_in, ws_size); grid = -1; return; }
        int dev = 0, cus = 0;
        if (hipGetDevice(&dev) != hipSuccess || hipDeviceGetAttribute(&cus, hipDeviceAttributeMultiprocessorCount, dev) != hipSuccess) { grid = -1; return; }
        if (hipFuncSetAttribute((const void*)mega_fwd, hipFuncAttributeMaxDynamicSharedMemorySize, LDS_BYTES) != hipSuccess) { fprintf(stderr, "kernel_launch: hipFuncSetAttribute failed\n"); grid = -1; return; }
        int per_cu = 0;
        if (hipOccupancyMaxActiveBlocksPerMultiprocessor(&per_cu, (const void*)mega_fwd, 512, LDS_BYTES) != hipSuccess || per_cu < 1) fprintf(stderr, "kernel_launch: occupancy query says %d\n", per_cu);
        (void)hipGetLastError();
        grid = cus;
    }
    if (grid < 0) return;
    (void)hipMemsetAsync((char*)d_ws + WS_CTL, 0, CTL_BYTES, stream);
    Args a; memset(&a, 0, sizeof a);
    for (int i = 0; i < 25; ++i) a.in[i] = (const float*)d_in[i];
    a.out = (float*)d_out; a.ws = (unsigned char*)d_ws;
    hipLaunchKernelGGL(mega_fwd, dim3(grid), dim3(512), LDS_BYTES, stream, a);
}
```
